# Optimizing an MI355X kernel written in HIP

```python
import math
import jax
import jax.numpy as jnp
from jax import lax
import numpy as np

D_MODEL = 2048
BATCH = 2
SEQ = 8192
DEPTH = 2

GRID_W = 64
CTX_LEN = 256
EPS = 1e-6
CONV_W = 4
CONV_LEFT = 2

D_LRU = D_MODEL
LRU_BLOCKS = 16
LRU_BS = D_LRU // LRU_BLOCKS
LRU_C = 8.0

D_RWKV = D_MODEL
RWKV_HEAD = 64
RWKV_HEADS = D_RWKV // RWKV_HEAD
W_LORA = 96
A_LORA = 96
G_LORA = 256
RWKV_GN_EPS = 64e-5

D_SSM = D_MODEL
SSM_HEADDIM = 64
SSM_HEADS = D_SSM // SSM_HEADDIM
SSM_STATE = 128
SSM_GROUPS = 4
SSM_CHUNK = 128
D_XBC = D_SSM + 2 * SSM_GROUPS * SSM_STATE

D_FF = 3 * D_MODEL
N_EXPERTS = 8
TOP_K = 2
D_FF_EXPERT = D_FF // 2
N_DENSE = (DEPTH + 1) // 2
N_MOE = DEPTH // 2

N_GATE = 3 * D_MODEL
N_LRU_IN = 2 * D_LRU
N_RWKV_IN = 3 * D_RWKV + 2 * W_LORA + 2 * A_LORA + G_LORA
N_SSM_IN = D_SSM + D_XBC + 2 * SSM_HEADS
OFF_LRU = N_GATE
OFF_RWKV = OFF_LRU + N_LRU_IN
OFF_SSM = OFF_RWKV + N_RWKV_IN
N_IN = OFF_SSM + N_SSM_IN

kernel_name = "hybrid_lru_rwkv7_mamba2_moe_dit"


def rms_norm(x, gain):
    xf = x.astype(jnp.float32)
    xf = xf * lax.rsqrt(jnp.mean(xf * xf, axis=-1, keepdims=True) + EPS)
    return (xf * gain).astype(x.dtype)


def centred_dwconv(u, w, b):
    l = u.shape[1]
    up = jnp.pad(u, ((0, 0), (CONV_LEFT, CONV_W - 1 - CONV_LEFT), (0, 0)))
    out = b
    for tap in range(CONV_W):
        out = out + up[:, tap:tap + l] * w[tap]
    return out


def bidir_token_shift(u, mu):
    prev = jnp.pad(u[:, :-1], ((0, 0), (1, 0), (0, 0)))
    nxt = jnp.pad(u[:, 1:], ((0, 0), (0, 1), (0, 0)))
    return u + mu * (0.5 * (prev + nxt) - u)


def grid_transpose(u, rows, cols):
    b, l, ch = u.shape
    return u.reshape(b, rows, cols, ch).transpose(0, 2, 1, 3).reshape(b, l, ch)


def linear_scan(a, bx, h0):
    def combine(lhs, rhs):
        return lhs[0] * rhs[0], rhs[0] * lhs[1] + rhs[1]
    a_cum, h = lax.associative_scan(combine, (a, bx), axis=1)
    return h + a_cum * h0[:, None]


def rglru_direction(xc, gate_w, gate_b, lam, h0, reverse):
    if reverse:
        xc = jnp.flip(xc, axis=1)
    b, l, _ = xc.shape
    xb = xc.reshape(b, l, LRU_BLOCKS, LRU_BS)
    gates = jnp.einsum('blnk,gnkj->gblnj', xb, gate_w).reshape(2, b, l, D_LRU) + gate_b[:, None, None]
    gates = jax.nn.sigmoid(gates.astype(jnp.float32))
    log_a = -LRU_C * gates[0] * jax.nn.softplus(-lam.astype(jnp.float32))
    a = jnp.exp(log_a)
    bx = jnp.sqrt(-jnp.expm1(2.0 * log_a)) * gates[1] * xc
    h = linear_scan(a, bx, h0)
    h_last = h[:, -1]
    if reverse:
        h = jnp.flip(h, axis=1)
    return h, h_last


def rglru_mixer(p_ctx, p_lat, conv_w, conv_b, gate_w, gate_b, lam):
    xc_ctx = centred_dwconv(p_ctx[..., :D_LRU], conv_w, conv_b)
    xc_lat = centred_dwconv(p_lat[..., :D_LRU], conv_w, conv_b)
    h0 = jnp.zeros((p_ctx.shape[0], D_LRU), jnp.float32)
    y_ctx, y_lat = 0.0, 0.0
    for d in range(2):
        h_c, h_c_last = rglru_direction(xc_ctx, gate_w[d], gate_b[d], lam[d], h0, d == 1)
        h_l, _ = rglru_direction(xc_lat, gate_w[d], gate_b[d], lam[d], h_c_last, d == 1)
        y_ctx = y_ctx + h_c
        y_lat = y_lat + h_l
    return (y_ctx * jax.nn.gelu(p_ctx[..., D_LRU:]), y_lat * jax.nn.gelu(p_lat[..., D_LRU:]))


def rwkv7_features(p, mu, w0, w_up, a0, a_up, g_up, k_k, k_a):
    b, l, _ = p.shape
    p = bidir_token_shift(p, mu)
    heads = lambda t: t.reshape(b, l, RWKV_HEADS, RWKV_HEAD)
    r = p[..., 0:D_RWKV]
    k = p[..., D_RWKV:2 * D_RWKV]
    v = p[..., 2 * D_RWKV:3 * D_RWKV]
    o = 3 * D_RWKV
    w_lo = p[..., o:o + 2 * W_LORA].reshape(b, l, 2, W_LORA)
    o = o + 2 * W_LORA
    a_lo = p[..., o:o + 2 * A_LORA].reshape(b, l, 2, A_LORA)
    o = o + 2 * A_LORA
    g = jax.nn.sigmoid(p[..., o:o + G_LORA]) @ g_up
    kk = heads(k * k_k).astype(jnp.float32)
    kk = kk * lax.rsqrt(jnp.sum(kk * kk, axis=-1, keepdims=True) + 1e-12)
    decays, keys, b_vecs = [], [], []
    for d in range(2):
        w = -jax.nn.softplus(-(w0[d] + jnp.tanh(w_lo[:, :, d]) @ w_up[d]).astype(jnp.float32)) - 0.5
        decays.append(heads(jnp.exp(-jnp.exp(w))))
        a = jax.nn.sigmoid(a0[d] + a_lo[:, :, d] @ a_up[d])
        keys.append(heads(k * (1.0 + (a - 1.0) * k_a)))
        b_vecs.append(kk * heads(a))
    return heads(r), heads(v), kk, g, decays, keys, b_vecs


def rwkv7_scan(r, decay, k, v, a_vec, b_vec, s0, reverse):
    xs = tuple(jnp.moveaxis(t, 1, 0) for t in (r, decay, k, v, a_vec, b_vec))

    def step(s, inp):
        r_t, w_t, k_t, v_t, a_t, b_t = inp
        sa = jnp.einsum('bhvk,bhk->bhv', s, a_t)
        s = s * w_t[:, :, None, :] + sa[..., None] * b_t[:, :, None, :] + v_t[..., None] * k_t[:, :, None, :]
        return s, jnp.einsum('bhvk,bhk->bhv', s, r_t)

    s_fin, y = lax.scan(step, s0, xs, reverse=reverse)
    return jnp.moveaxis(y, 0, 1), s_fin


def rwkv7_output(r, v, g, keys, y, r_k, ln_w, ln_b):
    b, l = r.shape[:2]
    yf = y.astype(jnp.float32)
    mean = jnp.mean(yf, axis=-1, keepdims=True)
    var = jnp.mean(jnp.square(yf - mean), axis=-1, keepdims=True)
    yn = ((yf - mean) * lax.rsqrt(var + RWKV_GN_EPS)).reshape(b, l, D_RWKV) * ln_w + ln_b
    bonus = jnp.sum(r * (keys[0] + keys[1]) * r_k, axis=-1, keepdims=True) * v
    return (yn + bonus.reshape(b, l, D_RWKV)) * g


def rwkv7_mixer(p_ctx, p_lat, mu, w0, w_up, a0, a_up, g_up, k_k, k_a, r_k, ln_w, ln_b):
    rc, vc, kkc, gc, dec_c, key_c, bv_c = rwkv7_features(p_ctx, mu, w0, w_up, a0, a_up, g_up, k_k, k_a)
    rl, vl, kkl, gl, dec_l, key_l, bv_l = rwkv7_features(p_lat, mu, w0, w_up, a0, a_up, g_up, k_k, k_a)
    s0 = jnp.zeros((p_ctx.shape[0], RWKV_HEADS, RWKV_HEAD, RWKV_HEAD), jnp.float32)
    y_ctx, y_lat = 0.0, 0.0
    for d in range(2):
        yc, s_c = rwkv7_scan(rc, dec_c[d], key_c[d], vc, -kkc, bv_c[d], s0, d == 1)
        yl, _ = rwkv7_scan(rl, dec_l[d], key_l[d], vl, -kkl, bv_l[d], s_c, d == 1)
        y_ctx = y_ctx + yc
        y_lat = y_lat + yl
    return (rwkv7_output(rc, vc, gc, key_c, y_ctx, r_k, ln_w, ln_b),
            rwkv7_output(rl, vl, gl, key_l, y_lat, r_k, ln_w, ln_b))


def ssd_chunked(x, dt, a, bm, cm, h0):
    b, l, nh, pd = x.shape
    nc, q, g, hg, n = l // SSM_CHUNK, SSM_CHUNK, SSM_GROUPS, SSM_HEADS // SSM_GROUPS, SSM_STATE
    xq = x.reshape(b, nc, q, g, hg, pd)
    dtq = dt.reshape(b, nc, q, g, hg)
    bq = bm.reshape(b, nc, q, g, n)
    cq = cm.reshape(b, nc, q, g, n)
    cum = jnp.cumsum(dtq * a.reshape(g, hg), axis=2)
    seg = cum[:, :, :, None] - cum[:, :, None, :]
    lower = jnp.tril(jnp.ones((q, q), bool))[None, None, :, :, None, None]
    decay_ij = jnp.exp(jnp.where(lower, seg, -jnp.inf))
    cb = jnp.einsum('bcign,bcjgn->bcijg', cq, bq)
    scores = cb[..., None] * decay_ij * dtq[:, :, None]
    y_diag = jnp.einsum('bcijgh,bcjghp->bcighp', scores, xq)
    to_end = jnp.exp(cum[:, :, -1:] - cum) * dtq
    states = jnp.einsum('bcjgn,bcjgh,bcjghp->bcghpn', bq, to_end, xq)
    chunk_decay = jnp.exp(cum[:, :, -1])

    def step(h, inp):
        st, dc = inp
        return h * dc[..., None, None] + st, h

    h_fin, h_enter = lax.scan(step, h0.reshape(b, g, hg, pd, n),
                              (jnp.moveaxis(states, 1, 0), jnp.moveaxis(chunk_decay, 1, 0)))
    h_enter = jnp.moveaxis(h_enter, 0, 1)
    y_off = jnp.einsum('bcign,bcghpn->bcighp', cq, h_enter) * jnp.exp(cum)[..., None]
    return (y_diag + y_off).reshape(b, l, nh, pd), h_fin.reshape(b, nh, pd, n)


def ssd_direction(x, dt, a, bm, cm, h0, reverse):
    if reverse:
        x, dt, bm, cm = (jnp.flip(t, axis=1) for t in (x, dt, bm, cm))
    y, h_fin = ssd_chunked(x, dt, a, bm, cm, h0)
    if reverse:
        y = jnp.flip(y, axis=1)
    return y, h_fin


def mamba2_prepare(p, conv_w, conv_b):
    b, l, _ = p.shape
    z = p[..., :D_SSM]
    xbc = jax.nn.silu(centred_dwconv(p[..., D_SSM:D_SSM + D_XBC], conv_w, conv_b))
    xs = xbc[..., :D_SSM].reshape(b, l, SSM_HEADS, SSM_HEADDIM)
    bm = xbc[..., D_SSM:D_SSM + SSM_GROUPS * SSM_STATE].reshape(b, l, SSM_GROUPS, SSM_STATE)
    cm = xbc[..., D_SSM + SSM_GROUPS * SSM_STATE:].reshape(b, l, SSM_GROUPS, SSM_STATE)
    dt_raw = p[..., D_SSM + D_XBC:].reshape(b, l, 2, SSM_HEADS).astype(jnp.float32)
    return z, xs, bm, cm, dt_raw


def gated_rms_norm(y, z, gain):
    b, l, _ = z.shape
    yg = (y.reshape(b, l, D_SSM) * jax.nn.silu(z.astype(jnp.float32))).reshape(b, l, SSM_GROUPS, D_SSM // SSM_GROUPS)
    yg = yg * lax.rsqrt(jnp.mean(yg * yg, axis=-1, keepdims=True) + EPS)
    return yg.reshape(b, l, D_SSM) * gain


def mamba2_mixer(p_ctx, p_lat, conv_w, conv_b, a_log, dt_bias, d_skip, norm_w):
    zc, xc, bc, cc, dtc = mamba2_prepare(p_ctx, conv_w, conv_b)
    zl, xl, bl, cl, dtl = mamba2_prepare(p_lat, conv_w, conv_b)
    a = -jnp.exp(a_log.astype(jnp.float32))
    h0 = jnp.zeros((p_ctx.shape[0], SSM_HEADS, SSM_HEADDIM, SSM_STATE), jnp.float32)
    y_ctx = d_skip[:, None] * xc
    y_lat = d_skip[:, None] * xl
    for d in range(2):
        dt_c = jax.nn.softplus(dtc[:, :, d] + dt_bias[d])
        dt_l = jax.nn.softplus(dtl[:, :, d] + dt_bias[d])
        yc, h_c = ssd_direction(xc, dt_c, a[d], bc, cc, h0, d == 1)
        yl, _ = ssd_direction(xl, dt_l, a[d], bl, cl, h_c, d == 1)
        y_ctx = y_ctx + yc
        y_lat = y_lat + yl
    return gated_rms_norm(y_ctx, zc, norm_w), gated_rms_norm(y_lat, zl, norm_w)


def merge_branches(p_gate, y_lru, y_rwkv, y_ssm, w_out_lru, w_out_rwkv, w_out_ssm, w_o):
    g = jax.nn.sigmoid(p_gate)
    m = (g[..., :D_MODEL] * (y_lru @ w_out_lru)
         + g[..., D_MODEL:2 * D_MODEL] * (y_rwkv @ w_out_rwkv)
         + g[..., 2 * D_MODEL:] * (y_ssm @ w_out_ssm))
    return m @ w_o


def swiglu(u, w1, w3, w2):
    return (jax.nn.silu(u @ w1) * (u @ w3)) @ w2


def moe_swiglu(u, router, w1, w3, w2):
    shp = u.shape
    t = u.reshape(-1, shp[-1])
    logits = (t @ router).astype(jnp.float32)
    top_v, top_i = lax.top_k(logits, TOP_K)
    probs = jax.nn.softmax(top_v, axis=-1)
    gates = jnp.sum(jax.nn.one_hot(top_i, N_EXPERTS, dtype=probs.dtype) * probs[..., None], axis=-2)
    y = 0.0
    for e in range(N_EXPERTS):
        y = y + gates[:, e:e + 1] * swiglu(t, w1[e], w3[e], w2[e])
    return y.reshape(shp)


def channel_mixer(u, li, ffn_w1, ffn_w3, ffn_w2, moe_router, moe_w1, moe_w3, moe_w2):
    j = li // 2
    if li % 2 == 0:
        return swiglu(u, ffn_w1[j], ffn_w3[j], ffn_w2[j])
    return moe_swiglu(u, moe_router[j], moe_w1[j], moe_w3[j], moe_w2[j])


def setup_inputs(seed: int = 0) -> dict:
    key = jax.random.key(seed)
    ks = iter(jax.random.split(key, 64))
    f32 = jnp.float32

    def nrm(shape, scale):
        return jax.random.normal(next(ks), shape, f32) * scale

    def unif(shape, lo, hi):
        return jax.random.uniform(next(ks), shape, f32, lo, hi)

    lam_a = unif((DEPTH, 2, D_LRU), 0.9, 0.999)
    dt0 = jnp.exp(unif((DEPTH, 2, SSM_HEADS), math.log(1e-3), math.log(1e-1)))
    return {
        "x": nrm((BATCH, SEQ, D_MODEL), 1.0),
        "c": nrm((BATCH, D_MODEL), 1.0),
        "ctx": nrm((BATCH, CTX_LEN, D_MODEL), 1.0),
        "c_ctx": nrm((D_MODEL,), 1.0),
        "ada_w": nrm((DEPTH, D_MODEL, 6 * D_MODEL), 0.5 * D_MODEL ** -0.5),
        "ada_b": nrm((DEPTH, 6 * D_MODEL), 0.02),
        "norm_mix": 1.0 + nrm((DEPTH, D_MODEL), 0.02),
        "norm_ffn": 1.0 + nrm((DEPTH, D_MODEL), 0.02),
        "norm_final": 1.0 + nrm((D_MODEL,), 0.02),
        "w_in": nrm((DEPTH, D_MODEL, N_IN), D_MODEL ** -0.5),
        "lru_conv_w": nrm((DEPTH, CONV_W, D_LRU), 0.5),
        "lru_conv_b": nrm((DEPTH, D_LRU), 0.02),
        "lru_gate_w": nrm((DEPTH, 2, 2, LRU_BLOCKS, LRU_BS, LRU_BS), LRU_BS ** -0.5),
        "lru_gate_b": nrm((DEPTH, 2, 2, D_LRU), 0.1),
        "lru_lambda": jnp.log(lam_a) - jnp.log1p(-lam_a),
        "rwkv_mu": unif((DEPTH, N_RWKV_IN), 0.0, 1.0),
        "rwkv_w0": unif((DEPTH, 2, D_RWKV), -6.0, -1.0),
        "rwkv_w_up": nrm((DEPTH, 2, W_LORA, D_RWKV), 0.5 * W_LORA ** -0.5),
        "rwkv_a0": nrm((DEPTH, 2, D_RWKV), 0.3),
        "rwkv_a_up": nrm((DEPTH, 2, A_LORA, D_RWKV), 0.5 * A_LORA ** -0.5),
        "rwkv_g_up": nrm((DEPTH, G_LORA, D_RWKV), G_LORA ** -0.5),
        "rwkv_k_k": 0.85 + nrm((DEPTH, D_RWKV), 0.05),
        "rwkv_k_a": 1.0 + nrm((DEPTH, D_RWKV), 0.05),
        "rwkv_r_k": nrm((DEPTH, RWKV_HEADS, RWKV_HEAD), 0.1),
        "rwkv_ln_w": 1.0 + nrm((DEPTH, D_RWKV), 0.02),
        "rwkv_ln_b": nrm((DEPTH, D_RWKV), 0.02),
        "ssm_conv_w": nrm((DEPTH, CONV_W, D_XBC), 0.5),
        "ssm_conv_b": nrm((DEPTH, D_XBC), 0.02),
        "ssm_a_log": jnp.log(unif((DEPTH, 2, SSM_HEADS), 1.0, 16.0)),
        "ssm_dt_bias": dt0 + jnp.log(-jnp.expm1(-dt0)),
        "ssm_d": 1.0 + nrm((DEPTH, SSM_HEADS), 0.1),
        "ssm_norm_w": 1.0 + nrm((DEPTH, D_SSM), 0.02),
        "w_out_lru": nrm((DEPTH, D_LRU, D_MODEL), D_LRU ** -0.5),
        "w_out_rwkv": nrm((DEPTH, D_RWKV, D_MODEL), D_RWKV ** -0.5),
        "w_out_ssm": nrm((DEPTH, D_SSM, D_MODEL), D_SSM ** -0.5),
        "w_o": nrm((DEPTH, D_MODEL, D_MODEL), D_MODEL ** -0.5),
        "ffn_w1": nrm((N_DENSE, D_MODEL, D_FF), D_MODEL ** -0.5),
        "ffn_w3": nrm((N_DENSE, D_MODEL, D_FF), D_MODEL ** -0.5),
        "ffn_w2": nrm((N_DENSE, D_FF, D_MODEL), D_FF ** -0.5),
        "moe_router": nrm((N_MOE, D_MODEL, N_EXPERTS), D_MODEL ** -0.5),
        "moe_w1": nrm((N_MOE, N_EXPERTS, D_MODEL, D_FF_EXPERT), D_MODEL ** -0.5),
        "moe_w3": nrm((N_MOE, N_EXPERTS, D_MODEL, D_FF_EXPERT), D_MODEL ** -0.5),
        "moe_w2": nrm((N_MOE, N_EXPERTS, D_FF_EXPERT, D_MODEL), D_FF_EXPERT ** -0.5),
    }


def reference(x, c, ctx, c_ctx, ada_w, ada_b, norm_mix, norm_ffn, norm_final, w_in,
              lru_conv_w, lru_conv_b, lru_gate_w, lru_gate_b, lru_lambda,
              rwkv_mu, rwkv_w0, rwkv_w_up, rwkv_a0, rwkv_a_up, rwkv_g_up, rwkv_k_k, rwkv_k_a,
              rwkv_r_k, rwkv_ln_w, rwkv_ln_b,
              ssm_conv_w, ssm_conv_b, ssm_a_log, ssm_dt_bias, ssm_d, ssm_norm_w,
              w_out_lru, w_out_rwkv, w_out_ssm, w_o,
              ffn_w1, ffn_w3, ffn_w2, moe_router, moe_w1, moe_w3, moe_w2):
    rows = x.shape[1] // GRID_W
    h_lat, h_ctx = x, ctx
    for li in range(DEPTH):
        last = li == DEPTH - 1
        mod_lat = (jax.nn.silu(c) @ ada_w[li] + ada_b[li])[:, None, :]
        mod_ctx = (jax.nn.silu(c_ctx) @ ada_w[li] + ada_b[li])[None, None, :]
        shm_l, scm_l, gm_l, shf_l, scf_l, gf_l = jnp.split(mod_lat, 6, axis=-1)
        shm_c, scm_c, gm_c, shf_c, scf_c, gf_c = jnp.split(mod_ctx, 6, axis=-1)

        u_lat = rms_norm(h_lat, norm_mix[li]) * (1.0 + scm_l) + shm_l
        u_ctx = rms_norm(h_ctx, norm_mix[li]) * (1.0 + scm_c) + shm_c
        if li % 2 == 1:
            u_lat = grid_transpose(u_lat, rows, GRID_W)
        p_lat = u_lat @ w_in[li]
        p_ctx = u_ctx @ w_in[li]
        ya_c, ya_l = rglru_mixer(p_ctx[..., OFF_LRU:OFF_RWKV], p_lat[..., OFF_LRU:OFF_RWKV],
                                 lru_conv_w[li], lru_conv_b[li], lru_gate_w[li], lru_gate_b[li],
                                 lru_lambda[li])
        yb_c, yb_l = rwkv7_mixer(p_ctx[..., OFF_RWKV:OFF_SSM], p_lat[..., OFF_RWKV:OFF_SSM],
                                 rwkv_mu[li], rwkv_w0[li], rwkv_w_up[li], rwkv_a0[li], rwkv_a_up[li],
                                 rwkv_g_up[li], rwkv_k_k[li], rwkv_k_a[li], rwkv_r_k[li],
                                 rwkv_ln_w[li], rwkv_ln_b[li])
        yc_c, yc_l = mamba2_mixer(p_ctx[..., OFF_SSM:], p_lat[..., OFF_SSM:],
                                  ssm_conv_w[li], ssm_conv_b[li], ssm_a_log[li], ssm_dt_bias[li],
                                  ssm_d[li], ssm_norm_w[li])
        o_lat = merge_branches(p_lat[..., :OFF_LRU], ya_l, yb_l, yc_l,
                               w_out_lru[li], w_out_rwkv[li], w_out_ssm[li], w_o[li])
        if li % 2 == 1:
            o_lat = grid_transpose(o_lat, GRID_W, rows)
        h_lat = h_lat + gm_l * o_lat
        if not last:
            o_ctx = merge_branches(p_ctx[..., :OFF_LRU], ya_c, yb_c, yc_c,
                                   w_out_lru[li], w_out_rwkv[li], w_out_ssm[li], w_o[li])
            h_ctx = h_ctx + gm_c * o_ctx

        v_lat = rms_norm(h_lat, norm_ffn[li]) * (1.0 + scf_l) + shf_l
        h_lat = h_lat + gf_l * channel_mixer(v_lat, li, ffn_w1, ffn_w3, ffn_w2,
                                             moe_router, moe_w1, moe_w3, moe_w2)
        if not last:
            v_ctx = rms_norm(h_ctx, norm_ffn[li]) * (1.0 + scf_c) + shf_c
            h_ctx = h_ctx + gf_c * channel_mixer(v_ctx, li, ffn_w1, ffn_w3, ffn_w2,
                                                 moe_router, moe_w1, moe_w3, moe_w2)
    return rms_norm(h_lat, norm_final)
```

```cpp
#include <hip/hip_runtime.h>
#include <cstdio>
#include <cstdint>

#ifndef MK_PER_PHASE
#define MK_PER_PHASE 1
#endif

namespace pg8 {
#define PG8_LAS __attribute__((address_space(3)))
typedef unsigned short bf16_t;
typedef short bf16x8 __attribute__((ext_vector_type(8)));
typedef float f32x4 __attribute__((ext_vector_type(4)));
typedef unsigned u32x4 __attribute__((ext_vector_type(4)));
constexpr int BM = 256, BK = 64, HALF = 128, HTB = HALF * BK * 2  , STAGE_BYTES = 8 * HTB, NXCD = 8, WGM = 8;

__host__ __device__ __forceinline__ int lds_byte(int r, int c) { const int st = (r >> 4) * 2 + (c >> 5), rr = r & 15, cc = c & 31, ob = rr * 64 + cc * 2; return st * 1024 + (ob ^ (((ob >> 9) & 1) << 5)); }
__host__ __device__ __forceinline__ void stage_rc(int b, int& R, int& C) { const int st = b / 1024, sb = b % 1024, swz = sb ^ (((sb >> 9) & 1) << 5); R = (st >> 1) * 16 + swz / 64; C = (st & 1) * 32 + (swz % 64) / 2; }
__host__ __device__ __forceinline__ int perm32(int rho) { const int n = rho >> 4, i = rho & 15; return 8 * (i >> 2) + 4 * n + (i & 3); }

struct Unit { int pm, pn; };
struct Gemm { const bf16_t* A; const bf16_t* Bt; int M, N, K; };

struct StaticOrder {
    int nM, nN, nwg, G, c;
    __host__ __device__ void init(int M, int N, int G_, int c_) { nM = M / BM; nN = N / BM; nwg = nM * nN; G = G_; c = c_; }
    __host__ __device__ bool next(int i, Unit& u) const {
        const long L = (long)i * G + c; if (L >= nwg) return false;
        int wgid = (int)L; { const int q = nwg / NXCD, r = nwg % NXCD, xcd = wgid % NXCD, off = wgid / NXCD; wgid = (xcd < r ? xcd * (q + 1) : r * (q + 1) + (xcd - r) * q) + off; }
        const int nig = WGM * nN, gid = wgid / nig, fm = gid * WGM, gsz = (nM - fm) < WGM ? (nM - fm) : WGM;
        u.pm = fm + ((wgid % nig) % gsz); u.pn = (wgid % nig) / gsz; return true;
    }
    __device__ __forceinline__ void a_ready(const Unit&) const {}
    __device__ __forceinline__ void done(const Unit&) const {}
};
__device__ __forceinline__ unsigned cvt_pk_bf16(float lo, float hi) { unsigned r; asm volatile("v_cvt_pk_bf16_f32 %0, %1, %2" : "=v"(r) : "v"(lo), "v"(hi)); return r; }
typedef float f32x2 __attribute__((ext_vector_type(2)));
__device__ __forceinline__ f32x2 gelu_pk(f32x2 v) {
    const f32x2 av = __builtin_elementwise_abs(v), d = av * 0.2316418882f + 1.0f;
    f32x2 t; t.x = __builtin_amdgcn_rcpf(d.x); t.y = __builtin_amdgcn_rcpf(d.y);
    f32x2 q = t * 0.5307027145f + (-0.7265760135f); q = q * t + 0.7107068705f; q = q * t + (-0.142248368f); q = q * t + 0.127414796f; q = q * t;
    const f32x2 s = (v * v) * (-0.72134752044f);
    f32x2 e; e.x = __builtin_amdgcn_exp2f(s.x); e.y = __builtin_amdgcn_exp2f(s.y);
    const f32x2 m = v * (q * e), r = v - m;
    f32x2 o; o.x = v.x < 0.f ? m.x : r.x; o.y = v.y < 0.f ? m.y : r.y; return o;
}
template <class Epi, class Sched, bool STAMP = false>
__device__ __forceinline__ void gemm_phase(PG8_LAS unsigned char* lds, const Gemm g, const Sched& S, const Epi& E, unsigned long long* stamps) {
    const int tid = threadIdx.x, wid = __builtin_amdgcn_readfirstlane(tid >> 6), lane = tid & 63, wr = wid >> 2, wc = wid & 3, fr = lane & 15, fq = lane >> 4;
    const int K = g.K, nt = K / BK;
    int ts_lo = 0, ts_hi = 0, nts = 0; const unsigned long long rt_entry = STAMP ? (unsigned long long)wall_clock64() : 0ull;
#define PG8_STAMP() do { if (STAMP && wid == 0 && nts < 64) { const unsigned long long _c = (unsigned long long)clock64(); \
        ts_lo = (lane == nts) ? (int)(unsigned)_c : ts_lo; ts_hi = (lane == nts) ? (int)(unsigned)(_c >> 32) : ts_hi; ++nts; } } while (0)
    PG8_STAMP();
    unsigned voffA[2], voffB[2];
#pragma unroll
    for (int i = 0; i < 2; ++i) { int R, C; stage_rc(tid * 16 + i * 8192, R, C); const int Rb = Epi::PERM ? ((R & ~31) + perm32(R & 31)) : R;
        voffA[i] = (unsigned)(R * K + C) * 2u; voffB[i] = (unsigned)(Rb * K + C) * 2u; }
    const size_t kstep = (size_t)(BK * 2);
    const size_t hstep = (size_t)HALF * K * 2;
    const size_t tstep = 2 * hstep;
    const unsigned ldsw = (unsigned)wid * 1024u;
    const int aoff = lds_byte(wr * 64 + fr, fq * 8), boff = lds_byte(wc * 32 + fr, fq * 8);
#define PG8_SA(b, h) (((b) * 2 + (h)) * HTB)
#define PG8_SB(b, h) ((4 + (b) * 2 + (h)) * HTB)
#define PG8_STAGE(bufoff, gbase, voff) do { _Pragma("unroll") for (int _i = 0; _i < 2; ++_i) \
        __builtin_amdgcn_global_load_lds((const unsigned*)((const char*)(gbase) + (voff)[_i]), (PG8_LAS unsigned*)(lds + (bufoff) + ldsw + _i * 8192), 16, 0, 0); } while (0)
#define PG8_LDA(dst, b, h) do { _Pragma("unroll") for (int m = 0; m < 4; ++m) _Pragma("unroll") for (int k = 0; k < 2; ++k) dst[m][k] = *(const PG8_LAS bf16x8*)(lds + PG8_SA(b, h) + aoff + m * 2048 + k * 1024); } while (0)
#define PG8_LDB(dst, b, h) do { _Pragma("unroll") for (int n = 0; n < 2; ++n) _Pragma("unroll") for (int k = 0; k < 2; ++k) dst[n][k] = *(const PG8_LAS bf16x8*)(lds + PG8_SB(b, h) + boff + n * 2048 + k * 1024); } while (0)
#define PG8_MMA(ai, bj, At, Bt) do { __builtin_amdgcn_s_setprio(1); _Pragma("unroll") for (int m = 0; m < 4; ++m) _Pragma("unroll") for (int n = 0; n < 2; ++n) _Pragma("unroll") for (int k = 0; k < 2; ++k) \
        acc[ai][bj][m][n] = __builtin_amdgcn_mfma_f32_16x16x32_bf16(Bt[n][k], At[m][k], acc[ai][bj][m][n], 0, 0, 0); __builtin_amdgcn_s_setprio(0); } while (0)
#define PG8_WAIT_V(n) asm volatile("s_waitcnt vmcnt(" #n ")" ::: "memory")
#define PG8_WAIT_L(n) asm volatile("s_waitcnt lgkmcnt(" #n ")" ::: "memory")
#define PG8_BAR __builtin_amdgcn_s_barrier()
#define PG8_SCHED __builtin_amdgcn_sched_barrier(0)
    Unit cur, nxt; int ui = 0;
    if (!S.next(0, cur)) return;
    f32x4 acc[2][2][4][2];
#pragma unroll
    for (int a = 0; a < 2; ++a)
#pragma unroll
        for (int b = 0; b < 2; ++b)
#pragma unroll
            for (int m = 0; m < 4; ++m)
#pragma unroll
                for (int n = 0; n < 2; ++n) acc[a][b][m][n] = (f32x4){0.f, 0.f, 0.f, 0.f};
    bf16x8 At[4][2], B0[2][2], B1[2][2];
    const char* cA = (const char*)g.A + (size_t)cur.pm * tstep; const char* cB = (const char*)g.Bt + (size_t)cur.pn * tstep;
    S.a_ready(cur);
    PG8_STAGE(PG8_SB(0, 0), cB, voffB); PG8_STAGE(PG8_SA(0, 0), cA, voffA); PG8_STAGE(PG8_SB(0, 1), cB + hstep, voffB); PG8_STAGE(PG8_SA(0, 1), cA + hstep, voffA);
    if (wr == 1) PG8_BAR;
    PG8_WAIT_V(4); PG8_BAR;
    PG8_STAGE(PG8_SB(1, 0), cB + kstep, voffB); PG8_STAGE(PG8_SA(1, 0), cA + kstep, voffA); PG8_STAGE(PG8_SB(1, 1), cB + hstep + kstep, voffB);
    PG8_WAIT_V(6); PG8_BAR;
    PG8_STAMP();
    for (;;) {
        const bool has_next = S.next(ui + 1, nxt);
        const char* nA = has_next ? (const char*)g.A + (size_t)nxt.pm * tstep : cA; const char* nB = has_next ? (const char*)g.Bt + (size_t)nxt.pn * tstep : cB;
        for (int t = 0; t < nt; t += 2) {
            const bool last = (t == nt - 2);
            const char* a1 = cA + (size_t)(t + 1) * kstep;
            const char* a2 = last ? nA : cA + (size_t)(t + 2) * kstep; const char* b2 = last ? nB : cB + (size_t)(t + 2) * kstep;
            const char* a3 = a2 + kstep; const char* b3 = b2 + kstep;
            if (last && has_next) S.a_ready(nxt);
            PG8_LDB(B0, 0, 0); PG8_SCHED; PG8_LDA(At, 0, 0); PG8_STAGE(PG8_SA(1, 1), a1 + hstep, voffA);
            PG8_WAIT_L(8); PG8_BAR; PG8_WAIT_L(0); PG8_MMA(0, 0, At, B0); PG8_BAR; PG8_SCHED;
            PG8_LDB(B1, 0, 1); PG8_STAGE(PG8_SB(0, 0), b2, voffB);
            PG8_BAR; PG8_WAIT_L(0); PG8_MMA(0, 1, At, B1); PG8_BAR;
            PG8_LDA(At, 0, 1); PG8_STAGE(PG8_SA(0, 0), a2, voffA);
            PG8_BAR; PG8_WAIT_L(0); PG8_MMA(1, 0, At, B0); PG8_BAR; PG8_SCHED;
            PG8_STAGE(PG8_SB(0, 1), b2 + hstep, voffB);
            PG8_WAIT_V(6); PG8_BAR; PG8_MMA(1, 1, At, B1); PG8_BAR;
            PG8_LDB(B0, 1, 0); PG8_SCHED; PG8_LDA(At, 1, 0); PG8_STAGE(PG8_SA(0, 1), a2 + hstep, voffA);
            PG8_WAIT_L(8); PG8_BAR; PG8_WAIT_L(0); PG8_MMA(0, 0, At, B0); PG8_BAR; PG8_SCHED;
            PG8_LDB(B1, 1, 1); PG8_STAGE(PG8_SB(1, 0), b3, voffB);
            PG8_BAR; PG8_WAIT_L(0); PG8_MMA(0, 1, At, B1); PG8_BAR;
            PG8_LDA(At, 1, 1); PG8_STAGE(PG8_SA(1, 0), a3, voffA);
            PG8_BAR; PG8_WAIT_L(0); PG8_MMA(1, 0, At, B0); PG8_BAR; PG8_SCHED;
            PG8_STAGE(PG8_SB(1, 1), b3 + hstep, voffB);
            PG8_WAIT_V(6); PG8_BAR; PG8_MMA(1, 1, At, B1); PG8_BAR;
        }
        PG8_STAMP();
        if constexpr (!Epi::AFTER_DRAIN) { E(acc, cur, wr, wc, fr, fq); S.done(cur); }
        PG8_STAMP();
        if (!has_next) break;
#pragma unroll
        for (int a = 0; a < 2; ++a)
#pragma unroll
            for (int b = 0; b < 2; ++b)
#pragma unroll
                for (int m = 0; m < 4; ++m)
#pragma unroll
                    for (int n = 0; n < 2; ++n) acc[a][b][m][n] = (f32x4){0.f, 0.f, 0.f, 0.f};
        cur = nxt; cA = nA; cB = nB; ++ui;
    }
    PG8_WAIT_V(0);
    if (wr == 0) PG8_BAR;
    PG8_BAR;
    if constexpr (Epi::AFTER_DRAIN) { E.fused(acc, cur, wr, wc, fr, fq, lds, wid, lane); S.done(cur); }
    PG8_STAMP();
    if (STAMP && wid == 0) { stamps[lane] = lane < nts ? (((unsigned long long)(unsigned)ts_hi << 32) | (unsigned)ts_lo) : 0ull;
        if (lane == 62) stamps[62] = rt_entry; if (lane == 63) stamps[63] = (unsigned long long)wall_clock64(); }
#undef PG8_STAMP
#undef PG8_SA
#undef PG8_SB
#undef PG8_STAGE
#undef PG8_LDA
#undef PG8_LDB
#undef PG8_MMA
#undef PG8_WAIT_V
#undef PG8_WAIT_L
#undef PG8_BAR
#undef PG8_SCHED
}
__device__ __forceinline__ float bf_lo(unsigned w) { return __uint_as_float(w << 16); }
__device__ __forceinline__ float bf_hi(unsigned w) { return __uint_as_float(w & 0xffff0000u); }
__device__ __forceinline__ float sigmoidf_(float x) { return 1.0f / (1.0f + __expf(-x)); }

struct EpiStoreBf16 {
    static constexpr bool PERM = true, AFTER_DRAIN = false;
    bf16_t* O; int ldc; int npn;
    __device__ __forceinline__ void operator()(const f32x4 (&acc)[2][2][4][2], const Unit& u, int wr, int wc, int fr, int fq) const {
        const int pn = npn ? (u.pn % npn) : u.pn;
        const int row0 = u.pm * BM + wr * 64 + fr, col0 = pn * BM + wc * 32 + 8 * fq;
#pragma unroll
        for (int ai = 0; ai < 2; ++ai)
#pragma unroll
            for (int m = 0; m < 4; ++m) { bf16_t* rowp = O + (size_t)(row0 + ai * HALF + m * 16) * ldc + col0;
#pragma unroll
                for (int bj = 0; bj < 2; ++bj) { const f32x4 v0 = acc[ai][bj][m][0], v1 = acc[ai][bj][m][1];
                    u32x4 w; w.x = cvt_pk_bf16(v0[0], v0[1]); w.y = cvt_pk_bf16(v0[2], v0[3]); w.z = cvt_pk_bf16(v1[0], v1[1]); w.w = cvt_pk_bf16(v1[2], v1[3]);
                    *(u32x4*)(rowp + bj * HALF) = w; } }
    }
};
struct EpiSwiGLU {
    static constexpr bool PERM = true, AFTER_DRAIN = false;
    bf16_t* H; int ldh; int npn;
    __device__ __forceinline__ void operator()(const f32x4 (&acc)[2][2][4][2], const Unit& u, int wr, int wc, int fr, int fq) const {
        const int pn = npn ? (u.pn % npn) : u.pn;
        const int row0 = u.pm * BM + wr * 64 + fr, col0 = pn * HALF + wc * 32 + 8 * fq;
#pragma unroll
        for (int ai = 0; ai < 2; ++ai)
#pragma unroll
            for (int m = 0; m < 4; ++m) { bf16_t* rowp = H + (size_t)(row0 + ai * HALF + m * 16) * ldh + col0;
                float o[8];
#pragma unroll
                for (int n = 0; n < 2; ++n)
#pragma unroll
                    for (int j = 0; j < 4; ++j) { const float a = acc[ai][0][m][n][j], b = acc[ai][1][m][n][j]; o[n * 4 + j] = a * sigmoidf_(a) * b; }
                u32x4 w; w.x = cvt_pk_bf16(o[0], o[1]); w.y = cvt_pk_bf16(o[2], o[3]); w.z = cvt_pk_bf16(o[4], o[5]); w.w = cvt_pk_bf16(o[6], o[7]);
                *(u32x4*)rowp = w; }
    }
};
struct EpiMerge {
    static constexpr bool PERM = true, AFTER_DRAIN = false;
    const bf16_t* P; int ldp; bf16_t* Mb;
    __device__ __forceinline__ void operator()(const f32x4 (&acc)[2][2][4][2], const Unit& u, int wr, int wc, int fr, int fq) const {
        const int br = u.pn >> 3, pn = u.pn & 7, pm = u.pm - br * 66;
        const int row0 = pm * BM + wr * 64 + fr, col0 = pn * BM + wc * 32 + 8 * fq;
#pragma unroll
        for (int ai = 0; ai < 2; ++ai)
#pragma unroll
            for (int m = 0; m < 4; ++m) { const size_t row = (size_t)(row0 + ai * HALF + m * 16);
#pragma unroll
                for (int bj = 0; bj < 2; ++bj) { const int col = col0 + bj * HALF;
                    const u32x4 g = *(const u32x4*)(P + row * ldp + br * 2048 + col);
                    const f32x4 v0 = acc[ai][bj][m][0], v1 = acc[ai][bj][m][1];
                    float o[8];
                    o[0] = sigmoidf_(bf_lo(g.x)) * v0[0]; o[1] = sigmoidf_(bf_hi(g.x)) * v0[1]; o[2] = sigmoidf_(bf_lo(g.y)) * v0[2]; o[3] = sigmoidf_(bf_hi(g.y)) * v0[3];
                    o[4] = sigmoidf_(bf_lo(g.z)) * v1[0]; o[5] = sigmoidf_(bf_hi(g.z)) * v1[1]; o[6] = sigmoidf_(bf_lo(g.w)) * v1[2]; o[7] = sigmoidf_(bf_hi(g.w)) * v1[3];
                    bf16_t* mp = Mb + row * 2048 + col;
                    if (br > 0) { const u32x4 q = *(const u32x4*)mp;
                        o[0] += bf_lo(q.x); o[1] += bf_hi(q.x); o[2] += bf_lo(q.y); o[3] += bf_hi(q.y); o[4] += bf_lo(q.z); o[5] += bf_hi(q.z); o[6] += bf_lo(q.w); o[7] += bf_hi(q.w); }
                    u32x4 w; w.x = cvt_pk_bf16(o[0], o[1]); w.y = cvt_pk_bf16(o[2], o[3]); w.z = cvt_pk_bf16(o[4], o[5]); w.w = cvt_pk_bf16(o[6], o[7]);
                    *(u32x4*)mp = w; } }
    }
};
struct MergeOrder {
    int ntile, G, c;
    __device__ bool next(int i, Unit& u) const { const int t = i / 3, br = i - 3 * t; const long q = (long)t * G + c; if (q >= ntile) return false;
        u.pm = br * 66 + (int)(q >> 3); u.pn = br * 8 + (int)(q & 7); return true; }
    __device__ __forceinline__ void a_ready(const Unit&) const {}
    __device__ __forceinline__ void done(const Unit&) const {}
};
struct EpiResid {
    static constexpr bool PERM = false, AFTER_DRAIN = false;
    const float* hin_lat; const float* hin_ctx; float* hout_lat; float* hout_ctx; const float* gate; int odd;
    __device__ __forceinline__ void operator()(const f32x4 (&acc)[2][2][4][2], const Unit& u, int wr, int wc, int fr, int fq) const {
        const int row0 = u.pm * BM + wr * 64 + fr, col0 = u.pn * BM + wc * 32 + 4 * fq;
#pragma unroll
        for (int ai = 0; ai < 2; ++ai)
#pragma unroll
            for (int m = 0; m < 4; ++m) { const int R = row0 + ai * HALF + m * 16;
                const float* hi; float* ho; const float* gv;
                if (R < 16384) { const int b = R >> 13, lp = R & 8191; const int l = odd ? ((lp & 127) * 64 + (lp >> 7)) : lp; const size_t dr = (size_t)(b * 8192 + l) * 2048;
                    hi = hin_lat + dr; ho = hout_lat + dr; gv = gate + b * 12288; }
                else { const size_t dr = (size_t)(R - 16384) * 2048; hi = hin_ctx + dr; ho = hout_ctx + dr; gv = gate + 2 * 12288; }
#pragma unroll
                for (int bj = 0; bj < 2; ++bj)
#pragma unroll
                    for (int n = 0; n < 2; ++n) { const int c = col0 + bj * HALF + n * 16;
                        const f32x4 h = *(const f32x4*)(hi + c), g = *(const f32x4*)(gv + c);
                        *(f32x4*)(ho + c) = h + g * acc[ai][bj][m][n]; } }
    }
};
struct MoeOrder {
    const int* tile_e; const int* ntiles; int npn, G, c;
    __device__ bool next(int i, Unit& u) const { const long L = (long)i * G + c; const int nt = *ntiles; if (L >= (long)nt * npn) return false;
        const int pm = (int)(L / npn), pl = (int)(L - (long)pm * npn); u.pm = pm; u.pn = tile_e[pm] * npn + pl; return true; }
    __device__ __forceinline__ void a_ready(const Unit&) const {}
    __device__ __forceinline__ void done(const Unit&) const {}
};
}

#include <vector>
#include <vector>

#define XB_TMO      128
#define XB_XCNT(j)  (256  + 64 * (j))
#define XB_XSUB(j)  (1280 + 64 * (j))
#define XB_XGEN(j)  (2304 + 64 * (j))
#define XB_TOP      3328
#define XB_TOPGEN   3392
#define XCD_BAR_WORDS 3456
#define XB_SPIN_CAP (1u << 18)
#define LAS __attribute__((address_space(3)))

__device__ __forceinline__ unsigned xb_ld(unsigned* p)              { return __hip_atomic_load(p, __ATOMIC_RELAXED, __HIP_MEMORY_SCOPE_AGENT); }
__device__ __forceinline__ unsigned xb_add(unsigned* p, unsigned v) { return __hip_atomic_fetch_add(p, v, __ATOMIC_RELAXED, __HIP_MEMORY_SCOPE_AGENT); }
__device__ __forceinline__ unsigned xb_xcc_id() { return (unsigned)__builtin_amdgcn_s_getreg((3 << 11) | 20) & 0xFu; }
#define XB_SPIN(cond, bar) do { unsigned _sp = 0; while (cond) { __builtin_amdgcn_s_sleep(1); \
    if ((++_sp & 255u) == 0u) { if (xb_ld(&(bar)[XB_TMO])) break; if (_sp > XB_SPIN_CAP) { atomicAdd(&(bar)[XB_TMO], 1u); break; } } } } while (0)

struct XcdBarrier {
    unsigned* bar; unsigned x;
    volatile LAS unsigned* st;
};

__device__ __forceinline__ XcdBarrier xcd_barrier_post(unsigned* bar, volatile LAS unsigned* st) {
    XcdBarrier b; b.bar = bar; b.x = xb_xcc_id(); b.st = st;
    if (threadIdx.x == 0) (void)xb_add(&bar[XB_XCNT(b.x)], 1u);
    return b;
}
__device__ __forceinline__ void xcd_barrier_complete(unsigned* bar, unsigned x, unsigned& nloc, unsigned& nx) {
    const unsigned G = gridDim.x * gridDim.y * gridDim.z;
    unsigned sum, cnt, mine, sp = 0u;
    for (;;) {
        sum = 0u; cnt = 0u; mine = 0u;
#pragma unroll
        for (unsigned j = 0; j < 16; ++j) { const unsigned c = xb_ld(&bar[XB_XCNT(j)]); sum += c; cnt += (c > 0u) ? 1u : 0u; mine = (j == x) ? c : mine; }
        if (sum == G) break;
        __builtin_amdgcn_s_sleep(1);
        if ((++sp & 255u) == 0u) { if (xb_ld(&bar[XB_TMO])) break; if (sp > XB_SPIN_CAP) { atomicAdd(&bar[XB_TMO], 1u); break; } }
    }
    nloc = mine > 0u ? mine : 1u; nx = cnt > 0u ? cnt : 1u;
}

__device__ __forceinline__ void xcd_barrier(const XcdBarrier& b) {
    asm volatile("s_waitcnt vmcnt(0)" ::: "memory");
    __syncthreads();
    if (threadIdx.x == 0) {
        unsigned* bar = b.bar;
        __builtin_amdgcn_s_waitcnt(0);
        unsigned nloc = b.st[0], nx = b.st[1];
        if (nloc == 0u) { xcd_barrier_complete(bar, b.x, nloc, nx); b.st[0] = nloc; b.st[1] = nx; }
        const unsigned old = xb_add(&bar[XB_XSUB(b.x)], 1u);
        const unsigned gen = old / nloc;
        if (old + 1u == (gen + 1u) * nloc) {
            __builtin_amdgcn_fence(__ATOMIC_RELEASE, "agent");
            asm volatile("s_waitcnt vmcnt(0)" ::: "memory");
            const unsigned og = xb_add(&bar[XB_TOP], 1u);
            const unsigned tg = og / nx;
            if (og + 1u == (tg + 1u) * nx) xb_add(&bar[XB_TOPGEN], 1u);
            else XB_SPIN(xb_ld(&bar[XB_TOPGEN]) == tg, bar);
            __builtin_amdgcn_fence(__ATOMIC_ACQUIRE, "agent");
            xb_add(&bar[XB_XGEN(b.x)], 1u);
            asm volatile("s_waitcnt vmcnt(0)" ::: "memory");
        } else {
            XB_SPIN(xb_ld(&bar[XB_XGEN(b.x)]) == gen, bar);
            __builtin_amdgcn_fence(__ATOMIC_ACQUIRE, "agent");
            asm volatile("s_waitcnt vmcnt(0)" ::: "memory");
        }
    }
    __syncthreads();
}

typedef unsigned short bf16;
typedef unsigned v4u __attribute__((ext_vector_type(4)));
typedef float f32x4 __attribute__((ext_vector_type(4)));
constexpr int D = 2048, SEQ = 8192, CTXL = 256, MLAT = 16384, MCTX = 512, MROWS = 16896;
constexpr int NP = 22272;
constexpr int PG = 0, PL = 6144, PLG = 8192, PR = 10240, PK = 12288, PV = 14336, PZ = 16384, PX = 18432, PWL = 21504, PAL = 21696, PGL = 21888, PDT = 22144;
constexpr int N_IN = 22208;
constexpr float EPS = 1e-6f;
enum { I_X = 0, I_C, I_CTX, I_CCTX, I_ADAW, I_ADAB, I_NMIX, I_NFFN, I_NFIN, I_WIN, I_LCW, I_LCB, I_LGW, I_LGB, I_LLAM,
       I_RMU, I_RW0, I_RWUP, I_RA0, I_RAUP, I_RGUP, I_RKK, I_RKA, I_RRK, I_RLNW, I_RLNB,
       I_SCW, I_SCB, I_SALOG, I_SDTB, I_SD, I_SNW, I_WOL, I_WOR, I_WOS, I_WO, I_F1, I_F3, I_F2, I_MR, I_M1, I_M3, I_M2, N_INPUTS };
constexpr size_t MiB = 1u << 20;
constexpr size_t WS_CTL = 0, CTL_BYTES = 1 * MiB;
constexpr size_t WS_MOD = 1 * MiB;
constexpr size_t WS_ROUTE = 2 * MiB;
constexpr size_t WS_BONUS = 3 * MiB;
constexpr size_t WS_HCTX = 8 * MiB;
constexpr size_t WS_WOUT = 12 * MiB;
constexpr size_t WS_HLAT = 44 * MiB;
constexpr size_t WS_Y3 = 172 * MiB;
constexpr size_t WS_X1 = 370 * MiB;
constexpr size_t WS_U = WS_X1 + 87 * MiB;
constexpr size_t WS_P = 523 * MiB;
constexpr size_t WS_END = 1241 * MiB;
constexpr size_t WS_F13 = WS_P, WS_F2 = WS_P + 48 * MiB, WS_FH = WS_P + 72 * MiB;
constexpr size_t WS_M13 = WS_P, WS_M2 = WS_P + 192 * MiB, WS_MA = WS_P + 288 * MiB, WS_MH = WS_P + 424 * MiB;
constexpr int MOE_ROWS = 34816;
static_assert(WS_MH + (size_t)MOE_ROWS * 3072 * 2 <= WS_END && WS_FH + (size_t)MROWS * 6144 * 2 <= WS_END && WS_P + (size_t)MROWS * NP * 2 <= WS_END, "ws map");
constexpr int CW_BAR = 4096;
constexpr int CW_CNT = 16384, CW_CUR = 16384 + 64;
constexpr int RT_TOKE = 0, RT_TOKP = 32768, RT_TOKROW = 65536, RT_TILEE = 98304, RT_NT = 98304 + 256, RT_BASE = 98304 + 320;
constexpr int LDS_BYTES = 147456, MISC_OFF = 131072 + 320;

struct Args { const float* in[N_INPUTS]; float* out; unsigned char* ws; int lo, hi; };

__device__ __forceinline__ float bf2f(bf16 b) { return __uint_as_float(((unsigned)b) << 16); }
__device__ __forceinline__ bf16 f2bf(float f) { unsigned u = __float_as_uint(f); u += 0x7FFFu + ((u >> 16) & 1u); return (bf16)(u >> 16); }
__device__ __forceinline__ unsigned pk2(float lo, float hi) { return (unsigned)f2bf(lo) | ((unsigned)f2bf(hi) << 16); }
__device__ __forceinline__ float wave_sum(float v) { v += __shfl_xor(v, 1); v += __shfl_xor(v, 2); v += __shfl_xor(v, 4); v += __shfl_xor(v, 8); v += __shfl_xor(v, 16); v += __shfl_xor(v, 32); return v; }
__device__ __forceinline__ float sigm(float x) { return 1.0f / (1.0f + __expf(-x)); }
__device__ __forceinline__ float siluf(float x) { return x * sigm(x); }
__device__ __forceinline__ float softplusf(float x) { return x > 20.f ? x : log1pf(__expf(x)); }
__device__ __forceinline__ float gelu_tanh(float x) { const float u = 0.7978845608028654f * (x + 0.044715f * x * x * x); return 0.5f * x * (1.0f + tanhf(u)); }
__device__ __forceinline__ void seq_pos(int row, int& pos, int& len) { if (row < MLAT) { pos = row & (SEQ - 1); len = SEQ; } else { pos = (row - MLAT) & (CTXL - 1); len = CTXL; } }
__device__ __forceinline__ int chain_row(int b, int dir, int s) { if (s < CTXL) { const int t = dir ? CTXL - 1 - s : s; return MLAT + b * CTXL + t; } s -= CTXL; const int t = dir ? SEQ - 1 - s : s; return b * SEQ + t; }
__device__ __forceinline__ float Pat(const bf16* P, int row, int col) { return bf2f(P[(size_t)row * NP + col]); }
__device__ __forceinline__ float shifted(const bf16* P, int row, int col, float mu) {
    int pos, len; seq_pos(row, pos, len);
    const float p = Pat(P, row, col), pv = pos > 0 ? Pat(P, row - 1, col) : 0.f, nx = pos < len - 1 ? Pat(P, row + 1, col) : 0.f;
    return p + mu * (0.5f * (pv + nx) - p);
}
__device__ __forceinline__ float dwconv(const bf16* P, int row, int col, const float* w, int ncol, int wc, float bias) {
    int pos, len; seq_pos(row, pos, len);
    float o = bias;
#pragma unroll
    for (int tap = 0; tap < 4; ++tap) { const int q = pos + tap - 2; if (q >= 0 && q < len) o += w[tap * ncol + wc] * Pat(P, row + tap - 2, col); }
    return o;
}
#define LAS3 __attribute__((address_space(3)))

struct Frame { const Args* a; unsigned char* ws; LAS3 unsigned char* lds; int tid, lane, wave, G, bid; };

__device__ __forceinline__ void phase_mod(const Frame& F) {
    LAS3 float* sv = (LAS3 float*)F.lds;
    LAS3 float* red = sv + 3 * 2048;
    const float* c = F.a->in[I_C]; const float* cc = F.a->in[I_CCTX];
    for (int i = F.tid; i < 3 * 2048; i += 512) { const int w = i >> 11, k = i & 2047; const float x = w < 2 ? c[w * 2048 + k] : cc[k]; sv[i] = siluf(x); }
    __syncthreads();
    float* mod = (float*)(F.ws + WS_MOD);
    const int kg = F.tid >> 7, j = F.tid & 127;
    for (int unit = F.bid; unit < 192; unit += F.G) {
        const int layer = unit / 96, col = (unit % 96) * 128 + j;
        const float* W = F.a->in[I_ADAW] + (size_t)layer * 2048 * 12288 + col;
        float a0 = 0.f, a1 = 0.f, a2 = 0.f;
        for (int k = kg * 512; k < kg * 512 + 512; ++k) { const float w = W[(size_t)k * 12288]; a0 += sv[k] * w; a1 += sv[2048 + k] * w; a2 += sv[4096 + k] * w; }
        red[(kg * 3 + 0) * 128 + j] = a0; red[(kg * 3 + 1) * 128 + j] = a1; red[(kg * 3 + 2) * 128 + j] = a2;
        __syncthreads();
        if (F.tid < 384) { const int w = F.tid >> 7; float s = F.a->in[I_ADAB][layer * 12288 + col];
            for (int q = 0; q < 4; ++q) s += red[(q * 3 + w) * 128 + j];
            mod[(size_t)(layer * 3 + w) * 12288 + col] = s; }
        __syncthreads();
    }
}

__device__ __forceinline__ int map_row(int type, int base, int n) {
    if (type == 0) return base + n;
    if (type == 2) return base + (n >> 7) * 256 + (n & 127);
    if (n < 16384) return n;
    if (n < 17024) return PWL + (n - 16384);
    if (n < 22144) return n - 640;
    return PDT + (n - 22144);
}
__device__ __forceinline__ void convT(const Frame& F, const float* src, int K, int N, bf16* dst, int type, int base, int& tile_rot) {
    LAS3 float* tile = (LAS3 float*)F.lds;
    const int nkt = K / 64, nnt = N / 64, nt = nkt * nnt;
    for (int t = (F.bid + F.G - (tile_rot % F.G)) % F.G; t < nt; t += F.G) {
        const int kt = t % nkt, ntl = t / nkt, k0 = kt * 64, n0 = ntl * 64;
        { const int r = F.tid >> 4, c4 = (F.tid & 15) * 4;
#pragma unroll
          for (int p = 0; p < 2; ++p) { const f32x4 v = *(const f32x4*)(src + (size_t)(k0 + r + p * 32) * N + n0 + c4);
              tile[(r + p * 32) * 65 + c4 + 0] = v[0]; tile[(r + p * 32) * 65 + c4 + 1] = v[1]; tile[(r + p * 32) * 65 + c4 + 2] = v[2]; tile[(r + p * 32) * 65 + c4 + 3] = v[3]; } }
        __syncthreads();
        { const int n = F.tid >> 3, kq = (F.tid & 7) * 8; float v[8];
#pragma unroll
          for (int i = 0; i < 8; ++i) v[i] = tile[(kq + i) * 65 + n];
          v4u w; w.x = pk2(v[0], v[1]); w.y = pk2(v[2], v[3]); w.z = pk2(v[4], v[5]); w.w = pk2(v[6], v[7]);
          *(v4u*)(dst + (size_t)map_row(type, base, n0 + n) * K + k0 + kq) = w; }
        __syncthreads();
    }
    tile_rot += nt;
}
__device__ __forceinline__ void phase_convw_layer(const Frame& F, int L) {
    int rot = 0;
    bf16* wt_in = (bf16*)(F.ws + WS_X1); bf16* wt_out = (bf16*)(F.ws + WS_WOUT);
    convT(F, F.a->in[I_WIN] + (size_t)L * 2048 * N_IN, 2048, N_IN, wt_in, 1, 0, rot);
    for (int i = F.bid * 512 + F.tid; i < 64 * 2048 / 8; i += F.G * 512) ((v4u*)(wt_in + (size_t)N_IN * 2048))[i] = (v4u){0u, 0u, 0u, 0u};
    convT(F, F.a->in[I_WOL] + (size_t)L * 2048 * 2048, 2048, 2048, wt_out, 0, 0, rot);
    convT(F, F.a->in[I_WOR] + (size_t)L * 2048 * 2048, 2048, 2048, wt_out, 0, 2048, rot);
    convT(F, F.a->in[I_WOS] + (size_t)L * 2048 * 2048, 2048, 2048, wt_out, 0, 4096, rot);
    convT(F, F.a->in[I_WO] + (size_t)L * 2048 * 2048, 2048, 2048, wt_out, 0, 6144, rot);
}
__device__ __forceinline__ void phase_convw_ffn(const Frame& F, int L) {
    int rot = 0;
    if (L == 0) {
        convT(F, F.a->in[I_F1], 2048, 6144, (bf16*)(F.ws + WS_F13), 2, 0, rot);
        convT(F, F.a->in[I_F3], 2048, 6144, (bf16*)(F.ws + WS_F13), 2, 128, rot);
        convT(F, F.a->in[I_F2], 6144, 2048, (bf16*)(F.ws + WS_F2), 0, 0, rot);
    } else {
        for (int e = 0; e < 8; ++e) {
            convT(F, F.a->in[I_M1] + (size_t)e * 2048 * 3072, 2048, 3072, (bf16*)(F.ws + WS_M13), 2, e * 6144, rot);
            convT(F, F.a->in[I_M3] + (size_t)e * 2048 * 3072, 2048, 3072, (bf16*)(F.ws + WS_M13), 2, e * 6144 + 128, rot);
            convT(F, F.a->in[I_M2] + (size_t)e * 3072 * 2048, 3072, 2048, (bf16*)(F.ws + WS_M2), 0, e * 2048, rot);
        }
    }
}

template <bool ROUTER> __forceinline__
__device__ __forceinline__ void phase_norm(const Frame& F, const float* hlat, const float* hctx, const float* gain, const float* modL, int sh_off, int sc_off, bf16* out, int permute, int nrows) {
    const float* router = F.a->in[I_MR];
    int* rt = (int*)(F.ws + WS_ROUTE); unsigned* ctl = (unsigned*)(F.ws + WS_CTL);
    for (int row = F.bid * 8 + F.wave; row < nrows; row += F.G * 8) {
        const float* src; const float* mv; int drow;
        if (row < MLAT) { const int b = row >> 13, l = row & 8191; src = hlat + (size_t)row * D; mv = modL + b * 12288;
            drow = permute ? (b * 8192 + (l & 63) * 128 + (l >> 6)) : row; }
        else { src = hctx + (size_t)(row - MLAT) * D; mv = modL + 2 * 12288; drow = row; }
        f32x4 x[8]; float ss = 0.f;
#pragma unroll
        for (int i = 0; i < 8; ++i) { x[i] = *(const f32x4*)(src + i * 256 + F.lane * 4); ss += x[i][0] * x[i][0] + x[i][1] * x[i][1] + x[i][2] * x[i][2] + x[i][3] * x[i][3]; }
        ss = wave_sum(ss);
        const float rs = rsqrtf(ss * (1.0f / D) + EPS);
        float lg[8];
        if (ROUTER) {
#pragma unroll
            for (int e = 0; e < 8; ++e) lg[e] = 0.f; }
#pragma unroll
        for (int i = 0; i < 8; ++i) { const int c = i * 256 + F.lane * 4;
            const f32x4 g = *(const f32x4*)(gain + c), sc = *(const f32x4*)(mv + sc_off + c), sh = *(const f32x4*)(mv + sh_off + c);
            f32x4 v;
#pragma unroll
            for (int j = 0; j < 4; ++j) v[j] = x[i][j] * rs * g[j] * (1.0f + sc[j]) + sh[j];
            uint2 w; w.x = pk2(v[0], v[1]); w.y = pk2(v[2], v[3]);
            *(uint2*)(out + (size_t)drow * D + c) = w;
            if (ROUTER) {
#pragma unroll
                for (int j = 0; j < 4; ++j) { const f32x4 r0 = *(const f32x4*)(router + (size_t)(c + j) * 8), r1 = *(const f32x4*)(router + (size_t)(c + j) * 8 + 4);
                    lg[0] += v[j] * r0[0]; lg[1] += v[j] * r0[1]; lg[2] += v[j] * r0[2]; lg[3] += v[j] * r0[3]; lg[4] += v[j] * r1[0]; lg[5] += v[j] * r1[1]; lg[6] += v[j] * r1[2]; lg[7] += v[j] * r1[3]; } }
        }
        if (ROUTER) {
#pragma unroll
            for (int e = 0; e < 8; ++e) lg[e] = wave_sum(lg[e]);
            if (F.lane == 0) {
                int e0 = 0; float v0 = lg[0];
#pragma unroll
                for (int e = 1; e < 8; ++e) if (lg[e] > v0) { v0 = lg[e]; e0 = e; }
                int e1 = -1; float v1 = -3.0e38f;
#pragma unroll
                for (int e = 0; e < 8; ++e) if (e != e0 && lg[e] > v1) { v1 = lg[e]; e1 = e; }
                const float p0 = 1.0f / (1.0f + __expf(v1 - v0));
                rt[RT_TOKE + row * 2] = e0; rt[RT_TOKE + row * 2 + 1] = e1;
                ((float*)rt)[RT_TOKP + row * 2] = p0; ((float*)rt)[RT_TOKP + row * 2 + 1] = 1.0f - p0;
                atomicAdd(&ctl[CW_CNT + e0], 1u); atomicAdd(&ctl[CW_CNT + e1], 1u);
            }
        }
    }
}

__device__ __forceinline__ void phase_rwkv_seq(const Frame& F, int L) {
    const bf16* P = (const bf16*)(F.ws + WS_P);
    bf16* ydir = (bf16*)(F.ws + WS_X1);
    float* bonus = (float*)(F.ws + WS_BONUS);
    const float* mu = F.a->in[I_RMU] + (size_t)L * 6784;
    LAS3 float* Fr = (LAS3 float*)F.lds; LAS3 float* Fk = Fr + 2048; LAS3 float* Fv = Fk + 2048; LAS3 float* Fa = Fv + 2048; LAS3 float* Fb = Fa + 2048; LAS3 float* Fw = Fb + 2048;
    LAS3 float* Lw = Fw + 2048; LAS3 float* La = Lw + 32 * 96; LAS3 float* Yb = La + 32 * 96;
    for (int unit = F.bid; unit < 128; unit += F.G) {
        const int b = unit >> 6, h = (unit >> 1) & 31, d = unit & 1;
        const float* w0 = F.a->in[I_RW0] + (size_t)(L * 2 + d) * 2048; const float* a0 = F.a->in[I_RA0] + (size_t)(L * 2 + d) * 2048;
        const float* wup = F.a->in[I_RWUP] + (size_t)(L * 2 + d) * 96 * 2048; const float* aup = F.a->in[I_RAUP] + (size_t)(L * 2 + d) * 96 * 2048;
        const float* kkw = F.a->in[I_RKK] + (size_t)L * 2048; const float* kaw = F.a->in[I_RKA] + (size_t)L * 2048; const float* rkw = F.a->in[I_RRK] + (size_t)L * 2048;
        float S[8];
#pragma unroll
        for (int j = 0; j < 8; ++j) S[j] = 0.f;
        for (int ch = 0; ch < 264; ++ch) {
            for (int idx = F.tid; idx < 32 * 96; idx += 512) { const int t = idx / 96, j = idx - t * 96; const int row = chain_row(b, d, ch * 32 + t);
                Lw[idx] = tanhf(shifted(P, row, PWL + d * 96 + j, mu[6144 + d * 96 + j]));
                La[idx] = shifted(P, row, PAL + d * 96 + j, mu[6144 + 192 + d * 96 + j]); }
            __syncthreads();
            for (int i = 0; i < 4; ++i) { const int t = F.wave * 4 + i, c = F.lane, col = h * 64 + c; const int row = chain_row(b, d, ch * 32 + t);
                const float r = shifted(P, row, PR + col, mu[col]), k = shifted(P, row, PK + col, mu[2048 + col]), v = shifted(P, row, PV + col, mu[4096 + col]);
                float wpre = w0[col], apre = a0[col];
                for (int j = 0; j < 96; ++j) { wpre += Lw[t * 96 + j] * wup[(size_t)j * 2048 + col]; apre += La[t * 96 + j] * aup[(size_t)j * 2048 + col]; }
                const float wraw = -softplusf(-wpre) - 0.5f, wdec = __expf(-__expf(wraw)), asig = sigm(apre);
                const float kkv = k * kkw[col], n2 = wave_sum(kkv * kkv), kk = kkv * rsqrtf(n2 + 1e-12f);
                const float key = k * (1.0f + (asig - 1.0f) * kaw[col]);
                const float bon = wave_sum(r * key * rkw[col]);
                if (c == 0) bonus[((size_t)d * MROWS + row) * 32 + h] = bon;
                Fr[t * 64 + c] = r; Fk[t * 64 + c] = key; Fv[t * 64 + c] = v; Fa[t * 64 + c] = -kk; Fb[t * 64 + c] = kk * asig; Fw[t * 64 + c] = wdec; }
            __syncthreads();
            { const int vi = F.tid >> 3, kp = F.tid & 7;
              for (int t = 0; t < 32; ++t) { const int o = t * 64 + kp * 8;
                  float sa = 0.f;
#pragma unroll
                  for (int j = 0; j < 8; ++j) sa += S[j] * Fa[o + j];
                  sa += __shfl_xor(sa, 1); sa += __shfl_xor(sa, 2); sa += __shfl_xor(sa, 4);
                  const float vv = Fv[t * 64 + vi]; float y = 0.f;
#pragma unroll
                  for (int j = 0; j < 8; ++j) { S[j] = S[j] * Fw[o + j] + sa * Fb[o + j] + vv * Fk[o + j]; y += S[j] * Fr[o + j]; }
                  y += __shfl_xor(y, 1); y += __shfl_xor(y, 2); y += __shfl_xor(y, 4);
                  if (kp == 0) Yb[t * 64 + vi] = y; } }
            __syncthreads();
            for (int idx = F.tid; idx < 2048; idx += 512) { const int t = idx >> 6, c = idx & 63; const int row = chain_row(b, d, ch * 32 + t);
                ydir[((size_t)d * MROWS + row) * D + h * 64 + c] = f2bf(Yb[idx]); }
        }
        __syncthreads();
    }
}
__device__ __forceinline__ void phase_rwkv_out(const Frame& F, int L) {
    const bf16* P = (const bf16*)(F.ws + WS_P);
    const bf16* ydir = (const bf16*)(F.ws + WS_X1);
    const float* bonus = (const float*)(F.ws + WS_BONUS);
    bf16* Y = (bf16*)(F.ws + WS_Y3) + (size_t)1 * MROWS * D;
    const float* mu = F.a->in[I_RMU] + (size_t)L * 6784;
    const float* gup = F.a->in[I_RGUP] + (size_t)L * 256 * 2048;
    const float* lnw = F.a->in[I_RLNW] + (size_t)L * 2048; const float* lnb = F.a->in[I_RLNB] + (size_t)L * 2048;
    LAS3 float* sg = (LAS3 float*)F.lds;
    const int c4 = F.tid * 4, h = c4 >> 6;
    for (int unit = F.bid; unit < MROWS / 16; unit += F.G) {
        const int row0 = unit * 16;
        for (int idx = F.tid; idx < 16 * 256; idx += 512) { const int t = idx >> 8, j = idx & 255; sg[idx] = sigm(shifted(P, row0 + t, PGL + j, mu[6144 + 384 + j])); }
        __syncthreads();
        f32x4 g[16];
#pragma unroll
        for (int t = 0; t < 16; ++t) g[t] = (f32x4){0.f, 0.f, 0.f, 0.f};
        for (int j = 0; j < 256; ++j) { const f32x4 w = *(const f32x4*)(gup + (size_t)j * 2048 + c4);
#pragma unroll
            for (int t = 0; t < 16; ++t) { const float s = sg[t * 256 + j]; g[t] += w * s; } }
        const f32x4 lw = *(const f32x4*)(lnw + c4), lb = *(const f32x4*)(lnb + c4);
        const f32x4 muv = *(const f32x4*)(mu + 4096 + c4);
#pragma unroll
        for (int t = 0; t < 16; ++t) { const int row = row0 + t;
            const uint2 a = *(const uint2*)(ydir + (size_t)row * D + c4), bb = *(const uint2*)(ydir + ((size_t)MROWS + row) * D + c4);
            f32x4 y; y[0] = pg8::bf_lo(a.x) + pg8::bf_lo(bb.x); y[1] = pg8::bf_hi(a.x) + pg8::bf_hi(bb.x); y[2] = pg8::bf_lo(a.y) + pg8::bf_lo(bb.y); y[3] = pg8::bf_hi(a.y) + pg8::bf_hi(bb.y);
            float s = y[0] + y[1] + y[2] + y[3];
            s += __shfl_xor(s, 1); s += __shfl_xor(s, 2); s += __shfl_xor(s, 4); s += __shfl_xor(s, 8);
            const float mean = s * (1.0f / 64.0f);
            float q = 0.f;
#pragma unroll
            for (int j = 0; j < 4; ++j) { const float dlt = y[j] - mean; q += dlt * dlt; }
            q += __shfl_xor(q, 1); q += __shfl_xor(q, 2); q += __shfl_xor(q, 4); q += __shfl_xor(q, 8);
            const float rstd = rsqrtf(q * (1.0f / 64.0f) + 64e-5f);
            const float bon = bonus[(size_t)row * 32 + h] + bonus[((size_t)MROWS + row) * 32 + h];
            float o[4];
#pragma unroll
            for (int j = 0; j < 4; ++j) { const float vv = shifted(P, row, PV + c4 + j, muv[j]); o[j] = ((y[j] - mean) * rstd * lw[j] + lb[j] + bon * vv) * g[t][j]; }
            uint2 w; w.x = pk2(o[0], o[1]); w.y = pk2(o[2], o[3]);
            *(uint2*)(Y + (size_t)row * D + c4) = w; }
        __syncthreads();
    }
}

__device__ __forceinline__ void phase_ssm_seq(const Frame& F, int L) {
    const bf16* P = (const bf16*)(F.ws + WS_P);
    bf16* ydir = (bf16*)(F.ws + WS_X1);
    const float* cw = F.a->in[I_SCW] + (size_t)L * 4 * 3072; const float* cb = F.a->in[I_SCB] + (size_t)L * 3072;
    LAS3 float* X = (LAS3 float*)F.lds; LAS3 float* Bm = X + 32 * 64; LAS3 float* Cm = Bm + 32 * 128; LAS3 float* dtv = Cm + 32 * 128; LAS3 float* dav = dtv + 32; LAS3 float* Yb = dav + 32;
    for (int unit = F.bid; unit < 128; unit += F.G) {
        const int b = unit >> 6, h = (unit >> 1) & 31, d = unit & 1, g = h >> 3;
        const float Ad = -__expf(F.a->in[I_SALOG][(L * 2 + d) * 32 + h]); const float dtb = F.a->in[I_SDTB][(L * 2 + d) * 32 + h];
        float hs[16];
#pragma unroll
        for (int j = 0; j < 16; ++j) hs[j] = 0.f;
        for (int ch = 0; ch < 264; ++ch) {
            for (int idx = F.tid; idx < 32 * 320; idx += 512) { const int t = idx / 320, q = idx - t * 320; const int row = chain_row(b, d, ch * 32 + t);
                const int col = q < 64 ? h * 64 + q : (q < 192 ? 2048 + g * 128 + (q - 64) : 2560 + g * 128 + (q - 192));
                const float v = siluf(dwconv(P, row, PX + col, cw, 3072, col, cb[col]));
                if (q < 64) X[t * 64 + q] = v; else if (q < 192) Bm[t * 128 + q - 64] = v; else Cm[t * 128 + q - 192] = v; }
            if (F.tid < 32) { const int row = chain_row(b, d, ch * 32 + F.tid); const float dt = softplusf(Pat(P, row, PDT + d * 32 + h) + dtb); dtv[F.tid] = dt; dav[F.tid] = __expf(dt * Ad); }
            __syncthreads();
            { const int p = F.tid >> 3, np = F.tid & 7;
              for (int t = 0; t < 32; ++t) { const float da = dav[t], xs = dtv[t] * X[t * 64 + p]; float y = 0.f;
#pragma unroll
                  for (int j = 0; j < 16; ++j) { hs[j] = hs[j] * da + xs * Bm[t * 128 + np * 16 + j]; y += hs[j] * Cm[t * 128 + np * 16 + j]; }
                  y += __shfl_xor(y, 1); y += __shfl_xor(y, 2); y += __shfl_xor(y, 4);
                  if (np == 0) Yb[t * 64 + p] = y; } }
            __syncthreads();
            for (int idx = F.tid; idx < 2048; idx += 512) { const int t = idx >> 6, c = idx & 63; const int row = chain_row(b, d, ch * 32 + t);
                ydir[((size_t)d * MROWS + row) * D + h * 64 + c] = f2bf(Yb[idx]); }
        }
        __syncthreads();
    }
}
__device__ __forceinline__ void phase_ssm_out(const Frame& F, int L) {
    const bf16* P = (const bf16*)(F.ws + WS_P);
    const bf16* ydir = (const bf16*)(F.ws + WS_X1);
    bf16* Y = (bf16*)(F.ws + WS_Y3) + (size_t)2 * MROWS * D;
    const float* cw = F.a->in[I_SCW] + (size_t)L * 4 * 3072; const float* cb = F.a->in[I_SCB] + (size_t)L * 3072;
    const float* dsk = F.a->in[I_SD] + (size_t)L * 32; const float* nw = F.a->in[I_SNW] + (size_t)L * 2048;
    for (int row = F.bid * 8 + F.wave; row < MROWS; row += F.G * 8) {
#pragma unroll 1
        for (int g = 0; g < 4; ++g) { const int c0 = g * 512 + F.lane * 8;
            const v4u a = *(const v4u*)(ydir + (size_t)row * D + c0), bb = *(const v4u*)(ydir + ((size_t)MROWS + row) * D + c0), zz = *(const v4u*)(P + (size_t)row * NP + PZ + c0);
            float y[8], z[8];
            y[0] = pg8::bf_lo(a.x) + pg8::bf_lo(bb.x); y[1] = pg8::bf_hi(a.x) + pg8::bf_hi(bb.x); y[2] = pg8::bf_lo(a.y) + pg8::bf_lo(bb.y); y[3] = pg8::bf_hi(a.y) + pg8::bf_hi(bb.y);
            y[4] = pg8::bf_lo(a.z) + pg8::bf_lo(bb.z); y[5] = pg8::bf_hi(a.z) + pg8::bf_hi(bb.z); y[6] = pg8::bf_lo(a.w) + pg8::bf_lo(bb.w); y[7] = pg8::bf_hi(a.w) + pg8::bf_hi(bb.w);
            z[0] = pg8::bf_lo(zz.x); z[1] = pg8::bf_hi(zz.x); z[2] = pg8::bf_lo(zz.y); z[3] = pg8::bf_hi(zz.y); z[4] = pg8::bf_lo(zz.z); z[5] = pg8::bf_hi(zz.z); z[6] = pg8::bf_lo(zz.w); z[7] = pg8::bf_hi(zz.w);
            const float dk = dsk[c0 >> 6]; float ss = 0.f;
#pragma unroll
            for (int j = 0; j < 8; ++j) { const float x = siluf(dwconv(P, row, PX + c0 + j, cw, 3072, c0 + j, cb[c0 + j])); y[j] = (y[j] + dk * x) * siluf(z[j]); ss += y[j] * y[j]; }
            ss = wave_sum(ss);
            const float rs = rsqrtf(ss * (1.0f / 512.0f) + EPS);
            v4u w; w.x = pk2(y[0] * rs * nw[c0 + 0], y[1] * rs * nw[c0 + 1]); w.y = pk2(y[2] * rs * nw[c0 + 2], y[3] * rs * nw[c0 + 3]);
            w.z = pk2(y[4] * rs * nw[c0 + 4], y[5] * rs * nw[c0 + 5]); w.w = pk2(y[6] * rs * nw[c0 + 6], y[7] * rs * nw[c0 + 7]);
            *(v4u*)(Y + (size_t)row * D + c0) = w; }
    }
}

__device__ __forceinline__ void phase_lru_seq(const Frame& F, int L) {
    const bf16* P = (const bf16*)(F.ws + WS_P);
    bf16* hdir = (bf16*)(F.ws + WS_X1);
    const float* cw = F.a->in[I_LCW] + (size_t)L * 4 * 2048; const float* cb = F.a->in[I_LCB] + (size_t)L * 2048;
    LAS3 float* Xc = (LAS3 float*)F.lds; LAS3 float* Ga = Xc + 32 * 128; LAS3 float* Gb = Ga + 32 * 128; LAS3 float* Hb = Gb + 32 * 128;
    for (int unit = F.bid; unit < 64; unit += F.G) {
        const int b = unit >> 5, n = (unit >> 1) & 15, d = unit & 1;
        const int half = F.tid >> 8, gi = (F.tid >> 7) & 1, j = F.tid & 127, col = n * 128 + j;
        const float* gw = F.a->in[I_LGW] + ((((size_t)L * 2 + d) * 2 + gi) * 16 + n) * 128 * 128;
        const float gb = F.a->in[I_LGB][(((size_t)L * 2 + d) * 2 + gi) * 2048 + col];
        const float sp = softplusf(-F.a->in[I_LLAM][((size_t)L * 2 + d) * 2048 + col]);
        float hst = 0.f;
        for (int ch = 0; ch < 264; ++ch) {
            for (int idx = F.tid; idx < 32 * 128; idx += 512) { const int t = idx >> 7, k = idx & 127; const int row = chain_row(b, d, ch * 32 + t);
                Xc[idx] = dwconv(P, row, PL + n * 128 + k, cw, 2048, n * 128 + k, cb[n * 128 + k]); }
            __syncthreads();
            { float acc[16];
#pragma unroll
              for (int i = 0; i < 16; ++i) acc[i] = gb;
              for (int k = 0; k < 128; ++k) { const float w = gw[k * 128 + j];
#pragma unroll
                  for (int i = 0; i < 16; ++i) acc[i] += Xc[(half * 16 + i) * 128 + k] * w; }
#pragma unroll
              for (int i = 0; i < 16; ++i) { const float s = sigm(acc[i]); if (gi == 0) Ga[(half * 16 + i) * 128 + j] = -8.0f * s * sp; else Gb[(half * 16 + i) * 128 + j] = s; } }
            __syncthreads();
            if (F.tid < 128) { for (int t = 0; t < 32; ++t) { const float la = Ga[t * 128 + j], a = __expf(la); const float bx = sqrtf(-expm1f(2.0f * la)) * Gb[t * 128 + j] * Xc[t * 128 + j]; hst = a * hst + bx; Hb[t * 128 + j] = hst; } }
            __syncthreads();
            for (int idx = F.tid; idx < 32 * 128; idx += 512) { const int t = idx >> 7, k = idx & 127; const int row = chain_row(b, d, ch * 32 + t);
                hdir[((size_t)d * MROWS + row) * D + n * 128 + k] = f2bf(Hb[idx]); }
        }
        __syncthreads();
    }
}
__device__ __forceinline__ void phase_lru_out(const Frame& F, int L) {
    const bf16* P = (const bf16*)(F.ws + WS_P);
    const bf16* hdir = (const bf16*)(F.ws + WS_X1);
    bf16* Y = (bf16*)(F.ws + WS_Y3);
    for (size_t i = (size_t)F.bid * 512 + F.tid; i < (size_t)MROWS * D / 8; i += (size_t)F.G * 512) { const int row = (int)(i >> 8), c0 = (int)(i & 255) * 8;
        const v4u a = *(const v4u*)(hdir + (size_t)row * D + c0), bb = *(const v4u*)(hdir + ((size_t)MROWS + row) * D + c0), gg = *(const v4u*)(P + (size_t)row * NP + PLG + c0);
        v4u w;
        w.x = pk2((pg8::bf_lo(a.x) + pg8::bf_lo(bb.x)) * gelu_tanh(pg8::bf_lo(gg.x)), (pg8::bf_hi(a.x) + pg8::bf_hi(bb.x)) * gelu_tanh(pg8::bf_hi(gg.x)));
        w.y = pk2((pg8::bf_lo(a.y) + pg8::bf_lo(bb.y)) * gelu_tanh(pg8::bf_lo(gg.y)), (pg8::bf_hi(a.y) + pg8::bf_hi(bb.y)) * gelu_tanh(pg8::bf_hi(gg.y)));
        w.z = pk2((pg8::bf_lo(a.z) + pg8::bf_lo(bb.z)) * gelu_tanh(pg8::bf_lo(gg.z)), (pg8::bf_hi(a.z) + pg8::bf_hi(bb.z)) * gelu_tanh(pg8::bf_hi(gg.z)));
        w.w = pk2((pg8::bf_lo(a.w) + pg8::bf_lo(bb.w)) * gelu_tanh(pg8::bf_lo(gg.w)), (pg8::bf_hi(a.w) + pg8::bf_hi(bb.w)) * gelu_tanh(pg8::bf_hi(gg.w)));
        *(v4u*)(Y + (size_t)row * D + c0) = w; }
}

__device__ __forceinline__ void phase_route(const Frame& F) {
    int* rt = (int*)(F.ws + WS_ROUTE); unsigned* ctl = (unsigned*)(F.ws + WS_CTL);
    const bf16* V = (const bf16*)(F.ws + WS_U); bf16* A = (bf16*)(F.ws + WS_MA);
    int base[9]; base[0] = 0;
#pragma unroll
    for (int e = 0; e < 8; ++e) { const int c = (int)__hip_atomic_load(&ctl[CW_CNT + e], __ATOMIC_RELAXED, __HIP_MEMORY_SCOPE_AGENT); base[e + 1] = base[e] + ((c + 255) & ~255); }
    if (F.bid == 0 && F.tid == 0) { rt[RT_NT] = base[8] >> 8; for (int e = 0; e < 8; ++e) { rt[RT_BASE + e] = base[e]; for (int t = base[e] >> 8; t < (base[e + 1] >> 8); ++t) rt[RT_TILEE + t] = e; } }
    for (int tok = F.bid * 8 + F.wave; tok < MLAT; tok += F.G * 8) {
        int r0 = 0, r1 = 0;
        if (F.lane == 0) { const int e0 = rt[RT_TOKE + tok * 2], e1 = rt[RT_TOKE + tok * 2 + 1];
            int b0 = 0, b1 = 0;
#pragma unroll
            for (int e = 0; e < 8; ++e) { if (e == e0) b0 = base[e]; if (e == e1) b1 = base[e]; }
            r0 = b0 + (int)atomicAdd(&ctl[CW_CUR + e0], 1u); r1 = b1 + (int)atomicAdd(&ctl[CW_CUR + e1], 1u);
            rt[RT_TOKROW + tok * 2] = r0; rt[RT_TOKROW + tok * 2 + 1] = r1; }
        r0 = __shfl(r0, 0); r1 = __shfl(r1, 0);
#pragma unroll
        for (int i = 0; i < 4; ++i) { const v4u v = *(const v4u*)(V + (size_t)tok * D + i * 512 + F.lane * 8);
            *(v4u*)(A + (size_t)r0 * D + i * 512 + F.lane * 8) = v; *(v4u*)(A + (size_t)r1 * D + i * 512 + F.lane * 8) = v; }
    }
    for (int e = 0; e < 8; ++e) { const int c = (int)__hip_atomic_load(&ctl[CW_CNT + e], __ATOMIC_RELAXED, __HIP_MEMORY_SCOPE_AGENT); const int lo = base[e] + c, hi = base[e + 1];
        for (int row = lo + F.bid * 8 + F.wave; row < hi; row += F.G * 8)
#pragma unroll
            for (int i = 0; i < 4; ++i) *(v4u*)(A + (size_t)row * D + i * 512 + F.lane * 8) = (v4u){0u, 0u, 0u, 0u}; }
}
__device__ __forceinline__ void phase_final(const Frame& F, const float* modL) {
    const int* rt = (const int*)(F.ws + WS_ROUTE);
    const float* hlat = (const float*)(F.ws + WS_HLAT); const bf16* O = (const bf16*)(F.ws + WS_X1);
    const float* nf = F.a->in[I_NFIN]; float* out = F.a->out;
    for (int tok = F.bid * 8 + F.wave; tok < MLAT; tok += F.G * 8) {
        const int b = tok >> 13; const float* gf = modL + b * 12288 + 5 * 2048;
        const int r0 = rt[RT_TOKROW + tok * 2], r1 = rt[RT_TOKROW + tok * 2 + 1]; const float p0 = ((const float*)rt)[RT_TOKP + tok * 2], p1 = ((const float*)rt)[RT_TOKP + tok * 2 + 1];
        f32x4 x[8]; float ss = 0.f;
#pragma unroll
        for (int i = 0; i < 8; ++i) { const int c = i * 256 + F.lane * 4;
            const f32x4 h = *(const f32x4*)(hlat + (size_t)tok * D + c), g = *(const f32x4*)(gf + c);
            const uint2 a = *(const uint2*)(O + (size_t)r0 * D + c), bb = *(const uint2*)(O + (size_t)r1 * D + c);
            f32x4 m; m[0] = p0 * pg8::bf_lo(a.x) + p1 * pg8::bf_lo(bb.x); m[1] = p0 * pg8::bf_hi(a.x) + p1 * pg8::bf_hi(bb.x); m[2] = p0 * pg8::bf_lo(a.y) + p1 * pg8::bf_lo(bb.y); m[3] = p0 * pg8::bf_hi(a.y) + p1 * pg8::bf_hi(bb.y);
            x[i] = h + g * m; ss += x[i][0] * x[i][0] + x[i][1] * x[i][1] + x[i][2] * x[i][2] + x[i][3] * x[i][3]; }
        ss = wave_sum(ss);
        const float rs = rsqrtf(ss * (1.0f / D) + EPS);
#pragma unroll
        for (int i = 0; i < 8; ++i) { const int c = i * 256 + F.lane * 4; const f32x4 g = *(const f32x4*)(nf + c); *(f32x4*)(out + (size_t)tok * D + c) = x[i] * rs * g; }
    }
}

constexpr int NPH_LAYER = 17, NPH = 1 + 2 * NPH_LAYER;
#if !MK_PER_PHASE
#define SEAM() xcd_barrier(bar)
#else
#define SEAM() do {} while (0)
#endif
#define IN(k) (lo <= (PB + (k)) && (PB + (k)) < hi)
template <int L>
__device__ __forceinline__ void layer_program(const Frame& F, const Args& args, const XcdBarrier& bar, const int lo, const int hi) {
    constexpr int PB = 1 + L * NPH_LAYER;
    const float* modL = (const float*)(F.ws + WS_MOD) + (size_t)L * 3 * 12288;
    if (IN(0)) { phase_convw_layer(F, L); SEAM(); }
    if (IN(1)) { phase_norm<false>(F, L == 0 ? args.in[I_X] : (const float*)(F.ws + WS_HLAT), L == 0 ? args.in[I_CTX] : (const float*)(F.ws + WS_HCTX), args.in[I_NMIX] + L * 2048, modL, 0, 2048, (bf16*)(F.ws + WS_U), L & 1, MROWS); SEAM(); }
    if (IN(2)) { pg8::Gemm g{(const bf16*)(F.ws + WS_U), (const bf16*)(F.ws + WS_X1), MROWS, NP, 2048}; pg8::StaticOrder S; S.init(MROWS, NP, F.G, F.bid); pg8::EpiStoreBf16 E{(bf16*)(F.ws + WS_P), NP, 0};
        pg8::gemm_phase<pg8::EpiStoreBf16, pg8::StaticOrder, false>(F.lds, g, S, E, nullptr); SEAM(); }
    if (IN(3)) { phase_rwkv_seq(F, L); SEAM(); }
    if (IN(4)) { phase_rwkv_out(F, L); SEAM(); }
    if (IN(5)) { phase_ssm_seq(F, L); SEAM(); }
    if (IN(6)) { phase_ssm_out(F, L); SEAM(); }
    if (IN(7)) { phase_lru_seq(F, L); SEAM(); }
    if (IN(8)) { phase_lru_out(F, L); SEAM(); }
    constexpr int nM = L == 1 ? 64 : 66;
    if (IN(9)) { pg8::Gemm g{(const bf16*)(F.ws + WS_Y3), (const bf16*)(F.ws + WS_WOUT), MROWS, 2048, 2048}; pg8::MergeOrder S{nM * 8, F.G, F.bid}; pg8::EpiMerge E{(const bf16*)(F.ws + WS_P), NP, (bf16*)(F.ws + WS_X1)};
        pg8::gemm_phase<pg8::EpiMerge, pg8::MergeOrder, false>(F.lds, g, S, E, nullptr); SEAM(); }
    if (IN(10)) { pg8::Gemm g{(const bf16*)(F.ws + WS_X1), (const bf16*)(F.ws + WS_WOUT) + (size_t)3 * 2048 * 2048, nM * 256, 2048, 2048}; pg8::StaticOrder S; S.init(nM * 256, 2048, F.G, F.bid);
        pg8::EpiResid E{L == 0 ? args.in[I_X] : (const float*)(F.ws + WS_HLAT), L == 0 ? args.in[I_CTX] : (const float*)(F.ws + WS_HCTX), (float*)(F.ws + WS_HLAT), (float*)(F.ws + WS_HCTX), modL + 2 * 2048, L & 1};
        pg8::gemm_phase<pg8::EpiResid, pg8::StaticOrder, false>(F.lds, g, S, E, nullptr); SEAM(); }
    if (IN(11)) { phase_norm<L == 1>(F, (const float*)(F.ws + WS_HLAT), (const float*)(F.ws + WS_HCTX), args.in[I_NFFN] + L * 2048, modL, 3 * 2048, 4 * 2048, (bf16*)(F.ws + WS_U), 0, L == 0 ? MROWS : MLAT); SEAM(); }
    if (IN(12)) { phase_convw_ffn(F, L); SEAM(); }
    if constexpr (L == 0) {
        if (IN(13)) { pg8::Gemm g{(const bf16*)(F.ws + WS_U), (const bf16*)(F.ws + WS_F13), MROWS, 12288, 2048}; pg8::StaticOrder S; S.init(MROWS, 12288, F.G, F.bid); pg8::EpiSwiGLU E{(bf16*)(F.ws + WS_FH), 6144, 0};
            pg8::gemm_phase<pg8::EpiSwiGLU, pg8::StaticOrder, false>(F.lds, g, S, E, nullptr); SEAM(); }
        if (IN(14)) { pg8::Gemm g{(const bf16*)(F.ws + WS_FH), (const bf16*)(F.ws + WS_F2), MROWS, 2048, 6144}; pg8::StaticOrder S; S.init(MROWS, 2048, F.G, F.bid);
            pg8::EpiResid E{(const float*)(F.ws + WS_HLAT), (const float*)(F.ws + WS_HCTX), (float*)(F.ws + WS_HLAT), (float*)(F.ws + WS_HCTX), modL + 5 * 2048, 0};
            pg8::gemm_phase<pg8::EpiResid, pg8::StaticOrder, false>(F.lds, g, S, E, nullptr); SEAM(); }
    } else {
        const int* rt = (const int*)(F.ws + WS_ROUTE);
        if (IN(13)) { phase_route(F); SEAM(); }
        if (IN(14)) { pg8::Gemm g{(const bf16*)(F.ws + WS_MA), (const bf16*)(F.ws + WS_M13), MOE_ROWS, 8 * 6144, 2048}; pg8::MoeOrder S{rt + RT_TILEE, rt + RT_NT, 24, F.G, F.bid};
            pg8::EpiSwiGLU E{(bf16*)(F.ws + WS_MH), 3072, 24};
            pg8::gemm_phase<pg8::EpiSwiGLU, pg8::MoeOrder, false>(F.lds, g, S, E, nullptr); SEAM(); }
        if (IN(15)) { pg8::Gemm g{(const bf16*)(F.ws + WS_MH), (const bf16*)(F.ws + WS_M2), MOE_ROWS, 8 * 2048, 3072}; pg8::MoeOrder S{rt + RT_TILEE, rt + RT_NT, 8, F.G, F.bid};
            pg8::EpiStoreBf16 E{(bf16*)(F.ws + WS_X1), 2048, 8};
            pg8::gemm_phase<pg8::EpiStoreBf16, pg8::MoeOrder, false>(F.lds, g, S, E, nullptr); SEAM(); }
        if (IN(16)) { phase_final(F, modL); }
    }
}
#undef IN
__global__ void __launch_bounds__(512, 2) fwd(Args args) {
    extern __shared__ __attribute__((aligned(16))) unsigned char lds_raw[];
    Frame F; F.a = &args; F.ws = args.ws; F.lds = (LAS3 unsigned char*)lds_raw;
    F.tid = threadIdx.x; F.lane = F.tid & 63; F.wave = __builtin_amdgcn_readfirstlane(F.tid >> 6); F.G = gridDim.x; F.bid = blockIdx.x;
    volatile LAS3 unsigned* MISC = (volatile LAS3 unsigned*)(F.lds + MISC_OFF);
    if (F.tid < 32) MISC[F.tid] = 0u;
    __syncthreads();
    unsigned* ctl = (unsigned*)(F.ws + WS_CTL);
#if !MK_PER_PHASE
    XcdBarrier bar = xcd_barrier_post(ctl + CW_BAR, MISC + 8);
#else
    XcdBarrier bar; bar.bar = ctl + CW_BAR; bar.x = 0; bar.st = MISC + 8;
#endif
    const int lo = args.lo, hi = args.hi;
    if (lo <= 0 && 0 < hi) { phase_mod(F); SEAM(); }
    layer_program<0>(F, args, bar, lo, hi);
    layer_program<1>(F, args, bar, lo, hi);
}

extern "C" void kernel_launch(void* const* d_in, const int* in_sizes, int n_in, void* d_out, int out_size, void* d_ws, size_t ws_size, hipStream_t stream) {
    static int grid = 0;
    if (grid == 0) {
        if (n_in != N_INPUTS || out_size != MLAT * D || ws_size < WS_END) { fprintf(stderr, "kernel_launch: unexpected shapes (n_in %d, out %d, ws %zu); nothing launched\n", n_in, out_size, ws_size); grid = -1; return; }
        int dev = 0, cus = 0;
        if (hipGetDevice(&dev) != hipSuccess || hipDeviceGetAttribute(&cus, hipDeviceAttributeMultiprocessorCount, dev) != hipSuccess) { grid = -1; return; }
        if (hipFuncSetAttribute((const void*)fwd, hipFuncAttributeMaxDynamicSharedMemorySize, LDS_BYTES) != hipSuccess) { fprintf(stderr, "kernel_launch: hipFuncSetAttribute failed\n"); grid = -1; return; }
        int per_cu = 0;
        if (hipOccupancyMaxActiveBlocksPerMultiprocessor(&per_cu, (const void*)fwd, 512, LDS_BYTES) != hipSuccess || per_cu < 1) { fprintf(stderr, "kernel_launch: occupancy query says %d\n", per_cu); }
        (void)hipGetLastError();
        grid = cus;
    }
    if (grid < 0) return;
    (void)hipMemsetAsync((char*)d_ws + WS_CTL, 0, CTL_BYTES, stream);
    Args a{};
    for (int i = 0; i < N_INPUTS; ++i) a.in[i] = (const float*)d_in[i];
    a.out = (float*)d_out; a.ws = (unsigned char*)d_ws;
#if MK_PER_PHASE
    for (int p = 0; p < NPH; ++p) { a.lo = p; a.hi = p + 1; hipLaunchKernelGGL(fwd, dim3(grid), dim3(512), LDS_BYTES, stream, a); }
#else
    a.lo = 0; a.hi = NPH; hipLaunchKernelGGL(fwd, dim3(grid), dim3(512), LDS_BYTES, stream, a);
#endif
}
```

```cpp
#include <hip/hip_runtime.h>
#include <cstdio>
#include <cstdint>

#ifndef MK_PER_PHASE
#define MK_PER_PHASE 0
#endif

namespace pg8 {
#define PG8_LAS __attribute__((address_space(3)))
typedef unsigned short bf16_t;
typedef short bf16x8 __attribute__((ext_vector_type(8)));
typedef float f32x4 __attribute__((ext_vector_type(4)));
typedef unsigned u32x4 __attribute__((ext_vector_type(4)));
constexpr int BM = 256, BK = 64, HALF = 128, HTB = HALF * BK * 2  , STAGE_BYTES = 8 * HTB, NXCD = 8, WGM = 8;

__host__ __device__ __forceinline__ int lds_byte(int r, int c) { const int st = (r >> 4) * 2 + (c >> 5), rr = r & 15, cc = c & 31, ob = rr * 64 + cc * 2; return st * 1024 + (ob ^ (((ob >> 9) & 1) << 5)); }
__host__ __device__ __forceinline__ void stage_rc(int b, int& R, int& C) { const int st = b / 1024, sb = b % 1024, swz = sb ^ (((sb >> 9) & 1) << 5); R = (st >> 1) * 16 + swz / 64; C = (st & 1) * 32 + (swz % 64) / 2; }
__host__ __device__ __forceinline__ int perm32(int rho) { const int n = rho >> 4, i = rho & 15; return 8 * (i >> 2) + 4 * n + (i & 3); }

struct Unit { int pm, pn; };
struct Gemm { const bf16_t* A; const bf16_t* Bt; int M, N, K; };

struct StaticOrder {
    int nM, nN, nwg, G, c;
    __host__ __device__ void init(int M, int N, int G_, int c_) { nM = M / BM; nN = N / BM; nwg = nM * nN; G = G_; c = c_; }
    __host__ __device__ bool next(int i, Unit& u) const {
        const long L = (long)i * G + c; if (L >= nwg) return false;
        int wgid = (int)L; { const int q = nwg / NXCD, r = nwg % NXCD, xcd = wgid % NXCD, off = wgid / NXCD; wgid = (xcd < r ? xcd * (q + 1) : r * (q + 1) + (xcd - r) * q) + off; }
        const int nig = WGM * nN, gid = wgid / nig, fm = gid * WGM, gsz = (nM - fm) < WGM ? (nM - fm) : WGM;
        u.pm = fm + ((wgid % nig) % gsz); u.pn = (wgid % nig) / gsz; return true;
    }
    __device__ __forceinline__ void a_ready(const Unit&) const {}
    __device__ __forceinline__ void done(const Unit&) const {}
};
typedef __bf16 hbf16x2_ __attribute__((ext_vector_type(2)));
typedef float hf32x2_ __attribute__((ext_vector_type(2)));
__device__ __forceinline__ unsigned cvt_pk_bf16(float lo, float hi) { const hf32x2_ v = {lo, hi}; const hbf16x2_ b = __builtin_convertvector(v, hbf16x2_); return __builtin_bit_cast(unsigned, b); }
typedef float f32x2 __attribute__((ext_vector_type(2)));
__device__ __forceinline__ f32x2 gelu_pk(f32x2 v) {
    const f32x2 av = __builtin_elementwise_abs(v), d = av * 0.2316418882f + 1.0f;
    f32x2 t; t.x = __builtin_amdgcn_rcpf(d.x); t.y = __builtin_amdgcn_rcpf(d.y);
    f32x2 q = t * 0.5307027145f + (-0.7265760135f); q = q * t + 0.7107068705f; q = q * t + (-0.142248368f); q = q * t + 0.127414796f; q = q * t;
    const f32x2 s = (v * v) * (-0.72134752044f);
    f32x2 e; e.x = __builtin_amdgcn_exp2f(s.x); e.y = __builtin_amdgcn_exp2f(s.y);
    const f32x2 m = v * (q * e), r = v - m;
    f32x2 o; o.x = v.x < 0.f ? m.x : r.x; o.y = v.y < 0.f ? m.y : r.y; return o;
}
template <class Epi, class Sched, bool ALIGN_EPI = false, bool SP2 = false>
__device__ __forceinline__ void gemm_phase(PG8_LAS unsigned char* lds, const Gemm g, const Sched& S, const Epi& E) {
    const int tid = threadIdx.x, wid = __builtin_amdgcn_readfirstlane(tid >> 6), lane = tid & 63, wr = wid >> 2, wc = wid & 3, fr = lane & 15, fq = lane >> 4;
    const int K = g.K, nt = K / BK;
    unsigned voffA[2], voffB[2];
#pragma unroll
    for (int i = 0; i < 2; ++i) { int R, C; stage_rc(tid * 16 + i * 8192, R, C); const int Rb = Epi::PERM ? ((R & ~31) + perm32(R & 31)) : R;
        voffA[i] = (unsigned)(R * K + C) * 2u; voffB[i] = (unsigned)(Rb * K + C) * 2u; }
    const size_t kstep = (size_t)(BK * 2);
    const size_t hstep = (size_t)HALF * K * 2;
    const size_t tstep = 2 * hstep;
    const unsigned ldsw = (unsigned)wid * 1024u;
    const int aoff = lds_byte(wr * 64 + fr, fq * 8), boff = lds_byte(wc * 32 + fr, fq * 8);
#define PG8_SA(b, h) (((b) * 2 + (h)) * HTB)
#define PG8_SB(b, h) ((4 + (b) * 2 + (h)) * HTB)
#define PG8_STAGE(bufoff, gbase, voff) do { _Pragma("unroll") for (int _i = 0; _i < 2; ++_i) \
        __builtin_amdgcn_global_load_lds((const unsigned*)((const char*)(gbase) + (voff)[_i]), (PG8_LAS unsigned*)(lds + (bufoff) + ldsw + _i * 8192), 16, 0, 0); } while (0)
#define PG8_LDA(dst, b, h) do { _Pragma("unroll") for (int m = 0; m < 4; ++m) _Pragma("unroll") for (int k = 0; k < 2; ++k) dst[m][k] = *(const PG8_LAS bf16x8*)(lds + PG8_SA(b, h) + aoff + m * 2048 + k * 1024); } while (0)
#define PG8_LDB(dst, b, h) do { _Pragma("unroll") for (int n = 0; n < 2; ++n) _Pragma("unroll") for (int k = 0; k < 2; ++k) dst[n][k] = *(const PG8_LAS bf16x8*)(lds + PG8_SB(b, h) + boff + n * 2048 + k * 1024); } while (0)
#define PG8_MMA(ai, bj, At, Bt) do { __builtin_amdgcn_s_setprio(1); _Pragma("unroll") for (int m = 0; m < 4; ++m) _Pragma("unroll") for (int n = 0; n < 2; ++n) _Pragma("unroll") for (int k = 0; k < 2; ++k) \
        acc[ai][bj][m][n] = __builtin_amdgcn_mfma_f32_16x16x32_bf16(Bt[n][k], At[m][k], acc[ai][bj][m][n], 0, 0, 0); __builtin_amdgcn_s_setprio(0); } while (0)
#define PG8_WAIT_V(n) asm volatile("s_waitcnt vmcnt(" #n ")" ::: "memory")
#define PG8_WAIT_L(n) asm volatile("s_waitcnt lgkmcnt(" #n ")" ::: "memory")
#define PG8_BAR __builtin_amdgcn_s_barrier()
#define PG8_SCHED __builtin_amdgcn_sched_barrier(0)
    Unit cur, nxt; int ui = 0;
    if (!S.next(0, cur)) return;
    f32x4 acc[2][2][4][2];
#pragma unroll
    for (int a = 0; a < 2; ++a)
#pragma unroll
        for (int b = 0; b < 2; ++b)
#pragma unroll
            for (int m = 0; m < 4; ++m)
#pragma unroll
                for (int n = 0; n < 2; ++n) acc[a][b][m][n] = (f32x4){0.f, 0.f, 0.f, 0.f};
    bf16x8 At[4][2], B0[2][2], B1[2][2];
    const char* cA = (const char*)g.A + (size_t)cur.pm * tstep; const char* cB = (const char*)g.Bt + (size_t)cur.pn * tstep;
    S.a_ready(cur);
    if constexpr (SP2) {
        PG8_STAGE(PG8_SB(0, 0), cB, voffB); PG8_STAGE(PG8_SB(0, 1), cB + hstep, voffB); PG8_STAGE(PG8_SA(0, 0), cA, voffA); PG8_STAGE(PG8_SA(0, 1), cA + hstep, voffA);
        if (wr == 1) PG8_BAR;
        PG8_WAIT_V(2); PG8_BAR;
        PG8_STAGE(PG8_SB(1, 0), cB + kstep, voffB); PG8_STAGE(PG8_SA(1, 0), cA + kstep, voffA); PG8_STAGE(PG8_SB(1, 1), cB + hstep + kstep, voffB);
        PG8_WAIT_V(6); PG8_BAR;
    } else {
        PG8_STAGE(PG8_SB(0, 0), cB, voffB); PG8_STAGE(PG8_SA(0, 0), cA, voffA); PG8_STAGE(PG8_SB(0, 1), cB + hstep, voffB); PG8_STAGE(PG8_SA(0, 1), cA + hstep, voffA);
        if (wr == 1) PG8_BAR;
        PG8_WAIT_V(4); PG8_BAR;
        PG8_STAGE(PG8_SB(1, 0), cB + kstep, voffB); PG8_STAGE(PG8_SA(1, 0), cA + kstep, voffA); PG8_STAGE(PG8_SB(1, 1), cB + hstep + kstep, voffB);
        PG8_WAIT_V(6); PG8_BAR;
    }
    for (;;) {
        const bool has_next = S.next(ui + 1, nxt);
        const char* nA = has_next ? (const char*)g.A + (size_t)nxt.pm * tstep : cA; const char* nB = has_next ? (const char*)g.Bt + (size_t)nxt.pn * tstep : cB;
        for (int t = 0; t < nt; t += 2) {
            const bool last = (t == nt - 2);
            const char* a1 = cA + (size_t)(t + 1) * kstep;
            const char* a2 = last ? nA : cA + (size_t)(t + 2) * kstep; const char* b2 = last ? nB : cB + (size_t)(t + 2) * kstep;
            const char* a3 = a2 + kstep; const char* b3 = b2 + kstep;
            if (last && has_next) S.a_ready(nxt);
            if constexpr (SP2) {
            PG8_LDB(B0, 0, 0); PG8_LDB(B1, 0, 1); PG8_SCHED; PG8_LDA(At, 0, 0); PG8_STAGE(PG8_SA(1, 1), a1 + hstep, voffA);
            PG8_WAIT_V(8); PG8_WAIT_L(0); PG8_BAR; PG8_MMA(0, 0, At, B0); PG8_MMA(0, 1, At, B1); PG8_BAR; PG8_SCHED;
            PG8_LDA(At, 0, 1); PG8_STAGE(PG8_SB(0, 0), b2, voffB); PG8_STAGE(PG8_SB(0, 1), b2 + hstep, voffB); PG8_STAGE(PG8_SA(0, 0), a2, voffA);
            PG8_WAIT_V(8); PG8_WAIT_L(0); PG8_BAR; PG8_MMA(1, 0, At, B0); PG8_MMA(1, 1, At, B1); PG8_BAR; PG8_SCHED;
            PG8_LDB(B0, 1, 0); PG8_LDB(B1, 1, 1); PG8_SCHED; PG8_LDA(At, 1, 0); PG8_STAGE(PG8_SA(0, 1), a2 + hstep, voffA);
            PG8_WAIT_V(8); PG8_WAIT_L(0); PG8_BAR; PG8_MMA(0, 0, At, B0); PG8_MMA(0, 1, At, B1); PG8_BAR; PG8_SCHED;
            PG8_LDA(At, 1, 1); PG8_STAGE(PG8_SB(1, 0), b3, voffB); PG8_STAGE(PG8_SB(1, 1), b3 + hstep, voffB); PG8_STAGE(PG8_SA(1, 0), a3, voffA);
            PG8_WAIT_V(8); PG8_WAIT_L(0); PG8_BAR; PG8_MMA(1, 0, At, B0); PG8_MMA(1, 1, At, B1); PG8_BAR; PG8_SCHED;
            } else {
            PG8_LDB(B0, 0, 0); PG8_SCHED; PG8_LDA(At, 0, 0); PG8_STAGE(PG8_SA(1, 1), a1 + hstep, voffA);
            PG8_WAIT_L(8); PG8_BAR; PG8_WAIT_L(0); PG8_MMA(0, 0, At, B0); PG8_BAR; PG8_SCHED;
            PG8_LDB(B1, 0, 1); PG8_STAGE(PG8_SB(0, 0), b2, voffB);
            PG8_BAR; PG8_WAIT_L(0); PG8_MMA(0, 1, At, B1); PG8_BAR;
            PG8_LDA(At, 0, 1); PG8_STAGE(PG8_SA(0, 0), a2, voffA);
            PG8_BAR; PG8_WAIT_L(0); PG8_MMA(1, 0, At, B0); PG8_BAR; PG8_SCHED;
            PG8_STAGE(PG8_SB(0, 1), b2 + hstep, voffB);
            PG8_WAIT_V(6); PG8_BAR; PG8_MMA(1, 1, At, B1); PG8_BAR;
            PG8_LDB(B0, 1, 0); PG8_SCHED; PG8_LDA(At, 1, 0); PG8_STAGE(PG8_SA(0, 1), a2 + hstep, voffA);
            PG8_WAIT_L(8); PG8_BAR; PG8_WAIT_L(0); PG8_MMA(0, 0, At, B0); PG8_BAR; PG8_SCHED;
            PG8_LDB(B1, 1, 1); PG8_STAGE(PG8_SB(1, 0), b3, voffB);
            PG8_BAR; PG8_WAIT_L(0); PG8_MMA(0, 1, At, B1); PG8_BAR;
            PG8_LDA(At, 1, 1); PG8_STAGE(PG8_SA(1, 0), a3, voffA);
            PG8_BAR; PG8_WAIT_L(0); PG8_MMA(1, 0, At, B0); PG8_BAR; PG8_SCHED;
            PG8_STAGE(PG8_SB(1, 1), b3 + hstep, voffB);
            PG8_WAIT_V(6); PG8_BAR; PG8_MMA(1, 1, At, B1); PG8_BAR;
            }
        }
        if constexpr (ALIGN_EPI) { if (wr == 0) PG8_BAR; }
        if constexpr (!Epi::AFTER_DRAIN) { E(acc, cur, wr, wc, fr, fq); S.done(cur); }
        if (!has_next) break;
#pragma unroll
        for (int a = 0; a < 2; ++a)
#pragma unroll
            for (int b = 0; b < 2; ++b)
#pragma unroll
                for (int m = 0; m < 4; ++m)
#pragma unroll
                    for (int n = 0; n < 2; ++n) acc[a][b][m][n] = (f32x4){0.f, 0.f, 0.f, 0.f};
        cur = nxt; cA = nA; cB = nB; ++ui;
        if constexpr (ALIGN_EPI) { if (wr == 1) PG8_BAR; }
    }
    PG8_WAIT_V(0);
    if constexpr (!ALIGN_EPI) { if (wr == 0) PG8_BAR; }
    PG8_BAR;
    if constexpr (Epi::AFTER_DRAIN) { E.fused(acc, cur, wr, wc, fr, fq, lds, wid, lane); S.done(cur); }
#undef PG8_SA
#undef PG8_SB
#undef PG8_STAGE
#undef PG8_LDA
#undef PG8_LDB
#undef PG8_MMA
#undef PG8_WAIT_V
#undef PG8_WAIT_L
#undef PG8_BAR
#undef PG8_SCHED
}

template <class Epi, class Sched, bool STAMP>
__device__ __forceinline__ void gemm_phase(PG8_LAS unsigned char* lds, const Gemm g, const Sched& S, const Epi& E, unsigned long long*) { gemm_phase<Epi, Sched, true, true>(lds, g, S, E); }
__device__ __forceinline__ float bf_lo(unsigned w) { return __uint_as_float(w << 16); }
__device__ __forceinline__ float bf_hi(unsigned w) { return __uint_as_float(w & 0xffff0000u); }
__device__ __forceinline__ float sigmoidf_(float x) { return __builtin_amdgcn_rcpf(1.0f + __expf(-x)); }

struct EpiStoreBf16 {
    static constexpr bool PERM = true, AFTER_DRAIN = false;
    bf16_t* O; int ldc; int npn;
    __device__ __forceinline__ void operator()(const f32x4 (&acc)[2][2][4][2], const Unit& u, int wr, int wc, int fr, int fq) const {
        const int pn = npn ? (u.pn % npn) : u.pn;
        const int row0 = u.pm * BM + wr * 64 + fr, col0 = pn * BM + wc * 32 + 8 * fq;
#pragma unroll
        for (int ai = 0; ai < 2; ++ai)
#pragma unroll
            for (int m = 0; m < 4; ++m) { bf16_t* rowp = O + (size_t)(row0 + ai * HALF + m * 16) * ldc + col0;
#pragma unroll
                for (int bj = 0; bj < 2; ++bj) { const f32x4 v0 = acc[ai][bj][m][0], v1 = acc[ai][bj][m][1];
                    u32x4 w; w.x = cvt_pk_bf16(v0[0], v0[1]); w.y = cvt_pk_bf16(v0[2], v0[3]); w.z = cvt_pk_bf16(v1[0], v1[1]); w.w = cvt_pk_bf16(v1[2], v1[3]);
                    *(u32x4*)(rowp + bj * HALF) = w; } }
    }
};
struct EpiSwiGLU {
    static constexpr bool PERM = true, AFTER_DRAIN = false;
    bf16_t* H; int ldh; int npn;
    __device__ __forceinline__ void operator()(const f32x4 (&acc)[2][2][4][2], const Unit& u, int wr, int wc, int fr, int fq) const {
        const int pn = npn ? (u.pn % npn) : u.pn;
        const int row0 = u.pm * BM + wr * 64 + fr, col0 = pn * HALF + wc * 32 + 8 * fq;
#pragma unroll
        for (int ai = 0; ai < 2; ++ai)
#pragma unroll
            for (int m = 0; m < 4; ++m) { bf16_t* rowp = H + (size_t)(row0 + ai * HALF + m * 16) * ldh + col0;
                float o[8];
#pragma unroll
                for (int n = 0; n < 2; ++n)
#pragma unroll
                    for (int j = 0; j < 4; ++j) { const float a = acc[ai][0][m][n][j], b = acc[ai][1][m][n][j]; o[n * 4 + j] = a * sigmoidf_(a) * b; }
                u32x4 w; w.x = cvt_pk_bf16(o[0], o[1]); w.y = cvt_pk_bf16(o[2], o[3]); w.z = cvt_pk_bf16(o[4], o[5]); w.w = cvt_pk_bf16(o[6], o[7]);
                *(u32x4*)rowp = w; }
    }
};
struct EpiMerge {
    static constexpr bool PERM = true, AFTER_DRAIN = false;
    const bf16_t* P; int ldp; bf16_t* Mb;
    __device__ __forceinline__ void operator()(const f32x4 (&acc)[2][2][4][2], const Unit& u, int wr, int wc, int fr, int fq) const {
        const int br = u.pn >> 3, pn = u.pn & 7, pm = u.pm - br * 66;
        const int row0 = pm * BM + wr * 64 + fr, col0 = pn * BM + wc * 32 + 8 * fq;
#pragma unroll
        for (int ai = 0; ai < 2; ++ai)
#pragma unroll
            for (int m = 0; m < 4; ++m) { const size_t row = (size_t)(row0 + ai * HALF + m * 16);
#pragma unroll
                for (int bj = 0; bj < 2; ++bj) { const int col = col0 + bj * HALF;
                    const u32x4 g = *(const u32x4*)(P + row * ldp + br * 2048 + col);
                    const f32x4 v0 = acc[ai][bj][m][0], v1 = acc[ai][bj][m][1];
                    float o[8];
                    o[0] = sigmoidf_(bf_lo(g.x)) * v0[0]; o[1] = sigmoidf_(bf_hi(g.x)) * v0[1]; o[2] = sigmoidf_(bf_lo(g.y)) * v0[2]; o[3] = sigmoidf_(bf_hi(g.y)) * v0[3];
                    o[4] = sigmoidf_(bf_lo(g.z)) * v1[0]; o[5] = sigmoidf_(bf_hi(g.z)) * v1[1]; o[6] = sigmoidf_(bf_lo(g.w)) * v1[2]; o[7] = sigmoidf_(bf_hi(g.w)) * v1[3];
                    bf16_t* mp = Mb + row * 2048 + col;
                    if (br > 0) { const u32x4 q = *(const u32x4*)mp;
                        o[0] += bf_lo(q.x); o[1] += bf_hi(q.x); o[2] += bf_lo(q.y); o[3] += bf_hi(q.y); o[4] += bf_lo(q.z); o[5] += bf_hi(q.z); o[6] += bf_lo(q.w); o[7] += bf_hi(q.w); }
                    u32x4 w; w.x = cvt_pk_bf16(o[0], o[1]); w.y = cvt_pk_bf16(o[2], o[3]); w.z = cvt_pk_bf16(o[4], o[5]); w.w = cvt_pk_bf16(o[6], o[7]);
                    *(u32x4*)mp = w; } }
    }
};
struct MergeOrder {
    int ntile, G, c;
    __device__ bool next(int i, Unit& u) const { const int t = i / 3, br = i - 3 * t; const long q = (long)t * G + c; if (q >= ntile) return false;
        u.pm = br * 66 + (int)(q >> 3); u.pn = br * 8 + (int)(q & 7); return true; }
    __device__ __forceinline__ void a_ready(const Unit&) const {}
    __device__ __forceinline__ void done(const Unit&) const {}
};
struct EpiResid {
    static constexpr bool PERM = false, AFTER_DRAIN = false;
    const float* hin_lat; const float* hin_ctx; float* hout_lat; float* hout_ctx; const float* gate; int odd;
    __device__ __forceinline__ void operator()(const f32x4 (&acc)[2][2][4][2], const Unit& u, int wr, int wc, int fr, int fq) const {
        const int row0 = u.pm * BM + wr * 64 + fr, col0 = u.pn * BM + wc * 32 + 4 * fq;
#pragma unroll
        for (int ai = 0; ai < 2; ++ai)
#pragma unroll
            for (int m = 0; m < 4; ++m) { const int R = row0 + ai * HALF + m * 16;
                const float* hi; float* ho; const float* gv;
                if (R < 16384) { const int b = R >> 13, lp = R & 8191; const int l = odd ? ((lp & 127) * 64 + (lp >> 7)) : lp; const size_t dr = (size_t)(b * 8192 + l) * 2048;
                    hi = hin_lat + dr; ho = hout_lat + dr; gv = gate + b * 12288; }
                else { const size_t dr = (size_t)(R - 16384) * 2048; hi = hin_ctx + dr; ho = hout_ctx + dr; gv = gate + 2 * 12288; }
#pragma unroll
                for (int bj = 0; bj < 2; ++bj)
#pragma unroll
                    for (int n = 0; n < 2; ++n) { const int c = col0 + bj * HALF + n * 16;
                        const f32x4 h = *(const f32x4*)(hi + c), g = *(const f32x4*)(gv + c);
                        *(f32x4*)(ho + c) = h + g * acc[ai][bj][m][n]; } }
    }
};
struct MoeOrder {
    const int* tile_e; const int* ntiles; int npn, G, c;
    __device__ bool next(int i, Unit& u) const { const long L = (long)i * G + c; const int nt = *ntiles; if (L >= (long)nt * npn) return false;
        const int pm = (int)(L / npn), pl = (int)(L - (long)pm * npn); u.pm = pm; u.pn = tile_e[pm] * npn + pl; return true; }
    __device__ __forceinline__ void a_ready(const Unit&) const {}
    __device__ __forceinline__ void done(const Unit&) const {}
};
}

#include <vector>
#include <vector>

#define XB_TMO      128
#define XB_XCNT(j)  (256  + 64 * (j))
#define XB_XSUB(j)  (1280 + 64 * (j))
#define XB_XGEN(j)  (2304 + 64 * (j))
#define XB_TOP      3328
#define XB_TOPGEN   3392
#define XCD_BAR_WORDS 3456
#define XB_SPIN_CAP (1u << 18)
#define LAS __attribute__((address_space(3)))

__device__ __forceinline__ unsigned xb_ld(unsigned* p)              { return __hip_atomic_load(p, __ATOMIC_RELAXED, __HIP_MEMORY_SCOPE_AGENT); }
__device__ __forceinline__ unsigned xb_add(unsigned* p, unsigned v) { return __hip_atomic_fetch_add(p, v, __ATOMIC_RELAXED, __HIP_MEMORY_SCOPE_AGENT); }
__device__ __forceinline__ unsigned xb_xcc_id() { return (unsigned)__builtin_amdgcn_s_getreg((3 << 11) | 20) & 0xFu; }
#define XB_SPIN(cond, bar) do { unsigned _sp = 0; while (cond) { __builtin_amdgcn_s_sleep(1); \
    if ((++_sp & 255u) == 0u) { if (xb_ld(&(bar)[XB_TMO])) break; if (_sp > XB_SPIN_CAP) { atomicAdd(&(bar)[XB_TMO], 1u); break; } } } } while (0)

struct XcdBarrier {
    unsigned* bar; unsigned x;
    volatile LAS unsigned* st;
};

__device__ __forceinline__ XcdBarrier xcd_barrier_post(unsigned* bar, volatile LAS unsigned* st) {
    XcdBarrier b; b.bar = bar; b.x = xb_xcc_id(); b.st = st;
    if (threadIdx.x == 0) (void)xb_add(&bar[XB_XCNT(b.x)], 1u);
    return b;
}
__device__ __forceinline__ void xcd_barrier_complete(unsigned* bar, unsigned x, unsigned& nloc, unsigned& nx) {
    const unsigned G = gridDim.x * gridDim.y * gridDim.z;
    unsigned sum, cnt, mine, sp = 0u;
    for (;;) {
        sum = 0u; cnt = 0u; mine = 0u;
#pragma unroll
        for (unsigned j = 0; j < 16; ++j) { const unsigned c = xb_ld(&bar[XB_XCNT(j)]); sum += c; cnt += (c > 0u) ? 1u : 0u; mine = (j == x) ? c : mine; }
        if (sum == G) break;
        __builtin_amdgcn_s_sleep(1);
        if ((++sp & 255u) == 0u) { if (xb_ld(&bar[XB_TMO])) break; if (sp > XB_SPIN_CAP) { atomicAdd(&bar[XB_TMO], 1u); break; } }
    }
    nloc = mine > 0u ? mine : 1u; nx = cnt > 0u ? cnt : 1u;
}

__device__ __forceinline__ void xcd_barrier(const XcdBarrier& b) {
    asm volatile("s_waitcnt vmcnt(0)" ::: "memory");
    __syncthreads();
    if (threadIdx.x == 0) {
        unsigned* bar = b.bar;
        __builtin_amdgcn_s_waitcnt(0);
        unsigned nloc = b.st[0], nx = b.st[1];
        if (nloc == 0u) { xcd_barrier_complete(bar, b.x, nloc, nx); b.st[0] = nloc; b.st[1] = nx; }
        const unsigned old = xb_add(&bar[XB_XSUB(b.x)], 1u);
        const unsigned gen = old / nloc;
        if (old + 1u == (gen + 1u) * nloc) {
            __builtin_amdgcn_fence(__ATOMIC_RELEASE, "agent");
            asm volatile("s_waitcnt vmcnt(0)" ::: "memory");
            const unsigned og = xb_add(&bar[XB_TOP], 1u);
            const unsigned tg = og / nx;
            if (og + 1u == (tg + 1u) * nx) xb_add(&bar[XB_TOPGEN], 1u);
            else XB_SPIN(xb_ld(&bar[XB_TOPGEN]) == tg, bar);
            __builtin_amdgcn_fence(__ATOMIC_ACQUIRE, "agent");
            xb_add(&bar[XB_XGEN(b.x)], 1u);
            asm volatile("s_waitcnt vmcnt(0)" ::: "memory");
        } else {
            XB_SPIN(xb_ld(&bar[XB_XGEN(b.x)]) == gen, bar);
            __builtin_amdgcn_fence(__ATOMIC_ACQUIRE, "agent");
            asm volatile("s_waitcnt vmcnt(0)" ::: "memory");
        }
    }
    __syncthreads();
}

typedef unsigned short bf16;
typedef unsigned v4u __attribute__((ext_vector_type(4)));
typedef unsigned v2u __attribute__((ext_vector_type(2)));
typedef float f32x4 __attribute__((ext_vector_type(4)));
constexpr int D = 2048, SEQ = 8192, CTXL = 256, MLAT = 16384, MCTX = 512, MROWS = 16896;
constexpr int NP = 22272;
constexpr int PG = 0, PL = 6144, PLG = 8192, PR = 10240, PK = 12288, PV = 14336, PZ = 16384, PX = 18432, PWL = 21504, PAL = 21696, PGL = 21888, PDT = 22144;
constexpr int N_IN = 22208;
constexpr float EPS = 1e-6f;
enum { I_X = 0, I_C, I_CTX, I_CCTX, I_ADAW, I_ADAB, I_NMIX, I_NFFN, I_NFIN, I_WIN, I_LCW, I_LCB, I_LGW, I_LGB, I_LLAM,
       I_RMU, I_RW0, I_RWUP, I_RA0, I_RAUP, I_RGUP, I_RKK, I_RKA, I_RRK, I_RLNW, I_RLNB,
       I_SCW, I_SCB, I_SALOG, I_SDTB, I_SD, I_SNW, I_WOL, I_WOR, I_WOS, I_WO, I_F1, I_F3, I_F2, I_MR, I_M1, I_M3, I_M2, N_INPUTS };
constexpr size_t MiB = 1u << 20;
constexpr size_t WS_CTL = 0, CTL_BYTES = 1 * MiB;
constexpr size_t WS_MOD = 1 * MiB;
constexpr size_t WS_ROUTE = 2 * MiB;
constexpr size_t WS_BONUS = 3 * MiB;
constexpr size_t WS_HCTX = 8 * MiB;
constexpr size_t WS_WOUT = 12 * MiB;
constexpr size_t WS_HLAT = 44 * MiB;
constexpr size_t WS_Y3 = 172 * MiB;
constexpr size_t WS_X1 = 370 * MiB;
constexpr size_t WS_U = WS_X1 + 87 * MiB;
constexpr size_t WS_P = 523 * MiB;
constexpr size_t WS_LGW = 1241 * MiB;
constexpr size_t WS_LORA = 1243 * MiB;
constexpr size_t WS_GUP = 1245 * MiB;
constexpr size_t WS_LAGG = 1246 * MiB;
constexpr size_t WS_LCAR = 1256 * MiB;
constexpr size_t WS_X2 = 1264 * MiB;
constexpr size_t WS_LIN = 1396 * MiB;
constexpr size_t WS_END = 1409 * MiB;
constexpr size_t WS_F13 = WS_P, WS_F2 = WS_P + 48 * MiB, WS_FH = WS_P + 72 * MiB;
constexpr size_t WS_M13 = WS_P, WS_M2 = WS_P + 192 * MiB, WS_MA = WS_P + 288 * MiB, WS_MH = WS_P + 424 * MiB;
constexpr int MOE_ROWS = 34816;
static_assert(WS_MH + (size_t)MOE_ROWS * 3072 * 2 <= WS_END && WS_FH + (size_t)MROWS * 6144 * 2 <= WS_END && WS_P + (size_t)MROWS * NP * 2 <= WS_END, "ws map");
constexpr int CW_BAR = 4096;
constexpr int CW_CNT = 16384, CW_CUR = 16384 + 64;
constexpr int RT_TOKE = 0, RT_TOKP = 32768, RT_TOKROW = 65536, RT_TILEE = 98304, RT_NT = 98304 + 256, RT_BASE = 98304 + 320;
constexpr int LDS_BYTES = 163840, MISC_OFF = 163840 - 256;

struct Args { const float* in[N_INPUTS]; float* out; unsigned char* ws; int lo, hi; };

__device__ __forceinline__ float bf2f(bf16 b) { return __uint_as_float(((unsigned)b) << 16); }
typedef __bf16 hbf16x2 __attribute__((ext_vector_type(2)));
typedef float hf32x2 __attribute__((ext_vector_type(2)));
__device__ __forceinline__ unsigned pk2(float lo, float hi) { const hf32x2 v = {lo, hi}; const hbf16x2 b = __builtin_convertvector(v, hbf16x2); return __builtin_bit_cast(unsigned, b); }
__device__ __forceinline__ bf16 f2bf(float f) { return (bf16)(pk2(f, f) & 0xffffu); }
#define DPPF(v, ctrl) __int_as_float(__builtin_amdgcn_update_dpp(0, __float_as_int(v), (ctrl), 0xF, 0xF, true))
__device__ __forceinline__ float quad_xor1(float v) { return DPPF(v, 0xB1); }
__device__ __forceinline__ float quad_xor2(float v) { return DPPF(v, 0x4E); }
__device__ __forceinline__ float rdlane(float v, int l) { return __int_as_float(__builtin_amdgcn_readlane(__float_as_int(v), l)); }
__device__ __forceinline__ float wave_sum(float v) { v += DPPF(v, 0xB1); v += DPPF(v, 0x4E); v += DPPF(v, 0x141); v += DPPF(v, 0x140);
    v += __int_as_float(__builtin_amdgcn_update_dpp(0, __float_as_int(v), 0x142, 0xA, 0xF, false));
    v += __int_as_float(__builtin_amdgcn_update_dpp(0, __float_as_int(v), 0x143, 0xC, 0xF, false));
    return rdlane(v, 63); }
__device__ __forceinline__ float wave_scan(float v, int lane) { v += DPPF(v, 0x111); v += DPPF(v, 0x112); v += DPPF(v, 0x114); v += DPPF(v, 0x118);
    const float t0 = rdlane(v, 15), t1 = rdlane(v, 31), t2 = rdlane(v, 47); const int r = lane >> 4;
    return v + (r >= 1 ? t0 : 0.f) + (r >= 2 ? t1 : 0.f) + (r >= 3 ? t2 : 0.f); }
__device__ __forceinline__ float sigm(float x) { return __builtin_amdgcn_rcpf(1.0f + __expf(-x)); }
__device__ __forceinline__ float siluf(float x) { return x * sigm(x); }
__device__ __forceinline__ float softplusf(float x) { const float e = __expf(x); return x > 20.f ? x : (e < 0.05f ? e * (1.0f - e * (0.5f - e * (0.33333333f - 0.25f * e))) : __logf(1.0f + e)); }
__device__ __forceinline__ float tanh_fast(float x) { return 1.0f - 2.0f * __builtin_amdgcn_rcpf(1.0f + __expf(2.0f * x)); }
__device__ __forceinline__ float softplus_fast(float x) { return x > 20.f ? x : __logf(1.0f + __expf(x)); }
#define LBAR() do { asm volatile("s_waitcnt lgkmcnt(0)" ::: "memory"); __builtin_amdgcn_s_barrier(); asm volatile("" ::: "memory"); } while (0)
__device__ __forceinline__ float gelu_tanh(float x) { const float u = 0.7978845608028654f * (x + 0.044715f * x * x * x); return 0.5f * x * (1.0f + tanhf(u)); }
__device__ __forceinline__ void seq_pos(int row, int& pos, int& len) { if (row < MLAT) { pos = row & (SEQ - 1); len = SEQ; } else { pos = (row - MLAT) & (CTXL - 1); len = CTXL; } }
__device__ __forceinline__ int chain_row(int b, int dir, int s) { if (s < CTXL) { const int t = dir ? CTXL - 1 - s : s; return MLAT + b * CTXL + t; } s -= CTXL; const int t = dir ? SEQ - 1 - s : s; return b * SEQ + t; }
__device__ __forceinline__ float Pat(const bf16* P, int row, int col) { return bf2f(P[(size_t)row * NP + col]); }
__device__ __forceinline__ float shifted(const bf16* P, int row, int col, float mu) {
    int pos, len; seq_pos(row, pos, len);
    const float p = Pat(P, row, col), pv = pos > 0 ? Pat(P, row - 1, col) : 0.f, nx = pos < len - 1 ? Pat(P, row + 1, col) : 0.f;
    return p + mu * (0.5f * (pv + nx) - p);
}
__device__ __forceinline__ float dwconv(const bf16* P, int row, int col, const float* w, int ncol, int wc, float bias) {
    int pos, len; seq_pos(row, pos, len);
    float o = bias;
#pragma unroll
    for (int tap = 0; tap < 4; ++tap) { const int q = pos + tap - 2; if (q >= 0 && q < len) o += w[tap * ncol + wc] * Pat(P, row + tap - 2, col); }
    return o;
}
#define LAS3 __attribute__((address_space(3)))

struct Frame { const Args* a; unsigned char* ws; LAS3 unsigned char* lds; int tid, lane, wave, G, bid; };

__device__ __forceinline__ void phase_mod(const Frame& F) {
    LAS3 float* sv = (LAS3 float*)F.lds;
    LAS3 float* red = sv + 3 * 2048;
    const float* c = F.a->in[I_C]; const float* cc = F.a->in[I_CCTX];
    for (int i = F.tid; i < 3 * 2048; i += 512) { const int w = i >> 11, k = i & 2047; const float x = w < 2 ? c[w * 2048 + k] : cc[k]; sv[i] = siluf(x); }
    __syncthreads();
    float* mod = (float*)(F.ws + WS_MOD);
    const int kg = F.tid >> 7, j = F.tid & 127;
    for (int unit = F.bid; unit < 192; unit += F.G) {
        const int layer = unit / 96, col = (unit % 96) * 128 + j;
        const float* W = F.a->in[I_ADAW] + (size_t)layer * 2048 * 12288 + col;
        float a0 = 0.f, a1 = 0.f, a2 = 0.f;
        for (int k = kg * 512; k < kg * 512 + 512; ++k) { const float w = W[(size_t)k * 12288]; a0 += sv[k] * w; a1 += sv[2048 + k] * w; a2 += sv[4096 + k] * w; }
        red[(kg * 3 + 0) * 128 + j] = a0; red[(kg * 3 + 1) * 128 + j] = a1; red[(kg * 3 + 2) * 128 + j] = a2;
        __syncthreads();
        if (F.tid < 384) { const int w = F.tid >> 7; float s = F.a->in[I_ADAB][layer * 12288 + col];
            for (int q = 0; q < 4; ++q) s += red[(q * 3 + w) * 128 + j];
            mod[(size_t)(layer * 3 + w) * 12288 + col] = s; }
        __syncthreads();
    }
}

__device__ __forceinline__ int map_row(int type, int base, int n) {
    if (type == 0) return base + n;
    if (type == 2) return base + (n >> 7) * 256 + (n & 127);
    if (n < 16384) return n;
    if (n < 17024) return PWL + (n - 16384);
    if (n < 22144) return n - 640;
    return PDT + (n - 22144);
}
__device__ __forceinline__ void convT(const Frame& F, const float* src, int K, int N, bf16* dst, int type, int base, int& tile_rot, int nw, int rk) {
    LAS3 float* tile = (LAS3 float*)F.lds;
    const int nkt = K / 64, nnt = N / 64, nt = nkt * nnt;
    for (int t = (rk + nw - (tile_rot % nw)) % nw; t < nt; t += nw) {
        const int kt = t % nkt, ntl = t / nkt, k0 = kt * 64, n0 = ntl * 64;
        { const int r = F.tid >> 4, c4 = (F.tid & 15) * 4;
#pragma unroll
          for (int p = 0; p < 2; ++p) { const f32x4 v = *(const f32x4*)(src + (size_t)(k0 + r + p * 32) * N + n0 + c4);
              tile[(r + p * 32) * 65 + c4 + 0] = v[0]; tile[(r + p * 32) * 65 + c4 + 1] = v[1]; tile[(r + p * 32) * 65 + c4 + 2] = v[2]; tile[(r + p * 32) * 65 + c4 + 3] = v[3]; } }
        __syncthreads();
        { const int n = F.tid >> 3, kq = (F.tid & 7) * 8; float v[8];
#pragma unroll
          for (int i = 0; i < 8; ++i) v[i] = tile[(kq + i) * 65 + n];
          v4u w; w.x = pk2(v[0], v[1]); w.y = pk2(v[2], v[3]); w.z = pk2(v[4], v[5]); w.w = pk2(v[6], v[7]);
          *(v4u*)(dst + (size_t)map_row(type, base, n0 + n) * K + k0 + kq) = w; }
        __syncthreads();
    }
    tile_rot += nt;
}
__device__ __forceinline__ void phase_convw_layer(const Frame& F, int L, int nw, int rk) {
    int rot = 0;
    bf16* wt_in = (bf16*)(F.ws + WS_X1); bf16* wt_out = (bf16*)(F.ws + WS_WOUT);
    convT(F, F.a->in[I_WIN] + (size_t)L * 2048 * N_IN, 2048, N_IN, wt_in, 1, 0, rot, nw, rk);
    for (int i = rk * 512 + F.tid; i < 64 * 2048 / 8; i += nw * 512) ((v4u*)(wt_in + (size_t)N_IN * 2048))[i] = (v4u){0u, 0u, 0u, 0u};
    convT(F, F.a->in[I_WOL] + (size_t)L * 2048 * 2048, 2048, 2048, wt_out, 0, 0, rot, nw, rk);
    convT(F, F.a->in[I_WOR] + (size_t)L * 2048 * 2048, 2048, 2048, wt_out, 0, 2048, rot, nw, rk);
    convT(F, F.a->in[I_WOS] + (size_t)L * 2048 * 2048, 2048, 2048, wt_out, 0, 4096, rot, nw, rk);
    convT(F, F.a->in[I_WO] + (size_t)L * 2048 * 2048, 2048, 2048, wt_out, 0, 6144, rot, nw, rk);
    convT(F, F.a->in[I_RGUP] + (size_t)L * 256 * 2048, 256, 2048, (bf16*)(F.ws + WS_GUP), 0, 0, rot, nw, rk);
    for (int m = 0; m < 64; ++m) convT(F, F.a->in[I_LGW] + ((size_t)L * 64 + m) * 128 * 128, 128, 128, (bf16*)(F.ws + WS_LGW), 0, m * 128, rot, nw, rk);
}
__device__ __forceinline__ void phase_convw_ffn(const Frame& F, int L, int nw, int rk) {
    int rot = 0;
    if (L == 0) {
        convT(F, F.a->in[I_F1], 2048, 6144, (bf16*)(F.ws + WS_F13), 2, 0, rot, nw, rk);
        convT(F, F.a->in[I_F3], 2048, 6144, (bf16*)(F.ws + WS_F13), 2, 128, rot, nw, rk);
        convT(F, F.a->in[I_F2], 6144, 2048, (bf16*)(F.ws + WS_F2), 0, 0, rot, nw, rk);
    } else {
        for (int e = 0; e < 8; ++e) {
            convT(F, F.a->in[I_M1] + (size_t)e * 2048 * 3072, 2048, 3072, (bf16*)(F.ws + WS_M13), 2, e * 6144, rot, nw, rk);
            convT(F, F.a->in[I_M3] + (size_t)e * 2048 * 3072, 2048, 3072, (bf16*)(F.ws + WS_M13), 2, e * 6144 + 128, rot, nw, rk);
            convT(F, F.a->in[I_M2] + (size_t)e * 3072 * 2048, 3072, 2048, (bf16*)(F.ws + WS_M2), 0, e * 2048, rot, nw, rk);
        }
    }
}

template <bool ROUTER> __forceinline__
__device__ __forceinline__ void phase_norm(const Frame& F, const float* hlat, const float* hctx, const float* gain, const float* modL, int sh_off, int sc_off, bf16* out, int permute, int nrows) {
    const float* router = F.a->in[I_MR];
    int* rt = (int*)(F.ws + WS_ROUTE); unsigned* ctl = (unsigned*)(F.ws + WS_CTL);
    for (int row = F.bid * 8 + F.wave; row < nrows; row += F.G * 8) {
        int lane = F.lane; asm volatile("" : "+v"(lane));
        const float* src; const float* mv; int drow;
        if (row < MLAT) { const int b = row >> 13, l = row & 8191; src = hlat + (size_t)row * D; mv = modL + b * 12288;
            drow = permute ? (b * 8192 + (l & 63) * 128 + (l >> 6)) : row; }
        else { src = hctx + (size_t)(row - MLAT) * D; mv = modL + 2 * 12288; drow = row; }
        f32x4 x[8]; float ss = 0.f;
#pragma unroll
        for (int i = 0; i < 8; ++i) { x[i] = *(const f32x4*)(src + i * 256 + lane * 4); ss += x[i][0] * x[i][0] + x[i][1] * x[i][1] + x[i][2] * x[i][2] + x[i][3] * x[i][3]; }
        ss = wave_sum(ss);
        const float rs = rsqrtf(ss * (1.0f / D) + EPS);
        float lg[8];
        if (ROUTER) {
#pragma unroll
            for (int e = 0; e < 8; ++e) lg[e] = 0.f; }
#pragma unroll
        for (int i = 0; i < 8; ++i) { const int c = i * 256 + lane * 4;
            const f32x4 g = *(const f32x4*)(gain + c), sc = *(const f32x4*)(mv + sc_off + c), sh = *(const f32x4*)(mv + sh_off + c);
            f32x4 v;
#pragma unroll
            for (int j = 0; j < 4; ++j) v[j] = x[i][j] * rs * g[j] * (1.0f + sc[j]) + sh[j];
            uint2 w; w.x = pk2(v[0], v[1]); w.y = pk2(v[2], v[3]);
            *(uint2*)(out + (size_t)drow * D + c) = w;
            if (ROUTER) {
#pragma unroll
                for (int j = 0; j < 4; ++j) { const f32x4 r0 = *(const f32x4*)(router + (size_t)(c + j) * 8), r1 = *(const f32x4*)(router + (size_t)(c + j) * 8 + 4);
                    lg[0] += v[j] * r0[0]; lg[1] += v[j] * r0[1]; lg[2] += v[j] * r0[2]; lg[3] += v[j] * r0[3]; lg[4] += v[j] * r1[0]; lg[5] += v[j] * r1[1]; lg[6] += v[j] * r1[2]; lg[7] += v[j] * r1[3]; } }
        }
        if (ROUTER) {
#pragma unroll
            for (int e = 0; e < 8; ++e) lg[e] = wave_sum(lg[e]);
            if (lane == 0) {
                int e0 = 0; float v0 = lg[0];
#pragma unroll
                for (int e = 1; e < 8; ++e) if (lg[e] > v0) { v0 = lg[e]; e0 = e; }
                int e1 = -1; float v1 = -3.0e38f;
#pragma unroll
                for (int e = 0; e < 8; ++e) if (e != e0 && lg[e] > v1) { v1 = lg[e]; e1 = e; }
                const float p0 = 1.0f / (1.0f + __expf(v1 - v0));
                rt[RT_TOKE + row * 2] = e0; rt[RT_TOKE + row * 2 + 1] = e1;
                ((float*)rt)[RT_TOKP + row * 2] = p0; ((float*)rt)[RT_TOKP + row * 2 + 1] = 1.0f - p0;
                atomicAdd(&ctl[CW_CNT + e0], 1u); atomicAdd(&ctl[CW_CNT + e1], 1u);
            }
        }
    }
}

typedef short bf16x8 __attribute__((ext_vector_type(8)));
__device__ __forceinline__ bf16x8 ldfrag(const LAS3 bf16* p, int ld, int r0, int k0, int fr, int fq) { return *(const LAS3 bf16x8*)(p + (r0 + fr) * ld + k0 + 8 * fq); }
__device__ __forceinline__ bf16x8 ldfrag_sw(const LAS3 bf16* p, int ld, int r0, int k0, int fr, int fq) { const int r = r0 + fr, c = ((k0 >> 3) + fq) ^ ((r >> 3) & 7); return *(const LAS3 bf16x8*)(p + r * ld + c * 8); }
__device__ __forceinline__ bf16x8 ldfrag_g(const bf16* p, int ld, int r0, int k0, int fr, int fq) { return *(const bf16x8*)(p + (size_t)(r0 + fr) * ld + k0 + 8 * fq); }
#define MMA_TRN(acc, xf, yf) acc = __builtin_amdgcn_mfma_f32_16x16x32_bf16(yf, xf, acc, 0, 0, 0)
#define MMA_STD(acc, xf, yf) acc = __builtin_amdgcn_mfma_f32_16x16x32_bf16(xf, yf, acc, 0, 0, 0)
__device__ __forceinline__ void phase_rwkv_seq(const Frame& F, int L) {
    const bf16* P = (const bf16*)(F.ws + WS_P);
    bf16* ydir = (bf16*)(F.ws + WS_X1);
    float* bonus = (float*)(F.ws + WS_BONUS);
    const float* mu = F.a->in[I_RMU] + (size_t)L * 6784;
    LAS3 float* Fr = (LAS3 float*)F.lds; LAS3 float* Fk = Fr + 2048; LAS3 float* Fv = Fk + 2048; LAS3 float* Fa = Fv + 2048; LAS3 float* Fb = Fa + 2048; LAS3 float* Fw = Fb + 2048;
    LAS3 float* Lw = Fw + 2048; LAS3 float* La = Lw + 32 * 96; LAS3 float* Yb = La + 32 * 96;
    for (int unit = F.bid; unit < 128; unit += F.G) {
        const int b = unit >> 6, h = (unit >> 1) & 31, d = unit & 1;
        const float* w0 = F.a->in[I_RW0] + (size_t)(L * 2 + d) * 2048; const float* a0 = F.a->in[I_RA0] + (size_t)(L * 2 + d) * 2048;
        const float* wup = F.a->in[I_RWUP] + (size_t)(L * 2 + d) * 96 * 2048; const float* aup = F.a->in[I_RAUP] + (size_t)(L * 2 + d) * 96 * 2048;
        const float* kkw = F.a->in[I_RKK] + (size_t)L * 2048; const float* kaw = F.a->in[I_RKA] + (size_t)L * 2048; const float* rkw = F.a->in[I_RRK] + (size_t)L * 2048;
        float S[8];
#pragma unroll
        for (int j = 0; j < 8; ++j) S[j] = 0.f;
        for (int ch = 0; ch < 264; ++ch) {
            for (int idx = F.tid; idx < 32 * 96; idx += 512) { const int t = idx / 96, j = idx - t * 96; const int row = chain_row(b, d, ch * 32 + t);
                Lw[idx] = tanhf(shifted(P, row, PWL + d * 96 + j, mu[6144 + d * 96 + j]));
                La[idx] = shifted(P, row, PAL + d * 96 + j, mu[6144 + 192 + d * 96 + j]); }
            __syncthreads();
            for (int i = 0; i < 4; ++i) { const int t = F.wave * 4 + i, c = F.lane, col = h * 64 + c; const int row = chain_row(b, d, ch * 32 + t);
                const float r = shifted(P, row, PR + col, mu[col]), k = shifted(P, row, PK + col, mu[2048 + col]), v = shifted(P, row, PV + col, mu[4096 + col]);
                float wpre = w0[col], apre = a0[col];
                for (int j = 0; j < 96; ++j) { wpre += Lw[t * 96 + j] * wup[(size_t)j * 2048 + col]; apre += La[t * 96 + j] * aup[(size_t)j * 2048 + col]; }
                const float wraw = -softplusf(-wpre) - 0.5f, wdec = __expf(-__expf(wraw)), asig = sigm(apre);
                const float kkv = k * kkw[col], n2 = wave_sum(kkv * kkv), kk = kkv * rsqrtf(n2 + 1e-12f);
                const float key = k * (1.0f + (asig - 1.0f) * kaw[col]);
                const float bon = wave_sum(r * key * rkw[col]);
                if (c == 0) bonus[((size_t)d * MROWS + row) * 32 + h] = bon;
                Fr[t * 64 + c] = r; Fk[t * 64 + c] = key; Fv[t * 64 + c] = v; Fa[t * 64 + c] = -kk; Fb[t * 64 + c] = kk * asig; Fw[t * 64 + c] = wdec; }
            __syncthreads();
            { const int vi = F.tid >> 3, kp = F.tid & 7;
              for (int t = 0; t < 32; ++t) { const int o = t * 64 + kp * 8;
                  float sa = 0.f;
#pragma unroll
                  for (int j = 0; j < 8; ++j) sa += S[j] * Fa[o + j];
                  sa += __shfl_xor(sa, 1); sa += __shfl_xor(sa, 2); sa += __shfl_xor(sa, 4);
                  const float vv = Fv[t * 64 + vi]; float y = 0.f;
#pragma unroll
                  for (int j = 0; j < 8; ++j) { S[j] = S[j] * Fw[o + j] + sa * Fb[o + j] + vv * Fk[o + j]; y += S[j] * Fr[o + j]; }
                  y += __shfl_xor(y, 1); y += __shfl_xor(y, 2); y += __shfl_xor(y, 4);
                  if (kp == 0) Yb[t * 64 + vi] = y; } }
            __syncthreads();
            for (int idx = F.tid; idx < 2048; idx += 512) { const int t = idx >> 6, c = idx & 63; const int row = chain_row(b, d, ch * 32 + t);
                ydir[((size_t)d * MROWS + row) * D + h * 64 + c] = f2bf(Yb[idx]); }
        }
        __syncthreads();
    }
}
__device__ __forceinline__ void phase_rwkv_out(const Frame& F, int L) {
    const bf16* P = (const bf16*)(F.ws + WS_P);
    const bf16* ydir = (const bf16*)(F.ws + WS_X1);
    const float* bonus = (const float*)(F.ws + WS_BONUS);
    bf16* Y = (bf16*)(F.ws + WS_Y3) + (size_t)1 * MROWS * D;
    const float* mu = F.a->in[I_RMU] + (size_t)L * 6784;
    const bf16* GupT = (const bf16*)(F.ws + WS_GUP);
    const float* lnw = F.a->in[I_RLNW] + (size_t)L * 2048; const float* lnb = F.a->in[I_RLNB] + (size_t)L * 2048;
    LAS3 bf16* sg = (LAS3 bf16*)F.lds;
    for (int unit = F.bid; unit < MROWS / 16; unit += F.G) {
        int tid = F.tid; asm volatile("" : "+v"(tid));
        const int lane = tid & 63, wave = __builtin_amdgcn_readfirstlane(tid >> 6), fr = lane & 15, fq = lane >> 4;
        const int row0 = unit * 16;
        { const int t = tid >> 5, j8 = (tid & 31) * 8, row = row0 + t; int pos, len; seq_pos(row, pos, len);
          const v4u x = *(const v4u*)(P + (size_t)row * NP + PGL + j8); v4u xp = (v4u){0u, 0u, 0u, 0u}, xn = xp;
          if (pos > 0) xp = *(const v4u*)(P + (size_t)(row - 1) * NP + PGL + j8);
          if (pos < len - 1) xn = *(const v4u*)(P + (size_t)(row + 1) * NP + PGL + j8);
          const float* mp = mu + 6144 + 384 + j8; float o[8];
          const float xv[8] = {pg8::bf_lo(x.x), pg8::bf_hi(x.x), pg8::bf_lo(x.y), pg8::bf_hi(x.y), pg8::bf_lo(x.z), pg8::bf_hi(x.z), pg8::bf_lo(x.w), pg8::bf_hi(x.w)};
          const float pv[8] = {pg8::bf_lo(xp.x), pg8::bf_hi(xp.x), pg8::bf_lo(xp.y), pg8::bf_hi(xp.y), pg8::bf_lo(xp.z), pg8::bf_hi(xp.z), pg8::bf_lo(xp.w), pg8::bf_hi(xp.w)};
          const float nv[8] = {pg8::bf_lo(xn.x), pg8::bf_hi(xn.x), pg8::bf_lo(xn.y), pg8::bf_hi(xn.y), pg8::bf_lo(xn.z), pg8::bf_hi(xn.z), pg8::bf_lo(xn.w), pg8::bf_hi(xn.w)};
#pragma unroll
          for (int j = 0; j < 8; ++j) o[j] = sigm(xv[j] + mp[j] * (0.5f * (pv[j] + nv[j]) - xv[j]));
          v4u w; w.x = pk2(o[0], o[1]); w.y = pk2(o[2], o[3]); w.z = pk2(o[4], o[5]); w.w = pk2(o[6], o[7]);
          *(LAS3 v4u*)(sg + t * 264 + j8) = w; }
        LBAR();
        bf16x8 af[8];
#pragma unroll
        for (int ks = 0; ks < 8; ++ks) af[ks] = ldfrag(sg, 264, 0, ks * 32, fr, fq);
        const int row = row0 + fr; int pos, len; seq_pos(row, pos, len);
#pragma unroll 1
        for (int hh = 0; hh < 4; ++hh) { const int h = wave * 4 + hh;
            f32x4 g[4], y[4];
#pragma unroll
            for (int nt = 0; nt < 4; ++nt) { g[nt] = (f32x4){0.f, 0.f, 0.f, 0.f};
#pragma unroll
                for (int ks = 0; ks < 8; ++ks) MMA_TRN(g[nt], af[ks], ldfrag_g(GupT, 256, h * 64 + nt * 16, ks * 32, fr, fq)); }
            float s1 = 0.f;
#pragma unroll
            for (int nt = 0; nt < 4; ++nt) { const int c4 = h * 64 + nt * 16 + 4 * fq;
                const uint2 a = *(const uint2*)(ydir + (size_t)row * D + c4), bb = *(const uint2*)(ydir + ((size_t)MROWS + row) * D + c4);
                y[nt][0] = pg8::bf_lo(a.x) + pg8::bf_lo(bb.x); y[nt][1] = pg8::bf_hi(a.x) + pg8::bf_hi(bb.x); y[nt][2] = pg8::bf_lo(a.y) + pg8::bf_lo(bb.y); y[nt][3] = pg8::bf_hi(a.y) + pg8::bf_hi(bb.y);
                s1 += y[nt][0] + y[nt][1] + y[nt][2] + y[nt][3]; }
            s1 += __shfl_xor(s1, 16); s1 += __shfl_xor(s1, 32);
            const float mean = s1 * (1.0f / 64.0f); float q = 0.f;
#pragma unroll
            for (int nt = 0; nt < 4; ++nt)
#pragma unroll
                for (int e = 0; e < 4; ++e) { const float dl = y[nt][e] - mean; q += dl * dl; }
            q += __shfl_xor(q, 16); q += __shfl_xor(q, 32);
            const float rstd = rsqrtf(q * (1.0f / 64.0f) + 64e-5f);
            const float bon = bonus[(size_t)row * 32 + h] + bonus[((size_t)MROWS + row) * 32 + h];
#pragma unroll
            for (int nt = 0; nt < 4; ++nt) { const int c4 = h * 64 + nt * 16 + 4 * fq;
                const uint2 x = *(const uint2*)(P + (size_t)row * NP + PV + c4); uint2 xp = make_uint2(0u, 0u), xn = xp;
                if (pos > 0) xp = *(const uint2*)(P + (size_t)(row - 1) * NP + PV + c4);
                if (pos < len - 1) xn = *(const uint2*)(P + (size_t)(row + 1) * NP + PV + c4);
                const f32x4 lw = *(const f32x4*)(lnw + c4), lb = *(const f32x4*)(lnb + c4), muv = *(const f32x4*)(mu + 4096 + c4);
                const float xv[4] = {pg8::bf_lo(x.x), pg8::bf_hi(x.x), pg8::bf_lo(x.y), pg8::bf_hi(x.y)}, pv[4] = {pg8::bf_lo(xp.x), pg8::bf_hi(xp.x), pg8::bf_lo(xp.y), pg8::bf_hi(xp.y)}, nv[4] = {pg8::bf_lo(xn.x), pg8::bf_hi(xn.x), pg8::bf_lo(xn.y), pg8::bf_hi(xn.y)};
                float o[4];
#pragma unroll
                for (int e = 0; e < 4; ++e) { const float vv = xv[e] + muv[e] * (0.5f * (pv[e] + nv[e]) - xv[e]); o[e] = ((y[nt][e] - mean) * rstd * lw[e] + lb[e] + bon * vv) * g[nt][e]; }
                uint2 w; w.x = pk2(o[0], o[1]); w.y = pk2(o[2], o[3]);
                *(uint2*)(Y + (size_t)row * D + c4) = w; } }
        LBAR();
    }
}

__device__ __forceinline__ void phase_ssm_seq(const Frame& F, int L) {
    const bf16* P = (const bf16*)(F.ws + WS_P);
    bf16* ydir = (bf16*)(F.ws + WS_X1);
    const float* cw = F.a->in[I_SCW] + (size_t)L * 4 * 3072; const float* cb = F.a->in[I_SCB] + (size_t)L * 3072;
    LAS3 float* X = (LAS3 float*)F.lds; LAS3 float* Bm = X + 32 * 64; LAS3 float* Cm = Bm + 32 * 128; LAS3 float* dtv = Cm + 32 * 128; LAS3 float* dav = dtv + 32; LAS3 float* Yb = dav + 32;
    for (int unit = F.bid; unit < 128; unit += F.G) {
        const int b = unit >> 6, h = (unit >> 1) & 31, d = unit & 1, g = h >> 3;
        const float Ad = -__expf(F.a->in[I_SALOG][(L * 2 + d) * 32 + h]); const float dtb = F.a->in[I_SDTB][(L * 2 + d) * 32 + h];
        float hs[16];
#pragma unroll
        for (int j = 0; j < 16; ++j) hs[j] = 0.f;
        for (int ch = 0; ch < 264; ++ch) {
            for (int idx = F.tid; idx < 32 * 320; idx += 512) { const int t = idx / 320, q = idx - t * 320; const int row = chain_row(b, d, ch * 32 + t);
                const int col = q < 64 ? h * 64 + q : (q < 192 ? 2048 + g * 128 + (q - 64) : 2560 + g * 128 + (q - 192));
                const float v = siluf(dwconv(P, row, PX + col, cw, 3072, col, cb[col]));
                if (q < 64) X[t * 64 + q] = v; else if (q < 192) Bm[t * 128 + q - 64] = v; else Cm[t * 128 + q - 192] = v; }
            if (F.tid < 32) { const int row = chain_row(b, d, ch * 32 + F.tid); const float dt = softplusf(Pat(P, row, PDT + d * 32 + h) + dtb); dtv[F.tid] = dt; dav[F.tid] = __expf(dt * Ad); }
            __syncthreads();
            { const int p = F.tid >> 3, np = F.tid & 7;
              for (int t = 0; t < 32; ++t) { const float da = dav[t], xs = dtv[t] * X[t * 64 + p]; float y = 0.f;
#pragma unroll
                  for (int j = 0; j < 16; ++j) { hs[j] = hs[j] * da + xs * Bm[t * 128 + np * 16 + j]; y += hs[j] * Cm[t * 128 + np * 16 + j]; }
                  y += __shfl_xor(y, 1); y += __shfl_xor(y, 2); y += __shfl_xor(y, 4);
                  if (np == 0) Yb[t * 64 + p] = y; } }
            __syncthreads();
            for (int idx = F.tid; idx < 2048; idx += 512) { const int t = idx >> 6, c = idx & 63; const int row = chain_row(b, d, ch * 32 + t);
                ydir[((size_t)d * MROWS + row) * D + h * 64 + c] = f2bf(Yb[idx]); }
        }
        __syncthreads();
    }
}
__device__ __forceinline__ void phase_ssm_out(const Frame& F, int L) {
    const bf16* P = (const bf16*)(F.ws + WS_P);
    const bf16* ydir = (const bf16*)(F.ws + WS_X1);
    bf16* Y = (bf16*)(F.ws + WS_Y3) + (size_t)2 * MROWS * D; const bf16* XA = (const bf16*)(F.ws + WS_X2);
    const float* dsk = F.a->in[I_SD] + (size_t)L * 32; const float* nw = F.a->in[I_SNW] + (size_t)L * 2048;
    for (int row = F.bid * 8 + F.wave; row < MROWS; row += F.G * 8) {
#pragma unroll 1
        for (int g = 0; g < 4; ++g) { const int c0 = g * 512 + F.lane * 8;
            const v4u a = *(const v4u*)(ydir + (size_t)row * D + c0), bb = *(const v4u*)(ydir + ((size_t)MROWS + row) * D + c0), zz = *(const v4u*)(P + (size_t)row * NP + PZ + c0);
            float y[8], z[8];
            y[0] = pg8::bf_lo(a.x) + pg8::bf_lo(bb.x); y[1] = pg8::bf_hi(a.x) + pg8::bf_hi(bb.x); y[2] = pg8::bf_lo(a.y) + pg8::bf_lo(bb.y); y[3] = pg8::bf_hi(a.y) + pg8::bf_hi(bb.y);
            y[4] = pg8::bf_lo(a.z) + pg8::bf_lo(bb.z); y[5] = pg8::bf_hi(a.z) + pg8::bf_hi(bb.z); y[6] = pg8::bf_lo(a.w) + pg8::bf_lo(bb.w); y[7] = pg8::bf_hi(a.w) + pg8::bf_hi(bb.w);
            z[0] = pg8::bf_lo(zz.x); z[1] = pg8::bf_hi(zz.x); z[2] = pg8::bf_lo(zz.y); z[3] = pg8::bf_hi(zz.y); z[4] = pg8::bf_lo(zz.z); z[5] = pg8::bf_hi(zz.z); z[6] = pg8::bf_lo(zz.w); z[7] = pg8::bf_hi(zz.w);
            const float dk = dsk[c0 >> 6]; float ss = 0.f; const v4u xx = *(const v4u*)(XA + (size_t)row * 3072 + c0);
            const float xs[8] = {pg8::bf_lo(xx.x), pg8::bf_hi(xx.x), pg8::bf_lo(xx.y), pg8::bf_hi(xx.y), pg8::bf_lo(xx.z), pg8::bf_hi(xx.z), pg8::bf_lo(xx.w), pg8::bf_hi(xx.w)};
#pragma unroll
            for (int j = 0; j < 8; ++j) { y[j] = (y[j] + dk * xs[j]) * siluf(z[j]); ss += y[j] * y[j]; }
            ss = wave_sum(ss);
            const float rs = rsqrtf(ss * (1.0f / 512.0f) + EPS);
            v4u w; w.x = pk2(y[0] * rs * nw[c0 + 0], y[1] * rs * nw[c0 + 1]); w.y = pk2(y[2] * rs * nw[c0 + 2], y[3] * rs * nw[c0 + 3]);
            w.z = pk2(y[4] * rs * nw[c0 + 4], y[5] * rs * nw[c0 + 5]); w.w = pk2(y[6] * rs * nw[c0 + 6], y[7] * rs * nw[c0 + 7]);
            *(v4u*)(Y + (size_t)row * D + c0) = w; }
    }
}

__device__ __forceinline__ void phase_lru_seq(const Frame& F, int L) {
    const bf16* P = (const bf16*)(F.ws + WS_P);
    bf16* hdir = (bf16*)(F.ws + WS_X1);
    const float* cw = F.a->in[I_LCW] + (size_t)L * 4 * 2048; const float* cb = F.a->in[I_LCB] + (size_t)L * 2048;
    LAS3 float* Xc = (LAS3 float*)F.lds; LAS3 float* Ga = Xc + 32 * 128; LAS3 float* Gb = Ga + 32 * 128; LAS3 float* Hb = Gb + 32 * 128;
    for (int unit = F.bid; unit < 64; unit += F.G) {
        const int b = unit >> 5, n = (unit >> 1) & 15, d = unit & 1;
        const int half = F.tid >> 8, gi = (F.tid >> 7) & 1, j = F.tid & 127, col = n * 128 + j;
        const float* gw = F.a->in[I_LGW] + ((((size_t)L * 2 + d) * 2 + gi) * 16 + n) * 128 * 128;
        const float gb = F.a->in[I_LGB][(((size_t)L * 2 + d) * 2 + gi) * 2048 + col];
        const float sp = softplusf(-F.a->in[I_LLAM][((size_t)L * 2 + d) * 2048 + col]);
        float hst = 0.f;
        for (int ch = 0; ch < 264; ++ch) {
            for (int idx = F.tid; idx < 32 * 128; idx += 512) { const int t = idx >> 7, k = idx & 127; const int row = chain_row(b, d, ch * 32 + t);
                Xc[idx] = dwconv(P, row, PL + n * 128 + k, cw, 2048, n * 128 + k, cb[n * 128 + k]); }
            __syncthreads();
            { float acc[16];
#pragma unroll
              for (int i = 0; i < 16; ++i) acc[i] = gb;
              for (int k = 0; k < 128; ++k) { const float w = gw[k * 128 + j];
#pragma unroll
                  for (int i = 0; i < 16; ++i) acc[i] += Xc[(half * 16 + i) * 128 + k] * w; }
#pragma unroll
              for (int i = 0; i < 16; ++i) { const float s = sigm(acc[i]); if (gi == 0) Ga[(half * 16 + i) * 128 + j] = -8.0f * s * sp; else Gb[(half * 16 + i) * 128 + j] = s; } }
            __syncthreads();
            if (F.tid < 128) { for (int t = 0; t < 32; ++t) { const float la = Ga[t * 128 + j], a = __expf(la); const float bx = sqrtf(-expm1f(2.0f * la)) * Gb[t * 128 + j] * Xc[t * 128 + j]; hst = a * hst + bx; Hb[t * 128 + j] = hst; } }
            __syncthreads();
            for (int idx = F.tid; idx < 32 * 128; idx += 512) { const int t = idx >> 7, k = idx & 127; const int row = chain_row(b, d, ch * 32 + t);
                hdir[((size_t)d * MROWS + row) * D + n * 128 + k] = f2bf(Hb[idx]); }
        }
        __syncthreads();
    }
}
__device__ __forceinline__ void phase_lru_out(const Frame& F, int L) {
    const bf16* P = (const bf16*)(F.ws + WS_P);
    const bf16* hdir = (const bf16*)(F.ws + WS_X1);
    bf16* Y = (bf16*)(F.ws + WS_Y3);
    for (size_t i = (size_t)F.bid * 512 + F.tid; i < (size_t)MROWS * D / 8; i += (size_t)F.G * 512) { const int row = (int)(i >> 8), c0 = (int)(i & 255) * 8;
        const v4u a = *(const v4u*)(hdir + (size_t)row * D + c0), bb = *(const v4u*)(hdir + ((size_t)MROWS + row) * D + c0), gg = *(const v4u*)(P + (size_t)row * NP + PLG + c0);
        v4u w;
        w.x = pk2((pg8::bf_lo(a.x) + pg8::bf_lo(bb.x)) * gelu_tanh(pg8::bf_lo(gg.x)), (pg8::bf_hi(a.x) + pg8::bf_hi(bb.x)) * gelu_tanh(pg8::bf_hi(gg.x)));
        w.y = pk2((pg8::bf_lo(a.y) + pg8::bf_lo(bb.y)) * gelu_tanh(pg8::bf_lo(gg.y)), (pg8::bf_hi(a.y) + pg8::bf_hi(bb.y)) * gelu_tanh(pg8::bf_hi(gg.y)));
        w.z = pk2((pg8::bf_lo(a.z) + pg8::bf_lo(bb.z)) * gelu_tanh(pg8::bf_lo(gg.z)), (pg8::bf_hi(a.z) + pg8::bf_hi(bb.z)) * gelu_tanh(pg8::bf_hi(gg.z)));
        w.w = pk2((pg8::bf_lo(a.w) + pg8::bf_lo(bb.w)) * gelu_tanh(pg8::bf_lo(gg.w)), (pg8::bf_hi(a.w) + pg8::bf_hi(bb.w)) * gelu_tanh(pg8::bf_hi(gg.w)));
        *(v4u*)(Y + (size_t)row * D + c0) = w; }
}


constexpr int RW_SLOT = 32768;
__device__ __forceinline__ void phase_lora_prep(const Frame& F, int L, int nw, int rk) {
    bf16* dst = (bf16*)(F.ws + WS_LORA);
    for (int idx = rk * 512 + F.tid; idx < 2 * 2 * 12 * 2048; idx += nw * 512) { const int col = idx & 2047, k8 = (idx >> 11) % 12, dw = idx / (12 * 2048);
        const float* src = (dw >> 1 ? F.a->in[I_RAUP] : F.a->in[I_RWUP]) + ((size_t)L * 2 + (dw & 1)) * 96 * 2048 + col; float v[8];
#pragma unroll
        for (int j = 0; j < 8; ++j) v[j] = src[(size_t)(k8 * 8 + j) * 2048];
        v4u w; w.x = pk2(v[0], v[1]); w.y = pk2(v[2], v[3]); w.z = pk2(v[4], v[5]); w.w = pk2(v[6], v[7]);
        *(v4u*)(dst + ((size_t)dw * 2048 + col) * 128 + k8 * 8) = w; }
}
__device__ __forceinline__ void phase_lora_in(const Frame& F, int L) {
    const bf16* P = (const bf16*)(F.ws + WS_P); bf16* LIN = (bf16*)(F.ws + WS_LIN);
    const float* mu = F.a->in[I_RMU] + (size_t)L * 6784 + 6144;
    for (int idx = F.bid * 512 + F.tid; idx < MROWS * 48; idx += F.G * 512) { const int row = idx / 48, g = idx - row * 48, d = g / 24, wa = (g % 24) / 12, k8 = (g % 12) * 8;
        const int col = (wa ? PAL : PWL) + d * 96 + k8; int pos, len; seq_pos(row, pos, len);
        const v4u x = *(const v4u*)(P + (size_t)row * NP + col); v4u xp = (v4u){0u, 0u, 0u, 0u}, xn = xp;
        if (pos > 0) xp = *(const v4u*)(P + (size_t)(row - 1) * NP + col);
        if (pos < len - 1) xn = *(const v4u*)(P + (size_t)(row + 1) * NP + col);
        const float* mp = mu + wa * 192 + d * 96 + k8; float o[8];
        const float xv[8] = {pg8::bf_lo(x.x), pg8::bf_hi(x.x), pg8::bf_lo(x.y), pg8::bf_hi(x.y), pg8::bf_lo(x.z), pg8::bf_hi(x.z), pg8::bf_lo(x.w), pg8::bf_hi(x.w)};
        const float pv[8] = {pg8::bf_lo(xp.x), pg8::bf_hi(xp.x), pg8::bf_lo(xp.y), pg8::bf_hi(xp.y), pg8::bf_lo(xp.z), pg8::bf_hi(xp.z), pg8::bf_lo(xp.w), pg8::bf_hi(xp.w)};
        const float nv[8] = {pg8::bf_lo(xn.x), pg8::bf_hi(xn.x), pg8::bf_lo(xn.y), pg8::bf_hi(xn.y), pg8::bf_lo(xn.z), pg8::bf_hi(xn.z), pg8::bf_lo(xn.w), pg8::bf_hi(xn.w)};
#pragma unroll
        for (int j = 0; j < 8; ++j) { const float sv = xv[j] + mp[j] * (0.5f * (pv[j] + nv[j]) - xv[j]); o[j] = wa ? sv : tanh_fast(sv); }
        v4u w; w.x = pk2(o[0], o[1]); w.y = pk2(o[2], o[3]); w.z = pk2(o[4], o[5]); w.w = pk2(o[6], o[7]);
        *(v4u*)(LIN + (size_t)row * 384 + d * 192 + wa * 96 + k8) = w; }
}
__device__ __forceinline__ void phase_rwkv_r1(const Frame& F, int L, int gq) {
    const bf16* P = (const bf16*)(F.ws + WS_P);
    float* bonus = (float*)(F.ws + WS_BONUS);
    const float* mu = F.a->in[I_RMU] + (size_t)L * 6784;
    const bf16* LoT = (const bf16*)(F.ws + WS_LORA); const bf16* LIN = (const bf16*)(F.ws + WS_LIN);
    unsigned char* scratch = F.ws + WS_X2;
    LAS3 unsigned char* B0 = F.lds;
    LAS3 bf16* LwB = (LAS3 bf16*)(B0 + 67584);
    LAS3 bf16* LaB = LwB + 64 * 136;
    LAS3 float* NT = (LAS3 float*)B0;
    LAS3 bf16* MkaT = (LAS3 bf16*)(B0 + 16384);
    LAS3 bf16* MbrT = (LAS3 bf16*)(B0 + 25600);
    LAS3 float* Wl = (LAS3 float*)(B0 + 34816);
    LAS3 float* As = (LAS3 float*)(B0 + 51200);
    LAS3 bf16* MkrT = (LAS3 bf16*)(B0 + 51200);
    LAS3 bf16* At = (LAS3 bf16*)(B0 + 67584);
    LAS3 bf16* Bt = At + 64 * 72; LAS3 bf16* Kt = Bt + 64 * 72; LAS3 bf16* Rt = Kt + 64 * 72; LAS3 bf16* BtT = Rt + 64 * 72; LAS3 bf16* KtT = BtT + 64 * 72; LAS3 bf16* Vt = KtT + 64 * 72;
    LAS3 bf16* Ap = (LAS3 bf16*)(B0 + 132096);
    LAS3 bf16* W1 = Ap + 64 * 72;
    LAS3 float* CX = (LAS3 float*)(B0 + 132096);
    LAS3 float* PC = (LAS3 float*)(B0 + 150528);
    LAS3 float* SEG = PC + 64;
    LAS3 bf16* RL = (LAS3 bf16*)(B0 + 67584);
    LAS3 bf16* RKV = (LAS3 bf16*)B0;
    v4u pl[4], pr[4];
#define R1_FETCH(cl__, WHICH) do { const int cl_ = (cl__), c_ = gq * 33 + cl_, d_ = d, h_ = h, b_ = b; \
        const int rmin_ = d_ ? chain_row(b_, d_, c_ * 64 + 63) : chain_row(b_, d_, c_ * 64); int pos_, len_; seq_pos(rmin_, pos_, len_); \
        int tid_ = F.tid; asm volatile("" : "+v"(tid_)); \
        _Pragma("unroll") for (int i_ = 0; i_ < 4; ++i_) { const int idx_ = tid_ + 512 * i_, rr_ = idx_ / 24, g_ = idx_ - rr_ * 24; \
            const bool ok_ = idx_ < 1584 && ((rr_ >= 1 && rr_ <= 64) || (rr_ == 0 && pos_ > 0) || (rr_ == 65 && pos_ + 64 < len_)); \
            const size_t ro_ = (size_t)(rmin_ - 1 + rr_) * NP; \
            if (WHICH == 0) { if (i_ < 3) { const int t_ = idx_ / 24, q_ = idx_ - t_ * 24; pl[i_] = *(const v4u*)(LIN + (size_t)chain_row(b_, d_, c_ * 64 + t_) * 384 + d_ * 192 + q_ * 8); } } \
            else { const int cr2_ = (g_ < 8 ? PR : (g_ < 16 ? PK - 64 : PV - 128)) + h_ * 64 + g_ * 8; pr[i_] = ok_ ? *(const v4u*)(P + ro_ + cr2_) : (v4u){0u, 0u, 0u, 0u}; } } } while (0)
    LAS3 bf16* NTb = (LAS3 bf16*)(B0 + 153600);
    LAS3 bf16* DTb = (LAS3 bf16*)(B0 + 150784);
    LAS3 bf16* Wsc = (LAS3 bf16*)(B0 + 16384);
    LAS3 float* MU = SEG + 512;
#pragma unroll 1
    for (int chn = F.bid >> 1; chn < 128; chn += F.G >> 1) {
    const int d = chn & 1, h = (chn >> 1) & 31, b = chn >> 6, cl0 = (F.bid & 1) * 17, cl1 = (F.bid & 1) ? 33 : 17;
    __syncthreads();
    for (int i = F.tid; i < 192; i += 512) MU[i] = mu[6144 + (i < 96 ? 0 : 192 - 96) + d * 96 + i];
    bf16x8 wfr[3]; f32x4 lbias; float mur, muk, muv, kkw, kaw, rkw;
    { const int wa0 = F.wave >> 2, nt0 = F.wave & 3, fr0 = F.lane & 15, fq0 = F.lane >> 4;
#pragma unroll
      for (int ks = 0; ks < 3; ++ks) wfr[ks] = ldfrag_g(LoT + (size_t)(wa0 * 2 + d) * 2048 * 128, 128, h * 64 + nt0 * 16, ks * 32, fr0, fq0);
      lbias = *(const f32x4*)((wa0 ? F.a->in[I_RA0] : F.a->in[I_RW0]) + ((size_t)L * 2 + d) * 2048 + h * 64 + nt0 * 16 + 4 * fq0);
      const int col0 = h * 64 + F.lane;
      mur = mu[col0]; muk = mu[2048 + col0]; muv = mu[4096 + col0];
      kkw = F.a->in[I_RKK][(size_t)L * 2048 + col0]; kaw = F.a->in[I_RKA][(size_t)L * 2048 + col0]; rkw = F.a->in[I_RRK][(size_t)L * 2048 + col0]; }
    R1_FETCH(cl0, 0); R1_FETCH(cl0, 1);
    __syncthreads();
    for (int cl = cl0; cl < cl1; ++cl) {
        int tid = F.tid; asm volatile("" : "+v"(tid));
        const int lane = tid & 63, wave = __builtin_amdgcn_readfirstlane(tid >> 6), fr = lane & 15, fq = lane >> 4;
        const int c = gq * 33 + cl, unit = chn * 33 + cl;
        unsigned char* slot = scratch + (size_t)unit * RW_SLOT;
#pragma unroll
        for (int i = 0; i < 3; ++i) { const int idx = tid + 512 * i, t = idx / 24, q = idx - t * 24; *(LAS3 v4u*)((q >= 12 ? LaB + (q - 12) * 8 : LwB + q * 8) + t * 136) = pl[i]; }
#pragma unroll
        for (int i = 0; i < 4; ++i) { const int idx = tid + 512 * i, rr = idx / 24, g = idx - rr * 24; if (idx < 1584) *(LAS3 v4u*)(RKV + rr * 200 + g * 8) = pr[i]; }
        LBAR();
        { const int wa = wave >> 2, nt = wave & 3; f32x4 acc[4];
#pragma unroll
          for (int mt = 0; mt < 4; ++mt) acc[mt] = (f32x4){0.f, 0.f, 0.f, 0.f};
          LAS3 bf16* Xs = wa ? LaB : LwB;
#pragma unroll
          for (int ks = 0; ks < 3; ++ks)
#pragma unroll
              for (int mt = 0; mt < 4; ++mt) MMA_TRN(acc[mt], ldfrag(Xs, 136, mt * 16, ks * 32, fr, fq), wfr[ks]);
          if (wa) {
#pragma unroll
              for (int mt = 0; mt < 4; ++mt) { f32x4 o;
#pragma unroll
                  for (int e = 0; e < 4; ++e) o[e] = sigm(acc[mt][e] + lbias[e]);
                  *(LAS3 f32x4*)(As + (mt * 16 + fr) * 64 + nt * 16 + 4 * fq) = o; } }
          else { f32x4 run = (f32x4){0.f, 0.f, 0.f, 0.f};
#pragma unroll
              for (int mt = 0; mt < 4; ++mt) { f32x4 inc, exc;
#pragma unroll
                  for (int e = 0; e < 4; ++e) { const float lw = -__expf(-softplus_fast(-(acc[mt][e] + lbias[e])) - 0.5f);
                      float v = lw; v += DPPF(v, 0x111); v += DPPF(v, 0x112); v += DPPF(v, 0x114); v += DPPF(v, 0x118);
                      inc[e] = v + run[e]; exc[e] = inc[e] - lw;
                      const float t0 = rdlane(v, 15), t1 = rdlane(v, 31), t2 = rdlane(v, 47), t3 = rdlane(v, 63);
                      run[e] += fq == 0 ? t0 : (fq == 1 ? t1 : (fq == 2 ? t2 : t3)); }
                  *(LAS3 f32x4*)(Wl + (mt * 16 + fr) * 64 + nt * 16 + 4 * fq) = inc; *(LAS3 f32x4*)(CX + (mt * 16 + fr) * 64 + nt * 16 + 4 * fq) = exc; }
              if (fr == 0) { f32x4 pc; pc[0] = __expf(run[0]); pc[1] = __expf(run[1]); pc[2] = __expf(run[2]); pc[3] = __expf(run[3]); *(LAS3 f32x4*)(PC + nt * 16 + 4 * fq) = pc; } } }
        LBAR();
        { const int ch = lane; const int rr0 = d ? 64 - wave * 8 : 1 + wave * 8, st = d ? -1 : 1;
          const LAS3 bf16* qb = RKV + ch;
          float rp = bf2f(qb[(rr0 - st) * 200]), kp = bf2f(qb[(rr0 - st) * 200 + 64]), vp = bf2f(qb[(rr0 - st) * 200 + 128]);
          float rc = bf2f(qb[rr0 * 200]), kc = bf2f(qb[rr0 * 200 + 64]), vc = bf2f(qb[rr0 * 200 + 128]);
#pragma unroll
          for (int i = 0; i < 8; ++i) { const int t = wave * 8 + i; const int row = chain_row(b, d, c * 64 + t); const int rn = rr0 + st * (i + 1);
              const float rx = bf2f(qb[rn * 200]), kx = bf2f(qb[rn * 200 + 64]), vx = bf2f(qb[rn * 200 + 128]);
              const float r = rc + mur * (0.5f * (rp + rx) - rc), k = kc + muk * (0.5f * (kp + kx) - kc), v = vc + muv * (0.5f * (vp + vx) - vc);
              rp = rc; kp = kc; vp = vc; rc = rx; kc = kx; vc = vx;
              const float asig = As[t * 64 + ch], cv = Wl[t * 64 + ch], cx = CX[t * 64 + ch];
              const float kkv = k * kkw, n2 = wave_sum(kkv * kkv), kk = kkv * rsqrtf(n2 + 1e-12f);
              const float key = k * (1.0f + (asig - 1.0f) * kaw);
              const float bon = wave_sum(r * key * rkw);
              if (ch == 0) bonus[((size_t)d * MROWS + row) * 32 + h] = bon;
              const float ep = __expf(cv), em = __expf(-cv), ex = __expf(cx);
              const bf16 a_ = f2bf(-kk * ex), b_ = f2bf(kk * asig * em), k_ = f2bf(key * em), r_ = f2bf(r * ep), v_ = f2bf(v);
              At[t * 72 + ch] = a_; Bt[t * 72 + ch] = b_; Kt[t * 72 + ch] = k_; Rt[t * 72 + ch] = r_;
              BtT[ch * 72 + t] = b_; KtT[ch * 72 + t] = k_; Vt[ch * 72 + t] = v_; } }
        LBAR();
        for (int i = tid; i < 18432 / 16; i += 512) ((LAS3 v4u*)Ap)[i] = (v4u){0u, 0u, 0u, 0u};
        { const int q = wave >> 1, hf = wave & 1; LAS3 bf16* Xs = q < 2 ? At : Rt; LAS3 bf16* Ys = (q & 1) ? Kt : Bt;
#pragma unroll
          for (int mi = 0; mi < 2; ++mi) { const int mt = hf * 2 + mi; f32x4 acc[4];
#pragma unroll
              for (int nt = 0; nt < 4; ++nt) acc[nt] = (f32x4){0.f, 0.f, 0.f, 0.f};
#pragma unroll
              for (int ks = 0; ks < 2; ++ks) { const bf16x8 a = ldfrag(Xs, 72, mt * 16, ks * 32, fr, fq);
#pragma unroll
                  for (int nt = 0; nt < 4; ++nt) MMA_TRN(acc[nt], a, ldfrag(Ys, 72, nt * 16, ks * 32, fr, fq)); }
              const int t = mt * 16 + fr;
#pragma unroll
              for (int nt = 0; nt < 4; ++nt) { const int i0 = nt * 16 + 4 * fq; f32x4 o;
#pragma unroll
                  for (int e = 0; e < 4; ++e) { const int i = i0 + e; const bool keep = q < 2 ? (i < t) : (i <= t); o[e] = keep ? acc[nt][e] : 0.f; }
                  if (q == 0) { *(LAS3 f32x4*)(NT + t * 64 + i0) = o; const bool offd = nt != mt; v2u w; w.x = offd ? pk2(o[0], o[1]) : 0u; w.y = offd ? pk2(o[2], o[3]) : 0u; *(LAS3 v2u*)(NTb + t * 72 + i0) = w; }
                  else { v2u w; w.x = pk2(o[0], o[1]); w.y = pk2(o[2], o[3]); *(LAS3 v2u*)((q == 1 ? MkaT : (q == 2 ? MbrT : MkrT)) + t * 72 + i0) = w; } } } }
        LBAR();
        if (wave > 0) {
            for (int tile = wave - 1; tile < 16; tile += 7) { const int mt = tile >> 2, nt = tile & 3; f32x4 acc = (f32x4){0.f, 0.f, 0.f, 0.f};
#pragma unroll
                for (int ks = 0; ks < 2; ++ks) MMA_TRN(acc, ldfrag(Vt, 72, mt * 16, ks * 32, fr, fq), ldfrag(MkaT, 72, nt * 16, ks * 32, fr, fq));
                *(LAS3 f32x4*)(Wl + (mt * 16 + fr) * 64 + nt * 16 + 4 * fq) = acc; } }
        else { const int J = lane >> 4, cc = lane & 15; float z[16];
#pragma unroll
            for (int t = 0; t < 16; ++t) { float acc = t == cc ? 1.0f : 0.f;
#pragma unroll
                for (int i4 = 0; i4 < (t + 3) / 4; ++i4) { const f32x4 nv = *(const LAS3 f32x4*)(NT + (J * 16 + t) * 64 + J * 16 + i4 * 4);
#pragma unroll
                    for (int e = 0; e < 4; ++e) if (i4 * 4 + e < t) acc += nv[e] * z[i4 * 4 + e]; }
                z[t] = acc; DTb[(J * 16 + t) * 16 + cc] = f2bf(acc); } }
        LBAR();
        { LAS3 bf16* Ws = Wsc + wave * 256; const int r = wave * 16 + fr;
#pragma unroll
          for (int J = 0; J < 4; ++J) { f32x4 acc = (f32x4){0.f, 0.f, 0.f, 0.f};
              if (J > 0) {
#pragma unroll
                  for (int ks = 0; ks < (J + 1) / 2; ++ks) MMA_TRN(acc, ldfrag(Ap, 72, wave * 16, ks * 32, fr, fq), ldfrag(NTb, 72, J * 16, ks * 32, fr, fq)); }
              const int t0 = J * 16 + 4 * fq;
              if (wave < 4) { acc[0] += bf2f(At[(t0 + 0) * 72 + r]); acc[1] += bf2f(At[(t0 + 1) * 72 + r]); acc[2] += bf2f(At[(t0 + 2) * 72 + r]); acc[3] += bf2f(At[(t0 + 3) * 72 + r]); }
              else acc += *(const LAS3 f32x4*)(Wl + (r - 64) * 64 + t0);
              { v2u w; w.x = pk2(acc[0], acc[1]); w.y = pk2(acc[2], acc[3]); *(LAS3 v2u*)(Ws + fr * 16 + 4 * fq) = w; }
              asm volatile("s_waitcnt lgkmcnt(0)" ::: "memory");
              const bf16x8 zero8 = (bf16x8){0, 0, 0, 0, 0, 0, 0, 0};
              const bf16x8 wf = fq < 2 ? *(const LAS3 bf16x8*)(Ws + fr * 16 + 8 * fq) : zero8;
              const bf16x8 zf = fq < 2 ? *(const LAS3 bf16x8*)(DTb + (J * 16 + fr) * 16 + 8 * fq) : zero8;
              f32x4 x = (f32x4){0.f, 0.f, 0.f, 0.f};
              MMA_TRN(x, wf, zf);
              { v2u w; w.x = pk2(x[0], x[1]); w.y = pk2(x[2], x[3]); *(LAS3 v2u*)(Ap + r * 72 + t0) = w; }
              asm volatile("s_waitcnt lgkmcnt(0)" ::: "memory"); } }
        LBAR();
        if (cl + 1 < cl1) { R1_FETCH(cl + 1, 0); R1_FETCH(cl + 1, 1); }
        { const int o = wave >> 1, hf = wave & 1;
#pragma unroll
          for (int mi = 0; mi < 2; ++mi) { const int mt = hf * 2 + mi; f32x4 acc[4];
#pragma unroll
              for (int nt = 0; nt < 4; ++nt) acc[nt] = (f32x4){0.f, 0.f, 0.f, 0.f};
              if (o < 2) {
                  LAS3 bf16* Xs = o == 0 ? MbrT : BtT;
#pragma unroll
                  for (int ks = 0; ks < 2; ++ks) { const bf16x8 a = ldfrag(Xs, 72, mt * 16, ks * 32, fr, fq);
#pragma unroll
                      for (int nt = 0; nt < 4; ++nt) MMA_TRN(acc[nt], a, ldfrag(Ap, 72, nt * 16, ks * 32, fr, fq)); }
                  const int m = mt * 16 + fr; const float pc = o == 1 ? PC[m] : 1.0f;
#pragma unroll
                  for (int nt = 0; nt < 4; ++nt) { const int k0 = nt * 16 + 4 * fq; float v[4];
                      if (o == 0) { const v2u rr = *(const LAS3 v2u*)(Rt + m * 72 + k0); v[0] = acc[nt][0] + pg8::bf_lo(rr.x); v[1] = acc[nt][1] + pg8::bf_hi(rr.x); v[2] = acc[nt][2] + pg8::bf_lo(rr.y); v[3] = acc[nt][3] + pg8::bf_hi(rr.y); }
                      else {
#pragma unroll
                          for (int e = 0; e < 4; ++e) v[e] = (acc[nt][e] + ((k0 + e) == m ? 1.0f : 0.f)) * pc; }
                      v2u w; w.x = pk2(v[0], v[1]); w.y = pk2(v[2], v[3]);
                      *(v2u*)(slot + (o == 0 ? 8192 : 0) + (size_t)(((mt * 2 + (nt >> 1)) * 64 + fq * 16 + fr) * 16 + (nt & 1) * 8)) = w; } }
              else {
                  LAS3 bf16* X1 = o == 2 ? BtT : MbrT; LAS3 bf16* X2 = o == 2 ? KtT : MkrT;
#pragma unroll
                  for (int ks = 0; ks < 2; ++ks) { const bf16x8 a1 = ldfrag(X1, 72, mt * 16, ks * 32, fr, fq), a2 = ldfrag(X2, 72, mt * 16, ks * 32, fr, fq);
#pragma unroll
                      for (int nt = 0; nt < 4; ++nt) { MMA_STD(acc[nt], a1, ldfrag(W1, 72, nt * 16, ks * 32, fr, fq)); MMA_STD(acc[nt], a2, ldfrag(Vt, 72, nt * 16, ks * 32, fr, fq)); } }
                  float pc[4];
#pragma unroll
                  for (int e = 0; e < 4; ++e) pc[e] = o == 2 ? PC[mt * 16 + 4 * fq + e] : 1.0f;
#pragma unroll
                  for (int nt = 0; nt < 4; ++nt) { v2u w; w.x = pk2(acc[nt][0] * pc[0], acc[nt][1] * pc[1]); w.y = pk2(acc[nt][2] * pc[2], acc[nt][3] * pc[3]);
                      *(v2u*)(slot + (o == 2 ? 16384 : 24576) + (size_t)(((nt * 4 + mt) * 64 + lane) * 8)) = w; } } } }
        LBAR();
    }
    }
}
#undef R1_FETCH
#define RW_LOAD(Tf, Rf, Sh, Yh, cl_) do { const unsigned char* slot_ = scratch + ((size_t)chn * 33 + (cl_)) * RW_SLOT; \
        _Pragma("unroll") for (int mt_ = 0; mt_ < 4; ++mt_) { \
            _Pragma("unroll") for (int s_ = 0; s_ < 2; ++s_) { Tf[mt_][s_] = *(const bf16x8*)(slot_ + ((mt_ * 2 + s_) * 64 + F.lane) * 16); Rf[mt_][s_] = *(const bf16x8*)(slot_ + 8192 + ((mt_ * 2 + s_) * 64 + F.lane) * 16); } \
            Sh[mt_] = *(const v2u*)(slot_ + 16384 + ((vt * 4 + mt_) * 64 + F.lane) * 8); Yh[mt_] = *(const v2u*)(slot_ + 24576 + ((vt * 4 + mt_) * 64 + F.lane) * 8); } } while (0)
#define RW_STEP(Tf, Rf, Sh, Yh, cl_) do { bf16x8 Sb[2]; \
        _Pragma("unroll") for (int s2 = 0; s2 < 2; ++s2) { v4u w; w.x = pk2(S[2 * s2][0], S[2 * s2][1]); w.y = pk2(S[2 * s2][2], S[2 * s2][3]); w.z = pk2(S[2 * s2 + 1][0], S[2 * s2 + 1][1]); w.w = pk2(S[2 * s2 + 1][2], S[2 * s2 + 1][3]); \
            Sb[s2] = __builtin_bit_cast(bf16x8, w); } \
        _Pragma("unroll") for (int mt = 0; mt < 4; ++mt) { \
            f32x4 ya = (f32x4){pg8::bf_lo(Yh[mt].x), pg8::bf_hi(Yh[mt].x), pg8::bf_lo(Yh[mt].y), pg8::bf_hi(Yh[mt].y)}; \
            f32x4 sn = (f32x4){pg8::bf_lo(Sh[mt].x), pg8::bf_hi(Sh[mt].x), pg8::bf_lo(Sh[mt].y), pg8::bf_hi(Sh[mt].y)}; \
            _Pragma("unroll") for (int s2 = 0; s2 < 2; ++s2) { MMA_STD(ya, Rf[mt][s2], Sb[s2]); MMA_STD(sn, Tf[mt][s2], Sb[s2]); } \
            _Pragma("unroll") for (int e = 0; e < 4; ++e) { const int t = mt * 16 + 4 * fq + e; const int row = chain_row(b, d, (gq * 33 + (cl_)) * 64 + t); \
                ydir[((size_t)d * MROWS + row) * D + h * 64 + vt * 16 + fr] = f2bf(ya[e]); } \
            S[mt] = sn; } } while (0)
__device__ __forceinline__ void phase_rwkv_r2(const Frame& F, int gq) {
    const unsigned char* scratch = F.ws + WS_X2; bf16* ydir = (bf16*)(F.ws + WS_X1);
    f32x4* state = (f32x4*)(F.ws + WS_LAGG);
    if (F.wave >= 2) return;
    const int fr = F.lane & 15, fq = F.lane >> 4;
    for (int task = F.bid * 2 + F.wave; task < 512; task += F.G * 2) {
        const int chn = task >> 2, vt = task & 3, d = chn & 1, h = (chn >> 1) & 31, b = chn >> 6;
        f32x4 S[4];
#pragma unroll
        for (int mt = 0; mt < 4; ++mt) S[mt] = gq == 0 ? (f32x4){0.f, 0.f, 0.f, 0.f} : state[((size_t)task * 4 + mt) * 64 + F.lane];
        bf16x8 Ta[4][2], Ra[4][2]; v2u Sa[4], Ya[4];
#pragma unroll 1
        for (int cl = 0; cl < 33; ++cl) { RW_LOAD(Ta, Ra, Sa, Ya, cl); RW_STEP(Ta, Ra, Sa, Ya, cl); }
        if (gq < 3) {
#pragma unroll
            for (int mt = 0; mt < 4; ++mt) state[((size_t)task * 4 + mt) * 64 + F.lane] = S[mt]; }
    }
}
#undef RW_LOAD
#undef RW_STEP

__device__ __forceinline__ void phase_ssm_conv(const Frame& F, int L) {
    const bf16* P = (const bf16*)(F.ws + WS_P); bf16* XA = (bf16*)(F.ws + WS_X2);
    const float* cw = F.a->in[I_SCW] + (size_t)L * 4 * 3072; const float* cb = F.a->in[I_SCB] + (size_t)L * 3072;
    for (size_t gI = (size_t)F.bid * 512 + F.tid; gI < (size_t)MROWS * 384; gI += (size_t)F.G * 512) { const int row = (int)(gI / 384), col = (int)(gI % 384) * 8;
        int pos, len; seq_pos(row, pos, len);
        float o[8];
#pragma unroll
        for (int j = 0; j < 8; ++j) o[j] = cb[col + j];
#pragma unroll
        for (int tap = 0; tap < 4; ++tap) { const int q = pos + tap - 2;
            if (q >= 0 && q < len) { const v4u x = *(const v4u*)(P + (size_t)(row + tap - 2) * NP + PX + col);
                const f32x4 w0 = *(const f32x4*)(cw + tap * 3072 + col), w1 = *(const f32x4*)(cw + tap * 3072 + col + 4);
                o[0] += w0[0] * pg8::bf_lo(x.x); o[1] += w0[1] * pg8::bf_hi(x.x); o[2] += w0[2] * pg8::bf_lo(x.y); o[3] += w0[3] * pg8::bf_hi(x.y);
                o[4] += w1[0] * pg8::bf_lo(x.z); o[5] += w1[1] * pg8::bf_hi(x.z); o[6] += w1[2] * pg8::bf_lo(x.w); o[7] += w1[3] * pg8::bf_hi(x.w); } }
        v4u w; w.x = pk2(siluf(o[0]), siluf(o[1])); w.y = pk2(siluf(o[2]), siluf(o[3])); w.z = pk2(siluf(o[4]), siluf(o[5])); w.w = pk2(siluf(o[6]), siluf(o[7]));
        *(v4u*)(XA + (size_t)row * 3072 + col) = w; }
}
__device__ __forceinline__ void phase_ssm_chain(const Frame& F, int L) {
    const bf16* P = (const bf16*)(F.ws + WS_P); const bf16* XA = (const bf16*)(F.ws + WS_X2);
    bf16* ydir = (bf16*)(F.ws + WS_X1);
    constexpr int SET = 72192;
    LAS3 bf16* Hb = (LAS3 bf16*)(F.lds + 2 * SET);
    const int fr = F.lane & 15, fq = F.lane >> 4;
#define SS_PTRS(set_) LAS3 bf16* Cb = (LAS3 bf16*)(F.lds + (set_) * SET); LAS3 bf16* Bb = Cb + 64 * 136; LAS3 bf16* BT = Bb + 64 * 136; LAS3 bf16* Sc = BT + 128 * 72; \
        LAS3 bf16* Xt = Sc + 64 * 72; LAS3 bf16* Xd = Xt + 32 * 72; LAS3 float* cum = (LAS3 float*)(Xd + 32 * 72); LAS3 float* dtj = cum + 64; (void)Cb; (void)Bb; (void)BT; (void)Sc; (void)Xt; (void)Xd; (void)cum; (void)dtj
    for (int unit = F.bid; unit < 256; unit += F.G) {
        const int b = unit >> 7, h = (unit >> 2) & 31, d = (unit >> 1) & 1, ph = unit & 1, g = h >> 3;
        const float Ad = -__expf(F.a->in[I_SALOG][(L * 2 + d) * 32 + h]); const float dtb = F.a->in[I_SDTB][(L * 2 + d) * 32 + h];
        const int xcol = h * 64 + ph * 32;
        for (int i = F.tid; i < 32 * 136 / 2; i += 512) ((LAS3 unsigned*)Hb)[i] = 0u;
        f32x4 hacc[2]; hacc[0] = (f32x4){0.f, 0.f, 0.f, 0.f}; hacc[1] = hacc[0];
        v4u nb[4], nx; float ndt = 0.f;
#define SS_LOAD(c_) do { \
            _Pragma("unroll") for (int i_ = 0; i_ < 4; ++i_) { const int gI_ = F.tid + 512 * i_, j_ = gI_ >> 5, q_ = gI_ & 31; const int row_ = chain_row(b, d, (c_) * 64 + j_); \
                const int col_ = q_ < 16 ? 2048 + g * 128 + q_ * 8 : 2560 + g * 128 + (q_ - 16) * 8; nb[i_] = *(const v4u*)(XA + (size_t)row_ * 3072 + col_); } \
            if (F.tid < 256) { const int j_ = F.tid >> 2, q_ = F.tid & 3; const int row_ = chain_row(b, d, (c_) * 64 + j_); nx = *(const v4u*)(XA + (size_t)row_ * 3072 + xcol + q_ * 8); } \
            if (F.wave == 4) { const int row_ = chain_row(b, d, (c_) * 64 + F.lane); ndt = bf2f(P[(size_t)row_ * NP + PDT + d * 32 + h]); } } while (0)
#define SS_FRONT1(set_) do { SS_PTRS(set_); \
            _Pragma("unroll") for (int i_ = 0; i_ < 4; ++i_) { const int gI_ = F.tid + 512 * i_, j_ = gI_ >> 5, q_ = gI_ & 31; const v4u v_ = nb[i_]; \
                if (q_ < 16) { *(LAS3 v4u*)(Bb + j_ * 136 + q_ * 8) = v_; LAS3 bf16* bt_ = BT + (q_ * 8) * 72 + ((((j_ >> 3) ^ (q_ & 7)) << 3) | (j_ & 7)); \
                    bt_[0 * 72] = (bf16)(v_.x & 0xffff); bt_[1 * 72] = (bf16)(v_.x >> 16); bt_[2 * 72] = (bf16)(v_.y & 0xffff); bt_[3 * 72] = (bf16)(v_.y >> 16); \
                    bt_[4 * 72] = (bf16)(v_.z & 0xffff); bt_[5 * 72] = (bf16)(v_.z >> 16); bt_[6 * 72] = (bf16)(v_.w & 0xffff); bt_[7 * 72] = (bf16)(v_.w >> 16); } \
                else *(LAS3 v4u*)(Cb + j_ * 136 + (q_ - 16) * 8) = v_; } \
            if (F.tid < 256) { const int j_ = F.tid >> 2, q_ = F.tid & 3; const v4u v_ = nx; LAS3 bf16* xt_ = Xt + (q_ * 8) * 72 + ((((j_ >> 3) ^ (q_ & 7)) << 3) | (j_ & 7)); \
                xt_[0 * 72] = (bf16)(v_.x & 0xffff); xt_[1 * 72] = (bf16)(v_.x >> 16); xt_[2 * 72] = (bf16)(v_.y & 0xffff); xt_[3 * 72] = (bf16)(v_.y >> 16); \
                xt_[4 * 72] = (bf16)(v_.z & 0xffff); xt_[5 * 72] = (bf16)(v_.z >> 16); xt_[6 * 72] = (bf16)(v_.w & 0xffff); xt_[7 * 72] = (bf16)(v_.w >> 16); } \
            if (F.wave == 4) { const float dtv_ = softplusf(ndt + dtb); const float v_ = wave_scan(dtv_ * Ad, F.lane); cum[F.lane] = v_; dtj[F.lane] = dtv_; } } while (0)
#define SS_FRONT2(set_) do { SS_PTRS(set_); \
            { const int mt_ = F.wave >> 1; f32x4 acc_[2]; acc_[0] = (f32x4){0.f, 0.f, 0.f, 0.f}; acc_[1] = acc_[0]; \
              _Pragma("unroll") for (int ks_ = 0; ks_ < 4; ++ks_) { const bf16x8 a_ = ldfrag(Cb, 136, mt_ * 16, ks_ * 32, fr, fq); \
                  _Pragma("unroll") for (int x_ = 0; x_ < 2; ++x_) { const bf16x8 bb_ = ldfrag(Bb, 136, ((F.wave & 1) * 2 + x_) * 16, ks_ * 32, fr, fq); MMA_TRN(acc_[x_], a_, bb_); } } \
              const int i_ = mt_ * 16 + fr; const float ci_ = cum[i_]; \
              _Pragma("unroll") for (int x_ = 0; x_ < 2; ++x_) { const int j0_ = ((F.wave & 1) * 2 + x_) * 16 + 4 * fq; float sc_[4]; \
                  _Pragma("unroll") for (int e_ = 0; e_ < 4; ++e_) { const int jj_ = j0_ + e_; sc_[e_] = jj_ <= i_ ? acc_[x_][e_] * __expf(ci_ - cum[jj_]) * dtj[jj_] : 0.f; } \
                  v2u w_; w_.x = pk2(sc_[0], sc_[1]); w_.y = pk2(sc_[2], sc_[3]); *(LAS3 v2u*)(Sc + i_ * 72 + j0_) = w_; } } \
            { const int idx_ = F.tid * 4, p_ = idx_ >> 6, j0_ = idx_ & 63; const float cl_ = cum[63]; const v2u xv_ = *(const LAS3 v2u*)(Xt + p_ * 72 + ((((j0_ >> 3) ^ ((p_ >> 3) & 7)) << 3) | (j0_ & 7))); \
              const float x0_ = pg8::bf_lo(xv_.x) * dtj[j0_] * __expf(cl_ - cum[j0_]), x1_ = pg8::bf_hi(xv_.x) * dtj[j0_ + 1] * __expf(cl_ - cum[j0_ + 1]); \
              const float x2_ = pg8::bf_lo(xv_.y) * dtj[j0_ + 2] * __expf(cl_ - cum[j0_ + 2]), x3_ = pg8::bf_hi(xv_.y) * dtj[j0_ + 3] * __expf(cl_ - cum[j0_ + 3]); \
              v2u w_; w_.x = pk2(x0_, x1_); w_.y = pk2(x2_, x3_); *(LAS3 v2u*)(Xd + p_ * 72 + j0_) = w_; } } while (0)
        SS_LOAD(0);
        __syncthreads();
        SS_FRONT1(0);
        SS_LOAD(1);
        LBAR();
        SS_FRONT2(0);
        LBAR();
        for (int c = 0; c < 132; ++c) {
            const int cur = c & 1;
            { SS_PTRS(cur);
              { const int mt = F.wave >> 1, nt = F.wave & 1; f32x4 ad = (f32x4){0.f, 0.f, 0.f, 0.f}, ao = ad;
#pragma unroll
                for (int ks = 0; ks < 2; ++ks) MMA_TRN(ad, ldfrag(Sc, 72, mt * 16, ks * 32, fr, fq), ldfrag_sw(Xt, 72, nt * 16, ks * 32, fr, fq));
#pragma unroll
                for (int ks = 0; ks < 4; ++ks) MMA_TRN(ao, ldfrag(Cb, 136, mt * 16, ks * 32, fr, fq), ldfrag(Hb, 136, nt * 16, ks * 32, fr, fq));
                const int i = mt * 16 + fr; const float ei = __expf(cum[i]); const int row = chain_row(b, d, c * 64 + i);
                v2u w; w.x = pk2(ad[0] + ei * ao[0], ad[1] + ei * ao[1]); w.y = pk2(ad[2] + ei * ao[2], ad[3] + ei * ao[3]);
                *(v2u*)(ydir + ((size_t)d * MROWS + row) * D + xcol + nt * 16 + 4 * fq) = w; }
              { const int mt = F.wave >> 2; const float dc = __expf(cum[63]);
#pragma unroll
                for (int x = 0; x < 2; ++x) { const int nt = (F.wave & 3) * 2 + x; hacc[x] *= dc;
#pragma unroll
                    for (int ks = 0; ks < 2; ++ks) MMA_TRN(hacc[x], ldfrag(Xd, 72, mt * 16, ks * 32, fr, fq), ldfrag_sw(BT, 72, nt * 16, ks * 32, fr, fq)); } } }
            if (c + 1 < 132) { SS_FRONT1(cur ^ 1); if (c + 2 < 132) SS_LOAD(c + 2); }
            LBAR();
            { const int mt = F.wave >> 2;
#pragma unroll
              for (int x = 0; x < 2; ++x) { const int nt = (F.wave & 3) * 2 + x; v2u w; w.x = pk2(hacc[x][0], hacc[x][1]); w.y = pk2(hacc[x][2], hacc[x][3]);
                  *(LAS3 v2u*)(Hb + (mt * 16 + fr) * 136 + nt * 16 + 4 * fq) = w; } }
            if (c + 1 < 132) SS_FRONT2(cur ^ 1);
            LBAR();
        }
        __syncthreads();
    }
#undef SS_PTRS
#undef SS_LOAD
#undef SS_FRONT1
#undef SS_FRONT2
}

__device__ __forceinline__ int chunk_row0(int ck) { return ck < 256 ? ck * 64 : MLAT + (ck - 256) * 64; }
template <bool FINAL>
__device__ __forceinline__ void phase_lru_par(const Frame& F, int L) {
    const bf16* P = (const bf16*)(F.ws + WS_P);
    const bf16* WgT = (const bf16*)(F.ws + WS_LGW);
    float* agg = (float*)(F.ws + WS_LAGG); const float* car = (const float*)(F.ws + WS_LCAR);
    bf16* Y = (bf16*)(F.ws + WS_Y3);
    const float* cw = F.a->in[I_LCW] + (size_t)L * 4 * 2048; const float* cb = F.a->in[I_LCB] + (size_t)L * 2048;
    LAS3 bf16* Xb = (LAS3 bf16*)F.lds;
    LAS3 float* Aa = (LAS3 float*)(F.lds + 17408);
    LAS3 float* Bx = Aa + 64 * 128;
    LAS3 float* Hf = Bx + 64 * 128;
    LAS3 bf16* RAW = (LAS3 bf16*)(F.lds + 115712);
    LAS3 bf16* GT = (LAS3 bf16*)(F.lds + 133936);
    LAS3 float* SGA = (LAS3 float*)(F.lds + 151344);
    LAS3 float* SGH = SGA + 512;
    v4u pw[3], pg[2];
#define LRU_FETCH(ck__) do { const int ck_ = (ck__), n_ = n, row0_ = chunk_row0(ck_); int pos_, len_; seq_pos(row0_, pos_, len_); \
        int tid_ = F.tid; asm volatile("" : "+v"(tid_)); \
        _Pragma("unroll") for (int i_ = 0; i_ < 3; ++i_) { const int idx_ = tid_ + 512 * i_, rr_ = idx_ >> 4, g_ = idx_ & 15; const int q_ = pos_ + rr_ - 2; \
            pw[i_] = (idx_ < 67 * 16 && q_ >= 0 && q_ < len_) ? *(const v4u*)(P + (size_t)(row0_ + rr_ - 2) * NP + PL + n_ * 128 + g_ * 8) : (v4u){0u, 0u, 0u, 0u}; } \
        if (FINAL) { _Pragma("unroll") for (int i_ = 0; i_ < 2; ++i_) { const int idx_ = tid_ + 512 * i_, rr_ = idx_ >> 4, g_ = idx_ & 15; \
            pg[i_] = *(const v4u*)(P + (size_t)(row0_ + rr_) * NP + PLG + n_ * 128 + g_ * 8); } } } while (0)
    const int n = F.bid & 15, ckstep = F.G >> 4;
    LAS3 float* CW = SGH + 512;
    for (int i = F.tid; i < 640; i += 512) CW[i] = i < 512 ? cw[(i >> 7) * 2048 + n * 128 + (i & 127)] : cb[n * 128 + (i & 127)];
    bf16x8 wf[2][2][4]; f32x4 gbv[2][2]; float sp8[2][4];
    { const int fr0 = F.lane & 15, fq0 = F.lane >> 4, j00 = F.wave * 16;
#pragma unroll
      for (int d = 0; d < 2; ++d) {
#pragma unroll
          for (int g = 0; g < 2; ++g) { const bf16* W = WgT + (size_t)(((d * 2 + g) * 16 + n) * 128) * 128;
#pragma unroll
              for (int ks = 0; ks < 4; ++ks) wf[d][g][ks] = ldfrag_g(W, 128, j00, ks * 32, fr0, fq0);
              gbv[d][g] = *(const f32x4*)(F.a->in[I_LGB] + (((size_t)L * 2 + d) * 2 + g) * 2048 + n * 128 + j00 + 4 * fq0); }
          const f32x4 lam = *(const f32x4*)(F.a->in[I_LLAM] + ((size_t)L * 2 + d) * 2048 + n * 128 + j00 + 4 * fq0);
#pragma unroll
          for (int i = 0; i < 4; ++i) sp8[d][i] = -8.0f * softplusf(-lam[i]); } }
    if ((F.bid >> 4) < 264) LRU_FETCH(F.bid >> 4);
    __syncthreads();
    for (int ck = F.bid >> 4; ck < 264; ck += ckstep) {
        int tid = F.tid; asm volatile("" : "+v"(tid));
        const int lane = tid & 63, wave = __builtin_amdgcn_readfirstlane(tid >> 6), fr = lane & 15, fq = lane >> 4;
        const int row0 = chunk_row0(ck);
#pragma unroll
        for (int i = 0; i < 3; ++i) { const int idx = tid + 512 * i, rr = idx >> 4, g = idx & 15; if (idx < 67 * 16) *(LAS3 v4u*)(RAW + rr * 136 + g * 8) = pw[i]; }
        if (FINAL) {
#pragma unroll
            for (int i = 0; i < 2; ++i) { const int idx = tid + 512 * i, rr = idx >> 4, g = idx & 15; *(LAS3 v4u*)(GT + rr * 136 + g * 8) = pg[i]; } }
        LBAR();
        if (ck + ckstep < 264) LRU_FETCH(ck + ckstep);
#pragma unroll 1
        for (int gI = tid; gI < 1024; gI += 512) { const int t = gI >> 4, c8 = (gI & 15) * 8, col = n * 128 + c8;
            float o[8];
            { const f32x4 b0 = *(const LAS3 f32x4*)(CW + 512 + c8), b1 = *(const LAS3 f32x4*)(CW + 512 + c8 + 4); o[0] = b0[0]; o[1] = b0[1]; o[2] = b0[2]; o[3] = b0[3]; o[4] = b1[0]; o[5] = b1[1]; o[6] = b1[2]; o[7] = b1[3]; }
#pragma unroll
            for (int tap = 0; tap < 4; ++tap) { const v4u x = *(const LAS3 v4u*)(RAW + (t + tap) * 136 + c8);
                const f32x4 w0 = *(const LAS3 f32x4*)(CW + tap * 128 + c8), w1 = *(const LAS3 f32x4*)(CW + tap * 128 + c8 + 4);
                o[0] += w0[0] * pg8::bf_lo(x.x); o[1] += w0[1] * pg8::bf_hi(x.x); o[2] += w0[2] * pg8::bf_lo(x.y); o[3] += w0[3] * pg8::bf_hi(x.y);
                o[4] += w1[0] * pg8::bf_lo(x.z); o[5] += w1[1] * pg8::bf_hi(x.z); o[6] += w1[2] * pg8::bf_lo(x.w); o[7] += w1[3] * pg8::bf_hi(x.w); }
            v4u w; w.x = pk2(o[0], o[1]); w.y = pk2(o[2], o[3]); w.z = pk2(o[4], o[5]); w.w = pk2(o[6], o[7]);
            *(LAS3 v4u*)(Xb + t * 136 + c8) = w; }
        LBAR();
#pragma unroll
        for (int d = 0; d < 2; ++d) {
            {
                const int j0 = wave * 16;
                f32x4 acc[2][4];
#pragma unroll
                for (int g = 0; g < 2; ++g)
#pragma unroll
                    for (int mt = 0; mt < 4; ++mt) acc[g][mt] = (f32x4){0.f, 0.f, 0.f, 0.f};
#pragma unroll
                for (int ks = 0; ks < 4; ++ks) {
#pragma unroll
                    for (int mt = 0; mt < 4; ++mt) { const bf16x8 a = ldfrag(Xb, 136, mt * 16, ks * 32, fr, fq); MMA_TRN(acc[0][mt], a, wf[d][0][ks]); MMA_TRN(acc[1][mt], a, wf[d][1][ks]); } }
                const f32x4 gb0 = gbv[d][0], gb1 = gbv[d][1];
#pragma unroll
                for (int mt = 0; mt < 4; ++mt) { const int t = mt * 16 + fr; f32x4 av, bv;
                    const v2u xr = *(const LAS3 v2u*)(Xb + t * 136 + j0 + 4 * fq);
                    const float xc[4] = {pg8::bf_lo(xr.x), pg8::bf_hi(xr.x), pg8::bf_lo(xr.y), pg8::bf_hi(xr.y)};
#pragma unroll
                    for (int i = 0; i < 4; ++i) { const float a = __expf(sigm(acc[0][mt][i] + gb0[i]) * sp8[d][i]); av[i] = a; bv[i] = __builtin_amdgcn_sqrtf(fmaxf(1.0f - a * a, 0.f)) * sigm(acc[1][mt][i] + gb1[i]) * xc[i]; }
                    *(LAS3 f32x4*)(Aa + t * 128 + j0 + 4 * fq) = av; *(LAS3 f32x4*)(Bx + t * 128 + j0 + 4 * fq) = bv; }
            }
            LBAR();
            {
                const int ch = tid & 127, sg = tid >> 7, col = n * 128 + ch;
                float h = 0.f, ap = 1.f;
#pragma unroll 4
                for (int s2 = 0; s2 < 16; ++s2) { const int s = sg * 16 + s2, t = d ? 63 - s : s; const float a = Aa[t * 128 + ch]; h = a * h + Bx[t * 128 + ch]; ap *= a; }
                SGA[sg * 128 + ch] = ap; SGH[sg * 128 + ch] = h;
                LBAR();
                if (!FINAL) {
                    if (sg == 0) { float hh = 0.f, aa = 1.f;
#pragma unroll
                        for (int q = 0; q < 4; ++q) { const float a = SGA[q * 128 + ch]; hh = a * hh + SGH[q * 128 + ch]; aa *= a; }
                        float2 o; o.x = aa; o.y = hh; *(float2*)(agg + (((size_t)d * 264 + ck) * 2048 + col) * 2) = o; } }
                else { float hh = car[((size_t)d * 264 + ck) * 2048 + col];
#pragma unroll
                    for (int q = 0; q < 3; ++q) if (q < sg) hh = SGA[q * 128 + ch] * hh + SGH[q * 128 + ch];
#pragma unroll 4
                    for (int s2 = 0; s2 < 16; ++s2) { const int s = sg * 16 + s2, t = d ? 63 - s : s; hh = Aa[t * 128 + ch] * hh + Bx[t * 128 + ch];
                        if (d == 0) Hf[t * 128 + ch] = hh;
                        else { const float gx = bf2f(GT[t * 136 + ch]); const float u = 0.7978845608028654f * (gx + 0.044715f * gx * gx * gx);
                            Y[(size_t)(row0 + t) * D + col] = f2bf((Hf[t * 128 + ch] + hh) * 0.5f * gx * (1.0f + tanh_fast(u))); } } }
            }
            LBAR();
        }
    }
#undef LRU_FETCH
}
__device__ __forceinline__ void phase_lru_carry(const Frame& F) {
    const float* agg = (const float*)(F.ws + WS_LAGG); float* car = (float*)(F.ws + WS_LCAR);
    const int gid = F.bid * 512 + F.tid;
    if (gid < 8192) { const int d = gid >> 12, b = (gid >> 11) & 1, col = gid & 2047; float h = 0.f;
#pragma unroll 1
        for (int i0 = 0; i0 < 132; i0 += 12) { float2 a[12]; size_t o[12];
#pragma unroll
            for (int j = 0; j < 12; ++j) { const int i = i0 + j; const int ck = i < 4 ? 256 + b * 4 + (d ? 3 - i : i) : b * 128 + (d ? 127 - (i - 4) : (i - 4));
                o[j] = ((size_t)d * 264 + ck) * 2048 + col; a[j] = *(const float2*)(agg + o[j] * 2); }
#pragma unroll
            for (int j = 0; j < 12; ++j) { car[o[j]] = h; h = a[j].x * h + a[j].y; } } }
}

__device__ __forceinline__ void phase_route(const Frame& F) {
    int* rt = (int*)(F.ws + WS_ROUTE); unsigned* ctl = (unsigned*)(F.ws + WS_CTL);
    const bf16* V = (const bf16*)(F.ws + WS_U); bf16* A = (bf16*)(F.ws + WS_MA);
    int base[9]; base[0] = 0;
#pragma unroll
    for (int e = 0; e < 8; ++e) { const int c = (int)__hip_atomic_load(&ctl[CW_CNT + e], __ATOMIC_RELAXED, __HIP_MEMORY_SCOPE_AGENT); base[e + 1] = base[e] + ((c + 255) & ~255); }
    if (F.bid == 0 && F.tid == 0) { rt[RT_NT] = base[8] >> 8; for (int e = 0; e < 8; ++e) { rt[RT_BASE + e] = base[e]; for (int t = base[e] >> 8; t < (base[e + 1] >> 8); ++t) rt[RT_TILEE + t] = e; } }
    for (int tok = F.bid * 8 + F.wave; tok < MLAT; tok += F.G * 8) {
        int r0 = 0, r1 = 0;
        if (F.lane == 0) { const int e0 = rt[RT_TOKE + tok * 2], e1 = rt[RT_TOKE + tok * 2 + 1];
            int b0 = 0, b1 = 0;
#pragma unroll
            for (int e = 0; e < 8; ++e) { if (e == e0) b0 = base[e]; if (e == e1) b1 = base[e]; }
            r0 = b0 + (int)atomicAdd(&ctl[CW_CUR + e0], 1u); r1 = b1 + (int)atomicAdd(&ctl[CW_CUR + e1], 1u);
            rt[RT_TOKROW + tok * 2] = r0; rt[RT_TOKROW + tok * 2 + 1] = r1; }
        r0 = __shfl(r0, 0); r1 = __shfl(r1, 0);
#pragma unroll
        for (int i = 0; i < 4; ++i) { const v4u v = *(const v4u*)(V + (size_t)tok * D + i * 512 + F.lane * 8);
            *(v4u*)(A + (size_t)r0 * D + i * 512 + F.lane * 8) = v; *(v4u*)(A + (size_t)r1 * D + i * 512 + F.lane * 8) = v; }
    }
    for (int e = 0; e < 8; ++e) { const int c = (int)__hip_atomic_load(&ctl[CW_CNT + e], __ATOMIC_RELAXED, __HIP_MEMORY_SCOPE_AGENT); const int lo = base[e] + c, hi = base[e + 1];
        for (int row = lo + F.bid * 8 + F.wave; row < hi; row += F.G * 8)
#pragma unroll
            for (int i = 0; i < 4; ++i) *(v4u*)(A + (size_t)row * D + i * 512 + F.lane * 8) = (v4u){0u, 0u, 0u, 0u}; }
}
__device__ __forceinline__ void phase_final(const Frame& F, const float* modL) {
    const int* rt = (const int*)(F.ws + WS_ROUTE);
    const float* hlat = (const float*)(F.ws + WS_HLAT); const bf16* O = (const bf16*)(F.ws + WS_X1);
    const float* nf = F.a->in[I_NFIN]; float* out = F.a->out;
    for (int tok = F.bid * 8 + F.wave; tok < MLAT; tok += F.G * 8) {
        const int b = tok >> 13; const float* gf = modL + b * 12288 + 5 * 2048;
        const int r0 = rt[RT_TOKROW + tok * 2], r1 = rt[RT_TOKROW + tok * 2 + 1]; const float p0 = ((const float*)rt)[RT_TOKP + tok * 2], p1 = ((const float*)rt)[RT_TOKP + tok * 2 + 1];
        f32x4 x[8]; float ss = 0.f;
#pragma unroll
        for (int i = 0; i < 8; ++i) { const int c = i * 256 + F.lane * 4;
            const f32x4 h = *(const f32x4*)(hlat + (size_t)tok * D + c), g = *(const f32x4*)(gf + c);
            const uint2 a = *(const uint2*)(O + (size_t)r0 * D + c), bb = *(const uint2*)(O + (size_t)r1 * D + c);
            f32x4 m; m[0] = p0 * pg8::bf_lo(a.x) + p1 * pg8::bf_lo(bb.x); m[1] = p0 * pg8::bf_hi(a.x) + p1 * pg8::bf_hi(bb.x); m[2] = p0 * pg8::bf_lo(a.y) + p1 * pg8::bf_lo(bb.y); m[3] = p0 * pg8::bf_hi(a.y) + p1 * pg8::bf_hi(bb.y);
            x[i] = h + g * m; ss += x[i][0] * x[i][0] + x[i][1] * x[i][1] + x[i][2] * x[i][2] + x[i][3] * x[i][3]; }
        ss = wave_sum(ss);
        const float rs = rsqrtf(ss * (1.0f / D) + EPS);
#pragma unroll
        for (int i = 0; i < 8; ++i) { const int c = i * 256 + F.lane * 4; const f32x4 g = *(const f32x4*)(nf + c); *(f32x4*)(out + (size_t)tok * D + c) = x[i] * rs * g; }
    }
}

constexpr int NPH_LAYER = 17, NPH = 1 + 2 * NPH_LAYER;
#if !MK_PER_PHASE
#define SEAM() xcd_barrier(bar)
#else
#define SEAM() do {} while (0)
#endif
#define IN(k) (lo <= (PB + (k)) && (PB + (k)) < hi)
template <int L>
__device__ __forceinline__ void layer_program(const Frame& F, const Args& args, const XcdBarrier& bar, const int lo, const int hi) {
    constexpr int PB = 1 + L * NPH_LAYER;
    const float* modL = (const float*)(F.ws + WS_MOD) + (size_t)L * 3 * 12288;
    if (IN(0)) { if (L == 0) { phase_mod(F); __syncthreads(); phase_convw_layer(F, L, F.G, F.bid); phase_lora_prep(F, L, F.G, F.bid); } SEAM(); }
    if (IN(1)) { phase_norm<false>(F, L == 0 ? args.in[I_X] : (const float*)(F.ws + WS_HLAT), L == 0 ? args.in[I_CTX] : (const float*)(F.ws + WS_HCTX), args.in[I_NMIX] + L * 2048, modL, 0, 2048, (bf16*)(F.ws + WS_U), L & 1, MROWS); SEAM(); }
    if (IN(2)) { pg8::Gemm g{(const bf16*)(F.ws + WS_U), (const bf16*)(F.ws + WS_X1), MROWS, NP, 2048}; pg8::StaticOrder S; S.init(MROWS, NP, F.G, F.bid); pg8::EpiStoreBf16 E{(bf16*)(F.ws + WS_P), NP, 0};
        pg8::gemm_phase<pg8::EpiStoreBf16, pg8::StaticOrder, false>(F.lds, g, S, E, nullptr); SEAM(); }
    if (IN(3)) { phase_lora_in(F, L); SEAM();
#pragma unroll 1
        for (int gq = 0; gq < 4; ++gq) { phase_rwkv_r1(F, L, gq); SEAM(); phase_rwkv_r2(F, gq); SEAM(); } }
    if (IN(4)) { phase_rwkv_out(F, L); SEAM(); }
    if (IN(5)) { phase_ssm_conv(F, L); __syncthreads(); phase_lru_par<false>(F, L); SEAM(); }
    if (IN(6)) { phase_lru_carry(F); phase_ssm_chain(F, L); SEAM(); }
    if (IN(7)) { phase_ssm_out(F, L); __syncthreads(); phase_lru_par<true>(F, L); SEAM(); }
    constexpr int nM = L == 1 ? 64 : 66;
    if (IN(9)) { pg8::Gemm g{(const bf16*)(F.ws + WS_Y3), (const bf16*)(F.ws + WS_WOUT), MROWS, 2048, 2048}; pg8::MergeOrder S{nM * 8, F.G, F.bid}; pg8::EpiMerge E{(const bf16*)(F.ws + WS_P), NP, (bf16*)(F.ws + WS_X1)};
        pg8::gemm_phase<pg8::EpiMerge, pg8::MergeOrder, false>(F.lds, g, S, E, nullptr); SEAM(); }
    if (IN(10)) { pg8::Gemm g{(const bf16*)(F.ws + WS_X1), (const bf16*)(F.ws + WS_WOUT) + (size_t)3 * 2048 * 2048, nM * 256, 2048, 2048}; pg8::StaticOrder S; S.init(nM * 256, 2048, F.G, F.bid);
        pg8::EpiResid E{L == 0 ? args.in[I_X] : (const float*)(F.ws + WS_HLAT), L == 0 ? args.in[I_CTX] : (const float*)(F.ws + WS_HCTX), (float*)(F.ws + WS_HLAT), (float*)(F.ws + WS_HCTX), modL + 2 * 2048, L & 1};
        pg8::gemm_phase<pg8::EpiResid, pg8::StaticOrder, false>(F.lds, g, S, E, nullptr);
        if (L == 0) { __syncthreads(); if (F.G > 32) { if (F.bid >= 16) phase_convw_ffn(F, L, F.G - 16, F.bid - 16); } else phase_convw_ffn(F, L, F.G, F.bid); }
        SEAM(); }
    if (IN(11)) { phase_norm<L == 1>(F, (const float*)(F.ws + WS_HLAT), (const float*)(F.ws + WS_HCTX), args.in[I_NFFN] + L * 2048, modL, 3 * 2048, 4 * 2048, (bf16*)(F.ws + WS_U), 0, L == 0 ? MROWS : MLAT); SEAM(); }
    if (IN(12)) { if (L == 1) { phase_convw_ffn(F, L, F.G, F.bid); SEAM(); } }
    if constexpr (L == 0) {
        if (IN(13)) { pg8::Gemm g{(const bf16*)(F.ws + WS_U), (const bf16*)(F.ws + WS_F13), MROWS, 12288, 2048}; pg8::StaticOrder S; S.init(MROWS, 12288, F.G, F.bid); pg8::EpiSwiGLU E{(bf16*)(F.ws + WS_FH), 6144, 0};
            pg8::gemm_phase<pg8::EpiSwiGLU, pg8::StaticOrder, false>(F.lds, g, S, E, nullptr); SEAM(); }
        if (IN(14)) { pg8::Gemm g{(const bf16*)(F.ws + WS_FH), (const bf16*)(F.ws + WS_F2), MROWS, 2048, 6144}; pg8::StaticOrder S; S.init(MROWS, 2048, F.G, F.bid);
            pg8::EpiResid E{(const float*)(F.ws + WS_HLAT), (const float*)(F.ws + WS_HCTX), (float*)(F.ws + WS_HLAT), (float*)(F.ws + WS_HCTX), modL + 5 * 2048, 0};
            pg8::gemm_phase<pg8::EpiResid, pg8::StaticOrder, false>(F.lds, g, S, E, nullptr);
            __syncthreads(); if (F.G > 32) { if (F.bid >= 16) { phase_convw_layer(F, 1, F.G - 16, F.bid - 16); phase_lora_prep(F, 1, F.G - 16, F.bid - 16); } } else { phase_convw_layer(F, 1, F.G, F.bid); phase_lora_prep(F, 1, F.G, F.bid); }
            SEAM(); }
    } else {
        const int* rt = (const int*)(F.ws + WS_ROUTE);
        if (IN(13)) { phase_route(F); SEAM(); }
        if (IN(14)) { pg8::Gemm g{(const bf16*)(F.ws + WS_MA), (const bf16*)(F.ws + WS_M13), MOE_ROWS, 8 * 6144, 2048}; pg8::MoeOrder S{rt + RT_TILEE, rt + RT_NT, 24, F.G, F.bid};
            pg8::EpiSwiGLU E{(bf16*)(F.ws + WS_MH), 3072, 24};
            pg8::gemm_phase<pg8::EpiSwiGLU, pg8::MoeOrder, false>(F.lds, g, S, E, nullptr); SEAM(); }
        if (IN(15)) { pg8::Gemm g{(const bf16*)(F.ws + WS_MH), (const bf16*)(F.ws + WS_M2), MOE_ROWS, 8 * 2048, 3072}; pg8::MoeOrder S{rt + RT_TILEE, rt + RT_NT, 8, F.G, F.bid};
            pg8::EpiStoreBf16 E{(bf16*)(F.ws + WS_X1), 2048, 8};
            pg8::gemm_phase<pg8::EpiStoreBf16, pg8::MoeOrder, false>(F.lds, g, S, E, nullptr); SEAM(); }
        if (IN(16)) { phase_final(F, modL); }
    }
}
#undef IN
__global__ void __launch_bounds__(512, 2) fwd(Args args) {
    extern __shared__ __attribute__((aligned(16))) unsigned char lds_raw[];
    Frame F; F.a = &args; F.ws = args.ws; F.lds = (LAS3 unsigned char*)lds_raw;
    F.tid = threadIdx.x; F.lane = F.tid & 63; F.wave = __builtin_amdgcn_readfirstlane(F.tid >> 6); F.G = gridDim.x; F.bid = blockIdx.x;
    volatile LAS3 unsigned* MISC = (volatile LAS3 unsigned*)(F.lds + MISC_OFF);
    if (F.tid < 32) MISC[F.tid] = 0u;
    __syncthreads();
    unsigned* ctl = (unsigned*)(F.ws + WS_CTL);
#if !MK_PER_PHASE
    XcdBarrier bar = xcd_barrier_post(ctl + CW_BAR, MISC + 8);
#else
    XcdBarrier bar; bar.bar = ctl + CW_BAR; bar.x = 0; bar.st = MISC + 8;
#endif
    const int lo = args.lo, hi = args.hi;
    layer_program<0>(F, args, bar, lo, hi);
    layer_program<1>(F, args, bar, lo, hi);
}

extern "C" void kernel_launch(void* const* d_in, const int* in_sizes, int n_in, void* d_out, int out_size, void* d_ws, size_t ws_size, hipStream_t stream) {
    static int grid = 0;
    if (grid == 0) {
        if (n_in != N_INPUTS || out_size != MLAT * D || ws_size < WS_END) { fprintf(stderr, "kernel_launch: unexpected shapes (n_in %d, out %d, ws %zu); nothing launched\n", n_in, out_size, ws_size); grid = -1; return; }
        int dev = 0, cus = 0;
        if (hipGetDevice(&dev) != hipSuccess || hipDeviceGetAttribute(&cus, hipDeviceAttributeMultiprocessorCount, dev) != hipSuccess) { grid = -1; return; }
        if (hipFuncSetAttribute((const void*)fwd, hipFuncAttributeMaxDynamicSharedMemorySize, LDS_BYTES) != hipSuccess) { fprintf(stderr, "kernel_launch: hipFuncSetAttribute failed\n"); grid = -1; return; }
        int per_cu = 0;
        if (hipOccupancyMaxActiveBlocksPerMultiprocessor(&per_cu, (const void*)fwd, 512, LDS_BYTES) != hipSuccess || per_cu < 1) { fprintf(stderr, "kernel_launch: occupancy query says %d\n", per_cu); }
        (void)hipGetLastError();
        grid = cus;
    }
    if (grid < 0) return;
    (void)hipMemsetAsync((char*)d_ws + WS_CTL, 0, CTL_BYTES, stream);
    Args a{};
    for (int i = 0; i < N_INPUTS; ++i) a.in[i] = (const float*)d_in[i];
    a.out = (float*)d_out; a.ws = (unsigned char*)d_ws;
#if MK_PER_PHASE
    for (int p = 0; p < NPH; ++p) { a.lo = p; a.hi = p + 1; hipLaunchKernelGGL(fwd, dim3(grid), dim3(512), LDS_BYTES, stream, a); }
#else
    a.lo = 0; a.hi = NPH; hipLaunchKernelGGL(fwd, dim3(grid), dim3(512), LDS_BYTES, stream, a);
#endif
}
```

```cpp
#include <hip/hip_runtime.h>
#include <cstdio>
#include <cstdint>

#ifndef MK_PER_PHASE
#define MK_PER_PHASE 0
#endif

namespace pg8 {
#define PG8_LAS __attribute__((address_space(3)))
typedef unsigned short bf16_t;
typedef short bf16x8 __attribute__((ext_vector_type(8)));
typedef float f32x4 __attribute__((ext_vector_type(4)));
typedef unsigned u32x4 __attribute__((ext_vector_type(4)));
constexpr int BM = 256, BK = 64, HALF = 128, HTB = HALF * BK * 2  , STAGE_BYTES = 8 * HTB, NXCD = 8, WGM = 8;

__host__ __device__ __forceinline__ int lds_byte(int r, int c) { const int st = (r >> 4) * 2 + (c >> 5), rr = r & 15, cc = c & 31, ob = rr * 64 + cc * 2; return st * 1024 + (ob ^ (((ob >> 9) & 1) << 5)); }
__host__ __device__ __forceinline__ void stage_rc(int b, int& R, int& C) { const int st = b / 1024, sb = b % 1024, swz = sb ^ (((sb >> 9) & 1) << 5); R = (st >> 1) * 16 + swz / 64; C = (st & 1) * 32 + (swz % 64) / 2; }
__host__ __device__ __forceinline__ int perm32(int rho) { const int n = rho >> 4, i = rho & 15; return 8 * (i >> 2) + 4 * n + (i & 3); }

struct Unit { int pm, pn; };
struct Gemm { const bf16_t* A; const bf16_t* Bt; int M, N, K; };

struct StaticOrder {
    int nM, nN, nwg, G, c;
    __host__ __device__ void init(int M, int N, int G_, int c_) { nM = M / BM; nN = N / BM; nwg = nM * nN; G = G_; c = c_; }
    __host__ __device__ bool next(int i, Unit& u) const {
        const long L = (long)i * G + c; if (L >= nwg) return false;
        int wgid = (int)L; { const int q = nwg / NXCD, r = nwg % NXCD, xcd = wgid % NXCD, off = wgid / NXCD; wgid = (xcd < r ? xcd * (q + 1) : r * (q + 1) + (xcd - r) * q) + off; }
        const int nig = WGM * nN, gid = wgid / nig, fm = gid * WGM, gsz = (nM - fm) < WGM ? (nM - fm) : WGM;
        u.pm = fm + ((wgid % nig) % gsz); u.pn = (wgid % nig) / gsz; return true;
    }
    __device__ __forceinline__ void a_ready(const Unit&) const {}
    __device__ __forceinline__ void done(const Unit&) const {}
};
typedef __bf16 hbf16x2_ __attribute__((ext_vector_type(2)));
typedef float hf32x2_ __attribute__((ext_vector_type(2)));
__device__ __forceinline__ unsigned cvt_pk_bf16(float lo, float hi) { const hf32x2_ v = {lo, hi}; const hbf16x2_ b = __builtin_convertvector(v, hbf16x2_); return __builtin_bit_cast(unsigned, b); }
typedef float f32x2 __attribute__((ext_vector_type(2)));
__device__ __forceinline__ f32x2 gelu_pk(f32x2 v) {
    const f32x2 av = __builtin_elementwise_abs(v), d = av * 0.2316418882f + 1.0f;
    f32x2 t; t.x = __builtin_amdgcn_rcpf(d.x); t.y = __builtin_amdgcn_rcpf(d.y);
    f32x2 q = t * 0.5307027145f + (-0.7265760135f); q = q * t + 0.7107068705f; q = q * t + (-0.142248368f); q = q * t + 0.127414796f; q = q * t;
    const f32x2 s = (v * v) * (-0.72134752044f);
    f32x2 e; e.x = __builtin_amdgcn_exp2f(s.x); e.y = __builtin_amdgcn_exp2f(s.y);
    const f32x2 m = v * (q * e), r = v - m;
    f32x2 o; o.x = v.x < 0.f ? m.x : r.x; o.y = v.y < 0.f ? m.y : r.y; return o;
}
template <class Epi, class Sched, bool ALIGN_EPI = false, bool SP2 = false>
__device__ __forceinline__ void gemm_phase(PG8_LAS unsigned char* lds, const Gemm g, const Sched& S, const Epi& E) {
    const int tid = threadIdx.x, wid = __builtin_amdgcn_readfirstlane(tid >> 6), lane = tid & 63, wr = wid >> 2, wc = wid & 3, fr = lane & 15, fq = lane >> 4;
    const int K = g.K, nt = K / BK;
    unsigned voffA[2], voffB[2];
#pragma unroll
    for (int i = 0; i < 2; ++i) { int R, C; stage_rc(tid * 16 + i * 8192, R, C); const int Rb = Epi::PERM ? ((R & ~31) + perm32(R & 31)) : R;
        voffA[i] = (unsigned)(R * K + C) * 2u; voffB[i] = (unsigned)(Rb * K + C) * 2u; }
    const size_t kstep = (size_t)(BK * 2);
    const size_t hstep = (size_t)HALF * K * 2;
    const size_t tstep = 2 * hstep;
    const unsigned ldsw = (unsigned)wid * 1024u;
    const int aoff = lds_byte(wr * 64 + fr, fq * 8), boff = lds_byte(wc * 32 + fr, fq * 8);
#define PG8_SA(b, h) (((b) * 2 + (h)) * HTB)
#define PG8_SB(b, h) ((4 + (b) * 2 + (h)) * HTB)
#define PG8_STAGE(bufoff, gbase, voff) do { _Pragma("unroll") for (int _i = 0; _i < 2; ++_i) \
        __builtin_amdgcn_global_load_lds((const unsigned*)((const char*)(gbase) + (voff)[_i]), (PG8_LAS unsigned*)(lds + (bufoff) + ldsw + _i * 8192), 16, 0, 0); } while (0)
#define PG8_LDA(dst, b, h) do { _Pragma("unroll") for (int m = 0; m < 4; ++m) _Pragma("unroll") for (int k = 0; k < 2; ++k) dst[m][k] = *(const PG8_LAS bf16x8*)(lds + PG8_SA(b, h) + aoff + m * 2048 + k * 1024); } while (0)
#define PG8_LDB(dst, b, h) do { _Pragma("unroll") for (int n = 0; n < 2; ++n) _Pragma("unroll") for (int k = 0; k < 2; ++k) dst[n][k] = *(const PG8_LAS bf16x8*)(lds + PG8_SB(b, h) + boff + n * 2048 + k * 1024); } while (0)
#define PG8_MMA(ai, bj, At, Bt) do { __builtin_amdgcn_s_setprio(1); _Pragma("unroll") for (int m = 0; m < 4; ++m) _Pragma("unroll") for (int n = 0; n < 2; ++n) _Pragma("unroll") for (int k = 0; k < 2; ++k) \
        acc[ai][bj][m][n] = __builtin_amdgcn_mfma_f32_16x16x32_bf16(Bt[n][k], At[m][k], acc[ai][bj][m][n], 0, 0, 0); __builtin_amdgcn_s_setprio(0); } while (0)
#define PG8_WAIT_V(n) asm volatile("s_waitcnt vmcnt(" #n ")" ::: "memory")
#define PG8_WAIT_L(n) asm volatile("s_waitcnt lgkmcnt(" #n ")" ::: "memory")
#define PG8_BAR __builtin_amdgcn_s_barrier()
#define PG8_SCHED __builtin_amdgcn_sched_barrier(0)
    Unit cur, nxt; int ui = 0;
    if (!S.next(0, cur)) return;
    f32x4 acc[2][2][4][2];
#pragma unroll
    for (int a = 0; a < 2; ++a)
#pragma unroll
        for (int b = 0; b < 2; ++b)
#pragma unroll
            for (int m = 0; m < 4; ++m)
#pragma unroll
                for (int n = 0; n < 2; ++n) acc[a][b][m][n] = (f32x4){0.f, 0.f, 0.f, 0.f};
    bf16x8 At[4][2], B0[2][2], B1[2][2];
    const char* cA = (const char*)g.A + (size_t)cur.pm * tstep; const char* cB = (const char*)g.Bt + (size_t)cur.pn * tstep;
    S.a_ready(cur);
    if constexpr (SP2) {
        PG8_STAGE(PG8_SB(0, 0), cB, voffB); PG8_STAGE(PG8_SB(0, 1), cB + hstep, voffB); PG8_STAGE(PG8_SA(0, 0), cA, voffA); PG8_STAGE(PG8_SA(0, 1), cA + hstep, voffA);
        if (wr == 1) PG8_BAR;
        PG8_WAIT_V(2); PG8_BAR;
        PG8_STAGE(PG8_SB(1, 0), cB + kstep, voffB); PG8_STAGE(PG8_SA(1, 0), cA + kstep, voffA); PG8_STAGE(PG8_SB(1, 1), cB + hstep + kstep, voffB);
        PG8_WAIT_V(6); PG8_BAR;
    } else {
        PG8_STAGE(PG8_SB(0, 0), cB, voffB); PG8_STAGE(PG8_SA(0, 0), cA, voffA); PG8_STAGE(PG8_SB(0, 1), cB + hstep, voffB); PG8_STAGE(PG8_SA(0, 1), cA + hstep, voffA);
        if (wr == 1) PG8_BAR;
        PG8_WAIT_V(4); PG8_BAR;
        PG8_STAGE(PG8_SB(1, 0), cB + kstep, voffB); PG8_STAGE(PG8_SA(1, 0), cA + kstep, voffA); PG8_STAGE(PG8_SB(1, 1), cB + hstep + kstep, voffB);
        PG8_WAIT_V(6); PG8_BAR;
    }
    for (;;) {
        const bool has_next = S.next(ui + 1, nxt);
        const char* nA = has_next ? (const char*)g.A + (size_t)nxt.pm * tstep : cA; const char* nB = has_next ? (const char*)g.Bt + (size_t)nxt.pn * tstep : cB;
        for (int t = 0; t < nt; t += 2) {
            const bool last = (t == nt - 2);
            const char* a1 = cA + (size_t)(t + 1) * kstep;
            const char* a2 = last ? nA : cA + (size_t)(t + 2) * kstep; const char* b2 = last ? nB : cB + (size_t)(t + 2) * kstep;
            const char* a3 = a2 + kstep; const char* b3 = b2 + kstep;
            if (last && has_next) S.a_ready(nxt);
            if constexpr (SP2) {
            PG8_LDB(B0, 0, 0); PG8_LDB(B1, 0, 1); PG8_SCHED; PG8_LDA(At, 0, 0); PG8_STAGE(PG8_SA(1, 1), a1 + hstep, voffA);
            PG8_WAIT_V(8); PG8_WAIT_L(0); PG8_BAR; PG8_MMA(0, 0, At, B0); PG8_MMA(0, 1, At, B1); PG8_BAR; PG8_SCHED;
            PG8_LDA(At, 0, 1); PG8_STAGE(PG8_SB(0, 0), b2, voffB); PG8_STAGE(PG8_SB(0, 1), b2 + hstep, voffB); PG8_STAGE(PG8_SA(0, 0), a2, voffA);
            PG8_WAIT_V(8); PG8_WAIT_L(0); PG8_BAR; PG8_MMA(1, 0, At, B0); PG8_MMA(1, 1, At, B1); PG8_BAR; PG8_SCHED;
            PG8_LDB(B0, 1, 0); PG8_LDB(B1, 1, 1); PG8_SCHED; PG8_LDA(At, 1, 0); PG8_STAGE(PG8_SA(0, 1), a2 + hstep, voffA);
            PG8_WAIT_V(8); PG8_WAIT_L(0); PG8_BAR; PG8_MMA(0, 0, At, B0); PG8_MMA(0, 1, At, B1); PG8_BAR; PG8_SCHED;
            PG8_LDA(At, 1, 1); PG8_STAGE(PG8_SB(1, 0), b3, voffB); PG8_STAGE(PG8_SB(1, 1), b3 + hstep, voffB); PG8_STAGE(PG8_SA(1, 0), a3, voffA);
            PG8_WAIT_V(8); PG8_WAIT_L(0); PG8_BAR; PG8_MMA(1, 0, At, B0); PG8_MMA(1, 1, At, B1); PG8_BAR; PG8_SCHED;
            } else {
            PG8_LDB(B0, 0, 0); PG8_SCHED; PG8_LDA(At, 0, 0); PG8_STAGE(PG8_SA(1, 1), a1 + hstep, voffA);
            PG8_WAIT_L(8); PG8_BAR; PG8_WAIT_L(0); PG8_MMA(0, 0, At, B0); PG8_BAR; PG8_SCHED;
            PG8_LDB(B1, 0, 1); PG8_STAGE(PG8_SB(0, 0), b2, voffB);
            PG8_BAR; PG8_WAIT_L(0); PG8_MMA(0, 1, At, B1); PG8_BAR;
            PG8_LDA(At, 0, 1); PG8_STAGE(PG8_SA(0, 0), a2, voffA);
            PG8_BAR; PG8_WAIT_L(0); PG8_MMA(1, 0, At, B0); PG8_BAR; PG8_SCHED;
            PG8_STAGE(PG8_SB(0, 1), b2 + hstep, voffB);
            PG8_WAIT_V(6); PG8_BAR; PG8_MMA(1, 1, At, B1); PG8_BAR;
            PG8_LDB(B0, 1, 0); PG8_SCHED; PG8_LDA(At, 1, 0); PG8_STAGE(PG8_SA(0, 1), a2 + hstep, voffA);
            PG8_WAIT_L(8); PG8_BAR; PG8_WAIT_L(0); PG8_MMA(0, 0, At, B0); PG8_BAR; PG8_SCHED;
            PG8_LDB(B1, 1, 1); PG8_STAGE(PG8_SB(1, 0), b3, voffB);
            PG8_BAR; PG8_WAIT_L(0); PG8_MMA(0, 1, At, B1); PG8_BAR;
            PG8_LDA(At, 1, 1); PG8_STAGE(PG8_SA(1, 0), a3, voffA);
            PG8_BAR; PG8_WAIT_L(0); PG8_MMA(1, 0, At, B0); PG8_BAR; PG8_SCHED;
            PG8_STAGE(PG8_SB(1, 1), b3 + hstep, voffB);
            PG8_WAIT_V(6); PG8_BAR; PG8_MMA(1, 1, At, B1); PG8_BAR;
            }
        }
        if constexpr (ALIGN_EPI) { if (wr == 0) PG8_BAR; }
        if constexpr (!Epi::AFTER_DRAIN) { E(acc, cur, wr, wc, fr, fq); S.done(cur); }
        if (!has_next) break;
#pragma unroll
        for (int a = 0; a < 2; ++a)
#pragma unroll
            for (int b = 0; b < 2; ++b)
#pragma unroll
                for (int m = 0; m < 4; ++m)
#pragma unroll
                    for (int n = 0; n < 2; ++n) acc[a][b][m][n] = (f32x4){0.f, 0.f, 0.f, 0.f};
        cur = nxt; cA = nA; cB = nB; ++ui;
        if constexpr (ALIGN_EPI) { if (wr == 1) PG8_BAR; }
    }
    PG8_WAIT_V(0);
    if constexpr (!ALIGN_EPI) { if (wr == 0) PG8_BAR; }
    PG8_BAR;
    if constexpr (Epi::AFTER_DRAIN) { E.fused(acc, cur, wr, wc, fr, fq, lds, wid, lane); S.done(cur); }
#undef PG8_SA
#undef PG8_SB
#undef PG8_STAGE
#undef PG8_LDA
#undef PG8_LDB
#undef PG8_MMA
#undef PG8_WAIT_V
#undef PG8_WAIT_L
#undef PG8_BAR
#undef PG8_SCHED
}

template <class Epi, class Sched, bool STAMP>
__device__ __forceinline__ void gemm_phase(PG8_LAS unsigned char* lds, const Gemm g, const Sched& S, const Epi& E, unsigned long long*) { gemm_phase<Epi, Sched, true, true>(lds, g, S, E); }
__device__ __forceinline__ float bf_lo(unsigned w) { return __uint_as_float(w << 16); }
__device__ __forceinline__ float bf_hi(unsigned w) { return __uint_as_float(w & 0xffff0000u); }
__device__ __forceinline__ float sigmoidf_(float x) { return __builtin_amdgcn_rcpf(1.0f + __expf(-x)); }

struct EpiStoreBf16 {
    static constexpr bool PERM = true, AFTER_DRAIN = false;
    bf16_t* O; int ldc; int npn;
    __device__ __forceinline__ void operator()(const f32x4 (&acc)[2][2][4][2], const Unit& u, int wr, int wc, int fr, int fq) const {
        const int pn = npn ? (u.pn % npn) : u.pn;
        const int row0 = u.pm * BM + wr * 64 + fr, col0 = pn * BM + wc * 32 + 8 * fq;
#pragma unroll
        for (int ai = 0; ai < 2; ++ai)
#pragma unroll
            for (int m = 0; m < 4; ++m) { bf16_t* rowp = O + (size_t)(row0 + ai * HALF + m * 16) * ldc + col0;
#pragma unroll
                for (int bj = 0; bj < 2; ++bj) { const f32x4 v0 = acc[ai][bj][m][0], v1 = acc[ai][bj][m][1];
                    u32x4 w; w.x = cvt_pk_bf16(v0[0], v0[1]); w.y = cvt_pk_bf16(v0[2], v0[3]); w.z = cvt_pk_bf16(v1[0], v1[1]); w.w = cvt_pk_bf16(v1[2], v1[3]);
                    *(u32x4*)(rowp + bj * HALF) = w; } }
    }
};
struct EpiSwiGLU {
    static constexpr bool PERM = true, AFTER_DRAIN = false;
    bf16_t* H; int ldh; int npn;
    __device__ __forceinline__ void operator()(const f32x4 (&acc)[2][2][4][2], const Unit& u, int wr, int wc, int fr, int fq) const {
        const int pn = npn ? (u.pn % npn) : u.pn;
        const int row0 = u.pm * BM + wr * 64 + fr, col0 = pn * HALF + wc * 32 + 8 * fq;
#pragma unroll
        for (int ai = 0; ai < 2; ++ai)
#pragma unroll
            for (int m = 0; m < 4; ++m) { bf16_t* rowp = H + (size_t)(row0 + ai * HALF + m * 16) * ldh + col0;
                float o[8];
#pragma unroll
                for (int n = 0; n < 2; ++n)
#pragma unroll
                    for (int j = 0; j < 4; ++j) { const float a = acc[ai][0][m][n][j], b = acc[ai][1][m][n][j]; o[n * 4 + j] = a * sigmoidf_(a) * b; }
                u32x4 w; w.x = cvt_pk_bf16(o[0], o[1]); w.y = cvt_pk_bf16(o[2], o[3]); w.z = cvt_pk_bf16(o[4], o[5]); w.w = cvt_pk_bf16(o[6], o[7]);
                *(u32x4*)rowp = w; }
    }
};
struct EpiMerge {
    static constexpr bool PERM = true, AFTER_DRAIN = false;
    const bf16_t* P; int ldp; bf16_t* Mb;
    __device__ __forceinline__ void operator()(const f32x4 (&acc)[2][2][4][2], const Unit& u, int wr, int wc, int fr, int fq) const {
        const int br = u.pn >> 3, pn = u.pn & 7, pm = u.pm - br * 66;
        const int row0 = pm * BM + wr * 64 + fr, col0 = pn * BM + wc * 32 + 8 * fq;
#pragma unroll
        for (int ai = 0; ai < 2; ++ai)
#pragma unroll
            for (int m = 0; m < 4; ++m) { const size_t row = (size_t)(row0 + ai * HALF + m * 16);
#pragma unroll
                for (int bj = 0; bj < 2; ++bj) { const int col = col0 + bj * HALF;
                    const u32x4 g = *(const u32x4*)(P + row * ldp + br * 2048 + col);
                    const f32x4 v0 = acc[ai][bj][m][0], v1 = acc[ai][bj][m][1];
                    float o[8];
                    o[0] = sigmoidf_(bf_lo(g.x)) * v0[0]; o[1] = sigmoidf_(bf_hi(g.x)) * v0[1]; o[2] = sigmoidf_(bf_lo(g.y)) * v0[2]; o[3] = sigmoidf_(bf_hi(g.y)) * v0[3];
                    o[4] = sigmoidf_(bf_lo(g.z)) * v1[0]; o[5] = sigmoidf_(bf_hi(g.z)) * v1[1]; o[6] = sigmoidf_(bf_lo(g.w)) * v1[2]; o[7] = sigmoidf_(bf_hi(g.w)) * v1[3];
                    bf16_t* mp = Mb + row * 2048 + col;
                    if (br > 0) { const u32x4 q = *(const u32x4*)mp;
                        o[0] += bf_lo(q.x); o[1] += bf_hi(q.x); o[2] += bf_lo(q.y); o[3] += bf_hi(q.y); o[4] += bf_lo(q.z); o[5] += bf_hi(q.z); o[6] += bf_lo(q.w); o[7] += bf_hi(q.w); }
                    u32x4 w; w.x = cvt_pk_bf16(o[0], o[1]); w.y = cvt_pk_bf16(o[2], o[3]); w.z = cvt_pk_bf16(o[4], o[5]); w.w = cvt_pk_bf16(o[6], o[7]);
                    *(u32x4*)mp = w; } }
    }
};
struct MergeOrder {
    int ntile, G, c;
    __device__ bool next(int i, Unit& u) const { const int t = i / 3, br = i - 3 * t; const long q = (long)t * G + c; if (q >= ntile) return false;
        u.pm = br * 66 + (int)(q >> 3); u.pn = br * 8 + (int)(q & 7); return true; }
    __device__ __forceinline__ void a_ready(const Unit&) const {}
    __device__ __forceinline__ void done(const Unit&) const {}
};
struct EpiResid {
    static constexpr bool PERM = false, AFTER_DRAIN = false;
    const float* hin_lat; const float* hin_ctx; float* hout_lat; float* hout_ctx; const float* gate; int odd;
    __device__ __forceinline__ void operator()(const f32x4 (&acc)[2][2][4][2], const Unit& u, int wr, int wc, int fr, int fq) const {
        const int row0 = u.pm * BM + wr * 64 + fr, col0 = u.pn * BM + wc * 32 + 4 * fq;
#pragma unroll
        for (int ai = 0; ai < 2; ++ai)
#pragma unroll
            for (int m = 0; m < 4; ++m) { const int R = row0 + ai * HALF + m * 16;
                const float* hi; float* ho; const float* gv;
                if (R < 16384) { const int b = R >> 13, lp = R & 8191; const int l = odd ? ((lp & 127) * 64 + (lp >> 7)) : lp; const size_t dr = (size_t)(b * 8192 + l) * 2048;
                    hi = hin_lat + dr; ho = hout_lat + dr; gv = gate + b * 12288; }
                else { const size_t dr = (size_t)(R - 16384) * 2048; hi = hin_ctx + dr; ho = hout_ctx + dr; gv = gate + 2 * 12288; }
#pragma unroll
                for (int bj = 0; bj < 2; ++bj)
#pragma unroll
                    for (int n = 0; n < 2; ++n) { const int c = col0 + bj * HALF + n * 16;
                        const f32x4 h = *(const f32x4*)(hi + c), g = *(const f32x4*)(gv + c);
                        *(f32x4*)(ho + c) = h + g * acc[ai][bj][m][n]; } }
    }
};
struct EpiGateMul {
    static constexpr bool PERM = true, AFTER_DRAIN = false;
    const bf16_t* Z; bf16_t* Y;
    __device__ __forceinline__ void operator()(const f32x4 (&acc)[2][2][4][2], const Unit& u, int wr, int wc, int fr, int fq) const {
        const int row0 = u.pm * BM + wr * 64 + fr, col0 = u.pn * BM + wc * 32 + 8 * fq;
#pragma unroll
        for (int ai = 0; ai < 2; ++ai)
#pragma unroll
            for (int m = 0; m < 4; ++m) { const size_t ro = (size_t)(row0 + ai * HALF + m * 16) * 2048 + col0;
#pragma unroll
                for (int bj = 0; bj < 2; ++bj) { const u32x4 z = *(const u32x4*)(Z + ro + bj * HALF); const f32x4 v0 = acc[ai][bj][m][0], v1 = acc[ai][bj][m][1];
                    u32x4 w; w.x = cvt_pk_bf16(bf_lo(z.x) * v0[0], bf_hi(z.x) * v0[1]); w.y = cvt_pk_bf16(bf_lo(z.y) * v0[2], bf_hi(z.y) * v0[3]);
                    w.z = cvt_pk_bf16(bf_lo(z.z) * v1[0], bf_hi(z.z) * v1[1]); w.w = cvt_pk_bf16(bf_lo(z.w) * v1[2], bf_hi(z.w) * v1[3]);
                    *(u32x4*)(Y + ro + bj * HALF) = w; } }
    }
};
struct MoeOrder {
    const int* tile_e; const int* ntiles; int npn, G, c;
    __device__ bool next(int i, Unit& u) const { const long L = (long)i * G + c; const int nt = *ntiles; if (L >= (long)nt * npn) return false;
        const int pm = (int)(L / npn), pl = (int)(L - (long)pm * npn); u.pm = pm; u.pn = tile_e[pm] * npn + pl; return true; }
    __device__ __forceinline__ void a_ready(const Unit&) const {}
    __device__ __forceinline__ void done(const Unit&) const {}
};
}

#include <vector>
#include <vector>

#define XB_TMO      128
#define XB_XCNT(j)  (256  + 64 * (j))
#define XB_XSUB(j)  (1280 + 64 * (j))
#define XB_XGEN(j)  (2304 + 64 * (j))
#define XB_TOP      3328
#define XB_TOPGEN   3392
#define XCD_BAR_WORDS 3456
#define XB_SPIN_CAP (1u << 18)
#define LAS __attribute__((address_space(3)))

__device__ __forceinline__ unsigned xb_ld(unsigned* p)              { return __hip_atomic_load(p, __ATOMIC_RELAXED, __HIP_MEMORY_SCOPE_AGENT); }
__device__ __forceinline__ unsigned xb_add(unsigned* p, unsigned v) { return __hip_atomic_fetch_add(p, v, __ATOMIC_RELAXED, __HIP_MEMORY_SCOPE_AGENT); }
__device__ __forceinline__ unsigned xb_xcc_id() { return (unsigned)__builtin_amdgcn_s_getreg((3 << 11) | 20) & 0xFu; }
#define XB_SPIN(cond, bar) do { unsigned _sp = 0; while (cond) { __builtin_amdgcn_s_sleep(1); \
    if ((++_sp & 255u) == 0u) { if (xb_ld(&(bar)[XB_TMO])) break; if (_sp > XB_SPIN_CAP) { atomicAdd(&(bar)[XB_TMO], 1u); break; } } } } while (0)

struct XcdBarrier {
    unsigned* bar; unsigned x;
    volatile LAS unsigned* st;
};

__device__ __forceinline__ XcdBarrier xcd_barrier_post(unsigned* bar, volatile LAS unsigned* st) {
    XcdBarrier b; b.bar = bar; b.x = xb_xcc_id(); b.st = st;
    if (threadIdx.x == 0) (void)xb_add(&bar[XB_XCNT(b.x)], 1u);
    return b;
}
__device__ __forceinline__ void xcd_barrier_complete(unsigned* bar, unsigned x, unsigned& nloc, unsigned& nx) {
    const unsigned G = gridDim.x * gridDim.y * gridDim.z;
    unsigned sum, cnt, mine, sp = 0u;
    for (;;) {
        sum = 0u; cnt = 0u; mine = 0u;
#pragma unroll
        for (unsigned j = 0; j < 16; ++j) { const unsigned c = xb_ld(&bar[XB_XCNT(j)]); sum += c; cnt += (c > 0u) ? 1u : 0u; mine = (j == x) ? c : mine; }
        if (sum == G) break;
        __builtin_amdgcn_s_sleep(1);
        if ((++sp & 255u) == 0u) { if (xb_ld(&bar[XB_TMO])) break; if (sp > XB_SPIN_CAP) { atomicAdd(&bar[XB_TMO], 1u); break; } }
    }
    nloc = mine > 0u ? mine : 1u; nx = cnt > 0u ? cnt : 1u;
}

__device__ __forceinline__ void xcd_barrier(const XcdBarrier& b) {
    asm volatile("s_waitcnt vmcnt(0)" ::: "memory");
    __syncthreads();
    if (threadIdx.x == 0) {
        unsigned* bar = b.bar;
        __builtin_amdgcn_s_waitcnt(0);
        unsigned nloc = b.st[0], nx = b.st[1];
        if (nloc == 0u) { xcd_barrier_complete(bar, b.x, nloc, nx); b.st[0] = nloc; b.st[1] = nx; }
        const unsigned old = xb_add(&bar[XB_XSUB(b.x)], 1u);
        const unsigned gen = old / nloc;
        if (old + 1u == (gen + 1u) * nloc) {
            __builtin_amdgcn_fence(__ATOMIC_RELEASE, "agent");
            asm volatile("s_waitcnt vmcnt(0)" ::: "memory");
            const unsigned og = xb_add(&bar[XB_TOP], 1u);
            const unsigned tg = og / nx;
            if (og + 1u == (tg + 1u) * nx) xb_add(&bar[XB_TOPGEN], 1u);
            else XB_SPIN(xb_ld(&bar[XB_TOPGEN]) == tg, bar);
            __builtin_amdgcn_fence(__ATOMIC_ACQUIRE, "agent");
            xb_add(&bar[XB_XGEN(b.x)], 1u);
            asm volatile("s_waitcnt vmcnt(0)" ::: "memory");
        } else {
            XB_SPIN(xb_ld(&bar[XB_XGEN(b.x)]) == gen, bar);
            __builtin_amdgcn_fence(__ATOMIC_ACQUIRE, "agent");
            asm volatile("s_waitcnt vmcnt(0)" ::: "memory");
        }
    }
    __syncthreads();
}

typedef unsigned short bf16;
typedef unsigned v4u __attribute__((ext_vector_type(4)));
typedef unsigned v2u __attribute__((ext_vector_type(2)));
typedef float f32x4 __attribute__((ext_vector_type(4)));
constexpr int D = 2048, SEQ = 8192, CTXL = 256, MLAT = 16384, MCTX = 512, MROWS = 16896;
constexpr int NP = 22272;
constexpr int PG = 0, PL = 6144, PLG = 8192, PR = 10240, PK = 12288, PV = 14336, PZ = 16384, PX = 18432, PWL = 21504, PAL = 21696, PGL = 21888, PDT = 22144;
constexpr int N_IN = 22208;
constexpr float EPS = 1e-6f;
enum { I_X = 0, I_C, I_CTX, I_CCTX, I_ADAW, I_ADAB, I_NMIX, I_NFFN, I_NFIN, I_WIN, I_LCW, I_LCB, I_LGW, I_LGB, I_LLAM,
       I_RMU, I_RW0, I_RWUP, I_RA0, I_RAUP, I_RGUP, I_RKK, I_RKA, I_RRK, I_RLNW, I_RLNB,
       I_SCW, I_SCB, I_SALOG, I_SDTB, I_SD, I_SNW, I_WOL, I_WOR, I_WOS, I_WO, I_F1, I_F3, I_F2, I_MR, I_M1, I_M3, I_M2, N_INPUTS };
constexpr size_t MiB = 1u << 20;
constexpr size_t WS_CTL = 0, CTL_BYTES = 1 * MiB;
constexpr size_t WS_MOD = 1 * MiB;
constexpr size_t WS_ROUTE = 2 * MiB;
constexpr size_t WS_BONUS = 3 * MiB;
constexpr size_t WS_HCTX = 8 * MiB;
constexpr size_t WS_WOUT = 12 * MiB;
constexpr size_t WS_HLAT = 44 * MiB;
constexpr size_t WS_Y3 = 172 * MiB;
constexpr size_t WS_X1 = 370 * MiB;
constexpr size_t WS_U = WS_X1 + 87 * MiB;
constexpr size_t WS_P = 523 * MiB;
constexpr size_t WS_LGW = 1241 * MiB;
constexpr size_t WS_LORA = 1243 * MiB;
constexpr size_t WS_GUP = 1245 * MiB;
constexpr size_t WS_LAGG = 1246 * MiB;
constexpr size_t WS_LCAR = 1256 * MiB;
constexpr size_t WS_X2 = 1264 * MiB;
constexpr size_t WS_LIN = 1396 * MiB;
constexpr size_t WS_SG = 1409 * MiB;
constexpr size_t WS_END = 1418 * MiB;
constexpr size_t WS_F13 = WS_P, WS_F2 = WS_P + 48 * MiB, WS_FH = WS_P + 72 * MiB;
constexpr size_t WS_M13 = WS_P, WS_M2 = WS_P + 192 * MiB, WS_MA = WS_P + 288 * MiB, WS_MH = WS_P + 424 * MiB;
constexpr int MOE_ROWS = 34816;
static_assert(WS_MH + (size_t)MOE_ROWS * 3072 * 2 <= WS_END && WS_FH + (size_t)MROWS * 6144 * 2 <= WS_END && WS_P + (size_t)MROWS * NP * 2 <= WS_END, "ws map");
constexpr int CW_BAR = 4096;
constexpr int CW_CNT = 16384, CW_CUR = 16384 + 64;
constexpr int RT_TOKE = 0, RT_TOKP = 32768, RT_TOKROW = 65536, RT_TILEE = 98304, RT_NT = 98304 + 256, RT_BASE = 98304 + 320;
constexpr int LDS_BYTES = 163840, MISC_OFF = 163840 - 256;

struct Args { const float* in[N_INPUTS]; float* out; unsigned char* ws; int lo, hi; };

__device__ __forceinline__ float bf2f(bf16 b) { return __uint_as_float(((unsigned)b) << 16); }
typedef __bf16 hbf16x2 __attribute__((ext_vector_type(2)));
typedef float hf32x2 __attribute__((ext_vector_type(2)));
__device__ __forceinline__ unsigned pk2(float lo, float hi) { const hf32x2 v = {lo, hi}; const hbf16x2 b = __builtin_convertvector(v, hbf16x2); return __builtin_bit_cast(unsigned, b); }
__device__ __forceinline__ bf16 f2bf(float f) { return (bf16)(pk2(f, f) & 0xffffu); }
#define DPPF(v, ctrl) __int_as_float(__builtin_amdgcn_update_dpp(0, __float_as_int(v), (ctrl), 0xF, 0xF, true))
__device__ __forceinline__ float quad_xor1(float v) { return DPPF(v, 0xB1); }
__device__ __forceinline__ float quad_xor2(float v) { return DPPF(v, 0x4E); }
__device__ __forceinline__ float rdlane(float v, int l) { return __int_as_float(__builtin_amdgcn_readlane(__float_as_int(v), l)); }
__device__ __forceinline__ float wave_sum(float v) { v += DPPF(v, 0xB1); v += DPPF(v, 0x4E); v += DPPF(v, 0x141); v += DPPF(v, 0x140);
    v += __int_as_float(__builtin_amdgcn_update_dpp(0, __float_as_int(v), 0x142, 0xA, 0xF, false));
    v += __int_as_float(__builtin_amdgcn_update_dpp(0, __float_as_int(v), 0x143, 0xC, 0xF, false));
    return rdlane(v, 63); }
__device__ __forceinline__ float wave_scan(float v, int lane) { v += DPPF(v, 0x111); v += DPPF(v, 0x112); v += DPPF(v, 0x114); v += DPPF(v, 0x118);
    const float t0 = rdlane(v, 15), t1 = rdlane(v, 31), t2 = rdlane(v, 47); const int r = lane >> 4;
    return v + (r >= 1 ? t0 : 0.f) + (r >= 2 ? t1 : 0.f) + (r >= 3 ? t2 : 0.f); }
__device__ __forceinline__ float sigm(float x) { return __builtin_amdgcn_rcpf(1.0f + __expf(-x)); }
__device__ __forceinline__ float siluf(float x) { return x * sigm(x); }
__device__ __forceinline__ float softplusf(float x) { const float e = __expf(x); return x > 20.f ? x : (e < 0.05f ? e * (1.0f - e * (0.5f - e * (0.33333333f - 0.25f * e))) : __logf(1.0f + e)); }
__device__ __forceinline__ float tanh_fast(float x) { return 1.0f - 2.0f * __builtin_amdgcn_rcpf(1.0f + __expf(2.0f * x)); }
__device__ __forceinline__ float softplus_fast(float x) { return x > 20.f ? x : __logf(1.0f + __expf(x)); }
#define LBAR() do { asm volatile("s_waitcnt lgkmcnt(0)" ::: "memory"); __builtin_amdgcn_s_barrier(); asm volatile("" ::: "memory"); } while (0)
__device__ __forceinline__ float gelu_tanh(float x) { const float u = 0.7978845608028654f * (x + 0.044715f * x * x * x); return 0.5f * x * (1.0f + tanhf(u)); }
__device__ __forceinline__ void seq_pos(int row, int& pos, int& len) { if (row < MLAT) { pos = row & (SEQ - 1); len = SEQ; } else { pos = (row - MLAT) & (CTXL - 1); len = CTXL; } }
__device__ __forceinline__ int chain_row(int b, int dir, int s) { if (s < CTXL) { const int t = dir ? CTXL - 1 - s : s; return MLAT + b * CTXL + t; } s -= CTXL; const int t = dir ? SEQ - 1 - s : s; return b * SEQ + t; }
#define CROW(r0_, dir_, t_) ((dir_) ? (r0_) - (t_) : (r0_) + (t_))
__device__ __forceinline__ float Pat(const bf16* P, int row, int col) { return bf2f(P[(size_t)row * NP + col]); }
__device__ __forceinline__ float shifted(const bf16* P, int row, int col, float mu) {
    int pos, len; seq_pos(row, pos, len);
    const float p = Pat(P, row, col), pv = pos > 0 ? Pat(P, row - 1, col) : 0.f, nx = pos < len - 1 ? Pat(P, row + 1, col) : 0.f;
    return p + mu * (0.5f * (pv + nx) - p);
}
__device__ __forceinline__ float dwconv(const bf16* P, int row, int col, const float* w, int ncol, int wc, float bias) {
    int pos, len; seq_pos(row, pos, len);
    float o = bias;
#pragma unroll
    for (int tap = 0; tap < 4; ++tap) { const int q = pos + tap - 2; if (q >= 0 && q < len) o += w[tap * ncol + wc] * Pat(P, row + tap - 2, col); }
    return o;
}
#define LAS3 __attribute__((address_space(3)))

struct Frame { const Args* a; unsigned char* ws; LAS3 unsigned char* lds; int tid, lane, wave, G, bid; };

__device__ __forceinline__ void phase_mod(const Frame& F) {
    LAS3 float* sv = (LAS3 float*)F.lds;
    LAS3 float* red = sv + 3 * 2048;
    const float* c = F.a->in[I_C]; const float* cc = F.a->in[I_CCTX];
    for (int i = F.tid; i < 3 * 2048; i += 512) { const int w = i >> 11, k = i & 2047; const float x = w < 2 ? c[w * 2048 + k] : cc[k]; sv[i] = siluf(x); }
    __syncthreads();
    float* mod = (float*)(F.ws + WS_MOD);
    const int kg = F.tid >> 7, j = F.tid & 127;
    for (int unit = F.bid; unit < 192; unit += F.G) {
        const int layer = unit / 96, col = (unit % 96) * 128 + j;
        const float* W = F.a->in[I_ADAW] + (size_t)layer * 2048 * 12288 + col;
        float a0 = 0.f, a1 = 0.f, a2 = 0.f;
        for (int k = kg * 512; k < kg * 512 + 512; ++k) { const float w = W[(size_t)k * 12288]; a0 += sv[k] * w; a1 += sv[2048 + k] * w; a2 += sv[4096 + k] * w; }
        red[(kg * 3 + 0) * 128 + j] = a0; red[(kg * 3 + 1) * 128 + j] = a1; red[(kg * 3 + 2) * 128 + j] = a2;
        __syncthreads();
        if (F.tid < 384) { const int w = F.tid >> 7; float s = F.a->in[I_ADAB][layer * 12288 + col];
            for (int q = 0; q < 4; ++q) s += red[(q * 3 + w) * 128 + j];
            mod[(size_t)(layer * 3 + w) * 12288 + col] = s; }
        __syncthreads();
    }
}

__device__ __forceinline__ int map_row(int type, int base, int n) {
    if (type == 0) return base + n;
    if (type == 2) return base + (n >> 7) * 256 + (n & 127);
    if (n < 16384) return n;
    if (n < 17024) return PWL + (n - 16384);
    if (n < 22144) return n - 640;
    return PDT + (n - 22144);
}
__device__ __forceinline__ void convT(const Frame& F, const float* src, int K, int N, bf16* dst, int type, int base, int& tile_rot, int nw, int rk) {
    LAS3 float* tile = (LAS3 float*)F.lds;
    const int nkt = K / 64, nnt = N / 64, nt = nkt * nnt;
    for (int t = (rk + nw - (tile_rot % nw)) % nw; t < nt; t += nw) {
        const int kt = t % nkt, ntl = t / nkt, k0 = kt * 64, n0 = ntl * 64;
        { const int r = F.tid >> 4, c4 = (F.tid & 15) * 4;
#pragma unroll
          for (int p = 0; p < 2; ++p) { const f32x4 v = *(const f32x4*)(src + (size_t)(k0 + r + p * 32) * N + n0 + c4);
              tile[(r + p * 32) * 65 + c4 + 0] = v[0]; tile[(r + p * 32) * 65 + c4 + 1] = v[1]; tile[(r + p * 32) * 65 + c4 + 2] = v[2]; tile[(r + p * 32) * 65 + c4 + 3] = v[3]; } }
        __syncthreads();
        { const int n = F.tid >> 3, kq = (F.tid & 7) * 8; float v[8];
#pragma unroll
          for (int i = 0; i < 8; ++i) v[i] = tile[(kq + i) * 65 + n];
          v4u w; w.x = pk2(v[0], v[1]); w.y = pk2(v[2], v[3]); w.z = pk2(v[4], v[5]); w.w = pk2(v[6], v[7]);
          *(v4u*)(dst + (size_t)map_row(type, base, n0 + n) * K + k0 + kq) = w; }
        __syncthreads();
    }
    tile_rot += nt;
}
__device__ __forceinline__ void phase_convw_layer(const Frame& F, int L, int nw, int rk) {
    int rot = 0;
    bf16* wt_in = (bf16*)(F.ws + WS_X1); bf16* wt_out = (bf16*)(F.ws + WS_WOUT);
    convT(F, F.a->in[I_WIN] + (size_t)L * 2048 * N_IN, 2048, N_IN, wt_in, 1, 0, rot, nw, rk);
    for (int i = rk * 512 + F.tid; i < 64 * 2048 / 8; i += nw * 512) ((v4u*)(wt_in + (size_t)N_IN * 2048))[i] = (v4u){0u, 0u, 0u, 0u};
    convT(F, F.a->in[I_WOL] + (size_t)L * 2048 * 2048, 2048, 2048, wt_out, 0, 0, rot, nw, rk);
    convT(F, F.a->in[I_WOR] + (size_t)L * 2048 * 2048, 2048, 2048, wt_out, 0, 2048, rot, nw, rk);
    convT(F, F.a->in[I_WOS] + (size_t)L * 2048 * 2048, 2048, 2048, wt_out, 0, 4096, rot, nw, rk);
    convT(F, F.a->in[I_WO] + (size_t)L * 2048 * 2048, 2048, 2048, wt_out, 0, 6144, rot, nw, rk);
    convT(F, F.a->in[I_RGUP] + (size_t)L * 256 * 2048, 256, 2048, (bf16*)(F.ws + WS_GUP), 0, 0, rot, nw, rk);
    for (int m = 0; m < 64; ++m) convT(F, F.a->in[I_LGW] + ((size_t)L * 64 + m) * 128 * 128, 128, 128, (bf16*)(F.ws + WS_LGW), 0, m * 128, rot, nw, rk);
}
__device__ __forceinline__ void phase_convw_ffn(const Frame& F, int L, int nw, int rk) {
    int rot = 0;
    if (L == 0) {
        convT(F, F.a->in[I_F1], 2048, 6144, (bf16*)(F.ws + WS_F13), 2, 0, rot, nw, rk);
        convT(F, F.a->in[I_F3], 2048, 6144, (bf16*)(F.ws + WS_F13), 2, 128, rot, nw, rk);
        convT(F, F.a->in[I_F2], 6144, 2048, (bf16*)(F.ws + WS_F2), 0, 0, rot, nw, rk);
    } else {
        for (int e = 0; e < 8; ++e) {
            convT(F, F.a->in[I_M1] + (size_t)e * 2048 * 3072, 2048, 3072, (bf16*)(F.ws + WS_M13), 2, e * 6144, rot, nw, rk);
            convT(F, F.a->in[I_M3] + (size_t)e * 2048 * 3072, 2048, 3072, (bf16*)(F.ws + WS_M13), 2, e * 6144 + 128, rot, nw, rk);
            convT(F, F.a->in[I_M2] + (size_t)e * 3072 * 2048, 3072, 2048, (bf16*)(F.ws + WS_M2), 0, e * 2048, rot, nw, rk);
        }
    }
}

template <bool ROUTER> __forceinline__
__device__ __forceinline__ void phase_norm(const Frame& F, const float* hlat, const float* hctx, const float* gain, const float* modL, int sh_off, int sc_off, bf16* out, int permute, int nrows) {
    const float* router = F.a->in[I_MR];
    int* rt = (int*)(F.ws + WS_ROUTE); unsigned* ctl = (unsigned*)(F.ws + WS_CTL);
    for (int row = F.bid * 8 + F.wave; row < nrows; row += F.G * 8) {
        int lane = F.lane; asm volatile("" : "+v"(lane));
        const float* src; const float* mv; int drow;
        if (row < MLAT) { const int b = row >> 13, l = row & 8191; src = hlat + (size_t)row * D; mv = modL + b * 12288;
            drow = permute ? (b * 8192 + (l & 63) * 128 + (l >> 6)) : row; }
        else { src = hctx + (size_t)(row - MLAT) * D; mv = modL + 2 * 12288; drow = row; }
        f32x4 x[8]; float ss = 0.f;
#pragma unroll
        for (int i = 0; i < 8; ++i) { x[i] = *(const f32x4*)(src + i * 256 + lane * 4); ss += x[i][0] * x[i][0] + x[i][1] * x[i][1] + x[i][2] * x[i][2] + x[i][3] * x[i][3]; }
        ss = wave_sum(ss);
        const float rs = rsqrtf(ss * (1.0f / D) + EPS);
        float lg[8];
        if (ROUTER) {
#pragma unroll
            for (int e = 0; e < 8; ++e) lg[e] = 0.f; }
#pragma unroll
        for (int i = 0; i < 8; ++i) { const int c = i * 256 + lane * 4;
            const f32x4 g = *(const f32x4*)(gain + c), sc = *(const f32x4*)(mv + sc_off + c), sh = *(const f32x4*)(mv + sh_off + c);
            f32x4 v;
#pragma unroll
            for (int j = 0; j < 4; ++j) v[j] = x[i][j] * rs * g[j] * (1.0f + sc[j]) + sh[j];
            uint2 w; w.x = pk2(v[0], v[1]); w.y = pk2(v[2], v[3]);
            *(uint2*)(out + (size_t)drow * D + c) = w;
            if (ROUTER) {
#pragma unroll
                for (int j = 0; j < 4; ++j) { const f32x4 r0 = *(const f32x4*)(router + (size_t)(c + j) * 8), r1 = *(const f32x4*)(router + (size_t)(c + j) * 8 + 4);
                    lg[0] += v[j] * r0[0]; lg[1] += v[j] * r0[1]; lg[2] += v[j] * r0[2]; lg[3] += v[j] * r0[3]; lg[4] += v[j] * r1[0]; lg[5] += v[j] * r1[1]; lg[6] += v[j] * r1[2]; lg[7] += v[j] * r1[3]; } }
        }
        if (ROUTER) {
#pragma unroll
            for (int e = 0; e < 8; ++e) lg[e] = wave_sum(lg[e]);
            if (lane == 0) {
                int e0 = 0; float v0 = lg[0];
#pragma unroll
                for (int e = 1; e < 8; ++e) if (lg[e] > v0) { v0 = lg[e]; e0 = e; }
                int e1 = -1; float v1 = -3.0e38f;
#pragma unroll
                for (int e = 0; e < 8; ++e) if (e != e0 && lg[e] > v1) { v1 = lg[e]; e1 = e; }
                const float p0 = 1.0f / (1.0f + __expf(v1 - v0));
                rt[RT_TOKE + row * 2] = e0; rt[RT_TOKE + row * 2 + 1] = e1;
                ((float*)rt)[RT_TOKP + row * 2] = p0; ((float*)rt)[RT_TOKP + row * 2 + 1] = 1.0f - p0;
                atomicAdd(&ctl[CW_CNT + e0], 1u); atomicAdd(&ctl[CW_CNT + e1], 1u);
            }
        }
    }
}

typedef short bf16x8 __attribute__((ext_vector_type(8)));
__device__ __forceinline__ bf16x8 ldfrag(const LAS3 bf16* p, int ld, int r0, int k0, int fr, int fq) { return *(const LAS3 bf16x8*)(p + (r0 + fr) * ld + k0 + 8 * fq); }
__device__ __forceinline__ bf16x8 ldfrag_sw(const LAS3 bf16* p, int ld, int r0, int k0, int fr, int fq) { const int r = r0 + fr, c = ((k0 >> 3) + fq) ^ ((r >> 3) & 7); return *(const LAS3 bf16x8*)(p + r * ld + c * 8); }
__device__ __forceinline__ bf16x8 ldfrag_g(const bf16* p, int ld, int r0, int k0, int fr, int fq) { return *(const bf16x8*)(p + (size_t)(r0 + fr) * ld + k0 + 8 * fq); }
#define MMA_TRN(acc, xf, yf) acc = __builtin_amdgcn_mfma_f32_16x16x32_bf16(yf, xf, acc, 0, 0, 0)
#define MMA_STD(acc, xf, yf) acc = __builtin_amdgcn_mfma_f32_16x16x32_bf16(xf, yf, acc, 0, 0, 0)
__device__ __forceinline__ void phase_rwkv_seq(const Frame& F, int L) {
    const bf16* P = (const bf16*)(F.ws + WS_P);
    bf16* ydir = (bf16*)(F.ws + WS_X1);
    float* bonus = (float*)(F.ws + WS_BONUS);
    const float* mu = F.a->in[I_RMU] + (size_t)L * 6784;
    LAS3 float* Fr = (LAS3 float*)F.lds; LAS3 float* Fk = Fr + 2048; LAS3 float* Fv = Fk + 2048; LAS3 float* Fa = Fv + 2048; LAS3 float* Fb = Fa + 2048; LAS3 float* Fw = Fb + 2048;
    LAS3 float* Lw = Fw + 2048; LAS3 float* La = Lw + 32 * 96; LAS3 float* Yb = La + 32 * 96;
    for (int unit = F.bid; unit < 128; unit += F.G) {
        const int b = unit >> 6, h = (unit >> 1) & 31, d = unit & 1;
        const float* w0 = F.a->in[I_RW0] + (size_t)(L * 2 + d) * 2048; const float* a0 = F.a->in[I_RA0] + (size_t)(L * 2 + d) * 2048;
        const float* wup = F.a->in[I_RWUP] + (size_t)(L * 2 + d) * 96 * 2048; const float* aup = F.a->in[I_RAUP] + (size_t)(L * 2 + d) * 96 * 2048;
        const float* kkw = F.a->in[I_RKK] + (size_t)L * 2048; const float* kaw = F.a->in[I_RKA] + (size_t)L * 2048; const float* rkw = F.a->in[I_RRK] + (size_t)L * 2048;
        float S[8];
#pragma unroll
        for (int j = 0; j < 8; ++j) S[j] = 0.f;
        for (int ch = 0; ch < 264; ++ch) {
            for (int idx = F.tid; idx < 32 * 96; idx += 512) { const int t = idx / 96, j = idx - t * 96; const int row = chain_row(b, d, ch * 32 + t);
                Lw[idx] = tanhf(shifted(P, row, PWL + d * 96 + j, mu[6144 + d * 96 + j]));
                La[idx] = shifted(P, row, PAL + d * 96 + j, mu[6144 + 192 + d * 96 + j]); }
            __syncthreads();
            for (int i = 0; i < 4; ++i) { const int t = F.wave * 4 + i, c = F.lane, col = h * 64 + c; const int row = chain_row(b, d, ch * 32 + t);
                const float r = shifted(P, row, PR + col, mu[col]), k = shifted(P, row, PK + col, mu[2048 + col]), v = shifted(P, row, PV + col, mu[4096 + col]);
                float wpre = w0[col], apre = a0[col];
                for (int j = 0; j < 96; ++j) { wpre += Lw[t * 96 + j] * wup[(size_t)j * 2048 + col]; apre += La[t * 96 + j] * aup[(size_t)j * 2048 + col]; }
                const float wraw = -softplusf(-wpre) - 0.5f, wdec = __expf(-__expf(wraw)), asig = sigm(apre);
                const float kkv = k * kkw[col], n2 = wave_sum(kkv * kkv), kk = kkv * rsqrtf(n2 + 1e-12f);
                const float key = k * (1.0f + (asig - 1.0f) * kaw[col]);
                const float bon = wave_sum(r * key * rkw[col]);
                if (c == 0) bonus[((size_t)d * MROWS + row) * 32 + h] = bon;
                Fr[t * 64 + c] = r; Fk[t * 64 + c] = key; Fv[t * 64 + c] = v; Fa[t * 64 + c] = -kk; Fb[t * 64 + c] = kk * asig; Fw[t * 64 + c] = wdec; }
            __syncthreads();
            { const int vi = F.tid >> 3, kp = F.tid & 7;
              for (int t = 0; t < 32; ++t) { const int o = t * 64 + kp * 8;
                  float sa = 0.f;
#pragma unroll
                  for (int j = 0; j < 8; ++j) sa += S[j] * Fa[o + j];
                  sa += __shfl_xor(sa, 1); sa += __shfl_xor(sa, 2); sa += __shfl_xor(sa, 4);
                  const float vv = Fv[t * 64 + vi]; float y = 0.f;
#pragma unroll
                  for (int j = 0; j < 8; ++j) { S[j] = S[j] * Fw[o + j] + sa * Fb[o + j] + vv * Fk[o + j]; y += S[j] * Fr[o + j]; }
                  y += __shfl_xor(y, 1); y += __shfl_xor(y, 2); y += __shfl_xor(y, 4);
                  if (kp == 0) Yb[t * 64 + vi] = y; } }
            __syncthreads();
            for (int idx = F.tid; idx < 2048; idx += 512) { const int t = idx >> 6, c = idx & 63; const int row = chain_row(b, d, ch * 32 + t);
                ydir[((size_t)d * MROWS + row) * D + h * 64 + c] = f2bf(Yb[idx]); }
        }
        __syncthreads();
    }
}
__device__ __forceinline__ void phase_rwkv_out(const Frame& F, int L) {
    const bf16* P = (const bf16*)(F.ws + WS_P);
    const bf16* ydir = (const bf16*)(F.ws + WS_X1);
    const float* bonus = (const float*)(F.ws + WS_BONUS);
    bf16* Y = (bf16*)(F.ws + WS_Y3) + (size_t)1 * MROWS * D;
    const float* mu = F.a->in[I_RMU] + (size_t)L * 6784;
    const bf16* GupT = (const bf16*)(F.ws + WS_GUP);
    const float* lnw = F.a->in[I_RLNW] + (size_t)L * 2048; const float* lnb = F.a->in[I_RLNB] + (size_t)L * 2048;
    LAS3 bf16* sg = (LAS3 bf16*)F.lds;
    for (int unit = F.bid; unit < MROWS / 16; unit += F.G) {
        int tid = F.tid; asm volatile("" : "+v"(tid));
        const int lane = tid & 63, wave = __builtin_amdgcn_readfirstlane(tid >> 6), fr = lane & 15, fq = lane >> 4;
        const int row0 = unit * 16;
        { const int t = tid >> 5, j8 = (tid & 31) * 8, row = row0 + t; int pos, len; seq_pos(row, pos, len);
          const v4u x = *(const v4u*)(P + (size_t)row * NP + PGL + j8); v4u xp = (v4u){0u, 0u, 0u, 0u}, xn = xp;
          if (pos > 0) xp = *(const v4u*)(P + (size_t)(row - 1) * NP + PGL + j8);
          if (pos < len - 1) xn = *(const v4u*)(P + (size_t)(row + 1) * NP + PGL + j8);
          const float* mp = mu + 6144 + 384 + j8; float o[8];
          const float xv[8] = {pg8::bf_lo(x.x), pg8::bf_hi(x.x), pg8::bf_lo(x.y), pg8::bf_hi(x.y), pg8::bf_lo(x.z), pg8::bf_hi(x.z), pg8::bf_lo(x.w), pg8::bf_hi(x.w)};
          const float pv[8] = {pg8::bf_lo(xp.x), pg8::bf_hi(xp.x), pg8::bf_lo(xp.y), pg8::bf_hi(xp.y), pg8::bf_lo(xp.z), pg8::bf_hi(xp.z), pg8::bf_lo(xp.w), pg8::bf_hi(xp.w)};
          const float nv[8] = {pg8::bf_lo(xn.x), pg8::bf_hi(xn.x), pg8::bf_lo(xn.y), pg8::bf_hi(xn.y), pg8::bf_lo(xn.z), pg8::bf_hi(xn.z), pg8::bf_lo(xn.w), pg8::bf_hi(xn.w)};
#pragma unroll
          for (int j = 0; j < 8; ++j) o[j] = sigm(xv[j] + mp[j] * (0.5f * (pv[j] + nv[j]) - xv[j]));
          v4u w; w.x = pk2(o[0], o[1]); w.y = pk2(o[2], o[3]); w.z = pk2(o[4], o[5]); w.w = pk2(o[6], o[7]);
          *(LAS3 v4u*)(sg + t * 264 + j8) = w; }
        LBAR();
        bf16x8 af[8];
#pragma unroll
        for (int ks = 0; ks < 8; ++ks) af[ks] = ldfrag(sg, 264, 0, ks * 32, fr, fq);
        const int row = row0 + fr; int pos, len; seq_pos(row, pos, len);
#pragma unroll 1
        for (int hh = 0; hh < 4; ++hh) { const int h = wave * 4 + hh;
            f32x4 g[4], y[4];
#pragma unroll
            for (int nt = 0; nt < 4; ++nt) { g[nt] = (f32x4){0.f, 0.f, 0.f, 0.f};
#pragma unroll
                for (int ks = 0; ks < 8; ++ks) MMA_TRN(g[nt], af[ks], ldfrag_g(GupT, 256, h * 64 + nt * 16, ks * 32, fr, fq)); }
            float s1 = 0.f;
#pragma unroll
            for (int nt = 0; nt < 4; ++nt) { const int c4 = h * 64 + nt * 16 + 4 * fq;
                const uint2 a = *(const uint2*)(ydir + (size_t)row * D + c4), bb = *(const uint2*)(ydir + ((size_t)MROWS + row) * D + c4);
                y[nt][0] = pg8::bf_lo(a.x) + pg8::bf_lo(bb.x); y[nt][1] = pg8::bf_hi(a.x) + pg8::bf_hi(bb.x); y[nt][2] = pg8::bf_lo(a.y) + pg8::bf_lo(bb.y); y[nt][3] = pg8::bf_hi(a.y) + pg8::bf_hi(bb.y);
                s1 += y[nt][0] + y[nt][1] + y[nt][2] + y[nt][3]; }
            s1 += __shfl_xor(s1, 16); s1 += __shfl_xor(s1, 32);
            const float mean = s1 * (1.0f / 64.0f); float q = 0.f;
#pragma unroll
            for (int nt = 0; nt < 4; ++nt)
#pragma unroll
                for (int e = 0; e < 4; ++e) { const float dl = y[nt][e] - mean; q += dl * dl; }
            q += __shfl_xor(q, 16); q += __shfl_xor(q, 32);
            const float rstd = rsqrtf(q * (1.0f / 64.0f) + 64e-5f);
            const float bon = bonus[(size_t)row * 32 + h] + bonus[((size_t)MROWS + row) * 32 + h];
#pragma unroll
            for (int nt = 0; nt < 4; ++nt) { const int c4 = h * 64 + nt * 16 + 4 * fq;
                const uint2 x = *(const uint2*)(P + (size_t)row * NP + PV + c4); uint2 xp = make_uint2(0u, 0u), xn = xp;
                if (pos > 0) xp = *(const uint2*)(P + (size_t)(row - 1) * NP + PV + c4);
                if (pos < len - 1) xn = *(const uint2*)(P + (size_t)(row + 1) * NP + PV + c4);
                const f32x4 lw = *(const f32x4*)(lnw + c4), lb = *(const f32x4*)(lnb + c4), muv = *(const f32x4*)(mu + 4096 + c4);
                const float xv[4] = {pg8::bf_lo(x.x), pg8::bf_hi(x.x), pg8::bf_lo(x.y), pg8::bf_hi(x.y)}, pv[4] = {pg8::bf_lo(xp.x), pg8::bf_hi(xp.x), pg8::bf_lo(xp.y), pg8::bf_hi(xp.y)}, nv[4] = {pg8::bf_lo(xn.x), pg8::bf_hi(xn.x), pg8::bf_lo(xn.y), pg8::bf_hi(xn.y)};
                float o[4];
#pragma unroll
                for (int e = 0; e < 4; ++e) { const float vv = xv[e] + muv[e] * (0.5f * (pv[e] + nv[e]) - xv[e]); o[e] = ((y[nt][e] - mean) * rstd * lw[e] + lb[e] + bon * vv) * g[nt][e]; }
                uint2 w; w.x = pk2(o[0], o[1]); w.y = pk2(o[2], o[3]);
                *(uint2*)(Y + (size_t)row * D + c4) = w; } }
        LBAR();
    }
}

__device__ __forceinline__ void phase_ssm_seq(const Frame& F, int L) {
    const bf16* P = (const bf16*)(F.ws + WS_P);
    bf16* ydir = (bf16*)(F.ws + WS_X1);
    const float* cw = F.a->in[I_SCW] + (size_t)L * 4 * 3072; const float* cb = F.a->in[I_SCB] + (size_t)L * 3072;
    LAS3 float* X = (LAS3 float*)F.lds; LAS3 float* Bm = X + 32 * 64; LAS3 float* Cm = Bm + 32 * 128; LAS3 float* dtv = Cm + 32 * 128; LAS3 float* dav = dtv + 32; LAS3 float* Yb = dav + 32;
    for (int unit = F.bid; unit < 128; unit += F.G) {
        const int b = unit >> 6, h = (unit >> 1) & 31, d = unit & 1, g = h >> 3;
        const float Ad = -__expf(F.a->in[I_SALOG][(L * 2 + d) * 32 + h]); const float dtb = F.a->in[I_SDTB][(L * 2 + d) * 32 + h];
        float hs[16];
#pragma unroll
        for (int j = 0; j < 16; ++j) hs[j] = 0.f;
        for (int ch = 0; ch < 264; ++ch) {
            for (int idx = F.tid; idx < 32 * 320; idx += 512) { const int t = idx / 320, q = idx - t * 320; const int row = chain_row(b, d, ch * 32 + t);
                const int col = q < 64 ? h * 64 + q : (q < 192 ? 2048 + g * 128 + (q - 64) : 2560 + g * 128 + (q - 192));
                const float v = siluf(dwconv(P, row, PX + col, cw, 3072, col, cb[col]));
                if (q < 64) X[t * 64 + q] = v; else if (q < 192) Bm[t * 128 + q - 64] = v; else Cm[t * 128 + q - 192] = v; }
            if (F.tid < 32) { const int row = chain_row(b, d, ch * 32 + F.tid); const float dt = softplusf(Pat(P, row, PDT + d * 32 + h) + dtb); dtv[F.tid] = dt; dav[F.tid] = __expf(dt * Ad); }
            __syncthreads();
            { const int p = F.tid >> 3, np = F.tid & 7;
              for (int t = 0; t < 32; ++t) { const float da = dav[t], xs = dtv[t] * X[t * 64 + p]; float y = 0.f;
#pragma unroll
                  for (int j = 0; j < 16; ++j) { hs[j] = hs[j] * da + xs * Bm[t * 128 + np * 16 + j]; y += hs[j] * Cm[t * 128 + np * 16 + j]; }
                  y += __shfl_xor(y, 1); y += __shfl_xor(y, 2); y += __shfl_xor(y, 4);
                  if (np == 0) Yb[t * 64 + p] = y; } }
            __syncthreads();
            for (int idx = F.tid; idx < 2048; idx += 512) { const int t = idx >> 6, c = idx & 63; const int row = chain_row(b, d, ch * 32 + t);
                ydir[((size_t)d * MROWS + row) * D + h * 64 + c] = f2bf(Yb[idx]); }
        }
        __syncthreads();
    }
}
__device__ __forceinline__ void phase_ssm_out(const Frame& F, int L) {
    const bf16* P = (const bf16*)(F.ws + WS_P);
    const bf16* ydir = (const bf16*)(F.ws + WS_X1);
    bf16* Y = (bf16*)(F.ws + WS_Y3) + (size_t)2 * MROWS * D; const bf16* XA = (const bf16*)(F.ws + WS_X2);
    const float* dsk = F.a->in[I_SD] + (size_t)L * 32; const float* nw = F.a->in[I_SNW] + (size_t)L * 2048;
    for (int row = F.bid * 8 + F.wave; row < MROWS; row += F.G * 8) {
#pragma unroll 1
        for (int g = 0; g < 4; ++g) { const int c0 = g * 512 + F.lane * 8;
            const v4u a = *(const v4u*)(ydir + (size_t)row * D + c0), bb = *(const v4u*)(ydir + ((size_t)MROWS + row) * D + c0), zz = *(const v4u*)(P + (size_t)row * NP + PZ + c0);
            float y[8], z[8];
            y[0] = pg8::bf_lo(a.x) + pg8::bf_lo(bb.x); y[1] = pg8::bf_hi(a.x) + pg8::bf_hi(bb.x); y[2] = pg8::bf_lo(a.y) + pg8::bf_lo(bb.y); y[3] = pg8::bf_hi(a.y) + pg8::bf_hi(bb.y);
            y[4] = pg8::bf_lo(a.z) + pg8::bf_lo(bb.z); y[5] = pg8::bf_hi(a.z) + pg8::bf_hi(bb.z); y[6] = pg8::bf_lo(a.w) + pg8::bf_lo(bb.w); y[7] = pg8::bf_hi(a.w) + pg8::bf_hi(bb.w);
            z[0] = pg8::bf_lo(zz.x); z[1] = pg8::bf_hi(zz.x); z[2] = pg8::bf_lo(zz.y); z[3] = pg8::bf_hi(zz.y); z[4] = pg8::bf_lo(zz.z); z[5] = pg8::bf_hi(zz.z); z[6] = pg8::bf_lo(zz.w); z[7] = pg8::bf_hi(zz.w);
            const float dk = dsk[c0 >> 6]; float ss = 0.f; const v4u xx = *(const v4u*)(XA + (size_t)row * 3072 + c0);
            const float xs[8] = {pg8::bf_lo(xx.x), pg8::bf_hi(xx.x), pg8::bf_lo(xx.y), pg8::bf_hi(xx.y), pg8::bf_lo(xx.z), pg8::bf_hi(xx.z), pg8::bf_lo(xx.w), pg8::bf_hi(xx.w)};
#pragma unroll
            for (int j = 0; j < 8; ++j) { y[j] = (y[j] + dk * xs[j]) * siluf(z[j]); ss += y[j] * y[j]; }
            ss = wave_sum(ss);
            const float rs = rsqrtf(ss * (1.0f / 512.0f) + EPS);
            v4u w; w.x = pk2(y[0] * rs * nw[c0 + 0], y[1] * rs * nw[c0 + 1]); w.y = pk2(y[2] * rs * nw[c0 + 2], y[3] * rs * nw[c0 + 3]);
            w.z = pk2(y[4] * rs * nw[c0 + 4], y[5] * rs * nw[c0 + 5]); w.w = pk2(y[6] * rs * nw[c0 + 6], y[7] * rs * nw[c0 + 7]);
            *(v4u*)(Y + (size_t)row * D + c0) = w; }
    }
}

__device__ __forceinline__ void phase_lru_seq(const Frame& F, int L) {
    const bf16* P = (const bf16*)(F.ws + WS_P);
    bf16* hdir = (bf16*)(F.ws + WS_X1);
    const float* cw = F.a->in[I_LCW] + (size_t)L * 4 * 2048; const float* cb = F.a->in[I_LCB] + (size_t)L * 2048;
    LAS3 float* Xc = (LAS3 float*)F.lds; LAS3 float* Ga = Xc + 32 * 128; LAS3 float* Gb = Ga + 32 * 128; LAS3 float* Hb = Gb + 32 * 128;
    for (int unit = F.bid; unit < 64; unit += F.G) {
        const int b = unit >> 5, n = (unit >> 1) & 15, d = unit & 1;
        const int half = F.tid >> 8, gi = (F.tid >> 7) & 1, j = F.tid & 127, col = n * 128 + j;
        const float* gw = F.a->in[I_LGW] + ((((size_t)L * 2 + d) * 2 + gi) * 16 + n) * 128 * 128;
        const float gb = F.a->in[I_LGB][(((size_t)L * 2 + d) * 2 + gi) * 2048 + col];
        const float sp = softplusf(-F.a->in[I_LLAM][((size_t)L * 2 + d) * 2048 + col]);
        float hst = 0.f;
        for (int ch = 0; ch < 264; ++ch) {
            for (int idx = F.tid; idx < 32 * 128; idx += 512) { const int t = idx >> 7, k = idx & 127; const int row = chain_row(b, d, ch * 32 + t);
                Xc[idx] = dwconv(P, row, PL + n * 128 + k, cw, 2048, n * 128 + k, cb[n * 128 + k]); }
            __syncthreads();
            { float acc[16];
#pragma unroll
              for (int i = 0; i < 16; ++i) acc[i] = gb;
              for (int k = 0; k < 128; ++k) { const float w = gw[k * 128 + j];
#pragma unroll
                  for (int i = 0; i < 16; ++i) acc[i] += Xc[(half * 16 + i) * 128 + k] * w; }
#pragma unroll
              for (int i = 0; i < 16; ++i) { const float s = sigm(acc[i]); if (gi == 0) Ga[(half * 16 + i) * 128 + j] = -8.0f * s * sp; else Gb[(half * 16 + i) * 128 + j] = s; } }
            __syncthreads();
            if (F.tid < 128) { for (int t = 0; t < 32; ++t) { const float la = Ga[t * 128 + j], a = __expf(la); const float bx = sqrtf(-expm1f(2.0f * la)) * Gb[t * 128 + j] * Xc[t * 128 + j]; hst = a * hst + bx; Hb[t * 128 + j] = hst; } }
            __syncthreads();
            for (int idx = F.tid; idx < 32 * 128; idx += 512) { const int t = idx >> 7, k = idx & 127; const int row = chain_row(b, d, ch * 32 + t);
                hdir[((size_t)d * MROWS + row) * D + n * 128 + k] = f2bf(Hb[idx]); }
        }
        __syncthreads();
    }
}
__device__ __forceinline__ void phase_lru_out(const Frame& F, int L) {
    const bf16* P = (const bf16*)(F.ws + WS_P);
    const bf16* hdir = (const bf16*)(F.ws + WS_X1);
    bf16* Y = (bf16*)(F.ws + WS_Y3);
    for (size_t i = (size_t)F.bid * 512 + F.tid; i < (size_t)MROWS * D / 8; i += (size_t)F.G * 512) { const int row = (int)(i >> 8), c0 = (int)(i & 255) * 8;
        const v4u a = *(const v4u*)(hdir + (size_t)row * D + c0), bb = *(const v4u*)(hdir + ((size_t)MROWS + row) * D + c0), gg = *(const v4u*)(P + (size_t)row * NP + PLG + c0);
        v4u w;
        w.x = pk2((pg8::bf_lo(a.x) + pg8::bf_lo(bb.x)) * gelu_tanh(pg8::bf_lo(gg.x)), (pg8::bf_hi(a.x) + pg8::bf_hi(bb.x)) * gelu_tanh(pg8::bf_hi(gg.x)));
        w.y = pk2((pg8::bf_lo(a.y) + pg8::bf_lo(bb.y)) * gelu_tanh(pg8::bf_lo(gg.y)), (pg8::bf_hi(a.y) + pg8::bf_hi(bb.y)) * gelu_tanh(pg8::bf_hi(gg.y)));
        w.z = pk2((pg8::bf_lo(a.z) + pg8::bf_lo(bb.z)) * gelu_tanh(pg8::bf_lo(gg.z)), (pg8::bf_hi(a.z) + pg8::bf_hi(bb.z)) * gelu_tanh(pg8::bf_hi(gg.z)));
        w.w = pk2((pg8::bf_lo(a.w) + pg8::bf_lo(bb.w)) * gelu_tanh(pg8::bf_lo(gg.w)), (pg8::bf_hi(a.w) + pg8::bf_hi(bb.w)) * gelu_tanh(pg8::bf_hi(gg.w)));
        *(v4u*)(Y + (size_t)row * D + c0) = w; }
}


constexpr int RW_SLOT = 32768;
__device__ __forceinline__ void phase_lora_prep(const Frame& F, int L, int nw, int rk) {
    bf16* dst = (bf16*)(F.ws + WS_LORA);
    for (int idx = rk * 512 + F.tid; idx < 2 * 2 * 12 * 2048; idx += nw * 512) { const int col = idx & 2047, k8 = (idx >> 11) % 12, dw = idx / (12 * 2048);
        const float* src = (dw >> 1 ? F.a->in[I_RAUP] : F.a->in[I_RWUP]) + ((size_t)L * 2 + (dw & 1)) * 96 * 2048 + col; float v[8];
#pragma unroll
        for (int j = 0; j < 8; ++j) v[j] = src[(size_t)(k8 * 8 + j) * 2048];
        v4u w; w.x = pk2(v[0], v[1]); w.y = pk2(v[2], v[3]); w.z = pk2(v[4], v[5]); w.w = pk2(v[6], v[7]);
        *(v4u*)(dst + ((size_t)dw * 2048 + col) * 128 + k8 * 8) = w; }
}
__device__ __forceinline__ void phase_lora_in(const Frame& F, int L) {
    const bf16* P = (const bf16*)(F.ws + WS_P); bf16* LIN = (bf16*)(F.ws + WS_LIN);
    const float* mu = F.a->in[I_RMU] + (size_t)L * 6784 + 6144;
    for (int idx = F.bid * 512 + F.tid; idx < MROWS * 48; idx += F.G * 512) { const int row = idx / 48, g = idx - row * 48, d = g / 24, wa = (g % 24) / 12, k8 = (g % 12) * 8;
        const int col = (wa ? PAL : PWL) + d * 96 + k8; int pos, len; seq_pos(row, pos, len);
        const v4u x = *(const v4u*)(P + (size_t)row * NP + col); v4u xp = (v4u){0u, 0u, 0u, 0u}, xn = xp;
        if (pos > 0) xp = *(const v4u*)(P + (size_t)(row - 1) * NP + col);
        if (pos < len - 1) xn = *(const v4u*)(P + (size_t)(row + 1) * NP + col);
        const float* mp = mu + wa * 192 + d * 96 + k8; float o[8];
        const float xv[8] = {pg8::bf_lo(x.x), pg8::bf_hi(x.x), pg8::bf_lo(x.y), pg8::bf_hi(x.y), pg8::bf_lo(x.z), pg8::bf_hi(x.z), pg8::bf_lo(x.w), pg8::bf_hi(x.w)};
        const float pv[8] = {pg8::bf_lo(xp.x), pg8::bf_hi(xp.x), pg8::bf_lo(xp.y), pg8::bf_hi(xp.y), pg8::bf_lo(xp.z), pg8::bf_hi(xp.z), pg8::bf_lo(xp.w), pg8::bf_hi(xp.w)};
        const float nv[8] = {pg8::bf_lo(xn.x), pg8::bf_hi(xn.x), pg8::bf_lo(xn.y), pg8::bf_hi(xn.y), pg8::bf_lo(xn.z), pg8::bf_hi(xn.z), pg8::bf_lo(xn.w), pg8::bf_hi(xn.w)};
#pragma unroll
        for (int j = 0; j < 8; ++j) { const float sv = xv[j] + mp[j] * (0.5f * (pv[j] + nv[j]) - xv[j]); o[j] = wa ? sv : tanh_fast(sv); }
        v4u w; w.x = pk2(o[0], o[1]); w.y = pk2(o[2], o[3]); w.z = pk2(o[4], o[5]); w.w = pk2(o[6], o[7]);
        *(v4u*)(LIN + (size_t)row * 384 + d * 192 + wa * 96 + k8) = w; }
    bf16* SG = (bf16*)(F.ws + WS_SG); const float* mug = F.a->in[I_RMU] + (size_t)L * 6784 + 6144 + 384;
    for (int idx = F.bid * 512 + F.tid; idx < MROWS * 32; idx += F.G * 512) { const int row = idx >> 5, j8 = (idx & 31) * 8; int pos, len; seq_pos(row, pos, len);
        const v4u x = *(const v4u*)(P + (size_t)row * NP + PGL + j8); v4u xp = (v4u){0u, 0u, 0u, 0u}, xn = xp;
        if (pos > 0) xp = *(const v4u*)(P + (size_t)(row - 1) * NP + PGL + j8);
        if (pos < len - 1) xn = *(const v4u*)(P + (size_t)(row + 1) * NP + PGL + j8);
        const float* mp = mug + j8; float o[8];
        const float xv[8] = {pg8::bf_lo(x.x), pg8::bf_hi(x.x), pg8::bf_lo(x.y), pg8::bf_hi(x.y), pg8::bf_lo(x.z), pg8::bf_hi(x.z), pg8::bf_lo(x.w), pg8::bf_hi(x.w)};
        const float pv[8] = {pg8::bf_lo(xp.x), pg8::bf_hi(xp.x), pg8::bf_lo(xp.y), pg8::bf_hi(xp.y), pg8::bf_lo(xp.z), pg8::bf_hi(xp.z), pg8::bf_lo(xp.w), pg8::bf_hi(xp.w)};
        const float nv[8] = {pg8::bf_lo(xn.x), pg8::bf_hi(xn.x), pg8::bf_lo(xn.y), pg8::bf_hi(xn.y), pg8::bf_lo(xn.z), pg8::bf_hi(xn.z), pg8::bf_lo(xn.w), pg8::bf_hi(xn.w)};
#pragma unroll
        for (int j = 0; j < 8; ++j) o[j] = sigm(xv[j] + mp[j] * (0.5f * (pv[j] + nv[j]) - xv[j]));
        v4u w; w.x = pk2(o[0], o[1]); w.y = pk2(o[2], o[3]); w.z = pk2(o[4], o[5]); w.w = pk2(o[6], o[7]);
        *(v4u*)(SG + (size_t)row * 256 + j8) = w; }
}
__device__ __forceinline__ void phase_rwkv_pre(const Frame& F, int L) {
    bf16* ydir = (bf16*)(F.ws + WS_X1); const float* bonus = (const float*)(F.ws + WS_BONUS); const bf16* P = (const bf16*)(F.ws + WS_P);
    const float* lnw = F.a->in[I_RLNW] + (size_t)L * 2048; const float* lnb = F.a->in[I_RLNB] + (size_t)L * 2048; const float* muv = F.a->in[I_RMU] + (size_t)L * 6784 + 4096;
    for (int row = F.bid * 8 + F.wave; row < MROWS; row += F.G * 8) {
        int lane = F.lane; asm volatile("" : "+v"(lane));
        int pos, len; seq_pos(row, pos, len);
#pragma unroll 2
        for (int i = 0; i < 4; ++i) { const int col = i * 512 + lane * 8, h = col >> 6;
            const v4u a = *(const v4u*)(ydir + (unsigned)(row * D + col)), bb = *(const v4u*)(ydir + (unsigned)((MROWS + row) * D + col));
            const v4u x = *(const v4u*)(P + (unsigned)(row * NP + PV + col)); v4u xp = (v4u){0u, 0u, 0u, 0u}, xn = xp;
            if (pos > 0) xp = *(const v4u*)(P + (unsigned)((row - 1) * NP + PV + col));
            if (pos < len - 1) xn = *(const v4u*)(P + (unsigned)((row + 1) * NP + PV + col));
            float y[8];
            y[0] = pg8::bf_lo(a.x) + pg8::bf_lo(bb.x); y[1] = pg8::bf_hi(a.x) + pg8::bf_hi(bb.x); y[2] = pg8::bf_lo(a.y) + pg8::bf_lo(bb.y); y[3] = pg8::bf_hi(a.y) + pg8::bf_hi(bb.y);
            y[4] = pg8::bf_lo(a.z) + pg8::bf_lo(bb.z); y[5] = pg8::bf_hi(a.z) + pg8::bf_hi(bb.z); y[6] = pg8::bf_lo(a.w) + pg8::bf_lo(bb.w); y[7] = pg8::bf_hi(a.w) + pg8::bf_hi(bb.w);
            float s1 = ((y[0] + y[1]) + (y[2] + y[3])) + ((y[4] + y[5]) + (y[6] + y[7]));
            s1 += DPPF(s1, 0xB1); s1 += DPPF(s1, 0x4E); s1 += DPPF(s1, 0x141);
            const float mean = s1 * (1.0f / 64.0f); float q = 0.f;
#pragma unroll
            for (int e = 0; e < 8; ++e) { const float dl = y[e] - mean; q += dl * dl; }
            q += DPPF(q, 0xB1); q += DPPF(q, 0x4E); q += DPPF(q, 0x141);
            const float rstd = rsqrtf(q * (1.0f / 64.0f) + 64e-5f);
            const float bon = bonus[(unsigned)(row * 32 + h)] + bonus[(unsigned)((MROWS + row) * 32 + h)];
            const f32x4 w0 = *(const f32x4*)(lnw + col), w1 = *(const f32x4*)(lnw + col + 4), b0 = *(const f32x4*)(lnb + col), b1 = *(const f32x4*)(lnb + col + 4), m0 = *(const f32x4*)(muv + col), m1 = *(const f32x4*)(muv + col + 4);
            const float xv[8] = {pg8::bf_lo(x.x), pg8::bf_hi(x.x), pg8::bf_lo(x.y), pg8::bf_hi(x.y), pg8::bf_lo(x.z), pg8::bf_hi(x.z), pg8::bf_lo(x.w), pg8::bf_hi(x.w)};
            const float pq[8] = {pg8::bf_lo(xp.x), pg8::bf_hi(xp.x), pg8::bf_lo(xp.y), pg8::bf_hi(xp.y), pg8::bf_lo(xp.z), pg8::bf_hi(xp.z), pg8::bf_lo(xp.w), pg8::bf_hi(xp.w)};
            const float nq[8] = {pg8::bf_lo(xn.x), pg8::bf_hi(xn.x), pg8::bf_lo(xn.y), pg8::bf_hi(xn.y), pg8::bf_lo(xn.z), pg8::bf_hi(xn.z), pg8::bf_lo(xn.w), pg8::bf_hi(xn.w)};
            const float lw[8] = {w0[0], w0[1], w0[2], w0[3], w1[0], w1[1], w1[2], w1[3]}, lb[8] = {b0[0], b0[1], b0[2], b0[3], b1[0], b1[1], b1[2], b1[3]}, mm[8] = {m0[0], m0[1], m0[2], m0[3], m1[0], m1[1], m1[2], m1[3]};
            float o[8];
#pragma unroll
            for (int e = 0; e < 8; ++e) { const float vv = xv[e] + mm[e] * (0.5f * (pq[e] + nq[e]) - xv[e]); o[e] = (y[e] - mean) * rstd * lw[e] + lb[e] + bon * vv; }
            v4u w; w.x = pk2(o[0], o[1]); w.y = pk2(o[2], o[3]); w.z = pk2(o[4], o[5]); w.w = pk2(o[6], o[7]);
            *(v4u*)(ydir + (unsigned)(row * D + col)) = w; }
    }
}
__device__ __forceinline__ void phase_rwkv_r1(const Frame& F, int L, int gq) {
    const bf16* P = (const bf16*)(F.ws + WS_P);
    float* bonus = (float*)(F.ws + WS_BONUS);
    const float* mu = F.a->in[I_RMU] + (size_t)L * 6784;
    const bf16* LoT = (const bf16*)(F.ws + WS_LORA); const bf16* LIN = (const bf16*)(F.ws + WS_LIN);
    unsigned char* scratch = F.ws + WS_X2;
    LAS3 unsigned char* B0 = F.lds;
    LAS3 bf16* LwB = (LAS3 bf16*)(B0 + 67584);
    LAS3 bf16* LaB = LwB + 64 * 136;
    LAS3 float* NT = (LAS3 float*)B0;
    LAS3 bf16* MkaT = (LAS3 bf16*)(B0 + 16384);
    LAS3 bf16* MbrT = (LAS3 bf16*)(B0 + 25600);
    LAS3 float* Wl = (LAS3 float*)(B0 + 34816);
    LAS3 float* As = (LAS3 float*)(B0 + 51200);
    LAS3 bf16* MkrT = (LAS3 bf16*)(B0 + 51200);
    LAS3 bf16* At = (LAS3 bf16*)(B0 + 67584);
    LAS3 bf16* Bt = At + 64 * 72; LAS3 bf16* Kt = Bt + 64 * 72; LAS3 bf16* Rt = Kt + 64 * 72; LAS3 bf16* BtT = Rt + 64 * 72; LAS3 bf16* KtT = BtT + 64 * 72; LAS3 bf16* Vt = KtT + 64 * 72;
    LAS3 bf16* Ap = (LAS3 bf16*)(B0 + 132096);
    LAS3 bf16* W1 = Ap + 64 * 72;
    LAS3 float* CX = (LAS3 float*)(B0 + 132096);
    LAS3 float* PC = (LAS3 float*)(B0 + 150528);
    LAS3 float* SEG = PC + 64;
    LAS3 bf16* RL = (LAS3 bf16*)(B0 + 67584);
    LAS3 bf16* RKV = (LAS3 bf16*)B0;
    v4u pl[4], pr[4];
#define R1_FETCH(cl__, WHICH) do { const int cl_ = (cl__), c_ = gq * 33 + cl_, d_ = d, h_ = h, b_ = b; \
        const int r0_ = chain_row(b_, d_, c_ * 64), rmin_ = d_ ? r0_ - 63 : r0_; int pos_, len_; seq_pos(rmin_, pos_, len_); \
        int tid_ = F.tid; asm volatile("" : "+v"(tid_)); \
        _Pragma("unroll") for (int i_ = 0; i_ < 4; ++i_) { const int idx_ = tid_ + 512 * i_, rr_ = idx_ / 24, g_ = idx_ - rr_ * 24; \
            const bool ok_ = idx_ < 1584 && ((rr_ >= 1 && rr_ <= 64) || (rr_ == 0 && pos_ > 0) || (rr_ == 65 && pos_ + 64 < len_)); \
            const unsigned ro_ = (unsigned)((rmin_ - 1 + rr_) * NP); \
            if (WHICH == 0) { if (i_ < 3) { const int t_ = idx_ / 24, q_ = idx_ - t_ * 24; pl[i_] = *(const v4u*)(LIN + (unsigned)(CROW(r0_, d_, t_) * 384 + d_ * 192 + q_ * 8)); } } \
            else { const int cr2_ = (g_ < 8 ? PR : (g_ < 16 ? PK - 64 : PV - 128)) + h_ * 64 + g_ * 8; pr[i_] = ok_ ? *(const v4u*)(P + ro_ + cr2_) : (v4u){0u, 0u, 0u, 0u}; } } } while (0)
    LAS3 bf16* NTb = (LAS3 bf16*)(B0 + 153600);
    LAS3 bf16* DTb = (LAS3 bf16*)(B0 + 150784);
    LAS3 bf16* Wsc = (LAS3 bf16*)(B0 + 16384);
    LAS3 float* MU = SEG + 512;
#pragma unroll 1
    for (int chn = F.bid >> 1; chn < 128; chn += F.G >> 1) {
    const int d = chn & 1, h = (chn >> 1) & 31, b = chn >> 6, cl0 = (F.bid & 1) * 17, cl1 = (F.bid & 1) ? 33 : 17;
    __syncthreads();
    for (int i = F.tid; i < 192; i += 512) MU[i] = mu[6144 + (i < 96 ? 0 : 192 - 96) + d * 96 + i];
    bf16x8 wfr[3]; f32x4 lbias; float mur, muk, muv, kkw, kaw, rkw;
    { const int wa0 = F.wave >> 2, nt0 = F.wave & 3, fr0 = F.lane & 15, fq0 = F.lane >> 4;
#pragma unroll
      for (int ks = 0; ks < 3; ++ks) wfr[ks] = ldfrag_g(LoT + (size_t)(wa0 * 2 + d) * 2048 * 128, 128, h * 64 + nt0 * 16, ks * 32, fr0, fq0);
      lbias = *(const f32x4*)((wa0 ? F.a->in[I_RA0] : F.a->in[I_RW0]) + ((size_t)L * 2 + d) * 2048 + h * 64 + nt0 * 16 + 4 * fq0);
      const int col0 = h * 64 + F.lane;
      mur = mu[col0]; muk = mu[2048 + col0]; muv = mu[4096 + col0];
      kkw = F.a->in[I_RKK][(size_t)L * 2048 + col0]; kaw = F.a->in[I_RKA][(size_t)L * 2048 + col0]; rkw = F.a->in[I_RRK][(size_t)L * 2048 + col0]; }
    R1_FETCH(cl0, 0); R1_FETCH(cl0, 1);
    __syncthreads();
    for (int cl = cl0; cl < cl1; ++cl) {
        int tid = F.tid; asm volatile("" : "+v"(tid));
        const int lane = tid & 63, wave = __builtin_amdgcn_readfirstlane(tid >> 6), fr = lane & 15, fq = lane >> 4;
        const int c = gq * 33 + cl, unit = chn * 33 + cl;
        unsigned char* slot = scratch + (size_t)unit * RW_SLOT;
#pragma unroll
        for (int i = 0; i < 3; ++i) { const int idx = tid + 512 * i, t = idx / 24, q = idx - t * 24; *(LAS3 v4u*)((q >= 12 ? LaB + (q - 12) * 8 : LwB + q * 8) + t * 136) = pl[i]; }
#pragma unroll
        for (int i = 0; i < 4; ++i) { const int idx = tid + 512 * i, rr = idx / 24, g = idx - rr * 24; if (idx < 1584) *(LAS3 v4u*)(RKV + rr * 200 + g * 8) = pr[i]; }
        LBAR();
        { const int wa = wave >> 2, nt = wave & 3; f32x4 acc[4];
#pragma unroll
          for (int mt = 0; mt < 4; ++mt) acc[mt] = (f32x4){0.f, 0.f, 0.f, 0.f};
          LAS3 bf16* Xs = wa ? LaB : LwB;
#pragma unroll
          for (int ks = 0; ks < 3; ++ks)
#pragma unroll
              for (int mt = 0; mt < 4; ++mt) MMA_TRN(acc[mt], ldfrag(Xs, 136, mt * 16, ks * 32, fr, fq), wfr[ks]);
          if (wa) {
#pragma unroll
              for (int mt = 0; mt < 4; ++mt) { f32x4 o;
#pragma unroll
                  for (int e = 0; e < 4; ++e) o[e] = sigm(acc[mt][e] + lbias[e]);
                  *(LAS3 f32x4*)(As + (mt * 16 + fr) * 64 + nt * 16 + 4 * fq) = o; } }
          else { f32x4 run = (f32x4){0.f, 0.f, 0.f, 0.f};
#pragma unroll
              for (int mt = 0; mt < 4; ++mt) { f32x4 inc, exc;
#pragma unroll
                  for (int e = 0; e < 4; ++e) { const float lw = -__expf(-softplus_fast(-(acc[mt][e] + lbias[e])) - 0.5f);
                      float v = lw; v += DPPF(v, 0x111); v += DPPF(v, 0x112); v += DPPF(v, 0x114); v += DPPF(v, 0x118);
                      inc[e] = v + run[e]; exc[e] = inc[e] - lw;
                      float tot = lw; tot += DPPF(tot, 0xB1); tot += DPPF(tot, 0x4E); tot += DPPF(tot, 0x141); tot += DPPF(tot, 0x140);
                      run[e] += tot; }
                  *(LAS3 f32x4*)(Wl + (mt * 16 + fr) * 64 + nt * 16 + 4 * fq) = inc; *(LAS3 f32x4*)(CX + (mt * 16 + fr) * 64 + nt * 16 + 4 * fq) = exc; }
              if (fr == 0) { f32x4 pc; pc[0] = __expf(run[0]); pc[1] = __expf(run[1]); pc[2] = __expf(run[2]); pc[3] = __expf(run[3]); *(LAS3 f32x4*)(PC + nt * 16 + 4 * fq) = pc; } } }
        LBAR();
        { const int ch = lane; const int rr0 = d ? 64 - wave * 8 : 1 + wave * 8, st = d ? -1 : 1;
          const LAS3 bf16* qb = RKV + ch;
          float rp = bf2f(qb[(rr0 - st) * 200]), kp = bf2f(qb[(rr0 - st) * 200 + 64]), vp = bf2f(qb[(rr0 - st) * 200 + 128]);
          float rc = bf2f(qb[rr0 * 200]), kc = bf2f(qb[rr0 * 200 + 64]), vc = bf2f(qb[rr0 * 200 + 128]);
          const int r0c = chain_row(b, d, c * 64);
#pragma unroll
          for (int i = 0; i < 8; ++i) { const int t = wave * 8 + i; const int row = CROW(r0c, d, t); const int rn = rr0 + st * (i + 1);
              const float rx = bf2f(qb[rn * 200]), kx = bf2f(qb[rn * 200 + 64]), vx = bf2f(qb[rn * 200 + 128]);
              const float r = rc + mur * (0.5f * (rp + rx) - rc), k = kc + muk * (0.5f * (kp + kx) - kc), v = vc + muv * (0.5f * (vp + vx) - vc);
              rp = rc; kp = kc; vp = vc; rc = rx; kc = kx; vc = vx;
              const float asig = As[t * 64 + ch], cv = Wl[t * 64 + ch], cx = CX[t * 64 + ch];
              const float kkv = k * kkw, n2 = wave_sum(kkv * kkv), kk = kkv * rsqrtf(n2 + 1e-12f);
              const float key = k * (1.0f + (asig - 1.0f) * kaw);
              const float bon = wave_sum(r * key * rkw);
              if (ch == 0) bonus[(unsigned)((d * MROWS + row) * 32 + h)] = bon;
              const float ep = __expf(cv), em = __expf(-cv), ex = __expf(cx);
              const bf16 a_ = f2bf(-kk * ex), b_ = f2bf(kk * asig * em), k_ = f2bf(key * em), r_ = f2bf(r * ep), v_ = f2bf(v);
              At[t * 72 + ch] = a_; Bt[t * 72 + ch] = b_; Kt[t * 72 + ch] = k_; Rt[t * 72 + ch] = r_;
              BtT[ch * 72 + t] = b_; KtT[ch * 72 + t] = k_; Vt[ch * 72 + t] = v_; } }
        LBAR();
        for (int i = tid; i < 18432 / 16; i += 512) ((LAS3 v4u*)Ap)[i] = (v4u){0u, 0u, 0u, 0u};
        { const int q = wave >> 1, hf = wave & 1; LAS3 bf16* Xs = q < 2 ? At : Rt; LAS3 bf16* Ys = (q & 1) ? Kt : Bt;
#pragma unroll
          for (int mi = 0; mi < 2; ++mi) { const int mt = hf * 2 + mi; f32x4 acc[4];
#pragma unroll
              for (int nt = 0; nt < 4; ++nt) acc[nt] = (f32x4){0.f, 0.f, 0.f, 0.f};
#pragma unroll
              for (int ks = 0; ks < 2; ++ks) { const bf16x8 a = ldfrag(Xs, 72, mt * 16, ks * 32, fr, fq);
#pragma unroll
                  for (int nt = 0; nt < 4; ++nt) MMA_TRN(acc[nt], a, ldfrag(Ys, 72, nt * 16, ks * 32, fr, fq)); }
              const int t = mt * 16 + fr;
#pragma unroll
              for (int nt = 0; nt < 4; ++nt) { const int i0 = nt * 16 + 4 * fq; f32x4 o;
#pragma unroll
                  for (int e = 0; e < 4; ++e) { const int i = i0 + e; const bool keep = q < 2 ? (i < t) : (i <= t); o[e] = keep ? acc[nt][e] : 0.f; }
                  if (q == 0) { *(LAS3 f32x4*)(NT + t * 64 + i0) = o; const bool offd = nt != mt; v2u w; w.x = offd ? pk2(o[0], o[1]) : 0u; w.y = offd ? pk2(o[2], o[3]) : 0u; *(LAS3 v2u*)(NTb + t * 72 + i0) = w; }
                  else { v2u w; w.x = pk2(o[0], o[1]); w.y = pk2(o[2], o[3]); *(LAS3 v2u*)((q == 1 ? MkaT : (q == 2 ? MbrT : MkrT)) + t * 72 + i0) = w; } } } }
        LBAR();
        if (wave > 0) {
            for (int tile = wave - 1; tile < 16; tile += 7) { const int mt = tile >> 2, nt = tile & 3; f32x4 acc = (f32x4){0.f, 0.f, 0.f, 0.f};
#pragma unroll
                for (int ks = 0; ks < 2; ++ks) MMA_TRN(acc, ldfrag(Vt, 72, mt * 16, ks * 32, fr, fq), ldfrag(MkaT, 72, nt * 16, ks * 32, fr, fq));
                *(LAS3 f32x4*)(Wl + (mt * 16 + fr) * 64 + nt * 16 + 4 * fq) = acc; } }
        else { const int J = lane >> 4, cc = lane & 15; float z[16];
#pragma unroll
            for (int t = 0; t < 16; ++t) { float acc = t == cc ? 1.0f : 0.f;
#pragma unroll
                for (int i4 = 0; i4 < (t + 3) / 4; ++i4) { const f32x4 nv = *(const LAS3 f32x4*)(NT + (J * 16 + t) * 64 + J * 16 + i4 * 4);
#pragma unroll
                    for (int e = 0; e < 4; ++e) if (i4 * 4 + e < t) acc += nv[e] * z[i4 * 4 + e]; }
                z[t] = acc; DTb[(J * 16 + t) * 16 + cc] = f2bf(acc); } }
        LBAR();
        { LAS3 bf16* Ws = Wsc + wave * 256; const int r = wave * 16 + fr;
#pragma unroll
          for (int J = 0; J < 4; ++J) { f32x4 acc = (f32x4){0.f, 0.f, 0.f, 0.f};
              if (J > 0) {
#pragma unroll
                  for (int ks = 0; ks < (J + 1) / 2; ++ks) MMA_TRN(acc, ldfrag(Ap, 72, wave * 16, ks * 32, fr, fq), ldfrag(NTb, 72, J * 16, ks * 32, fr, fq)); }
              const int t0 = J * 16 + 4 * fq;
              if (wave < 4) { acc[0] += bf2f(At[(t0 + 0) * 72 + r]); acc[1] += bf2f(At[(t0 + 1) * 72 + r]); acc[2] += bf2f(At[(t0 + 2) * 72 + r]); acc[3] += bf2f(At[(t0 + 3) * 72 + r]); }
              else acc += *(const LAS3 f32x4*)(Wl + (r - 64) * 64 + t0);
              { v2u w; w.x = pk2(acc[0], acc[1]); w.y = pk2(acc[2], acc[3]); *(LAS3 v2u*)(Ws + fr * 16 + 4 * fq) = w; }
              asm volatile("s_waitcnt lgkmcnt(0)" ::: "memory");
              const bf16x8 zero8 = (bf16x8){0, 0, 0, 0, 0, 0, 0, 0};
              const bf16x8 wf = fq < 2 ? *(const LAS3 bf16x8*)(Ws + fr * 16 + 8 * fq) : zero8;
              const bf16x8 zf = fq < 2 ? *(const LAS3 bf16x8*)(DTb + (J * 16 + fr) * 16 + 8 * fq) : zero8;
              f32x4 x = (f32x4){0.f, 0.f, 0.f, 0.f};
              MMA_TRN(x, wf, zf);
              { v2u w; w.x = pk2(x[0], x[1]); w.y = pk2(x[2], x[3]); *(LAS3 v2u*)(Ap + r * 72 + t0) = w; }
              asm volatile("s_waitcnt lgkmcnt(0)" ::: "memory"); } }
        LBAR();
        if (cl + 1 < cl1) { R1_FETCH(cl + 1, 0); R1_FETCH(cl + 1, 1); }
        { const int o = wave >> 1, hf = wave & 1;
#pragma unroll
          for (int mi = 0; mi < 2; ++mi) { const int mt = hf * 2 + mi; f32x4 acc[4];
#pragma unroll
              for (int nt = 0; nt < 4; ++nt) acc[nt] = (f32x4){0.f, 0.f, 0.f, 0.f};
              if (o < 2) {
                  LAS3 bf16* Xs = o == 0 ? MbrT : BtT;
#pragma unroll
                  for (int ks = 0; ks < 2; ++ks) { const bf16x8 a = ldfrag(Xs, 72, mt * 16, ks * 32, fr, fq);
#pragma unroll
                      for (int nt = 0; nt < 4; ++nt) MMA_TRN(acc[nt], a, ldfrag(Ap, 72, nt * 16, ks * 32, fr, fq)); }
                  const int m = mt * 16 + fr; const float pc = o == 1 ? PC[m] : 1.0f;
#pragma unroll
                  for (int nt = 0; nt < 4; ++nt) { const int k0 = nt * 16 + 4 * fq; float v[4];
                      if (o == 0) { const v2u rr = *(const LAS3 v2u*)(Rt + m * 72 + k0); v[0] = acc[nt][0] + pg8::bf_lo(rr.x); v[1] = acc[nt][1] + pg8::bf_hi(rr.x); v[2] = acc[nt][2] + pg8::bf_lo(rr.y); v[3] = acc[nt][3] + pg8::bf_hi(rr.y); }
                      else {
#pragma unroll
                          for (int e = 0; e < 4; ++e) v[e] = (acc[nt][e] + ((k0 + e) == m ? 1.0f : 0.f)) * pc; }
                      v2u w; w.x = pk2(v[0], v[1]); w.y = pk2(v[2], v[3]);
                      *(v2u*)(slot + (o == 0 ? 8192 : 0) + (size_t)(((mt * 2 + (nt >> 1)) * 64 + fq * 16 + fr) * 16 + (nt & 1) * 8)) = w; } }
              else {
                  LAS3 bf16* X1 = o == 2 ? BtT : MbrT; LAS3 bf16* X2 = o == 2 ? KtT : MkrT;
#pragma unroll
                  for (int ks = 0; ks < 2; ++ks) { const bf16x8 a1 = ldfrag(X1, 72, mt * 16, ks * 32, fr, fq), a2 = ldfrag(X2, 72, mt * 16, ks * 32, fr, fq);
#pragma unroll
                      for (int nt = 0; nt < 4; ++nt) { MMA_STD(acc[nt], a1, ldfrag(W1, 72, nt * 16, ks * 32, fr, fq)); MMA_STD(acc[nt], a2, ldfrag(Vt, 72, nt * 16, ks * 32, fr, fq)); } }
                  float pc[4];
#pragma unroll
                  for (int e = 0; e < 4; ++e) pc[e] = o == 2 ? PC[mt * 16 + 4 * fq + e] : 1.0f;
#pragma unroll
                  for (int nt = 0; nt < 4; ++nt) { v2u w; w.x = pk2(acc[nt][0] * pc[0], acc[nt][1] * pc[1]); w.y = pk2(acc[nt][2] * pc[2], acc[nt][3] * pc[3]);
                      *(v2u*)(slot + (o == 2 ? 16384 : 24576) + (size_t)(((nt * 4 + mt) * 64 + lane) * 8)) = w; } } } }
        LBAR();
    }
    }
}
#undef R1_FETCH
#define RW_LOAD(Tf, Rf, Sh, Yh, cl_) do { const unsigned char* slot_ = scratch + ((size_t)chn * 33 + (cl_)) * RW_SLOT; \
        _Pragma("unroll") for (int mt_ = 0; mt_ < 4; ++mt_) { \
            _Pragma("unroll") for (int s_ = 0; s_ < 2; ++s_) { Tf[mt_][s_] = *(const bf16x8*)(slot_ + ((mt_ * 2 + s_) * 64 + F.lane) * 16); Rf[mt_][s_] = *(const bf16x8*)(slot_ + 8192 + ((mt_ * 2 + s_) * 64 + F.lane) * 16); } \
            Sh[mt_] = *(const v2u*)(slot_ + 16384 + ((vt * 4 + mt_) * 64 + F.lane) * 8); Yh[mt_] = *(const v2u*)(slot_ + 24576 + ((vt * 4 + mt_) * 64 + F.lane) * 8); } } while (0)
#define RW_STEP(Tf, Rf, Sh, Yh, cl_) do { bf16x8 Sb[2]; const int r0s_ = chain_row(b, d, (gq * 33 + (cl_)) * 64); \
        _Pragma("unroll") for (int s2 = 0; s2 < 2; ++s2) { v4u w; w.x = pk2(S[2 * s2][0], S[2 * s2][1]); w.y = pk2(S[2 * s2][2], S[2 * s2][3]); w.z = pk2(S[2 * s2 + 1][0], S[2 * s2 + 1][1]); w.w = pk2(S[2 * s2 + 1][2], S[2 * s2 + 1][3]); \
            Sb[s2] = __builtin_bit_cast(bf16x8, w); } \
        _Pragma("unroll") for (int mt = 0; mt < 4; ++mt) { \
            f32x4 ya = (f32x4){pg8::bf_lo(Yh[mt].x), pg8::bf_hi(Yh[mt].x), pg8::bf_lo(Yh[mt].y), pg8::bf_hi(Yh[mt].y)}; \
            f32x4 sn = (f32x4){pg8::bf_lo(Sh[mt].x), pg8::bf_hi(Sh[mt].x), pg8::bf_lo(Sh[mt].y), pg8::bf_hi(Sh[mt].y)}; \
            _Pragma("unroll") for (int s2 = 0; s2 < 2; ++s2) { MMA_STD(ya, Rf[mt][s2], Sb[s2]); MMA_STD(sn, Tf[mt][s2], Sb[s2]); } \
            _Pragma("unroll") for (int e = 0; e < 4; ++e) { const int t = mt * 16 + 4 * fq + e; const int row = CROW(r0s_, d, t); \
                ydir[(unsigned)((d * MROWS + row) * D + h * 64 + vt * 16 + fr)] = f2bf(ya[e]); } \
            S[mt] = sn; } } while (0)
__device__ __forceinline__ void phase_rwkv_r2(const Frame& F, int gq) {
    const unsigned char* scratch = F.ws + WS_X2; bf16* ydir = (bf16*)(F.ws + WS_X1);
    f32x4* state = (f32x4*)(F.ws + WS_LAGG);
    if (F.wave >= 2) return;
    const int fr = F.lane & 15, fq = F.lane >> 4;
    for (int task = F.bid * 2 + F.wave; task < 512; task += F.G * 2) {
        const int chn = task >> 2, vt = task & 3, d = chn & 1, h = (chn >> 1) & 31, b = chn >> 6;
        f32x4 S[4];
#pragma unroll
        for (int mt = 0; mt < 4; ++mt) S[mt] = gq == 0 ? (f32x4){0.f, 0.f, 0.f, 0.f} : state[((size_t)task * 4 + mt) * 64 + F.lane];
        bf16x8 Ta[4][2], Ra[4][2]; v2u Sa[4], Ya[4];
#pragma unroll 1
        for (int cl = 0; cl < 33; ++cl) { RW_LOAD(Ta, Ra, Sa, Ya, cl); RW_STEP(Ta, Ra, Sa, Ya, cl); }
        if (gq < 3) {
#pragma unroll
            for (int mt = 0; mt < 4; ++mt) state[((size_t)task * 4 + mt) * 64 + F.lane] = S[mt]; }
    }
}
#undef RW_LOAD
#undef RW_STEP

__device__ __forceinline__ void phase_ssm_conv(const Frame& F, int L) {
    const bf16* P = (const bf16*)(F.ws + WS_P); bf16* XA = (bf16*)(F.ws + WS_X2);
    const float* cw = F.a->in[I_SCW] + (size_t)L * 4 * 3072; const float* cb = F.a->in[I_SCB] + (size_t)L * 3072;
    for (int gI = F.bid * 512 + F.tid; gI < (MROWS / 8) * 384; gI += F.G * 512) { const int rb = gI / 384, col = (gI - rb * 384) * 8, row0 = rb * 8;
        int pos0, len; seq_pos(row0, pos0, len);
        float w[4][8], bias[8];
#pragma unroll
        for (int tap = 0; tap < 4; ++tap) { const f32x4 a0 = *(const f32x4*)(cw + tap * 3072 + col), a1 = *(const f32x4*)(cw + tap * 3072 + col + 4);
            w[tap][0] = a0[0]; w[tap][1] = a0[1]; w[tap][2] = a0[2]; w[tap][3] = a0[3]; w[tap][4] = a1[0]; w[tap][5] = a1[1]; w[tap][6] = a1[2]; w[tap][7] = a1[3]; }
        { const f32x4 a0 = *(const f32x4*)(cb + col), a1 = *(const f32x4*)(cb + col + 4); bias[0] = a0[0]; bias[1] = a0[1]; bias[2] = a0[2]; bias[3] = a0[3]; bias[4] = a1[0]; bias[5] = a1[1]; bias[6] = a1[2]; bias[7] = a1[3]; }
        v4u win[3];
#pragma unroll
        for (int k = 0; k < 3; ++k) { const int q = pos0 + k - 2; win[k] = (q >= 0 && q < len) ? *(const v4u*)(P + (unsigned)((row0 + k - 2) * NP + PX + col)) : (v4u){0u, 0u, 0u, 0u}; }
#pragma unroll
        for (int r = 0; r < 8; ++r) { const int q = pos0 + r + 1; const v4u nx = (q < len) ? *(const v4u*)(P + (unsigned)((row0 + r + 1) * NP + PX + col)) : (v4u){0u, 0u, 0u, 0u};
            float o[8];
#pragma unroll
            for (int e = 0; e < 8; ++e) o[e] = bias[e];
            const v4u tp[4] = {win[0], win[1], win[2], nx};
#pragma unroll
            for (int tap = 0; tap < 4; ++tap) { const v4u x = tp[tap];
                o[0] += w[tap][0] * pg8::bf_lo(x.x); o[1] += w[tap][1] * pg8::bf_hi(x.x); o[2] += w[tap][2] * pg8::bf_lo(x.y); o[3] += w[tap][3] * pg8::bf_hi(x.y);
                o[4] += w[tap][4] * pg8::bf_lo(x.z); o[5] += w[tap][5] * pg8::bf_hi(x.z); o[6] += w[tap][6] * pg8::bf_lo(x.w); o[7] += w[tap][7] * pg8::bf_hi(x.w); }
            v4u wv; wv.x = pk2(siluf(o[0]), siluf(o[1])); wv.y = pk2(siluf(o[2]), siluf(o[3])); wv.z = pk2(siluf(o[4]), siluf(o[5])); wv.w = pk2(siluf(o[6]), siluf(o[7]));
            *(v4u*)(XA + (unsigned)((row0 + r) * 3072 + col)) = wv;
            win[0] = win[1]; win[1] = win[2]; win[2] = nx; }
    }
}
__device__ __forceinline__ void phase_ssm_chain(const Frame& F, int L) {
    const bf16* P = (const bf16*)(F.ws + WS_P); const bf16* XA = (const bf16*)(F.ws + WS_X2);
    bf16* ydir = (bf16*)(F.ws + WS_X1);
    constexpr int SET = 72192;
    LAS3 bf16* Hb = (LAS3 bf16*)(F.lds + 2 * SET);
    const int fr = F.lane & 15, fq = F.lane >> 4;
#define SS_PTRS(set_) LAS3 bf16* Cb = (LAS3 bf16*)(F.lds + (set_) * SET); LAS3 bf16* Bb = Cb + 64 * 136; LAS3 bf16* BT = Bb + 64 * 136; LAS3 bf16* Sc = BT + 128 * 72; \
        LAS3 bf16* Xt = Sc + 64 * 72; LAS3 bf16* Xd = Xt + 32 * 72; LAS3 float* cum = (LAS3 float*)(Xd + 32 * 72); LAS3 float* dtj = cum + 64; (void)Cb; (void)Bb; (void)BT; (void)Sc; (void)Xt; (void)Xd; (void)cum; (void)dtj
    for (int unit = F.bid; unit < 256; unit += F.G) {
        const int b = unit >> 7, h = (unit >> 2) & 31, d = (unit >> 1) & 1, ph = unit & 1, g = h >> 3;
        const float Ad = -__expf(F.a->in[I_SALOG][(L * 2 + d) * 32 + h]); const float dtb = F.a->in[I_SDTB][(L * 2 + d) * 32 + h];
        const int xcol = h * 64 + ph * 32;
        for (int i = F.tid; i < 32 * 136 / 2; i += 512) ((LAS3 unsigned*)Hb)[i] = 0u;
        f32x4 hacc[2]; hacc[0] = (f32x4){0.f, 0.f, 0.f, 0.f}; hacc[1] = hacc[0];
        v4u nb[4], nx; float ndt = 0.f;
#define SS_LOAD(c_) do { \
            const int r0l_ = chain_row(b, d, (c_) * 64); \
            _Pragma("unroll") for (int i_ = 0; i_ < 4; ++i_) { const int gI_ = F.tid + 512 * i_, j_ = gI_ >> 5, q_ = gI_ & 31; const int row_ = CROW(r0l_, d, j_); \
                const int col_ = q_ < 16 ? 2048 + g * 128 + q_ * 8 : 2560 + g * 128 + (q_ - 16) * 8; nb[i_] = *(const v4u*)(XA + (unsigned)(row_ * 3072 + col_)); } \
            if (F.tid < 256) { const int j_ = F.tid >> 2, q_ = F.tid & 3; const int row_ = CROW(r0l_, d, j_); nx = *(const v4u*)(XA + (unsigned)(row_ * 3072 + xcol + q_ * 8)); } \
            if (F.wave == 4) { const int row_ = CROW(r0l_, d, F.lane); ndt = bf2f(P[(unsigned)(row_ * NP + PDT + d * 32 + h)]); } } while (0)
#define SS_FRONT1(set_) do { SS_PTRS(set_); \
            _Pragma("unroll") for (int i_ = 0; i_ < 4; ++i_) { const int gI_ = F.tid + 512 * i_, j_ = gI_ >> 5, q_ = gI_ & 31; const v4u v_ = nb[i_]; \
                if (q_ < 16) { *(LAS3 v4u*)(Bb + j_ * 136 + q_ * 8) = v_; LAS3 bf16* bt_ = BT + (q_ * 8) * 72 + ((((j_ >> 3) ^ (q_ & 7)) << 3) | (j_ & 7)); \
                    bt_[0 * 72] = (bf16)(v_.x & 0xffff); bt_[1 * 72] = (bf16)(v_.x >> 16); bt_[2 * 72] = (bf16)(v_.y & 0xffff); bt_[3 * 72] = (bf16)(v_.y >> 16); \
                    bt_[4 * 72] = (bf16)(v_.z & 0xffff); bt_[5 * 72] = (bf16)(v_.z >> 16); bt_[6 * 72] = (bf16)(v_.w & 0xffff); bt_[7 * 72] = (bf16)(v_.w >> 16); } \
                else *(LAS3 v4u*)(Cb + j_ * 136 + (q_ - 16) * 8) = v_; } \
            if (F.tid < 256) { const int j_ = F.tid >> 2, q_ = F.tid & 3; const v4u v_ = nx; LAS3 bf16* xt_ = Xt + (q_ * 8) * 72 + ((((j_ >> 3) ^ (q_ & 7)) << 3) | (j_ & 7)); \
                xt_[0 * 72] = (bf16)(v_.x & 0xffff); xt_[1 * 72] = (bf16)(v_.x >> 16); xt_[2 * 72] = (bf16)(v_.y & 0xffff); xt_[3 * 72] = (bf16)(v_.y >> 16); \
                xt_[4 * 72] = (bf16)(v_.z & 0xffff); xt_[5 * 72] = (bf16)(v_.z >> 16); xt_[6 * 72] = (bf16)(v_.w & 0xffff); xt_[7 * 72] = (bf16)(v_.w >> 16); } \
            if (F.wave == 4) { const float dtv_ = softplusf(ndt + dtb); const float v_ = wave_scan(dtv_ * Ad, F.lane); cum[F.lane] = v_; dtj[F.lane] = dtv_; } } while (0)
#define SS_FRONT2(set_) do { SS_PTRS(set_); \
            { const int mt_ = F.wave >> 1; f32x4 acc_[2]; acc_[0] = (f32x4){0.f, 0.f, 0.f, 0.f}; acc_[1] = acc_[0]; \
              _Pragma("unroll") for (int ks_ = 0; ks_ < 4; ++ks_) { const bf16x8 a_ = ldfrag(Cb, 136, mt_ * 16, ks_ * 32, fr, fq); \
                  _Pragma("unroll") for (int x_ = 0; x_ < 2; ++x_) { const bf16x8 bb_ = ldfrag(Bb, 136, ((F.wave & 1) * 2 + x_) * 16, ks_ * 32, fr, fq); MMA_TRN(acc_[x_], a_, bb_); } } \
              const int i_ = mt_ * 16 + fr; const float ci_ = cum[i_]; \
              _Pragma("unroll") for (int x_ = 0; x_ < 2; ++x_) { const int j0_ = ((F.wave & 1) * 2 + x_) * 16 + 4 * fq; float sc_[4]; \
                  _Pragma("unroll") for (int e_ = 0; e_ < 4; ++e_) { const int jj_ = j0_ + e_; sc_[e_] = jj_ <= i_ ? acc_[x_][e_] * __expf(ci_ - cum[jj_]) * dtj[jj_] : 0.f; } \
                  v2u w_; w_.x = pk2(sc_[0], sc_[1]); w_.y = pk2(sc_[2], sc_[3]); *(LAS3 v2u*)(Sc + i_ * 72 + j0_) = w_; } } \
            { const int idx_ = F.tid * 4, p_ = idx_ >> 6, j0_ = idx_ & 63; const float cl_ = cum[63]; const v2u xv_ = *(const LAS3 v2u*)(Xt + p_ * 72 + ((((j0_ >> 3) ^ ((p_ >> 3) & 7)) << 3) | (j0_ & 7))); \
              const float x0_ = pg8::bf_lo(xv_.x) * dtj[j0_] * __expf(cl_ - cum[j0_]), x1_ = pg8::bf_hi(xv_.x) * dtj[j0_ + 1] * __expf(cl_ - cum[j0_ + 1]); \
              const float x2_ = pg8::bf_lo(xv_.y) * dtj[j0_ + 2] * __expf(cl_ - cum[j0_ + 2]), x3_ = pg8::bf_hi(xv_.y) * dtj[j0_ + 3] * __expf(cl_ - cum[j0_ + 3]); \
              v2u w_; w_.x = pk2(x0_, x1_); w_.y = pk2(x2_, x3_); *(LAS3 v2u*)(Xd + p_ * 72 + j0_) = w_; } } while (0)
        SS_LOAD(0);
        __syncthreads();
        SS_FRONT1(0);
        SS_LOAD(1);
        LBAR();
        SS_FRONT2(0);
        LBAR();
        for (int c = 0; c < 132; ++c) {
            const int cur = c & 1;
            if (c + 1 < 132) { SS_FRONT1(cur ^ 1); if (c + 2 < 132) SS_LOAD(c + 2); }
            { SS_PTRS(cur);
              { const int mt = F.wave >> 1, nt = F.wave & 1; f32x4 ad = (f32x4){0.f, 0.f, 0.f, 0.f}, ao = ad;
#pragma unroll
                for (int ks = 0; ks < 2; ++ks) MMA_TRN(ad, ldfrag(Sc, 72, mt * 16, ks * 32, fr, fq), ldfrag_sw(Xt, 72, nt * 16, ks * 32, fr, fq));
#pragma unroll
                for (int ks = 0; ks < 4; ++ks) MMA_TRN(ao, ldfrag(Cb, 136, mt * 16, ks * 32, fr, fq), ldfrag(Hb, 136, nt * 16, ks * 32, fr, fq));
                const int i = mt * 16 + fr; const float ei = __expf(cum[i]); const int row = CROW(chain_row(b, d, c * 64), d, i);
                v2u w; w.x = pk2(ad[0] + ei * ao[0], ad[1] + ei * ao[1]); w.y = pk2(ad[2] + ei * ao[2], ad[3] + ei * ao[3]);
                *(v2u*)(ydir + (unsigned)((d * MROWS + row) * D + xcol + nt * 16 + 4 * fq)) = w; }
              { const int mt = F.wave >> 2; const float dc = __expf(cum[63]);
#pragma unroll
                for (int x = 0; x < 2; ++x) { const int nt = (F.wave & 3) * 2 + x; hacc[x] *= dc;
#pragma unroll
                    for (int ks = 0; ks < 2; ++ks) MMA_TRN(hacc[x], ldfrag(Xd, 72, mt * 16, ks * 32, fr, fq), ldfrag_sw(BT, 72, nt * 16, ks * 32, fr, fq)); } } }
            LBAR();
            { const int mt = F.wave >> 2;
#pragma unroll
              for (int x = 0; x < 2; ++x) { const int nt = (F.wave & 3) * 2 + x; v2u w; w.x = pk2(hacc[x][0], hacc[x][1]); w.y = pk2(hacc[x][2], hacc[x][3]);
                  *(LAS3 v2u*)(Hb + (mt * 16 + fr) * 136 + nt * 16 + 4 * fq) = w; } }
            if (c + 1 < 132) SS_FRONT2(cur ^ 1);
            LBAR();
        }
        __syncthreads();
    }
#undef SS_PTRS
#undef SS_LOAD
#undef SS_FRONT1
#undef SS_FRONT2
}

__device__ __forceinline__ int chunk_row0(int ck) { return ck < 256 ? ck * 64 : MLAT + (ck - 256) * 64; }
template <bool FINAL>
__device__ __forceinline__ void phase_lru_par(const Frame& F, int L) {
    const bf16* P = (const bf16*)(F.ws + WS_P);
    const bf16* WgT = (const bf16*)(F.ws + WS_LGW);
    float* agg = (float*)(F.ws + WS_LAGG); const float* car = (const float*)(F.ws + WS_LCAR);
    bf16* Y = (bf16*)(F.ws + WS_Y3);
    const float* cw = F.a->in[I_LCW] + (size_t)L * 4 * 2048; const float* cb = F.a->in[I_LCB] + (size_t)L * 2048;
    LAS3 bf16* Xb = (LAS3 bf16*)F.lds;
    LAS3 float* Aa = (LAS3 float*)(F.lds + 17408);
    LAS3 float* Bx = Aa + 64 * 128;
    LAS3 float* Hf = Bx + 64 * 128;
    LAS3 bf16* RAW = (LAS3 bf16*)(F.lds + 115712);
    LAS3 bf16* GT = (LAS3 bf16*)(F.lds + 133936);
    LAS3 float* SGA = (LAS3 float*)(F.lds + 151344);
    LAS3 float* SGH = SGA + 512;
    v4u pw[3], pg[2];
#define LRU_FETCH(ck__) do { const int ck_ = (ck__), n_ = n, row0_ = chunk_row0(ck_); int pos_, len_; seq_pos(row0_, pos_, len_); \
        int tid_ = F.tid; asm volatile("" : "+v"(tid_)); \
        _Pragma("unroll") for (int i_ = 0; i_ < 3; ++i_) { const int idx_ = tid_ + 512 * i_, rr_ = idx_ >> 4, g_ = idx_ & 15; const int q_ = pos_ + rr_ - 2; \
            pw[i_] = (idx_ < 67 * 16 && q_ >= 0 && q_ < len_) ? *(const v4u*)(P + (size_t)(row0_ + rr_ - 2) * NP + PL + n_ * 128 + g_ * 8) : (v4u){0u, 0u, 0u, 0u}; } \
        if (FINAL) { _Pragma("unroll") for (int i_ = 0; i_ < 2; ++i_) { const int idx_ = tid_ + 512 * i_, rr_ = idx_ >> 4, g_ = idx_ & 15; \
            pg[i_] = *(const v4u*)(P + (size_t)(row0_ + rr_) * NP + PLG + n_ * 128 + g_ * 8); } } } while (0)
    const int n = F.bid & 15, ckstep = F.G >> 4;
    LAS3 float* CW = SGH + 512;
    for (int i = F.tid; i < 640; i += 512) CW[i] = i < 512 ? cw[(i >> 7) * 2048 + n * 128 + (i & 127)] : cb[n * 128 + (i & 127)];
    bf16x8 wf[2][2][4]; f32x4 gbv[2][2]; float sp8[2][4];
    { const int fr0 = F.lane & 15, fq0 = F.lane >> 4, j00 = F.wave * 16;
#pragma unroll
      for (int d = 0; d < 2; ++d) {
#pragma unroll
          for (int g = 0; g < 2; ++g) { const bf16* W = WgT + (size_t)(((d * 2 + g) * 16 + n) * 128) * 128;
#pragma unroll
              for (int ks = 0; ks < 4; ++ks) wf[d][g][ks] = ldfrag_g(W, 128, j00, ks * 32, fr0, fq0);
              gbv[d][g] = *(const f32x4*)(F.a->in[I_LGB] + (((size_t)L * 2 + d) * 2 + g) * 2048 + n * 128 + j00 + 4 * fq0); }
          const f32x4 lam = *(const f32x4*)(F.a->in[I_LLAM] + ((size_t)L * 2 + d) * 2048 + n * 128 + j00 + 4 * fq0);
#pragma unroll
          for (int i = 0; i < 4; ++i) sp8[d][i] = -8.0f * softplusf(-lam[i]); } }
    if ((F.bid >> 4) < 264) LRU_FETCH(F.bid >> 4);
    __syncthreads();
    for (int ck = F.bid >> 4; ck < 264; ck += ckstep) {
        int tid = F.tid; asm volatile("" : "+v"(tid));
        const int lane = tid & 63, wave = __builtin_amdgcn_readfirstlane(tid >> 6), fr = lane & 15, fq = lane >> 4;
        const int row0 = chunk_row0(ck);
#pragma unroll
        for (int i = 0; i < 3; ++i) { const int idx = tid + 512 * i, rr = idx >> 4, g = idx & 15; if (idx < 67 * 16) *(LAS3 v4u*)(RAW + rr * 136 + g * 8) = pw[i]; }
        if (FINAL) {
#pragma unroll
            for (int i = 0; i < 2; ++i) { const int idx = tid + 512 * i, rr = idx >> 4, g = idx & 15; *(LAS3 v4u*)(GT + rr * 136 + g * 8) = pg[i]; } }
        LBAR();
        if (ck + ckstep < 264) LRU_FETCH(ck + ckstep);
#pragma unroll 1
        for (int gI = tid; gI < 1024; gI += 512) { const int t = gI >> 4, c8 = (gI & 15) * 8, col = n * 128 + c8;
            float o[8];
            { const f32x4 b0 = *(const LAS3 f32x4*)(CW + 512 + c8), b1 = *(const LAS3 f32x4*)(CW + 512 + c8 + 4); o[0] = b0[0]; o[1] = b0[1]; o[2] = b0[2]; o[3] = b0[3]; o[4] = b1[0]; o[5] = b1[1]; o[6] = b1[2]; o[7] = b1[3]; }
#pragma unroll
            for (int tap = 0; tap < 4; ++tap) { const v4u x = *(const LAS3 v4u*)(RAW + (t + tap) * 136 + c8);
                const f32x4 w0 = *(const LAS3 f32x4*)(CW + tap * 128 + c8), w1 = *(const LAS3 f32x4*)(CW + tap * 128 + c8 + 4);
                o[0] += w0[0] * pg8::bf_lo(x.x); o[1] += w0[1] * pg8::bf_hi(x.x); o[2] += w0[2] * pg8::bf_lo(x.y); o[3] += w0[3] * pg8::bf_hi(x.y);
                o[4] += w1[0] * pg8::bf_lo(x.z); o[5] += w1[1] * pg8::bf_hi(x.z); o[6] += w1[2] * pg8::bf_lo(x.w); o[7] += w1[3] * pg8::bf_hi(x.w); }
            v4u w; w.x = pk2(o[0], o[1]); w.y = pk2(o[2], o[3]); w.z = pk2(o[4], o[5]); w.w = pk2(o[6], o[7]);
            *(LAS3 v4u*)(Xb + t * 136 + c8) = w; }
        LBAR();
#pragma unroll
        for (int d = 0; d < 2; ++d) {
            {
                const int j0 = wave * 16;
                f32x4 acc[2][4];
#pragma unroll
                for (int g = 0; g < 2; ++g)
#pragma unroll
                    for (int mt = 0; mt < 4; ++mt) acc[g][mt] = (f32x4){0.f, 0.f, 0.f, 0.f};
#pragma unroll
                for (int ks = 0; ks < 4; ++ks) {
#pragma unroll
                    for (int mt = 0; mt < 4; ++mt) { const bf16x8 a = ldfrag(Xb, 136, mt * 16, ks * 32, fr, fq); MMA_TRN(acc[0][mt], a, wf[d][0][ks]); MMA_TRN(acc[1][mt], a, wf[d][1][ks]); } }
                const f32x4 gb0 = gbv[d][0], gb1 = gbv[d][1];
#pragma unroll
                for (int mt = 0; mt < 4; ++mt) { const int t = mt * 16 + fr; f32x4 av, bv;
                    const v2u xr = *(const LAS3 v2u*)(Xb + t * 136 + j0 + 4 * fq);
                    const float xc[4] = {pg8::bf_lo(xr.x), pg8::bf_hi(xr.x), pg8::bf_lo(xr.y), pg8::bf_hi(xr.y)};
#pragma unroll
                    for (int i = 0; i < 4; ++i) { const float a = __expf(sigm(acc[0][mt][i] + gb0[i]) * sp8[d][i]); av[i] = a; bv[i] = __builtin_amdgcn_sqrtf(fmaxf(1.0f - a * a, 0.f)) * sigm(acc[1][mt][i] + gb1[i]) * xc[i]; }
                    *(LAS3 f32x4*)(Aa + t * 128 + j0 + 4 * fq) = av; *(LAS3 f32x4*)(Bx + t * 128 + j0 + 4 * fq) = bv; }
            }
            LBAR();
            {
                const int ch = tid & 127, sg = tid >> 7, col = n * 128 + ch;
                float h = 0.f, ap = 1.f;
#pragma unroll 4
                for (int s2 = 0; s2 < 16; ++s2) { const int s = sg * 16 + s2, t = d ? 63 - s : s; const float a = Aa[t * 128 + ch]; h = a * h + Bx[t * 128 + ch]; ap *= a; }
                SGA[sg * 128 + ch] = ap; SGH[sg * 128 + ch] = h;
                LBAR();
                if (!FINAL) {
                    if (sg == 0) { float hh = 0.f, aa = 1.f;
#pragma unroll
                        for (int q = 0; q < 4; ++q) { const float a = SGA[q * 128 + ch]; hh = a * hh + SGH[q * 128 + ch]; aa *= a; }
                        float2 o; o.x = aa; o.y = hh; *(float2*)(agg + (((size_t)d * 264 + ck) * 2048 + col) * 2) = o; } }
                else { float hh = car[((size_t)d * 264 + ck) * 2048 + col];
#pragma unroll
                    for (int q = 0; q < 3; ++q) if (q < sg) hh = SGA[q * 128 + ch] * hh + SGH[q * 128 + ch];
#pragma unroll 4
                    for (int s2 = 0; s2 < 16; ++s2) { const int s = sg * 16 + s2, t = d ? 63 - s : s; hh = Aa[t * 128 + ch] * hh + Bx[t * 128 + ch];
                        if (d == 0) Hf[t * 128 + ch] = hh;
                        else { const float gx = bf2f(GT[t * 136 + ch]); const float u = 0.7978845608028654f * (gx + 0.044715f * gx * gx * gx);
                            Y[(size_t)(row0 + t) * D + col] = f2bf((Hf[t * 128 + ch] + hh) * 0.5f * gx * (1.0f + tanh_fast(u))); } } }
            }
            LBAR();
        }
    }
#undef LRU_FETCH
}
__device__ __forceinline__ void phase_lru_carry(const Frame& F) {
    const float* agg = (const float*)(F.ws + WS_LAGG); float* car = (float*)(F.ws + WS_LCAR);
    const int gid = F.bid * 512 + F.tid;
    if (gid < 8192) { const int d = gid >> 12, b = (gid >> 11) & 1, col = gid & 2047; float h = 0.f;
#pragma unroll 1
        for (int i0 = 0; i0 < 132; i0 += 12) { float2 a[12]; size_t o[12];
#pragma unroll
            for (int j = 0; j < 12; ++j) { const int i = i0 + j; const int ck = i < 4 ? 256 + b * 4 + (d ? 3 - i : i) : b * 128 + (d ? 127 - (i - 4) : (i - 4));
                o[j] = ((size_t)d * 264 + ck) * 2048 + col; a[j] = *(const float2*)(agg + o[j] * 2); }
#pragma unroll
            for (int j = 0; j < 12; ++j) { car[o[j]] = h; h = a[j].x * h + a[j].y; } } }
}

__device__ __forceinline__ void phase_route(const Frame& F) {
    int* rt = (int*)(F.ws + WS_ROUTE); unsigned* ctl = (unsigned*)(F.ws + WS_CTL);
    const bf16* V = (const bf16*)(F.ws + WS_U); bf16* A = (bf16*)(F.ws + WS_MA);
    int base[9]; base[0] = 0;
#pragma unroll
    for (int e = 0; e < 8; ++e) { const int c = (int)__hip_atomic_load(&ctl[CW_CNT + e], __ATOMIC_RELAXED, __HIP_MEMORY_SCOPE_AGENT); base[e + 1] = base[e] + ((c + 255) & ~255); }
    if (F.bid == 0 && F.tid == 0) { rt[RT_NT] = base[8] >> 8; for (int e = 0; e < 8; ++e) { rt[RT_BASE + e] = base[e]; for (int t = base[e] >> 8; t < (base[e + 1] >> 8); ++t) rt[RT_TILEE + t] = e; } }
    for (int tok = F.bid * 8 + F.wave; tok < MLAT; tok += F.G * 8) {
        int r0 = 0, r1 = 0;
        if (F.lane == 0) { const int e0 = rt[RT_TOKE + tok * 2], e1 = rt[RT_TOKE + tok * 2 + 1];
            int b0 = 0, b1 = 0;
#pragma unroll
            for (int e = 0; e < 8; ++e) { if (e == e0) b0 = base[e]; if (e == e1) b1 = base[e]; }
            r0 = b0 + (int)atomicAdd(&ctl[CW_CUR + e0], 1u); r1 = b1 + (int)atomicAdd(&ctl[CW_CUR + e1], 1u);
            rt[RT_TOKROW + tok * 2] = r0; rt[RT_TOKROW + tok * 2 + 1] = r1; }
        r0 = __shfl(r0, 0); r1 = __shfl(r1, 0);
#pragma unroll
        for (int i = 0; i < 4; ++i) { const v4u v = *(const v4u*)(V + (size_t)tok * D + i * 512 + F.lane * 8);
            *(v4u*)(A + (size_t)r0 * D + i * 512 + F.lane * 8) = v; *(v4u*)(A + (size_t)r1 * D + i * 512 + F.lane * 8) = v; }
    }
    for (int e = 0; e < 8; ++e) { const int c = (int)__hip_atomic_load(&ctl[CW_CNT + e], __ATOMIC_RELAXED, __HIP_MEMORY_SCOPE_AGENT); const int lo = base[e] + c, hi = base[e + 1];
        for (int row = lo + F.bid * 8 + F.wave; row < hi; row += F.G * 8)
#pragma unroll
            for (int i = 0; i < 4; ++i) *(v4u*)(A + (size_t)row * D + i * 512 + F.lane * 8) = (v4u){0u, 0u, 0u, 0u}; }
}
__device__ __forceinline__ void phase_final(const Frame& F, const float* modL) {
    const int* rt = (const int*)(F.ws + WS_ROUTE);
    const float* hlat = (const float*)(F.ws + WS_HLAT); const bf16* O = (const bf16*)(F.ws + WS_X1);
    const float* nf = F.a->in[I_NFIN]; float* out = F.a->out;
    for (int tok = F.bid * 8 + F.wave; tok < MLAT; tok += F.G * 8) {
        const int b = tok >> 13; const float* gf = modL + b * 12288 + 5 * 2048;
        const int r0 = rt[RT_TOKROW + tok * 2], r1 = rt[RT_TOKROW + tok * 2 + 1]; const float p0 = ((const float*)rt)[RT_TOKP + tok * 2], p1 = ((const float*)rt)[RT_TOKP + tok * 2 + 1];
        f32x4 x[8]; float ss = 0.f;
#pragma unroll
        for (int i = 0; i < 8; ++i) { const int c = i * 256 + F.lane * 4;
            const f32x4 h = *(const f32x4*)(hlat + (size_t)tok * D + c), g = *(const f32x4*)(gf + c);
            const uint2 a = *(const uint2*)(O + (size_t)r0 * D + c), bb = *(const uint2*)(O + (size_t)r1 * D + c);
            f32x4 m; m[0] = p0 * pg8::bf_lo(a.x) + p1 * pg8::bf_lo(bb.x); m[1] = p0 * pg8::bf_hi(a.x) + p1 * pg8::bf_hi(bb.x); m[2] = p0 * pg8::bf_lo(a.y) + p1 * pg8::bf_lo(bb.y); m[3] = p0 * pg8::bf_hi(a.y) + p1 * pg8::bf_hi(bb.y);
            x[i] = h + g * m; ss += x[i][0] * x[i][0] + x[i][1] * x[i][1] + x[i][2] * x[i][2] + x[i][3] * x[i][3]; }
        ss = wave_sum(ss);
        const float rs = rsqrtf(ss * (1.0f / D) + EPS);
#pragma unroll
        for (int i = 0; i < 8; ++i) { const int c = i * 256 + F.lane * 4; const f32x4 g = *(const f32x4*)(nf + c); *(f32x4*)(out + (size_t)tok * D + c) = x[i] * rs * g; }
    }
}

constexpr int NPH_LAYER = 17, NPH = 1 + 2 * NPH_LAYER;
#if !MK_PER_PHASE
#define SEAM() xcd_barrier(bar)
#else
#define SEAM() do {} while (0)
#endif
#define IN(k) (lo <= (PB + (k)) && (PB + (k)) < hi)
template <int L>
__device__ __forceinline__ void layer_program(const Frame& F, const Args& args, const XcdBarrier& bar, const int lo, const int hi) {
    constexpr int PB = 1 + L * NPH_LAYER;
    const float* modL = (const float*)(F.ws + WS_MOD) + (size_t)L * 3 * 12288;
    if (IN(0)) { unsigned char* wsl = F.ws; asm volatile("" : "+s"(wsl)); if (L == 0) { phase_mod(F); __syncthreads(); phase_convw_layer(F, L, F.G, F.bid); phase_lora_prep(F, L, F.G, F.bid); } SEAM(); }
    if (IN(1)) { unsigned char* wsl = F.ws; asm volatile("" : "+s"(wsl)); phase_norm<false>(F, L == 0 ? args.in[I_X] : (const float*)(wsl + WS_HLAT), L == 0 ? args.in[I_CTX] : (const float*)(wsl + WS_HCTX), args.in[I_NMIX] + L * 2048, modL, 0, 2048, (bf16*)(wsl + WS_U), L & 1, MROWS); SEAM(); }
    if (IN(2)) { unsigned char* wsl = F.ws; asm volatile("" : "+s"(wsl)); pg8::Gemm g{(const bf16*)(wsl + WS_U), (const bf16*)(wsl + WS_X1), MROWS, NP, 2048}; pg8::StaticOrder S; S.init(MROWS, NP, F.G, F.bid); pg8::EpiStoreBf16 E{(bf16*)(wsl + WS_P), NP, 0};
        pg8::gemm_phase<pg8::EpiStoreBf16, pg8::StaticOrder, false>(F.lds, g, S, E, nullptr); SEAM(); }
    if (IN(3)) { unsigned char* wsl = F.ws; asm volatile("" : "+s"(wsl)); phase_lora_in(F, L); SEAM();
#pragma unroll 1
        for (int gq = 0; gq < 4; ++gq) { phase_rwkv_r1(F, L, gq); SEAM(); phase_rwkv_r2(F, gq); SEAM(); } }
    if (IN(4)) { unsigned char* wsl = F.ws; asm volatile("" : "+s"(wsl)); phase_rwkv_pre(F, L); SEAM();
        pg8::Gemm g{(const bf16*)(wsl + WS_SG), (const bf16*)(wsl + WS_GUP), MROWS, 2048, 256}; pg8::StaticOrder S; S.init(MROWS, 2048, F.G, F.bid);
        pg8::EpiGateMul E{(const bf16*)(wsl + WS_X1), (bf16*)(wsl + WS_Y3) + (size_t)MROWS * D};
        pg8::gemm_phase<pg8::EpiGateMul, pg8::StaticOrder, false>(F.lds, g, S, E, nullptr); SEAM(); }
    if (IN(5)) { unsigned char* wsl = F.ws; asm volatile("" : "+s"(wsl)); phase_ssm_conv(F, L); __syncthreads(); phase_lru_par<false>(F, L); SEAM(); }
    if (IN(6)) { unsigned char* wsl = F.ws; asm volatile("" : "+s"(wsl)); phase_lru_carry(F); phase_ssm_chain(F, L); SEAM(); }
    if (IN(7)) { unsigned char* wsl = F.ws; asm volatile("" : "+s"(wsl)); phase_ssm_out(F, L); __syncthreads(); phase_lru_par<true>(F, L); SEAM(); }
    constexpr int nM = L == 1 ? 64 : 66;
    if (IN(9)) { unsigned char* wsl = F.ws; asm volatile("" : "+s"(wsl)); pg8::Gemm g{(const bf16*)(wsl + WS_Y3), (const bf16*)(wsl + WS_WOUT), MROWS, 2048, 2048}; pg8::MergeOrder S{nM * 8, F.G, F.bid}; pg8::EpiMerge E{(const bf16*)(wsl + WS_P), NP, (bf16*)(wsl + WS_X1)};
        pg8::gemm_phase<pg8::EpiMerge, pg8::MergeOrder, false>(F.lds, g, S, E, nullptr); SEAM(); }
    if (IN(10)) { unsigned char* wsl = F.ws; asm volatile("" : "+s"(wsl)); pg8::Gemm g{(const bf16*)(wsl + WS_X1), (const bf16*)(wsl + WS_WOUT) + (size_t)3 * 2048 * 2048, nM * 256, 2048, 2048}; pg8::StaticOrder S; S.init(nM * 256, 2048, F.G, F.bid);
        pg8::EpiResid E{L == 0 ? args.in[I_X] : (const float*)(wsl + WS_HLAT), L == 0 ? args.in[I_CTX] : (const float*)(wsl + WS_HCTX), (float*)(wsl + WS_HLAT), (float*)(wsl + WS_HCTX), modL + 2 * 2048, L & 1};
        pg8::gemm_phase<pg8::EpiResid, pg8::StaticOrder, false>(F.lds, g, S, E, nullptr);
        if (L == 0) { __syncthreads(); if (F.G > 32) { if (F.bid >= 16) phase_convw_ffn(F, L, F.G - 16, F.bid - 16); } else phase_convw_ffn(F, L, F.G, F.bid); }
        SEAM(); }
    if (IN(11)) { unsigned char* wsl = F.ws; asm volatile("" : "+s"(wsl)); phase_norm<L == 1>(F, (const float*)(wsl + WS_HLAT), (const float*)(wsl + WS_HCTX), args.in[I_NFFN] + L * 2048, modL, 3 * 2048, 4 * 2048, (bf16*)(wsl + WS_U), 0, L == 0 ? MROWS : MLAT); SEAM(); }
    if (IN(12)) { unsigned char* wsl = F.ws; asm volatile("" : "+s"(wsl)); if (L == 1) { phase_convw_ffn(F, L, F.G, F.bid); SEAM(); } }
    if constexpr (L == 0) {
        if (IN(13)) { unsigned char* wsl = F.ws; asm volatile("" : "+s"(wsl)); pg8::Gemm g{(const bf16*)(wsl + WS_U), (const bf16*)(wsl + WS_F13), MROWS, 12288, 2048}; pg8::StaticOrder S; S.init(MROWS, 12288, F.G, F.bid); pg8::EpiSwiGLU E{(bf16*)(wsl + WS_FH), 6144, 0};
            pg8::gemm_phase<pg8::EpiSwiGLU, pg8::StaticOrder, false>(F.lds, g, S, E, nullptr); SEAM(); }
        if (IN(14)) { unsigned char* wsl = F.ws; asm volatile("" : "+s"(wsl)); pg8::Gemm g{(const bf16*)(wsl + WS_FH), (const bf16*)(wsl + WS_F2), MROWS, 2048, 6144}; pg8::StaticOrder S; S.init(MROWS, 2048, F.G, F.bid);
            pg8::EpiResid E{(const float*)(wsl + WS_HLAT), (const float*)(wsl + WS_HCTX), (float*)(wsl + WS_HLAT), (float*)(wsl + WS_HCTX), modL + 5 * 2048, 0};
            pg8::gemm_phase<pg8::EpiResid, pg8::StaticOrder, false>(F.lds, g, S, E, nullptr);
            __syncthreads(); if (F.G > 32) { if (F.bid >= 16) { phase_convw_layer(F, 1, F.G - 16, F.bid - 16); phase_lora_prep(F, 1, F.G - 16, F.bid - 16); } } else { phase_convw_layer(F, 1, F.G, F.bid); phase_lora_prep(F, 1, F.G, F.bid); }
            SEAM(); }
    } else {
        const int* rt = (const int*)(F.ws + WS_ROUTE);
        if (IN(13)) { unsigned char* wsl = F.ws; asm volatile("" : "+s"(wsl)); phase_route(F); SEAM(); }
        if (IN(14)) { unsigned char* wsl = F.ws; asm volatile("" : "+s"(wsl)); pg8::Gemm g{(const bf16*)(wsl + WS_MA), (const bf16*)(wsl + WS_M13), MOE_ROWS, 8 * 6144, 2048}; pg8::MoeOrder S{rt + RT_TILEE, rt + RT_NT, 24, F.G, F.bid};
            pg8::EpiSwiGLU E{(bf16*)(wsl + WS_MH), 3072, 24};
            pg8::gemm_phase<pg8::EpiSwiGLU, pg8::MoeOrder, false>(F.lds, g, S, E, nullptr); SEAM(); }
        if (IN(15)) { unsigned char* wsl = F.ws; asm volatile("" : "+s"(wsl)); pg8::Gemm g{(const bf16*)(wsl + WS_MH), (const bf16*)(wsl + WS_M2), MOE_ROWS, 8 * 2048, 3072}; pg8::MoeOrder S{rt + RT_TILEE, rt + RT_NT, 8, F.G, F.bid};
            pg8::EpiStoreBf16 E{(bf16*)(wsl + WS_X1), 2048, 8};
            pg8::gemm_phase<pg8::EpiStoreBf16, pg8::MoeOrder, false>(F.lds, g, S, E, nullptr); SEAM(); }
        if (IN(16)) { unsigned char* wsl = F.ws; asm volatile("" : "+s"(wsl)); phase_final(F, modL); }
    }
}
#undef IN
__global__ void __launch_bounds__(512, 2) fwd(Args args) {
    extern __shared__ __attribute__((aligned(16))) unsigned char lds_raw[];
    Frame F; F.a = &args; F.ws = args.ws; F.lds = (LAS3 unsigned char*)lds_raw;
    F.tid = threadIdx.x; F.lane = F.tid & 63; F.wave = __builtin_amdgcn_readfirstlane(F.tid >> 6); F.G = gridDim.x; F.bid = blockIdx.x;
    volatile LAS3 unsigned* MISC = (volatile LAS3 unsigned*)(F.lds + MISC_OFF);
    if (F.tid < 32) MISC[F.tid] = 0u;
    __syncthreads();
    unsigned* ctl = (unsigned*)(F.ws + WS_CTL);
#if !MK_PER_PHASE
    XcdBarrier bar = xcd_barrier_post(ctl + CW_BAR, MISC + 8);
#else
    XcdBarrier bar; bar.bar = ctl + CW_BAR; bar.x = 0; bar.st = MISC + 8;
#endif
    const int lo = args.lo, hi = args.hi;
    layer_program<0>(F, args, bar, lo, hi);
    layer_program<1>(F, args, bar, lo, hi);
}

extern "C" void kernel_launch(void* const* d_in, const int* in_sizes, int n_in, void* d_out, int out_size, void* d_ws, size_t ws_size, hipStream_t stream) {
    static int grid = 0;
    if (grid == 0) {
        if (n_in != N_INPUTS || out_size != MLAT * D || ws_size < WS_END) { fprintf(stderr, "kernel_launch: unexpected shapes (n_in %d, out %d, ws %zu); nothing launched\n", n_in, out_size, ws_size); grid = -1; return; }
        int dev = 0, cus = 0;
        if (hipGetDevice(&dev) != hipSuccess || hipDeviceGetAttribute(&cus, hipDeviceAttributeMultiprocessorCount, dev) != hipSuccess) { grid = -1; return; }
        if (hipFuncSetAttribute((const void*)fwd, hipFuncAttributeMaxDynamicSharedMemorySize, LDS_BYTES) != hipSuccess) { fprintf(stderr, "kernel_launch: hipFuncSetAttribute failed\n"); grid = -1; return; }
        int per_cu = 0;
        if (hipOccupancyMaxActiveBlocksPerMultiprocessor(&per_cu, (const void*)fwd, 512, LDS_BYTES) != hipSuccess || per_cu < 1) { fprintf(stderr, "kernel_launch: occupancy query says %d\n", per_cu); }
        (void)hipGetLastError();
        grid = cus;
    }
    if (grid < 0) return;
    (void)hipMemsetAsync((char*)d_ws + WS_CTL, 0, CTL_BYTES, stream);
    Args a{};
    for (int i = 0; i < N_INPUTS; ++i) a.in[i] = (const float*)d_in[i];
    a.out = (float*)d_out; a.ws = (unsigned char*)d_ws;
#if MK_PER_PHASE
    for (int p = 0; p < NPH; ++p) { a.lo = p; a.hi = p + 1; hipLaunchKernelGGL(fwd, dim3(grid), dim3(512), LDS_BYTES, stream, a); }
#else
    a.lo = 0; a.hi = NPH; hipLaunchKernelGGL(fwd, dim3(grid), dim3(512), LDS_BYTES, stream, a);
#endif
}
```

```cpp
#include <hip/hip_runtime.h>
#include <cstdio>
#include <cstdint>

#ifndef MK_PER_PHASE
#define MK_PER_PHASE 0
#endif

namespace pg8 {
#define PG8_LAS __attribute__((address_space(3)))
typedef unsigned short bf16_t;
typedef short bf16x8 __attribute__((ext_vector_type(8)));
typedef float f32x4 __attribute__((ext_vector_type(4)));
typedef unsigned u32x4 __attribute__((ext_vector_type(4)));
constexpr int BM = 256, BK = 64, HALF = 128, HTB = HALF * BK * 2  , STAGE_BYTES = 8 * HTB, NXCD = 8, WGM = 8;

__host__ __device__ __forceinline__ int lds_byte(int r, int c) { const int st = (r >> 4) * 2 + (c >> 5), rr = r & 15, cc = c & 31, ob = rr * 64 + cc * 2; return st * 1024 + (ob ^ (((ob >> 9) & 1) << 5)); }
__host__ __device__ __forceinline__ void stage_rc(int b, int& R, int& C) { const int st = b / 1024, sb = b % 1024, swz = sb ^ (((sb >> 9) & 1) << 5); R = (st >> 1) * 16 + swz / 64; C = (st & 1) * 32 + (swz % 64) / 2; }
__host__ __device__ __forceinline__ int perm32(int rho) { const int n = rho >> 4, i = rho & 15; return 8 * (i >> 2) + 4 * n + (i & 3); }

struct Unit { int pm, pn; };
struct Gemm { const bf16_t* A; const bf16_t* Bt; int M, N, K; };

struct StaticOrder {
    int nM, nN, nwg, G, c;
    __host__ __device__ void init(int M, int N, int G_, int c_) { nM = M / BM; nN = N / BM; nwg = nM * nN; G = G_; c = c_; }
    __host__ __device__ bool next(int i, Unit& u) const {
        const long L = (long)i * G + c; if (L >= nwg) return false;
        int wgid = (int)L; { const int q = nwg / NXCD, r = nwg % NXCD, xcd = wgid % NXCD, off = wgid / NXCD; wgid = (xcd < r ? xcd * (q + 1) : r * (q + 1) + (xcd - r) * q) + off; }
        const int nig = WGM * nN, gid = wgid / nig, fm = gid * WGM, gsz = (nM - fm) < WGM ? (nM - fm) : WGM;
        u.pm = fm + ((wgid % nig) % gsz); u.pn = (wgid % nig) / gsz; return true;
    }
    __device__ __forceinline__ void a_ready(const Unit&) const {}
    __device__ __forceinline__ void done(const Unit&) const {}
};
typedef __bf16 hbf16x2_ __attribute__((ext_vector_type(2)));
typedef float hf32x2_ __attribute__((ext_vector_type(2)));
__device__ __forceinline__ unsigned cvt_pk_bf16(float lo, float hi) { const hf32x2_ v = {lo, hi}; const hbf16x2_ b = __builtin_convertvector(v, hbf16x2_); return __builtin_bit_cast(unsigned, b); }
typedef float f32x2 __attribute__((ext_vector_type(2)));
__device__ __forceinline__ f32x2 gelu_pk(f32x2 v) {
    const f32x2 av = __builtin_elementwise_abs(v), d = av * 0.2316418882f + 1.0f;
    f32x2 t; t.x = __builtin_amdgcn_rcpf(d.x); t.y = __builtin_amdgcn_rcpf(d.y);
    f32x2 q = t * 0.5307027145f + (-0.7265760135f); q = q * t + 0.7107068705f; q = q * t + (-0.142248368f); q = q * t + 0.127414796f; q = q * t;
    const f32x2 s = (v * v) * (-0.72134752044f);
    f32x2 e; e.x = __builtin_amdgcn_exp2f(s.x); e.y = __builtin_amdgcn_exp2f(s.y);
    const f32x2 m = v * (q * e), r = v - m;
    f32x2 o; o.x = v.x < 0.f ? m.x : r.x; o.y = v.y < 0.f ? m.y : r.y; return o;
}
template <class Epi, class Sched, bool ALIGN_EPI = false, bool SP2 = false>
__device__ __forceinline__ void gemm_phase(PG8_LAS unsigned char* lds, const Gemm g, const Sched& S, const Epi& E) {
    const int tid = threadIdx.x, wid = __builtin_amdgcn_readfirstlane(tid >> 6), lane = tid & 63, wr = wid >> 2, wc = wid & 3, fr = lane & 15, fq = lane >> 4;
    const int K = g.K, nt = K / BK;
    unsigned voffA[2], voffB[2];
#pragma unroll
    for (int i = 0; i < 2; ++i) { int R, C; stage_rc(tid * 16 + i * 8192, R, C); const int Rb = Epi::PERM ? ((R & ~31) + perm32(R & 31)) : R;
        voffA[i] = (unsigned)(R * K + C) * 2u; voffB[i] = (unsigned)(Rb * K + C) * 2u; }
    const size_t kstep = (size_t)(BK * 2);
    const size_t hstep = (size_t)HALF * K * 2;
    const size_t tstep = 2 * hstep;
    const unsigned ldsw = (unsigned)wid * 1024u;
    const int aoff = lds_byte(wr * 64 + fr, fq * 8), boff = lds_byte(wc * 32 + fr, fq * 8);
#define PG8_SA(b, h) (((b) * 2 + (h)) * HTB)
#define PG8_SB(b, h) ((4 + (b) * 2 + (h)) * HTB)
#define PG8_STAGE(bufoff, gbase, voff) do { _Pragma("unroll") for (int _i = 0; _i < 2; ++_i) \
        __builtin_amdgcn_global_load_lds((const unsigned*)((const char*)(gbase) + (voff)[_i]), (PG8_LAS unsigned*)(lds + (bufoff) + ldsw + _i * 8192), 16, 0, 0); } while (0)
#define PG8_LDA(dst, b, h) do { _Pragma("unroll") for (int m = 0; m < 4; ++m) _Pragma("unroll") for (int k = 0; k < 2; ++k) dst[m][k] = *(const PG8_LAS bf16x8*)(lds + PG8_SA(b, h) + aoff + m * 2048 + k * 1024); } while (0)
#define PG8_LDB(dst, b, h) do { _Pragma("unroll") for (int n = 0; n < 2; ++n) _Pragma("unroll") for (int k = 0; k < 2; ++k) dst[n][k] = *(const PG8_LAS bf16x8*)(lds + PG8_SB(b, h) + boff + n * 2048 + k * 1024); } while (0)
#define PG8_MMA(ai, bj, At, Bt) do { __builtin_amdgcn_s_setprio(1); _Pragma("unroll") for (int m = 0; m < 4; ++m) _Pragma("unroll") for (int n = 0; n < 2; ++n) _Pragma("unroll") for (int k = 0; k < 2; ++k) \
        acc[ai][bj][m][n] = __builtin_amdgcn_mfma_f32_16x16x32_bf16(Bt[n][k], At[m][k], acc[ai][bj][m][n], 0, 0, 0); __builtin_amdgcn_s_setprio(0); } while (0)
#define PG8_WAIT_V(n) asm volatile("s_waitcnt vmcnt(" #n ")" ::: "memory")
#define PG8_WAIT_L(n) asm volatile("s_waitcnt lgkmcnt(" #n ")" ::: "memory")
#define PG8_BAR __builtin_amdgcn_s_barrier()
#define PG8_SCHED __builtin_amdgcn_sched_barrier(0)
    Unit cur, nxt; int ui = 0;
    if (!S.next(0, cur)) return;
    f32x4 acc[2][2][4][2];
#pragma unroll
    for (int a = 0; a < 2; ++a)
#pragma unroll
        for (int b = 0; b < 2; ++b)
#pragma unroll
            for (int m = 0; m < 4; ++m)
#pragma unroll
                for (int n = 0; n < 2; ++n) acc[a][b][m][n] = (f32x4){0.f, 0.f, 0.f, 0.f};
    bf16x8 At[4][2], B0[2][2], B1[2][2];
    const char* cA = (const char*)g.A + (size_t)cur.pm * tstep; const char* cB = (const char*)g.Bt + (size_t)cur.pn * tstep;
    S.a_ready(cur);
    if constexpr (SP2) {
        PG8_STAGE(PG8_SB(0, 0), cB, voffB); PG8_STAGE(PG8_SB(0, 1), cB + hstep, voffB); PG8_STAGE(PG8_SA(0, 0), cA, voffA); PG8_STAGE(PG8_SA(0, 1), cA + hstep, voffA);
        if (wr == 1) PG8_BAR;
        PG8_WAIT_V(2); PG8_BAR;
        PG8_STAGE(PG8_SB(1, 0), cB + kstep, voffB); PG8_STAGE(PG8_SA(1, 0), cA + kstep, voffA); PG8_STAGE(PG8_SB(1, 1), cB + hstep + kstep, voffB);
        PG8_WAIT_V(6); PG8_BAR;
    } else {
        PG8_STAGE(PG8_SB(0, 0), cB, voffB); PG8_STAGE(PG8_SA(0, 0), cA, voffA); PG8_STAGE(PG8_SB(0, 1), cB + hstep, voffB); PG8_STAGE(PG8_SA(0, 1), cA + hstep, voffA);
        if (wr == 1) PG8_BAR;
        PG8_WAIT_V(4); PG8_BAR;
        PG8_STAGE(PG8_SB(1, 0), cB + kstep, voffB); PG8_STAGE(PG8_SA(1, 0), cA + kstep, voffA); PG8_STAGE(PG8_SB(1, 1), cB + hstep + kstep, voffB);
        PG8_WAIT_V(6); PG8_BAR;
    }
    for (;;) {
        const bool has_next = S.next(ui + 1, nxt);
        const char* nA = has_next ? (const char*)g.A + (size_t)nxt.pm * tstep : cA; const char* nB = has_next ? (const char*)g.Bt + (size_t)nxt.pn * tstep : cB;
        for (int t = 0; t < nt; t += 2) {
            const bool last = (t == nt - 2);
            const char* a1 = cA + (size_t)(t + 1) * kstep;
            const char* a2 = last ? nA : cA + (size_t)(t + 2) * kstep; const char* b2 = last ? nB : cB + (size_t)(t + 2) * kstep;
            const char* a3 = a2 + kstep; const char* b3 = b2 + kstep;
            if (last && has_next) S.a_ready(nxt);
            if constexpr (SP2) {
            PG8_LDB(B0, 0, 0); PG8_LDB(B1, 0, 1); PG8_SCHED; PG8_LDA(At, 0, 0); PG8_STAGE(PG8_SA(1, 1), a1 + hstep, voffA);
            PG8_WAIT_V(8); PG8_WAIT_L(0); PG8_BAR; PG8_MMA(0, 0, At, B0); PG8_MMA(0, 1, At, B1); PG8_BAR; PG8_SCHED;
            PG8_LDA(At, 0, 1); PG8_STAGE(PG8_SB(0, 0), b2, voffB); PG8_STAGE(PG8_SB(0, 1), b2 + hstep, voffB); PG8_STAGE(PG8_SA(0, 0), a2, voffA);
            PG8_WAIT_V(8); PG8_WAIT_L(0); PG8_BAR; PG8_MMA(1, 0, At, B0); PG8_MMA(1, 1, At, B1); PG8_BAR; PG8_SCHED;
            PG8_LDB(B0, 1, 0); PG8_LDB(B1, 1, 1); PG8_SCHED; PG8_LDA(At, 1, 0); PG8_STAGE(PG8_SA(0, 1), a2 + hstep, voffA);
            PG8_WAIT_V(8); PG8_WAIT_L(0); PG8_BAR; PG8_MMA(0, 0, At, B0); PG8_MMA(0, 1, At, B1); PG8_BAR; PG8_SCHED;
            PG8_LDA(At, 1, 1); PG8_STAGE(PG8_SB(1, 0), b3, voffB); PG8_STAGE(PG8_SB(1, 1), b3 + hstep, voffB); PG8_STAGE(PG8_SA(1, 0), a3, voffA);
            PG8_WAIT_V(8); PG8_WAIT_L(0); PG8_BAR; PG8_MMA(1, 0, At, B0); PG8_MMA(1, 1, At, B1); PG8_BAR; PG8_SCHED;
            } else {
            PG8_LDB(B0, 0, 0); PG8_SCHED; PG8_LDA(At, 0, 0); PG8_STAGE(PG8_SA(1, 1), a1 + hstep, voffA);
            PG8_WAIT_L(8); PG8_BAR; PG8_WAIT_L(0); PG8_MMA(0, 0, At, B0); PG8_BAR; PG8_SCHED;
            PG8_LDB(B1, 0, 1); PG8_STAGE(PG8_SB(0, 0), b2, voffB);
            PG8_BAR; PG8_WAIT_L(0); PG8_MMA(0, 1, At, B1); PG8_BAR;
            PG8_LDA(At, 0, 1); PG8_STAGE(PG8_SA(0, 0), a2, voffA);
            PG8_BAR; PG8_WAIT_L(0); PG8_MMA(1, 0, At, B0); PG8_BAR; PG8_SCHED;
            PG8_STAGE(PG8_SB(0, 1), b2 + hstep, voffB);
            PG8_WAIT_V(6); PG8_BAR; PG8_MMA(1, 1, At, B1); PG8_BAR;
            PG8_LDB(B0, 1, 0); PG8_SCHED; PG8_LDA(At, 1, 0); PG8_STAGE(PG8_SA(0, 1), a2 + hstep, voffA);
            PG8_WAIT_L(8); PG8_BAR; PG8_WAIT_L(0); PG8_MMA(0, 0, At, B0); PG8_BAR; PG8_SCHED;
            PG8_LDB(B1, 1, 1); PG8_STAGE(PG8_SB(1, 0), b3, voffB);
            PG8_BAR; PG8_WAIT_L(0); PG8_MMA(0, 1, At, B1); PG8_BAR;
            PG8_LDA(At, 1, 1); PG8_STAGE(PG8_SA(1, 0), a3, voffA);
            PG8_BAR; PG8_WAIT_L(0); PG8_MMA(1, 0, At, B0); PG8_BAR; PG8_SCHED;
            PG8_STAGE(PG8_SB(1, 1), b3 + hstep, voffB);
            PG8_WAIT_V(6); PG8_BAR; PG8_MMA(1, 1, At, B1); PG8_BAR;
            }
        }
        if constexpr (ALIGN_EPI) { if (wr == 0) PG8_BAR; }
        if constexpr (!Epi::AFTER_DRAIN) { E(acc, cur, wr, wc, fr, fq); S.done(cur); }
        if (!has_next) break;
#pragma unroll
        for (int a = 0; a < 2; ++a)
#pragma unroll
            for (int b = 0; b < 2; ++b)
#pragma unroll
                for (int m = 0; m < 4; ++m)
#pragma unroll
                    for (int n = 0; n < 2; ++n) acc[a][b][m][n] = (f32x4){0.f, 0.f, 0.f, 0.f};
        cur = nxt; cA = nA; cB = nB; ++ui;
        if constexpr (ALIGN_EPI) { if (wr == 1) PG8_BAR; }
    }
    PG8_WAIT_V(0);
    if constexpr (!ALIGN_EPI) { if (wr == 0) PG8_BAR; }
    PG8_BAR;
    if constexpr (Epi::AFTER_DRAIN) { E.fused(acc, cur, wr, wc, fr, fq, lds, wid, lane); S.done(cur); }
#undef PG8_SA
#undef PG8_SB
#undef PG8_STAGE
#undef PG8_LDA
#undef PG8_LDB
#undef PG8_MMA
#undef PG8_WAIT_V
#undef PG8_WAIT_L
#undef PG8_BAR
#undef PG8_SCHED
}

template <class Epi, class Sched, bool STAMP>
__device__ __forceinline__ void gemm_phase(PG8_LAS unsigned char* lds, const Gemm g, const Sched& S, const Epi& E, unsigned long long*) { gemm_phase<Epi, Sched, true, true>(lds, g, S, E); }
__device__ __forceinline__ float bf_lo(unsigned w) { return __uint_as_float(w << 16); }
__device__ __forceinline__ float bf_hi(unsigned w) { return __uint_as_float(w & 0xffff0000u); }
__device__ __forceinline__ float sigmoidf_(float x) { return __builtin_amdgcn_rcpf(1.0f + __expf(-x)); }

struct EpiStoreBf16 {
    static constexpr bool PERM = true, AFTER_DRAIN = false;
    bf16_t* O; int ldc; int npn;
    __device__ __forceinline__ void operator()(const f32x4 (&acc)[2][2][4][2], const Unit& u, int wr, int wc, int fr, int fq) const {
        const int pn = npn ? (u.pn % npn) : u.pn;
        const int row0 = u.pm * BM + wr * 64 + fr, col0 = pn * BM + wc * 32 + 8 * fq;
#pragma unroll
        for (int ai = 0; ai < 2; ++ai)
#pragma unroll
            for (int m = 0; m < 4; ++m) { bf16_t* rowp = O + (size_t)(row0 + ai * HALF + m * 16) * ldc + col0;
#pragma unroll
                for (int bj = 0; bj < 2; ++bj) { const f32x4 v0 = acc[ai][bj][m][0], v1 = acc[ai][bj][m][1];
                    u32x4 w; w.x = cvt_pk_bf16(v0[0], v0[1]); w.y = cvt_pk_bf16(v0[2], v0[3]); w.z = cvt_pk_bf16(v1[0], v1[1]); w.w = cvt_pk_bf16(v1[2], v1[3]);
                    *(u32x4*)(rowp + bj * HALF) = w; } }
    }
};
struct EpiSwiGLU {
    static constexpr bool PERM = true, AFTER_DRAIN = false;
    bf16_t* H; int ldh; int npn;
    __device__ __forceinline__ void operator()(const f32x4 (&acc)[2][2][4][2], const Unit& u, int wr, int wc, int fr, int fq) const {
        const int pn = npn ? (u.pn % npn) : u.pn;
        const int row0 = u.pm * BM + wr * 64 + fr, col0 = pn * HALF + wc * 32 + 8 * fq;
#pragma unroll
        for (int ai = 0; ai < 2; ++ai)
#pragma unroll
            for (int m = 0; m < 4; ++m) { bf16_t* rowp = H + (size_t)(row0 + ai * HALF + m * 16) * ldh + col0;
                float o[8];
#pragma unroll
                for (int n = 0; n < 2; ++n)
#pragma unroll
                    for (int j = 0; j < 4; ++j) { const float a = acc[ai][0][m][n][j], b = acc[ai][1][m][n][j]; o[n * 4 + j] = a * sigmoidf_(a) * b; }
                u32x4 w; w.x = cvt_pk_bf16(o[0], o[1]); w.y = cvt_pk_bf16(o[2], o[3]); w.z = cvt_pk_bf16(o[4], o[5]); w.w = cvt_pk_bf16(o[6], o[7]);
                *(u32x4*)rowp = w; }
    }
};
struct EpiMerge {
    static constexpr bool PERM = true, AFTER_DRAIN = false;
    const bf16_t* P; int ldp; bf16_t* Mb;
    __device__ __forceinline__ void operator()(const f32x4 (&acc)[2][2][4][2], const Unit& u, int wr, int wc, int fr, int fq) const {
        const int br = u.pn >> 3, pn = u.pn & 7, pm = u.pm - br * 66;
        const int row0 = pm * BM + wr * 64 + fr, col0 = pn * BM + wc * 32 + 8 * fq;
#pragma unroll
        for (int ai = 0; ai < 2; ++ai)
#pragma unroll
            for (int m = 0; m < 4; ++m) { const size_t row = (size_t)(row0 + ai * HALF + m * 16);
#pragma unroll
                for (int bj = 0; bj < 2; ++bj) { const int col = col0 + bj * HALF;
                    const u32x4 g = *(const u32x4*)(P + row * ldp + br * 2048 + col);
                    const f32x4 v0 = acc[ai][bj][m][0], v1 = acc[ai][bj][m][1];
                    float o[8];
                    o[0] = sigmoidf_(bf_lo(g.x)) * v0[0]; o[1] = sigmoidf_(bf_hi(g.x)) * v0[1]; o[2] = sigmoidf_(bf_lo(g.y)) * v0[2]; o[3] = sigmoidf_(bf_hi(g.y)) * v0[3];
                    o[4] = sigmoidf_(bf_lo(g.z)) * v1[0]; o[5] = sigmoidf_(bf_hi(g.z)) * v1[1]; o[6] = sigmoidf_(bf_lo(g.w)) * v1[2]; o[7] = sigmoidf_(bf_hi(g.w)) * v1[3];
                    bf16_t* mp = Mb + row * 2048 + col;
                    if (br > 0) { const u32x4 q = *(const u32x4*)mp;
                        o[0] += bf_lo(q.x); o[1] += bf_hi(q.x); o[2] += bf_lo(q.y); o[3] += bf_hi(q.y); o[4] += bf_lo(q.z); o[5] += bf_hi(q.z); o[6] += bf_lo(q.w); o[7] += bf_hi(q.w); }
                    u32x4 w; w.x = cvt_pk_bf16(o[0], o[1]); w.y = cvt_pk_bf16(o[2], o[3]); w.z = cvt_pk_bf16(o[4], o[5]); w.w = cvt_pk_bf16(o[6], o[7]);
                    *(u32x4*)mp = w; } }
    }
};
struct MergeOrder {
    int ntile, G, c;
    __device__ bool next(int i, Unit& u) const { const int t = i / 3, br = i - 3 * t; const long q = (long)t * G + c; if (q >= ntile) return false;
        u.pm = br * 66 + (int)(q >> 3); u.pn = br * 8 + (int)(q & 7); return true; }
    __device__ __forceinline__ void a_ready(const Unit&) const {}
    __device__ __forceinline__ void done(const Unit&) const {}
};
struct EpiResid {
    static constexpr bool PERM = false, AFTER_DRAIN = false;
    const float* hin_lat; const float* hin_ctx; float* hout_lat; float* hout_ctx; const float* gate; int odd;
    __device__ __forceinline__ void operator()(const f32x4 (&acc)[2][2][4][2], const Unit& u, int wr, int wc, int fr, int fq) const {
        const int row0 = u.pm * BM + wr * 64 + fr, col0 = u.pn * BM + wc * 32 + 4 * fq;
#pragma unroll
        for (int ai = 0; ai < 2; ++ai)
#pragma unroll
            for (int m = 0; m < 4; ++m) { const int R = row0 + ai * HALF + m * 16;
                const float* hi; float* ho; const float* gv;
                if (R < 16384) { const int b = R >> 13, lp = R & 8191; const int l = odd ? ((lp & 127) * 64 + (lp >> 7)) : lp; const size_t dr = (size_t)(b * 8192 + l) * 2048;
                    hi = hin_lat + dr; ho = hout_lat + dr; gv = gate + b * 12288; }
                else { const size_t dr = (size_t)(R - 16384) * 2048; hi = hin_ctx + dr; ho = hout_ctx + dr; gv = gate + 2 * 12288; }
#pragma unroll
                for (int bj = 0; bj < 2; ++bj)
#pragma unroll
                    for (int n = 0; n < 2; ++n) { const int c = col0 + bj * HALF + n * 16;
                        const f32x4 h = *(const f32x4*)(hi + c), g = *(const f32x4*)(gv + c);
                        *(f32x4*)(ho + c) = h + g * acc[ai][bj][m][n]; } }
    }
};
struct EpiGateMul {
    static constexpr bool PERM = true, AFTER_DRAIN = false;
    const bf16_t* Z; bf16_t* Y;
    __device__ __forceinline__ void operator()(const f32x4 (&acc)[2][2][4][2], const Unit& u, int wr, int wc, int fr, int fq) const {
        const int row0 = u.pm * BM + wr * 64 + fr, col0 = u.pn * BM + wc * 32 + 8 * fq;
#pragma unroll
        for (int ai = 0; ai < 2; ++ai)
#pragma unroll
            for (int m = 0; m < 4; ++m) { const size_t ro = (size_t)(row0 + ai * HALF + m * 16) * 2048 + col0;
#pragma unroll
                for (int bj = 0; bj < 2; ++bj) { const u32x4 z = *(const u32x4*)(Z + ro + bj * HALF); const f32x4 v0 = acc[ai][bj][m][0], v1 = acc[ai][bj][m][1];
                    u32x4 w; w.x = cvt_pk_bf16(bf_lo(z.x) * v0[0], bf_hi(z.x) * v0[1]); w.y = cvt_pk_bf16(bf_lo(z.y) * v0[2], bf_hi(z.y) * v0[3]);
                    w.z = cvt_pk_bf16(bf_lo(z.z) * v1[0], bf_hi(z.z) * v1[1]); w.w = cvt_pk_bf16(bf_lo(z.w) * v1[2], bf_hi(z.w) * v1[3]);
                    *(u32x4*)(Y + ro + bj * HALF) = w; } }
    }
};
struct MoeOrder {
    const int* tile_e; const int* ntiles; int npn, G, c;
    __device__ bool next(int i, Unit& u) const { const long L = (long)i * G + c; const int nt = *ntiles; if (L >= (long)nt * npn) return false;
        const int pm = (int)(L / npn), pl = (int)(L - (long)pm * npn); u.pm = pm; u.pn = tile_e[pm] * npn + pl; return true; }
    __device__ __forceinline__ void a_ready(const Unit&) const {}
    __device__ __forceinline__ void done(const Unit&) const {}
};
}

#include <vector>
#include <vector>

#define XB_TMO      128
#define XB_XCNT(j)  (256  + 64 * (j))
#define XB_XSUB(j)  (1280 + 64 * (j))
#define XB_XGEN(j)  (2304 + 64 * (j))
#define XB_TOP      3328
#define XB_TOPGEN   3392
#define XCD_BAR_WORDS 3456
#define XB_SPIN_CAP (1u << 18)
#define LAS __attribute__((address_space(3)))

__device__ __forceinline__ unsigned xb_ld(unsigned* p)              { return __hip_atomic_load(p, __ATOMIC_RELAXED, __HIP_MEMORY_SCOPE_AGENT); }
__device__ __forceinline__ unsigned xb_add(unsigned* p, unsigned v) { return __hip_atomic_fetch_add(p, v, __ATOMIC_RELAXED, __HIP_MEMORY_SCOPE_AGENT); }
__device__ __forceinline__ unsigned xb_xcc_id() { return (unsigned)__builtin_amdgcn_s_getreg((3 << 11) | 20) & 0xFu; }
#define XB_SPIN(cond, bar) do { unsigned _sp = 0; while (cond) { __builtin_amdgcn_s_sleep(1); \
    if ((++_sp & 255u) == 0u) { if (xb_ld(&(bar)[XB_TMO])) break; if (_sp > XB_SPIN_CAP) { atomicAdd(&(bar)[XB_TMO], 1u); break; } } } } while (0)

struct XcdBarrier {
    unsigned* bar; unsigned x;
    volatile LAS unsigned* st;
};

__device__ __forceinline__ XcdBarrier xcd_barrier_post(unsigned* bar, volatile LAS unsigned* st) {
    XcdBarrier b; b.bar = bar; b.x = xb_xcc_id(); b.st = st;
    if (threadIdx.x == 0) (void)xb_add(&bar[XB_XCNT(b.x)], 1u);
    return b;
}
__device__ __forceinline__ void xcd_barrier_complete(unsigned* bar, unsigned x, unsigned& nloc, unsigned& nx) {
    const unsigned G = gridDim.x * gridDim.y * gridDim.z;
    unsigned sum, cnt, mine, sp = 0u;
    for (;;) {
        sum = 0u; cnt = 0u; mine = 0u;
#pragma unroll
        for (unsigned j = 0; j < 16; ++j) { const unsigned c = xb_ld(&bar[XB_XCNT(j)]); sum += c; cnt += (c > 0u) ? 1u : 0u; mine = (j == x) ? c : mine; }
        if (sum == G) break;
        __builtin_amdgcn_s_sleep(1);
        if ((++sp & 255u) == 0u) { if (xb_ld(&bar[XB_TMO])) break; if (sp > XB_SPIN_CAP) { atomicAdd(&bar[XB_TMO], 1u); break; } }
    }
    nloc = mine > 0u ? mine : 1u; nx = cnt > 0u ? cnt : 1u;
}

__device__ __forceinline__ void xcd_barrier(const XcdBarrier& b) {
    asm volatile("s_waitcnt vmcnt(0)" ::: "memory");
    __syncthreads();
    if (threadIdx.x == 0) {
        unsigned* bar = b.bar;
        __builtin_amdgcn_s_waitcnt(0);
        unsigned nloc = b.st[0], nx = b.st[1];
        if (nloc == 0u) { xcd_barrier_complete(bar, b.x, nloc, nx); b.st[0] = nloc; b.st[1] = nx; }
        const unsigned old = xb_add(&bar[XB_XSUB(b.x)], 1u);
        const unsigned gen = old / nloc;
        if (old + 1u == (gen + 1u) * nloc) {
            __builtin_amdgcn_fence(__ATOMIC_RELEASE, "agent");
            asm volatile("s_waitcnt vmcnt(0)" ::: "memory");
            const unsigned og = xb_add(&bar[XB_TOP], 1u);
            const unsigned tg = og / nx;
            if (og + 1u == (tg + 1u) * nx) xb_add(&bar[XB_TOPGEN], 1u);
            else XB_SPIN(xb_ld(&bar[XB_TOPGEN]) == tg, bar);
            __builtin_amdgcn_fence(__ATOMIC_ACQUIRE, "agent");
            xb_add(&bar[XB_XGEN(b.x)], 1u);
            asm volatile("s_waitcnt vmcnt(0)" ::: "memory");
        } else {
            XB_SPIN(xb_ld(&bar[XB_XGEN(b.x)]) == gen, bar);
            __builtin_amdgcn_fence(__ATOMIC_ACQUIRE, "agent");
            asm volatile("s_waitcnt vmcnt(0)" ::: "memory");
        }
    }
    __syncthreads();
}

typedef unsigned short bf16;
typedef unsigned v4u __attribute__((ext_vector_type(4)));
typedef unsigned v2u __attribute__((ext_vector_type(2)));
typedef float f32x4 __attribute__((ext_vector_type(4)));
constexpr int D = 2048, SEQ = 8192, CTXL = 256, MLAT = 16384, MCTX = 512, MROWS = 16896;
constexpr int NP = 22272;
constexpr int PG = 0, PL = 6144, PLG = 8192, PR = 10240, PK = 12288, PV = 14336, PZ = 16384, PX = 18432, PWL = 21504, PAL = 21696, PGL = 21888, PDT = 22144;
constexpr int N_IN = 22208;
constexpr float EPS = 1e-6f;
enum { I_X = 0, I_C, I_CTX, I_CCTX, I_ADAW, I_ADAB, I_NMIX, I_NFFN, I_NFIN, I_WIN, I_LCW, I_LCB, I_LGW, I_LGB, I_LLAM,
       I_RMU, I_RW0, I_RWUP, I_RA0, I_RAUP, I_RGUP, I_RKK, I_RKA, I_RRK, I_RLNW, I_RLNB,
       I_SCW, I_SCB, I_SALOG, I_SDTB, I_SD, I_SNW, I_WOL, I_WOR, I_WOS, I_WO, I_F1, I_F3, I_F2, I_MR, I_M1, I_M3, I_M2, N_INPUTS };
constexpr size_t MiB = 1u << 20;
constexpr size_t WS_CTL = 0, CTL_BYTES = 1 * MiB;
constexpr size_t WS_MOD = 1 * MiB;
constexpr size_t WS_ROUTE = 2 * MiB;
constexpr size_t WS_BONUS = 3 * MiB;
constexpr size_t WS_HCTX = 8 * MiB;
constexpr size_t WS_WOUT = 12 * MiB;
constexpr size_t WS_HLAT = 44 * MiB;
constexpr size_t WS_Y3 = 172 * MiB;
constexpr size_t WS_X1 = 370 * MiB;
constexpr size_t WS_U = WS_X1 + 87 * MiB;
constexpr size_t WS_P = 523 * MiB;
constexpr size_t WS_LGW = 1241 * MiB;
constexpr size_t WS_LORA = 1243 * MiB;
constexpr size_t WS_GUP = 1245 * MiB;
constexpr size_t WS_LAGG = 1246 * MiB;
constexpr size_t WS_LCAR = 1256 * MiB;
constexpr size_t WS_X2 = 1264 * MiB;
constexpr size_t WS_LIN = 1396 * MiB;
constexpr size_t WS_SG = 1409 * MiB;
constexpr size_t WS_END = 1418 * MiB;
constexpr size_t WS_F13 = WS_P, WS_F2 = WS_P + 48 * MiB, WS_FH = WS_P + 72 * MiB;
constexpr size_t WS_M13 = WS_P, WS_M2 = WS_P + 192 * MiB, WS_MA = WS_P + 288 * MiB, WS_MH = WS_P + 424 * MiB;
constexpr int MOE_ROWS = 34816;
static_assert(WS_MH + (size_t)MOE_ROWS * 3072 * 2 <= WS_END && WS_FH + (size_t)MROWS * 6144 * 2 <= WS_END && WS_P + (size_t)MROWS * NP * 2 <= WS_END, "ws map");
constexpr int CW_BAR = 4096;
constexpr int CW_CNT = 16384, CW_CUR = 16384 + 64;
constexpr int RT_TOKE = 0, RT_TOKP = 32768, RT_TOKROW = 65536, RT_TILEE = 98304, RT_NT = 98304 + 256, RT_BASE = 98304 + 320;
constexpr int LDS_BYTES = 163840, MISC_OFF = 163840 - 256;

struct Args { const float* in[N_INPUTS]; float* out; unsigned char* ws; int lo, hi; };

__device__ __forceinline__ float bf2f(bf16 b) { return __uint_as_float(((unsigned)b) << 16); }
typedef __bf16 hbf16x2 __attribute__((ext_vector_type(2)));
typedef float hf32x2 __attribute__((ext_vector_type(2)));
__device__ __forceinline__ unsigned pk2(float lo, float hi) { const hf32x2 v = {lo, hi}; const hbf16x2 b = __builtin_convertvector(v, hbf16x2); return __builtin_bit_cast(unsigned, b); }
__device__ __forceinline__ bf16 f2bf(float f) { return (bf16)(pk2(f, f) & 0xffffu); }
#define DPPF(v, ctrl) __int_as_float(__builtin_amdgcn_update_dpp(0, __float_as_int(v), (ctrl), 0xF, 0xF, true))
__device__ __forceinline__ float quad_xor1(float v) { return DPPF(v, 0xB1); }
__device__ __forceinline__ float quad_xor2(float v) { return DPPF(v, 0x4E); }
__device__ __forceinline__ float rdlane(float v, int l) { return __int_as_float(__builtin_amdgcn_readlane(__float_as_int(v), l)); }
__device__ __forceinline__ float wave_sum(float v) { v += DPPF(v, 0xB1); v += DPPF(v, 0x4E); v += DPPF(v, 0x141); v += DPPF(v, 0x140);
    v += __int_as_float(__builtin_amdgcn_update_dpp(0, __float_as_int(v), 0x142, 0xA, 0xF, false));
    v += __int_as_float(__builtin_amdgcn_update_dpp(0, __float_as_int(v), 0x143, 0xC, 0xF, false));
    return rdlane(v, 63); }
__device__ __forceinline__ float wave_scan(float v, int lane) { v += DPPF(v, 0x111); v += DPPF(v, 0x112); v += DPPF(v, 0x114); v += DPPF(v, 0x118);
    const float t0 = rdlane(v, 15), t1 = rdlane(v, 31), t2 = rdlane(v, 47); const int r = lane >> 4;
    return v + (r >= 1 ? t0 : 0.f) + (r >= 2 ? t1 : 0.f) + (r >= 3 ? t2 : 0.f); }
__device__ __forceinline__ float sigm(float x) { return __builtin_amdgcn_rcpf(1.0f + __expf(-x)); }
__device__ __forceinline__ float siluf(float x) { return x * sigm(x); }
__device__ __forceinline__ float softplusf(float x) { const float e = __expf(x); return x > 20.f ? x : (e < 0.05f ? e * (1.0f - e * (0.5f - e * (0.33333333f - 0.25f * e))) : __logf(1.0f + e)); }
__device__ __forceinline__ float tanh_fast(float x) { return 1.0f - 2.0f * __builtin_amdgcn_rcpf(1.0f + __expf(2.0f * x)); }
__device__ __forceinline__ float softplus_fast(float x) { return x > 20.f ? x : __logf(1.0f + __expf(x)); }
#define LBAR() do { asm volatile("s_waitcnt lgkmcnt(0)" ::: "memory"); __builtin_amdgcn_s_barrier(); asm volatile("" ::: "memory"); } while (0)
__device__ __forceinline__ float gelu_tanh(float x) { const float u = 0.7978845608028654f * (x + 0.044715f * x * x * x); return 0.5f * x * (1.0f + tanhf(u)); }
__device__ __forceinline__ void seq_pos(int row, int& pos, int& len) { if (row < MLAT) { pos = row & (SEQ - 1); len = SEQ; } else { pos = (row - MLAT) & (CTXL - 1); len = CTXL; } }
__device__ __forceinline__ int chain_row(int b, int dir, int s) { if (s < CTXL) { const int t = dir ? CTXL - 1 - s : s; return MLAT + b * CTXL + t; } s -= CTXL; const int t = dir ? SEQ - 1 - s : s; return b * SEQ + t; }
#define CROW(r0_, dir_, t_) ((dir_) ? (r0_) - (t_) : (r0_) + (t_))
__device__ __forceinline__ float Pat(const bf16* P, int row, int col) { return bf2f(P[(size_t)row * NP + col]); }
__device__ __forceinline__ float shifted(const bf16* P, int row, int col, float mu) {
    int pos, len; seq_pos(row, pos, len);
    const float p = Pat(P, row, col), pv = pos > 0 ? Pat(P, row - 1, col) : 0.f, nx = pos < len - 1 ? Pat(P, row + 1, col) : 0.f;
    return p + mu * (0.5f * (pv + nx) - p);
}
__device__ __forceinline__ float dwconv(const bf16* P, int row, int col, const float* w, int ncol, int wc, float bias) {
    int pos, len; seq_pos(row, pos, len);
    float o = bias;
#pragma unroll
    for (int tap = 0; tap < 4; ++tap) { const int q = pos + tap - 2; if (q >= 0 && q < len) o += w[tap * ncol + wc] * Pat(P, row + tap - 2, col); }
    return o;
}
#define LAS3 __attribute__((address_space(3)))

struct Frame { const Args* a; unsigned char* ws; LAS3 unsigned char* lds; int tid, lane, wave, G, bid; };

__device__ __forceinline__ void phase_mod(const Frame& F) {
    LAS3 float* sv = (LAS3 float*)F.lds;
    LAS3 float* red = sv + 3 * 2048;
    const float* c = F.a->in[I_C]; const float* cc = F.a->in[I_CCTX];
    for (int i = F.tid; i < 3 * 2048; i += 512) { const int w = i >> 11, k = i & 2047; const float x = w < 2 ? c[w * 2048 + k] : cc[k]; sv[i] = siluf(x); }
    __syncthreads();
    float* mod = (float*)(F.ws + WS_MOD);
    const int kg = F.tid >> 7, j = F.tid & 127;
    for (int unit = F.bid; unit < 192; unit += F.G) {
        const int layer = unit / 96, col = (unit % 96) * 128 + j;
        const float* W = F.a->in[I_ADAW] + (size_t)layer * 2048 * 12288 + col;
        float a0 = 0.f, a1 = 0.f, a2 = 0.f;
        for (int k = kg * 512; k < kg * 512 + 512; ++k) { const float w = W[(size_t)k * 12288]; a0 += sv[k] * w; a1 += sv[2048 + k] * w; a2 += sv[4096 + k] * w; }
        red[(kg * 3 + 0) * 128 + j] = a0; red[(kg * 3 + 1) * 128 + j] = a1; red[(kg * 3 + 2) * 128 + j] = a2;
        __syncthreads();
        if (F.tid < 384) { const int w = F.tid >> 7; float s = F.a->in[I_ADAB][layer * 12288 + col];
            for (int q = 0; q < 4; ++q) s += red[(q * 3 + w) * 128 + j];
            mod[(size_t)(layer * 3 + w) * 12288 + col] = s; }
        __syncthreads();
    }
}

__device__ __forceinline__ int map_row(int type, int base, int n) {
    if (type == 0) return base + n;
    if (type == 2) return base + (n >> 7) * 256 + (n & 127);
    if (n < 16384) return n;
    if (n < 17024) return PWL + (n - 16384);
    if (n < 22144) return n - 640;
    return PDT + (n - 22144);
}
__device__ __forceinline__ void convT(const Frame& F, const float* src, int K, int N, bf16* dst, int type, int base, int& tile_rot, int nw, int rk) {
    LAS3 float* tile = (LAS3 float*)F.lds;
    const int nkt = K / 64, nnt = N / 64, nt = nkt * nnt;
    for (int t = (rk + nw - (tile_rot % nw)) % nw; t < nt; t += nw) {
        const int kt = t % nkt, ntl = t / nkt, k0 = kt * 64, n0 = ntl * 64;
        { const int r = F.tid >> 4, c4 = (F.tid & 15) * 4;
#pragma unroll
          for (int p = 0; p < 2; ++p) { const f32x4 v = *(const f32x4*)(src + (size_t)(k0 + r + p * 32) * N + n0 + c4);
              tile[(r + p * 32) * 65 + c4 + 0] = v[0]; tile[(r + p * 32) * 65 + c4 + 1] = v[1]; tile[(r + p * 32) * 65 + c4 + 2] = v[2]; tile[(r + p * 32) * 65 + c4 + 3] = v[3]; } }
        __syncthreads();
        { const int n = F.tid >> 3, kq = (F.tid & 7) * 8; float v[8];
#pragma unroll
          for (int i = 0; i < 8; ++i) v[i] = tile[(kq + i) * 65 + n];
          v4u w; w.x = pk2(v[0], v[1]); w.y = pk2(v[2], v[3]); w.z = pk2(v[4], v[5]); w.w = pk2(v[6], v[7]);
          *(v4u*)(dst + (size_t)map_row(type, base, n0 + n) * K + k0 + kq) = w; }
        __syncthreads();
    }
    tile_rot += nt;
}
__device__ __forceinline__ void phase_convw_layer(const Frame& F, int L, int nw, int rk) {
    int rot = 0;
    bf16* wt_in = (bf16*)(F.ws + WS_X1); bf16* wt_out = (bf16*)(F.ws + WS_WOUT);
    convT(F, F.a->in[I_WIN] + (size_t)L * 2048 * N_IN, 2048, N_IN, wt_in, 1, 0, rot, nw, rk);
    for (int i = rk * 512 + F.tid; i < 64 * 2048 / 8; i += nw * 512) ((v4u*)(wt_in + (size_t)N_IN * 2048))[i] = (v4u){0u, 0u, 0u, 0u};
    convT(F, F.a->in[I_WOL] + (size_t)L * 2048 * 2048, 2048, 2048, wt_out, 0, 0, rot, nw, rk);
    convT(F, F.a->in[I_WOR] + (size_t)L * 2048 * 2048, 2048, 2048, wt_out, 0, 2048, rot, nw, rk);
    convT(F, F.a->in[I_WOS] + (size_t)L * 2048 * 2048, 2048, 2048, wt_out, 0, 4096, rot, nw, rk);
    convT(F, F.a->in[I_WO] + (size_t)L * 2048 * 2048, 2048, 2048, wt_out, 0, 6144, rot, nw, rk);
    convT(F, F.a->in[I_RGUP] + (size_t)L * 256 * 2048, 256, 2048, (bf16*)(F.ws + WS_GUP), 0, 0, rot, nw, rk);
    for (int m = 0; m < 64; ++m) convT(F, F.a->in[I_LGW] + ((size_t)L * 64 + m) * 128 * 128, 128, 128, (bf16*)(F.ws + WS_LGW), 0, m * 128, rot, nw, rk);
}
__device__ __forceinline__ void phase_convw_ffn(const Frame& F, int L, int nw, int rk) {
    int rot = 0;
    if (L == 0) {
        convT(F, F.a->in[I_F1], 2048, 6144, (bf16*)(F.ws + WS_F13), 2, 0, rot, nw, rk);
        convT(F, F.a->in[I_F3], 2048, 6144, (bf16*)(F.ws + WS_F13), 2, 128, rot, nw, rk);
        convT(F, F.a->in[I_F2], 6144, 2048, (bf16*)(F.ws + WS_F2), 0, 0, rot, nw, rk);
    } else {
        for (int e = 0; e < 8; ++e) {
            convT(F, F.a->in[I_M1] + (size_t)e * 2048 * 3072, 2048, 3072, (bf16*)(F.ws + WS_M13), 2, e * 6144, rot, nw, rk);
            convT(F, F.a->in[I_M3] + (size_t)e * 2048 * 3072, 2048, 3072, (bf16*)(F.ws + WS_M13), 2, e * 6144 + 128, rot, nw, rk);
            convT(F, F.a->in[I_M2] + (size_t)e * 3072 * 2048, 3072, 2048, (bf16*)(F.ws + WS_M2), 0, e * 2048, rot, nw, rk);
        }
    }
}

template <bool ROUTER> __forceinline__
__device__ __forceinline__ void phase_norm(const Frame& F, const float* hlat, const float* hctx, const float* gain, const float* modL, int sh_off, int sc_off, bf16* out, int permute, int nrows) {
    const float* router = F.a->in[I_MR];
    int* rt = (int*)(F.ws + WS_ROUTE); unsigned* ctl = (unsigned*)(F.ws + WS_CTL);
    for (int row = F.bid * 8 + F.wave; row < nrows; row += F.G * 8) {
        int lane = F.lane; asm volatile("" : "+v"(lane));
        const float* src; const float* mv; int drow;
        if (row < MLAT) { const int b = row >> 13, l = row & 8191; src = hlat + (size_t)row * D; mv = modL + b * 12288;
            drow = permute ? (b * 8192 + (l & 63) * 128 + (l >> 6)) : row; }
        else { src = hctx + (size_t)(row - MLAT) * D; mv = modL + 2 * 12288; drow = row; }
        f32x4 x[8]; float ss = 0.f;
#pragma unroll
        for (int i = 0; i < 8; ++i) { x[i] = *(const f32x4*)(src + i * 256 + lane * 4); ss += x[i][0] * x[i][0] + x[i][1] * x[i][1] + x[i][2] * x[i][2] + x[i][3] * x[i][3]; }
        ss = wave_sum(ss);
        const float rs = rsqrtf(ss * (1.0f / D) + EPS);
        float lg[8];
        if (ROUTER) {
#pragma unroll
            for (int e = 0; e < 8; ++e) lg[e] = 0.f; }
#pragma unroll
        for (int i = 0; i < 8; ++i) { const int c = i * 256 + lane * 4;
            const f32x4 g = *(const f32x4*)(gain + c), sc = *(const f32x4*)(mv + sc_off + c), sh = *(const f32x4*)(mv + sh_off + c);
            f32x4 v;
#pragma unroll
            for (int j = 0; j < 4; ++j) v[j] = x[i][j] * rs * g[j] * (1.0f + sc[j]) + sh[j];
            uint2 w; w.x = pk2(v[0], v[1]); w.y = pk2(v[2], v[3]);
            *(uint2*)(out + (size_t)drow * D + c) = w;
            if (ROUTER) {
#pragma unroll
                for (int j = 0; j < 4; ++j) { const f32x4 r0 = *(const f32x4*)(router + (size_t)(c + j) * 8), r1 = *(const f32x4*)(router + (size_t)(c + j) * 8 + 4);
                    lg[0] += v[j] * r0[0]; lg[1] += v[j] * r0[1]; lg[2] += v[j] * r0[2]; lg[3] += v[j] * r0[3]; lg[4] += v[j] * r1[0]; lg[5] += v[j] * r1[1]; lg[6] += v[j] * r1[2]; lg[7] += v[j] * r1[3]; } }
        }
        if (ROUTER) {
#pragma unroll
            for (int e = 0; e < 8; ++e) lg[e] = wave_sum(lg[e]);
            if (lane == 0) {
                int e0 = 0; float v0 = lg[0];
#pragma unroll
                for (int e = 1; e < 8; ++e) if (lg[e] > v0) { v0 = lg[e]; e0 = e; }
                int e1 = -1; float v1 = -3.0e38f;
#pragma unroll
                for (int e = 0; e < 8; ++e) if (e != e0 && lg[e] > v1) { v1 = lg[e]; e1 = e; }
                const float p0 = 1.0f / (1.0f + __expf(v1 - v0));
                rt[RT_TOKE + row * 2] = e0; rt[RT_TOKE + row * 2 + 1] = e1;
                ((float*)rt)[RT_TOKP + row * 2] = p0; ((float*)rt)[RT_TOKP + row * 2 + 1] = 1.0f - p0;
                atomicAdd(&ctl[CW_CNT + e0], 1u); atomicAdd(&ctl[CW_CNT + e1], 1u);
            }
        }
    }
}

typedef short bf16x8 __attribute__((ext_vector_type(8)));
__device__ __forceinline__ bf16x8 ldfrag(const LAS3 bf16* p, int ld, int r0, int k0, int fr, int fq) { return *(const LAS3 bf16x8*)(p + (r0 + fr) * ld + k0 + 8 * fq); }
__device__ __forceinline__ bf16x8 ldfrag_sw(const LAS3 bf16* p, int ld, int r0, int k0, int fr, int fq) { const int r = r0 + fr, c = ((k0 >> 3) + fq) ^ ((r >> 3) & 7); return *(const LAS3 bf16x8*)(p + r * ld + c * 8); }
__device__ __forceinline__ bf16x8 ldfrag_g(const bf16* p, int ld, int r0, int k0, int fr, int fq) { return *(const bf16x8*)(p + (size_t)(r0 + fr) * ld + k0 + 8 * fq); }
#define MMA_TRN(acc, xf, yf) acc = __builtin_amdgcn_mfma_f32_16x16x32_bf16(yf, xf, acc, 0, 0, 0)
#define MMA_STD(acc, xf, yf) acc = __builtin_amdgcn_mfma_f32_16x16x32_bf16(xf, yf, acc, 0, 0, 0)
__device__ __forceinline__ void phase_rwkv_seq(const Frame& F, int L) {
    const bf16* P = (const bf16*)(F.ws + WS_P);
    bf16* ydir = (bf16*)(F.ws + WS_X1);
    float* bonus = (float*)(F.ws + WS_BONUS);
    const float* mu = F.a->in[I_RMU] + (size_t)L * 6784;
    LAS3 float* Fr = (LAS3 float*)F.lds; LAS3 float* Fk = Fr + 2048; LAS3 float* Fv = Fk + 2048; LAS3 float* Fa = Fv + 2048; LAS3 float* Fb = Fa + 2048; LAS3 float* Fw = Fb + 2048;
    LAS3 float* Lw = Fw + 2048; LAS3 float* La = Lw + 32 * 96; LAS3 float* Yb = La + 32 * 96;
    for (int unit = F.bid; unit < 128; unit += F.G) {
        const int b = unit >> 6, h = (unit >> 1) & 31, d = unit & 1;
        const float* w0 = F.a->in[I_RW0] + (size_t)(L * 2 + d) * 2048; const float* a0 = F.a->in[I_RA0] + (size_t)(L * 2 + d) * 2048;
        const float* wup = F.a->in[I_RWUP] + (size_t)(L * 2 + d) * 96 * 2048; const float* aup = F.a->in[I_RAUP] + (size_t)(L * 2 + d) * 96 * 2048;
        const float* kkw = F.a->in[I_RKK] + (size_t)L * 2048; const float* kaw = F.a->in[I_RKA] + (size_t)L * 2048; const float* rkw = F.a->in[I_RRK] + (size_t)L * 2048;
        float S[8];
#pragma unroll
        for (int j = 0; j < 8; ++j) S[j] = 0.f;
        for (int ch = 0; ch < 264; ++ch) {
            for (int idx = F.tid; idx < 32 * 96; idx += 512) { const int t = idx / 96, j = idx - t * 96; const int row = chain_row(b, d, ch * 32 + t);
                Lw[idx] = tanhf(shifted(P, row, PWL + d * 96 + j, mu[6144 + d * 96 + j]));
                La[idx] = shifted(P, row, PAL + d * 96 + j, mu[6144 + 192 + d * 96 + j]); }
            __syncthreads();
            for (int i = 0; i < 4; ++i) { const int t = F.wave * 4 + i, c = F.lane, col = h * 64 + c; const int row = chain_row(b, d, ch * 32 + t);
                const float r = shifted(P, row, PR + col, mu[col]), k = shifted(P, row, PK + col, mu[2048 + col]), v = shifted(P, row, PV + col, mu[4096 + col]);
                float wpre = w0[col], apre = a0[col];
                for (int j = 0; j < 96; ++j) { wpre += Lw[t * 96 + j] * wup[(size_t)j * 2048 + col]; apre += La[t * 96 + j] * aup[(size_t)j * 2048 + col]; }
                const float wraw = -softplusf(-wpre) - 0.5f, wdec = __expf(-__expf(wraw)), asig = sigm(apre);
                const float kkv = k * kkw[col], n2 = wave_sum(kkv * kkv), kk = kkv * rsqrtf(n2 + 1e-12f);
                const float key = k * (1.0f + (asig - 1.0f) * kaw[col]);
                const float bon = wave_sum(r * key * rkw[col]);
                if (c == 0) bonus[((size_t)d * MROWS + row) * 32 + h] = bon;
                Fr[t * 64 + c] = r; Fk[t * 64 + c] = key; Fv[t * 64 + c] = v; Fa[t * 64 + c] = -kk; Fb[t * 64 + c] = kk * asig; Fw[t * 64 + c] = wdec; }
            __syncthreads();
            { const int vi = F.tid >> 3, kp = F.tid & 7;
              for (int t = 0; t < 32; ++t) { const int o = t * 64 + kp * 8;
                  float sa = 0.f;
#pragma unroll
                  for (int j = 0; j < 8; ++j) sa += S[j] * Fa[o + j];
                  sa += __shfl_xor(sa, 1); sa += __shfl_xor(sa, 2); sa += __shfl_xor(sa, 4);
                  const float vv = Fv[t * 64 + vi]; float y = 0.f;
#pragma unroll
                  for (int j = 0; j < 8; ++j) { S[j] = S[j] * Fw[o + j] + sa * Fb[o + j] + vv * Fk[o + j]; y += S[j] * Fr[o + j]; }
                  y += __shfl_xor(y, 1); y += __shfl_xor(y, 2); y += __shfl_xor(y, 4);
                  if (kp == 0) Yb[t * 64 + vi] = y; } }
            __syncthreads();
            for (int idx = F.tid; idx < 2048; idx += 512) { const int t = idx >> 6, c = idx & 63; const int row = chain_row(b, d, ch * 32 + t);
                ydir[((size_t)d * MROWS + row) * D + h * 64 + c] = f2bf(Yb[idx]); }
        }
        __syncthreads();
    }
}
__device__ __forceinline__ void phase_rwkv_out(const Frame& F, int L) {
    const bf16* P = (const bf16*)(F.ws + WS_P);
    const bf16* ydir = (const bf16*)(F.ws + WS_X1);
    const float* bonus = (const float*)(F.ws + WS_BONUS);
    bf16* Y = (bf16*)(F.ws + WS_Y3) + (size_t)1 * MROWS * D;
    const float* mu = F.a->in[I_RMU] + (size_t)L * 6784;
    const bf16* GupT = (const bf16*)(F.ws + WS_GUP);
    const float* lnw = F.a->in[I_RLNW] + (size_t)L * 2048; const float* lnb = F.a->in[I_RLNB] + (size_t)L * 2048;
    LAS3 bf16* sg = (LAS3 bf16*)F.lds;
    for (int unit = F.bid; unit < MROWS / 16; unit += F.G) {
        int tid = F.tid; asm volatile("" : "+v"(tid));
        const int lane = tid & 63, wave = __builtin_amdgcn_readfirstlane(tid >> 6), fr = lane & 15, fq = lane >> 4;
        const int row0 = unit * 16;
        { const int t = tid >> 5, j8 = (tid & 31) * 8, row = row0 + t; int pos, len; seq_pos(row, pos, len);
          const v4u x = *(const v4u*)(P + (size_t)row * NP + PGL + j8); v4u xp = (v4u){0u, 0u, 0u, 0u}, xn = xp;
          if (pos > 0) xp = *(const v4u*)(P + (size_t)(row - 1) * NP + PGL + j8);
          if (pos < len - 1) xn = *(const v4u*)(P + (size_t)(row + 1) * NP + PGL + j8);
          const float* mp = mu + 6144 + 384 + j8; float o[8];
          const float xv[8] = {pg8::bf_lo(x.x), pg8::bf_hi(x.x), pg8::bf_lo(x.y), pg8::bf_hi(x.y), pg8::bf_lo(x.z), pg8::bf_hi(x.z), pg8::bf_lo(x.w), pg8::bf_hi(x.w)};
          const float pv[8] = {pg8::bf_lo(xp.x), pg8::bf_hi(xp.x), pg8::bf_lo(xp.y), pg8::bf_hi(xp.y), pg8::bf_lo(xp.z), pg8::bf_hi(xp.z), pg8::bf_lo(xp.w), pg8::bf_hi(xp.w)};
          const float nv[8] = {pg8::bf_lo(xn.x), pg8::bf_hi(xn.x), pg8::bf_lo(xn.y), pg8::bf_hi(xn.y), pg8::bf_lo(xn.z), pg8::bf_hi(xn.z), pg8::bf_lo(xn.w), pg8::bf_hi(xn.w)};
#pragma unroll
          for (int j = 0; j < 8; ++j) o[j] = sigm(xv[j] + mp[j] * (0.5f * (pv[j] + nv[j]) - xv[j]));
          v4u w; w.x = pk2(o[0], o[1]); w.y = pk2(o[2], o[3]); w.z = pk2(o[4], o[5]); w.w = pk2(o[6], o[7]);
          *(LAS3 v4u*)(sg + t * 264 + j8) = w; }
        LBAR();
        bf16x8 af[8];
#pragma unroll
        for (int ks = 0; ks < 8; ++ks) af[ks] = ldfrag(sg, 264, 0, ks * 32, fr, fq);
        const int row = row0 + fr; int pos, len; seq_pos(row, pos, len);
#pragma unroll 1
        for (int hh = 0; hh < 4; ++hh) { const int h = wave * 4 + hh;
            f32x4 g[4], y[4];
#pragma unroll
            for (int nt = 0; nt < 4; ++nt) { g[nt] = (f32x4){0.f, 0.f, 0.f, 0.f};
#pragma unroll
                for (int ks = 0; ks < 8; ++ks) MMA_TRN(g[nt], af[ks], ldfrag_g(GupT, 256, h * 64 + nt * 16, ks * 32, fr, fq)); }
            float s1 = 0.f;
#pragma unroll
            for (int nt = 0; nt < 4; ++nt) { const int c4 = h * 64 + nt * 16 + 4 * fq;
                const uint2 a = *(const uint2*)(ydir + (size_t)row * D + c4), bb = *(const uint2*)(ydir + ((size_t)MROWS + row) * D + c4);
                y[nt][0] = pg8::bf_lo(a.x) + pg8::bf_lo(bb.x); y[nt][1] = pg8::bf_hi(a.x) + pg8::bf_hi(bb.x); y[nt][2] = pg8::bf_lo(a.y) + pg8::bf_lo(bb.y); y[nt][3] = pg8::bf_hi(a.y) + pg8::bf_hi(bb.y);
                s1 += y[nt][0] + y[nt][1] + y[nt][2] + y[nt][3]; }
            s1 += __shfl_xor(s1, 16); s1 += __shfl_xor(s1, 32);
            const float mean = s1 * (1.0f / 64.0f); float q = 0.f;
#pragma unroll
            for (int nt = 0; nt < 4; ++nt)
#pragma unroll
                for (int e = 0; e < 4; ++e) { const float dl = y[nt][e] - mean; q += dl * dl; }
            q += __shfl_xor(q, 16); q += __shfl_xor(q, 32);
            const float rstd = rsqrtf(q * (1.0f / 64.0f) + 64e-5f);
            const float bon = bonus[(size_t)row * 32 + h] + bonus[((size_t)MROWS + row) * 32 + h];
#pragma unroll
            for (int nt = 0; nt < 4; ++nt) { const int c4 = h * 64 + nt * 16 + 4 * fq;
                const uint2 x = *(const uint2*)(P + (size_t)row * NP + PV + c4); uint2 xp = make_uint2(0u, 0u), xn = xp;
                if (pos > 0) xp = *(const uint2*)(P + (size_t)(row - 1) * NP + PV + c4);
                if (pos < len - 1) xn = *(const uint2*)(P + (size_t)(row + 1) * NP + PV + c4);
                const f32x4 lw = *(const f32x4*)(lnw + c4), lb = *(const f32x4*)(lnb + c4), muv = *(const f32x4*)(mu + 4096 + c4);
                const float xv[4] = {pg8::bf_lo(x.x), pg8::bf_hi(x.x), pg8::bf_lo(x.y), pg8::bf_hi(x.y)}, pv[4] = {pg8::bf_lo(xp.x), pg8::bf_hi(xp.x), pg8::bf_lo(xp.y), pg8::bf_hi(xp.y)}, nv[4] = {pg8::bf_lo(xn.x), pg8::bf_hi(xn.x), pg8::bf_lo(xn.y), pg8::bf_hi(xn.y)};
                float o[4];
#pragma unroll
                for (int e = 0; e < 4; ++e) { const float vv = xv[e] + muv[e] * (0.5f * (pv[e] + nv[e]) - xv[e]); o[e] = ((y[nt][e] - mean) * rstd * lw[e] + lb[e] + bon * vv) * g[nt][e]; }
                uint2 w; w.x = pk2(o[0], o[1]); w.y = pk2(o[2], o[3]);
                *(uint2*)(Y + (size_t)row * D + c4) = w; } }
        LBAR();
    }
}

__device__ __forceinline__ void phase_ssm_seq(const Frame& F, int L) {
    const bf16* P = (const bf16*)(F.ws + WS_P);
    bf16* ydir = (bf16*)(F.ws + WS_X1);
    const float* cw = F.a->in[I_SCW] + (size_t)L * 4 * 3072; const float* cb = F.a->in[I_SCB] + (size_t)L * 3072;
    LAS3 float* X = (LAS3 float*)F.lds; LAS3 float* Bm = X + 32 * 64; LAS3 float* Cm = Bm + 32 * 128; LAS3 float* dtv = Cm + 32 * 128; LAS3 float* dav = dtv + 32; LAS3 float* Yb = dav + 32;
    for (int unit = F.bid; unit < 128; unit += F.G) {
        const int b = unit >> 6, h = (unit >> 1) & 31, d = unit & 1, g = h >> 3;
        const float Ad = -__expf(F.a->in[I_SALOG][(L * 2 + d) * 32 + h]); const float dtb = F.a->in[I_SDTB][(L * 2 + d) * 32 + h];
        float hs[16];
#pragma unroll
        for (int j = 0; j < 16; ++j) hs[j] = 0.f;
        for (int ch = 0; ch < 264; ++ch) {
            for (int idx = F.tid; idx < 32 * 320; idx += 512) { const int t = idx / 320, q = idx - t * 320; const int row = chain_row(b, d, ch * 32 + t);
                const int col = q < 64 ? h * 64 + q : (q < 192 ? 2048 + g * 128 + (q - 64) : 2560 + g * 128 + (q - 192));
                const float v = siluf(dwconv(P, row, PX + col, cw, 3072, col, cb[col]));
                if (q < 64) X[t * 64 + q] = v; else if (q < 192) Bm[t * 128 + q - 64] = v; else Cm[t * 128 + q - 192] = v; }
            if (F.tid < 32) { const int row = chain_row(b, d, ch * 32 + F.tid); const float dt = softplusf(Pat(P, row, PDT + d * 32 + h) + dtb); dtv[F.tid] = dt; dav[F.tid] = __expf(dt * Ad); }
            __syncthreads();
            { const int p = F.tid >> 3, np = F.tid & 7;
              for (int t = 0; t < 32; ++t) { const float da = dav[t], xs = dtv[t] * X[t * 64 + p]; float y = 0.f;
#pragma unroll
                  for (int j = 0; j < 16; ++j) { hs[j] = hs[j] * da + xs * Bm[t * 128 + np * 16 + j]; y += hs[j] * Cm[t * 128 + np * 16 + j]; }
                  y += __shfl_xor(y, 1); y += __shfl_xor(y, 2); y += __shfl_xor(y, 4);
                  if (np == 0) Yb[t * 64 + p] = y; } }
            __syncthreads();
            for (int idx = F.tid; idx < 2048; idx += 512) { const int t = idx >> 6, c = idx & 63; const int row = chain_row(b, d, ch * 32 + t);
                ydir[((size_t)d * MROWS + row) * D + h * 64 + c] = f2bf(Yb[idx]); }
        }
        __syncthreads();
    }
}
__device__ __forceinline__ void phase_ssm_out(const Frame& F, int L) {
    const bf16* P = (const bf16*)(F.ws + WS_P);
    const bf16* ydir = (const bf16*)(F.ws + WS_X1);
    bf16* Y = (bf16*)(F.ws + WS_Y3) + (size_t)2 * MROWS * D; const bf16* XA = (const bf16*)(F.ws + WS_X2);
    const float* dsk = F.a->in[I_SD] + (size_t)L * 32; const float* nw = F.a->in[I_SNW] + (size_t)L * 2048;
    for (int row = F.bid * 8 + F.wave; row < MROWS; row += F.G * 8) {
#pragma unroll 1
        for (int g = 0; g < 4; ++g) { const int c0 = g * 512 + F.lane * 8;
            const v4u a = *(const v4u*)(ydir + (size_t)row * D + c0), bb = *(const v4u*)(ydir + ((size_t)MROWS + row) * D + c0), zz = *(const v4u*)(P + (size_t)row * NP + PZ + c0);
            float y[8], z[8];
            y[0] = pg8::bf_lo(a.x) + pg8::bf_lo(bb.x); y[1] = pg8::bf_hi(a.x) + pg8::bf_hi(bb.x); y[2] = pg8::bf_lo(a.y) + pg8::bf_lo(bb.y); y[3] = pg8::bf_hi(a.y) + pg8::bf_hi(bb.y);
            y[4] = pg8::bf_lo(a.z) + pg8::bf_lo(bb.z); y[5] = pg8::bf_hi(a.z) + pg8::bf_hi(bb.z); y[6] = pg8::bf_lo(a.w) + pg8::bf_lo(bb.w); y[7] = pg8::bf_hi(a.w) + pg8::bf_hi(bb.w);
            z[0] = pg8::bf_lo(zz.x); z[1] = pg8::bf_hi(zz.x); z[2] = pg8::bf_lo(zz.y); z[3] = pg8::bf_hi(zz.y); z[4] = pg8::bf_lo(zz.z); z[5] = pg8::bf_hi(zz.z); z[6] = pg8::bf_lo(zz.w); z[7] = pg8::bf_hi(zz.w);
            const float dk = dsk[c0 >> 6]; float ss = 0.f; const v4u xx = *(const v4u*)(XA + (size_t)row * 3072 + c0);
            const float xs[8] = {pg8::bf_lo(xx.x), pg8::bf_hi(xx.x), pg8::bf_lo(xx.y), pg8::bf_hi(xx.y), pg8::bf_lo(xx.z), pg8::bf_hi(xx.z), pg8::bf_lo(xx.w), pg8::bf_hi(xx.w)};
#pragma unroll
            for (int j = 0; j < 8; ++j) { y[j] = (y[j] + dk * xs[j]) * siluf(z[j]); ss += y[j] * y[j]; }
            ss = wave_sum(ss);
            const float rs = rsqrtf(ss * (1.0f / 512.0f) + EPS);
            v4u w; w.x = pk2(y[0] * rs * nw[c0 + 0], y[1] * rs * nw[c0 + 1]); w.y = pk2(y[2] * rs * nw[c0 + 2], y[3] * rs * nw[c0 + 3]);
            w.z = pk2(y[4] * rs * nw[c0 + 4], y[5] * rs * nw[c0 + 5]); w.w = pk2(y[6] * rs * nw[c0 + 6], y[7] * rs * nw[c0 + 7]);
            *(v4u*)(Y + (size_t)row * D + c0) = w; }
    }
}

__device__ __forceinline__ void phase_lru_seq(const Frame& F, int L) {
    const bf16* P = (const bf16*)(F.ws + WS_P);
    bf16* hdir = (bf16*)(F.ws + WS_X1);
    const float* cw = F.a->in[I_LCW] + (size_t)L * 4 * 2048; const float* cb = F.a->in[I_LCB] + (size_t)L * 2048;
    LAS3 float* Xc = (LAS3 float*)F.lds; LAS3 float* Ga = Xc + 32 * 128; LAS3 float* Gb = Ga + 32 * 128; LAS3 float* Hb = Gb + 32 * 128;
    for (int unit = F.bid; unit < 64; unit += F.G) {
        const int b = unit >> 5, n = (unit >> 1) & 15, d = unit & 1;
        const int half = F.tid >> 8, gi = (F.tid >> 7) & 1, j = F.tid & 127, col = n * 128 + j;
        const float* gw = F.a->in[I_LGW] + ((((size_t)L * 2 + d) * 2 + gi) * 16 + n) * 128 * 128;
        const float gb = F.a->in[I_LGB][(((size_t)L * 2 + d) * 2 + gi) * 2048 + col];
        const float sp = softplusf(-F.a->in[I_LLAM][((size_t)L * 2 + d) * 2048 + col]);
        float hst = 0.f;
        for (int ch = 0; ch < 264; ++ch) {
            for (int idx = F.tid; idx < 32 * 128; idx += 512) { const int t = idx >> 7, k = idx & 127; const int row = chain_row(b, d, ch * 32 + t);
                Xc[idx] = dwconv(P, row, PL + n * 128 + k, cw, 2048, n * 128 + k, cb[n * 128 + k]); }
            __syncthreads();
            { float acc[16];
#pragma unroll
              for (int i = 0; i < 16; ++i) acc[i] = gb;
              for (int k = 0; k < 128; ++k) { const float w = gw[k * 128 + j];
#pragma unroll
                  for (int i = 0; i < 16; ++i) acc[i] += Xc[(half * 16 + i) * 128 + k] * w; }
#pragma unroll
              for (int i = 0; i < 16; ++i) { const float s = sigm(acc[i]); if (gi == 0) Ga[(half * 16 + i) * 128 + j] = -8.0f * s * sp; else Gb[(half * 16 + i) * 128 + j] = s; } }
            __syncthreads();
            if (F.tid < 128) { for (int t = 0; t < 32; ++t) { const float la = Ga[t * 128 + j], a = __expf(la); const float bx = sqrtf(-expm1f(2.0f * la)) * Gb[t * 128 + j] * Xc[t * 128 + j]; hst = a * hst + bx; Hb[t * 128 + j] = hst; } }
            __syncthreads();
            for (int idx = F.tid; idx < 32 * 128; idx += 512) { const int t = idx >> 7, k = idx & 127; const int row = chain_row(b, d, ch * 32 + t);
                hdir[((size_t)d * MROWS + row) * D + n * 128 + k] = f2bf(Hb[idx]); }
        }
        __syncthreads();
    }
}
__device__ __forceinline__ void phase_lru_out(const Frame& F, int L) {
    const bf16* P = (const bf16*)(F.ws + WS_P);
    const bf16* hdir = (const bf16*)(F.ws + WS_X1);
    bf16* Y = (bf16*)(F.ws + WS_Y3);
    for (size_t i = (size_t)F.bid * 512 + F.tid; i < (size_t)MROWS * D / 8; i += (size_t)F.G * 512) { const int row = (int)(i >> 8), c0 = (int)(i & 255) * 8;
        const v4u a = *(const v4u*)(hdir + (size_t)row * D + c0), bb = *(const v4u*)(hdir + ((size_t)MROWS + row) * D + c0), gg = *(const v4u*)(P + (size_t)row * NP + PLG + c0);
        v4u w;
        w.x = pk2((pg8::bf_lo(a.x) + pg8::bf_lo(bb.x)) * gelu_tanh(pg8::bf_lo(gg.x)), (pg8::bf_hi(a.x) + pg8::bf_hi(bb.x)) * gelu_tanh(pg8::bf_hi(gg.x)));
        w.y = pk2((pg8::bf_lo(a.y) + pg8::bf_lo(bb.y)) * gelu_tanh(pg8::bf_lo(gg.y)), (pg8::bf_hi(a.y) + pg8::bf_hi(bb.y)) * gelu_tanh(pg8::bf_hi(gg.y)));
        w.z = pk2((pg8::bf_lo(a.z) + pg8::bf_lo(bb.z)) * gelu_tanh(pg8::bf_lo(gg.z)), (pg8::bf_hi(a.z) + pg8::bf_hi(bb.z)) * gelu_tanh(pg8::bf_hi(gg.z)));
        w.w = pk2((pg8::bf_lo(a.w) + pg8::bf_lo(bb.w)) * gelu_tanh(pg8::bf_lo(gg.w)), (pg8::bf_hi(a.w) + pg8::bf_hi(bb.w)) * gelu_tanh(pg8::bf_hi(gg.w)));
        *(v4u*)(Y + (size_t)row * D + c0) = w; }
}


constexpr int RW_SLOT = 32768;
__device__ __forceinline__ void phase_lora_prep(const Frame& F, int L, int nw, int rk) {
    bf16* dst = (bf16*)(F.ws + WS_LORA);
    for (int idx = rk * 512 + F.tid; idx < 2 * 2 * 12 * 2048; idx += nw * 512) { const int col = idx & 2047, k8 = (idx >> 11) % 12, dw = idx / (12 * 2048);
        const float* src = (dw >> 1 ? F.a->in[I_RAUP] : F.a->in[I_RWUP]) + ((size_t)L * 2 + (dw & 1)) * 96 * 2048 + col; float v[8];
#pragma unroll
        for (int j = 0; j < 8; ++j) v[j] = src[(size_t)(k8 * 8 + j) * 2048];
        v4u w; w.x = pk2(v[0], v[1]); w.y = pk2(v[2], v[3]); w.z = pk2(v[4], v[5]); w.w = pk2(v[6], v[7]);
        *(v4u*)(dst + ((size_t)dw * 2048 + col) * 128 + k8 * 8) = w; }
}
__device__ __forceinline__ void phase_lora_in(const Frame& F, int L) {
    const bf16* P = (const bf16*)(F.ws + WS_P); bf16* LIN = (bf16*)(F.ws + WS_LIN);
    const float* mu = F.a->in[I_RMU] + (size_t)L * 6784 + 6144;
    for (int idx = F.bid * 512 + F.tid; idx < MROWS * 48; idx += F.G * 512) { const int row = idx / 48, g = idx - row * 48, d = g / 24, wa = (g % 24) / 12, k8 = (g % 12) * 8;
        const int col = (wa ? PAL : PWL) + d * 96 + k8; int pos, len; seq_pos(row, pos, len);
        const v4u x = *(const v4u*)(P + (size_t)row * NP + col); v4u xp = (v4u){0u, 0u, 0u, 0u}, xn = xp;
        if (pos > 0) xp = *(const v4u*)(P + (size_t)(row - 1) * NP + col);
        if (pos < len - 1) xn = *(const v4u*)(P + (size_t)(row + 1) * NP + col);
        const float* mp = mu + wa * 192 + d * 96 + k8; float o[8];
        const float xv[8] = {pg8::bf_lo(x.x), pg8::bf_hi(x.x), pg8::bf_lo(x.y), pg8::bf_hi(x.y), pg8::bf_lo(x.z), pg8::bf_hi(x.z), pg8::bf_lo(x.w), pg8::bf_hi(x.w)};
        const float pv[8] = {pg8::bf_lo(xp.x), pg8::bf_hi(xp.x), pg8::bf_lo(xp.y), pg8::bf_hi(xp.y), pg8::bf_lo(xp.z), pg8::bf_hi(xp.z), pg8::bf_lo(xp.w), pg8::bf_hi(xp.w)};
        const float nv[8] = {pg8::bf_lo(xn.x), pg8::bf_hi(xn.x), pg8::bf_lo(xn.y), pg8::bf_hi(xn.y), pg8::bf_lo(xn.z), pg8::bf_hi(xn.z), pg8::bf_lo(xn.w), pg8::bf_hi(xn.w)};
#pragma unroll
        for (int j = 0; j < 8; ++j) { const float sv = xv[j] + mp[j] * (0.5f * (pv[j] + nv[j]) - xv[j]); o[j] = wa ? sv : tanh_fast(sv); }
        v4u w; w.x = pk2(o[0], o[1]); w.y = pk2(o[2], o[3]); w.z = pk2(o[4], o[5]); w.w = pk2(o[6], o[7]);
        *(v4u*)(LIN + (size_t)row * 384 + d * 192 + wa * 96 + k8) = w; }
    bf16* SG = (bf16*)(F.ws + WS_SG); const float* mug = F.a->in[I_RMU] + (size_t)L * 6784 + 6144 + 384;
    for (int idx = F.bid * 512 + F.tid; idx < MROWS * 32; idx += F.G * 512) { const int row = idx >> 5, j8 = (idx & 31) * 8; int pos, len; seq_pos(row, pos, len);
        const v4u x = *(const v4u*)(P + (size_t)row * NP + PGL + j8); v4u xp = (v4u){0u, 0u, 0u, 0u}, xn = xp;
        if (pos > 0) xp = *(const v4u*)(P + (size_t)(row - 1) * NP + PGL + j8);
        if (pos < len - 1) xn = *(const v4u*)(P + (size_t)(row + 1) * NP + PGL + j8);
        const float* mp = mug + j8; float o[8];
        const float xv[8] = {pg8::bf_lo(x.x), pg8::bf_hi(x.x), pg8::bf_lo(x.y), pg8::bf_hi(x.y), pg8::bf_lo(x.z), pg8::bf_hi(x.z), pg8::bf_lo(x.w), pg8::bf_hi(x.w)};
        const float pv[8] = {pg8::bf_lo(xp.x), pg8::bf_hi(xp.x), pg8::bf_lo(xp.y), pg8::bf_hi(xp.y), pg8::bf_lo(xp.z), pg8::bf_hi(xp.z), pg8::bf_lo(xp.w), pg8::bf_hi(xp.w)};
        const float nv[8] = {pg8::bf_lo(xn.x), pg8::bf_hi(xn.x), pg8::bf_lo(xn.y), pg8::bf_hi(xn.y), pg8::bf_lo(xn.z), pg8::bf_hi(xn.z), pg8::bf_lo(xn.w), pg8::bf_hi(xn.w)};
#pragma unroll
        for (int j = 0; j < 8; ++j) o[j] = sigm(xv[j] + mp[j] * (0.5f * (pv[j] + nv[j]) - xv[j]));
        v4u w; w.x = pk2(o[0], o[1]); w.y = pk2(o[2], o[3]); w.z = pk2(o[4], o[5]); w.w = pk2(o[6], o[7]);
        *(v4u*)(SG + (size_t)row * 256 + j8) = w; }
}
__device__ __forceinline__ void phase_rwkv_pre(const Frame& F, int L) {
    bf16* ydir = (bf16*)(F.ws + WS_X1); const float* bonus = (const float*)(F.ws + WS_BONUS); const bf16* P = (const bf16*)(F.ws + WS_P);
    const float* lnw = F.a->in[I_RLNW] + (size_t)L * 2048; const float* lnb = F.a->in[I_RLNB] + (size_t)L * 2048; const float* muv = F.a->in[I_RMU] + (size_t)L * 6784 + 4096;
    for (int row = F.bid * 8 + F.wave; row < MROWS; row += F.G * 8) {
        int lane = F.lane; asm volatile("" : "+v"(lane));
        int pos, len; seq_pos(row, pos, len);
#pragma unroll 2
        for (int i = 0; i < 4; ++i) { const int col = i * 512 + lane * 8, h = col >> 6;
            const v4u a = *(const v4u*)(ydir + (unsigned)(row * D + col)), bb = *(const v4u*)(ydir + (unsigned)((MROWS + row) * D + col));
            const v4u x = *(const v4u*)(P + (unsigned)(row * NP + PV + col)); v4u xp = (v4u){0u, 0u, 0u, 0u}, xn = xp;
            if (pos > 0) xp = *(const v4u*)(P + (unsigned)((row - 1) * NP + PV + col));
            if (pos < len - 1) xn = *(const v4u*)(P + (unsigned)((row + 1) * NP + PV + col));
            float y[8];
            y[0] = pg8::bf_lo(a.x) + pg8::bf_lo(bb.x); y[1] = pg8::bf_hi(a.x) + pg8::bf_hi(bb.x); y[2] = pg8::bf_lo(a.y) + pg8::bf_lo(bb.y); y[3] = pg8::bf_hi(a.y) + pg8::bf_hi(bb.y);
            y[4] = pg8::bf_lo(a.z) + pg8::bf_lo(bb.z); y[5] = pg8::bf_hi(a.z) + pg8::bf_hi(bb.z); y[6] = pg8::bf_lo(a.w) + pg8::bf_lo(bb.w); y[7] = pg8::bf_hi(a.w) + pg8::bf_hi(bb.w);
            float s1 = ((y[0] + y[1]) + (y[2] + y[3])) + ((y[4] + y[5]) + (y[6] + y[7]));
            s1 += DPPF(s1, 0xB1); s1 += DPPF(s1, 0x4E); s1 += DPPF(s1, 0x141);
            const float mean = s1 * (1.0f / 64.0f); float q = 0.f;
#pragma unroll
            for (int e = 0; e < 8; ++e) { const float dl = y[e] - mean; q += dl * dl; }
            q += DPPF(q, 0xB1); q += DPPF(q, 0x4E); q += DPPF(q, 0x141);
            const float rstd = rsqrtf(q * (1.0f / 64.0f) + 64e-5f);
            const float bon = bonus[(unsigned)(row * 32 + h)] + bonus[(unsigned)((MROWS + row) * 32 + h)];
            const f32x4 w0 = *(const f32x4*)(lnw + col), w1 = *(const f32x4*)(lnw + col + 4), b0 = *(const f32x4*)(lnb + col), b1 = *(const f32x4*)(lnb + col + 4), m0 = *(const f32x4*)(muv + col), m1 = *(const f32x4*)(muv + col + 4);
            const float xv[8] = {pg8::bf_lo(x.x), pg8::bf_hi(x.x), pg8::bf_lo(x.y), pg8::bf_hi(x.y), pg8::bf_lo(x.z), pg8::bf_hi(x.z), pg8::bf_lo(x.w), pg8::bf_hi(x.w)};
            const float pq[8] = {pg8::bf_lo(xp.x), pg8::bf_hi(xp.x), pg8::bf_lo(xp.y), pg8::bf_hi(xp.y), pg8::bf_lo(xp.z), pg8::bf_hi(xp.z), pg8::bf_lo(xp.w), pg8::bf_hi(xp.w)};
            const float nq[8] = {pg8::bf_lo(xn.x), pg8::bf_hi(xn.x), pg8::bf_lo(xn.y), pg8::bf_hi(xn.y), pg8::bf_lo(xn.z), pg8::bf_hi(xn.z), pg8::bf_lo(xn.w), pg8::bf_hi(xn.w)};
            const float lw[8] = {w0[0], w0[1], w0[2], w0[3], w1[0], w1[1], w1[2], w1[3]}, lb[8] = {b0[0], b0[1], b0[2], b0[3], b1[0], b1[1], b1[2], b1[3]}, mm[8] = {m0[0], m0[1], m0[2], m0[3], m1[0], m1[1], m1[2], m1[3]};
            float o[8];
#pragma unroll
            for (int e = 0; e < 8; ++e) { const float vv = xv[e] + mm[e] * (0.5f * (pq[e] + nq[e]) - xv[e]); o[e] = (y[e] - mean) * rstd * lw[e] + lb[e] + bon * vv; }
            v4u w; w.x = pk2(o[0], o[1]); w.y = pk2(o[2], o[3]); w.z = pk2(o[4], o[5]); w.w = pk2(o[6], o[7]);
            *(v4u*)(ydir + (unsigned)(row * D + col)) = w; }
    }
}
__device__ __forceinline__ void phase_rwkv_r1(const Frame& F, int L, int gq) {
    const bf16* P = (const bf16*)(F.ws + WS_P);
    float* bonus = (float*)(F.ws + WS_BONUS);
    const float* mu = F.a->in[I_RMU] + (size_t)L * 6784;
    const bf16* LoT = (const bf16*)(F.ws + WS_LORA); const bf16* LIN = (const bf16*)(F.ws + WS_LIN);
    unsigned char* scratch = F.ws + WS_X2;
    LAS3 unsigned char* B0 = F.lds;
    LAS3 bf16* LwB = (LAS3 bf16*)(B0 + 67584);
    LAS3 bf16* LaB = LwB + 64 * 136;
    LAS3 float* NT = (LAS3 float*)B0;
    LAS3 bf16* MkaT = (LAS3 bf16*)(B0 + 16384);
    LAS3 bf16* MbrT = (LAS3 bf16*)(B0 + 25600);
    LAS3 float* Wl = (LAS3 float*)(B0 + 34816);
    LAS3 float* As = (LAS3 float*)(B0 + 51200);
    LAS3 bf16* MkrT = (LAS3 bf16*)(B0 + 51200);
    LAS3 bf16* At = (LAS3 bf16*)(B0 + 67584);
    LAS3 bf16* Bt = At + 64 * 72; LAS3 bf16* Kt = Bt + 64 * 72; LAS3 bf16* Rt = Kt + 64 * 72; LAS3 bf16* BtT = Rt + 64 * 72; LAS3 bf16* KtT = BtT + 64 * 72; LAS3 bf16* Vt = KtT + 64 * 72;
    LAS3 bf16* Ap = (LAS3 bf16*)(B0 + 132096);
    LAS3 bf16* W1 = Ap + 64 * 72;
    LAS3 float* CX = (LAS3 float*)(B0 + 132096);
    LAS3 float* PC = (LAS3 float*)(B0 + 150528);
    LAS3 float* SEG = PC + 64;
    LAS3 bf16* RL = (LAS3 bf16*)(B0 + 67584);
    LAS3 bf16* RKV = (LAS3 bf16*)B0;
    v4u pl[4], pr[4];
#define R1_FETCH(cl__, WHICH) do { const int cl_ = (cl__), c_ = gq * 33 + cl_, d_ = d, h_ = h, b_ = b; \
        const int r0_ = chain_row(b_, d_, c_ * 64), rmin_ = d_ ? r0_ - 63 : r0_; int pos_, len_; seq_pos(rmin_, pos_, len_); \
        int tid_ = F.tid; asm volatile("" : "+v"(tid_)); \
        _Pragma("unroll") for (int i_ = 0; i_ < 4; ++i_) { const int idx_ = tid_ + 512 * i_, rr_ = idx_ / 24, g_ = idx_ - rr_ * 24; \
            const bool ok_ = idx_ < 1584 && ((rr_ >= 1 && rr_ <= 64) || (rr_ == 0 && pos_ > 0) || (rr_ == 65 && pos_ + 64 < len_)); \
            const unsigned ro_ = (unsigned)((rmin_ - 1 + rr_) * NP); \
            if (WHICH == 0) { if (i_ < 3) { const int t_ = idx_ / 24, q_ = idx_ - t_ * 24; pl[i_] = *(const v4u*)(LIN + (unsigned)(CROW(r0_, d_, t_) * 384 + d_ * 192 + q_ * 8)); } } \
            else { const int cr2_ = (g_ < 8 ? PR : (g_ < 16 ? PK - 64 : PV - 128)) + h_ * 64 + g_ * 8; pr[i_] = ok_ ? *(const v4u*)(P + ro_ + cr2_) : (v4u){0u, 0u, 0u, 0u}; } } } while (0)
    LAS3 bf16* NTb = (LAS3 bf16*)(B0 + 153600);
    LAS3 bf16* DTb = (LAS3 bf16*)(B0 + 150784);
    LAS3 bf16* Wsc = (LAS3 bf16*)(B0 + 16384);
    LAS3 float* MU = SEG + 512;
#pragma unroll 1
    for (int chn = F.bid >> 1; chn < 128; chn += F.G >> 1) {
    const int d = chn & 1, h = (chn >> 1) & 31, b = chn >> 6, cl0 = (F.bid & 1) * 17, cl1 = (F.bid & 1) ? 33 : 17;
    __syncthreads();
    for (int i = F.tid; i < 192; i += 512) MU[i] = mu[6144 + (i < 96 ? 0 : 192 - 96) + d * 96 + i];
    bf16x8 wfr[3]; f32x4 lbias; float mur, muk, muv, kkw, kaw, rkw;
    { const int wa0 = F.wave >> 2, nt0 = F.wave & 3, fr0 = F.lane & 15, fq0 = F.lane >> 4;
#pragma unroll
      for (int ks = 0; ks < 3; ++ks) wfr[ks] = ldfrag_g(LoT + (size_t)(wa0 * 2 + d) * 2048 * 128, 128, h * 64 + nt0 * 16, ks * 32, fr0, fq0);
      lbias = *(const f32x4*)((wa0 ? F.a->in[I_RA0] : F.a->in[I_RW0]) + ((size_t)L * 2 + d) * 2048 + h * 64 + nt0 * 16 + 4 * fq0);
      const int col0 = h * 64 + F.lane;
      mur = mu[col0]; muk = mu[2048 + col0]; muv = mu[4096 + col0];
      kkw = F.a->in[I_RKK][(size_t)L * 2048 + col0]; kaw = F.a->in[I_RKA][(size_t)L * 2048 + col0]; rkw = F.a->in[I_RRK][(size_t)L * 2048 + col0]; }
    R1_FETCH(cl0, 0); R1_FETCH(cl0, 1);
    __syncthreads();
    for (int cl = cl0; cl < cl1; ++cl) {
        int tid = F.tid; asm volatile("" : "+v"(tid));
        const int lane = tid & 63, wave = __builtin_amdgcn_readfirstlane(tid >> 6), fr = lane & 15, fq = lane >> 4;
        const int c = gq * 33 + cl, unit = chn * 33 + cl;
        unsigned char* slot = scratch + (size_t)unit * RW_SLOT;
#pragma unroll
        for (int i = 0; i < 3; ++i) { const int idx = tid + 512 * i, t = idx / 24, q = idx - t * 24; *(LAS3 v4u*)((q >= 12 ? LaB + (q - 12) * 8 : LwB + q * 8) + t * 136) = pl[i]; }
#pragma unroll
        for (int i = 0; i < 4; ++i) { const int idx = tid + 512 * i, rr = idx / 24, g = idx - rr * 24; if (idx < 1584) *(LAS3 v4u*)(RKV + rr * 200 + g * 8) = pr[i]; }
        LBAR();
        { const int wa = wave >> 2, nt = wave & 3; f32x4 acc[4];
#pragma unroll
          for (int mt = 0; mt < 4; ++mt) acc[mt] = (f32x4){0.f, 0.f, 0.f, 0.f};
          LAS3 bf16* Xs = wa ? LaB : LwB;
#pragma unroll
          for (int ks = 0; ks < 3; ++ks)
#pragma unroll
              for (int mt = 0; mt < 4; ++mt) MMA_TRN(acc[mt], ldfrag(Xs, 136, mt * 16, ks * 32, fr, fq), wfr[ks]);
          if (wa) {
#pragma unroll
              for (int mt = 0; mt < 4; ++mt) { f32x4 o;
#pragma unroll
                  for (int e = 0; e < 4; ++e) o[e] = sigm(acc[mt][e] + lbias[e]);
                  *(LAS3 f32x4*)(As + (mt * 16 + fr) * 64 + nt * 16 + 4 * fq) = o; } }
          else { f32x4 run = (f32x4){0.f, 0.f, 0.f, 0.f};
#pragma unroll
              for (int mt = 0; mt < 4; ++mt) { f32x4 inc, exc;
#pragma unroll
                  for (int e = 0; e < 4; ++e) { const float lw = -__expf(-softplus_fast(-(acc[mt][e] + lbias[e])) - 0.5f);
                      float v = lw; v += DPPF(v, 0x111); v += DPPF(v, 0x112); v += DPPF(v, 0x114); v += DPPF(v, 0x118);
                      inc[e] = v + run[e]; exc[e] = inc[e] - lw;
                      float tot = lw; tot += DPPF(tot, 0xB1); tot += DPPF(tot, 0x4E); tot += DPPF(tot, 0x141); tot += DPPF(tot, 0x140);
                      run[e] += tot; }
                  *(LAS3 f32x4*)(Wl + (mt * 16 + fr) * 64 + nt * 16 + 4 * fq) = inc; *(LAS3 f32x4*)(CX + (mt * 16 + fr) * 64 + nt * 16 + 4 * fq) = exc; }
              if (fr == 0) { f32x4 pc; pc[0] = __expf(run[0]); pc[1] = __expf(run[1]); pc[2] = __expf(run[2]); pc[3] = __expf(run[3]); *(LAS3 f32x4*)(PC + nt * 16 + 4 * fq) = pc; } } }
        LBAR();
        { const int ch = lane; const int rr0 = d ? 64 - wave * 8 : 1 + wave * 8, st = d ? -1 : 1;
          const LAS3 bf16* qb = RKV + ch;
          float rp = bf2f(qb[(rr0 - st) * 200]), kp = bf2f(qb[(rr0 - st) * 200 + 64]), vp = bf2f(qb[(rr0 - st) * 200 + 128]);
          float rc = bf2f(qb[rr0 * 200]), kc = bf2f(qb[rr0 * 200 + 64]), vc = bf2f(qb[rr0 * 200 + 128]);
          const int r0c = chain_row(b, d, c * 64);
#pragma unroll
          for (int i = 0; i < 8; ++i) { const int t = wave * 8 + i; const int row = CROW(r0c, d, t); const int rn = rr0 + st * (i + 1);
              const float rx = bf2f(qb[rn * 200]), kx = bf2f(qb[rn * 200 + 64]), vx = bf2f(qb[rn * 200 + 128]);
              const float r = rc + mur * (0.5f * (rp + rx) - rc), k = kc + muk * (0.5f * (kp + kx) - kc), v = vc + muv * (0.5f * (vp + vx) - vc);
              rp = rc; kp = kc; vp = vc; rc = rx; kc = kx; vc = vx;
              const float asig = As[t * 64 + ch], cv = Wl[t * 64 + ch], cx = CX[t * 64 + ch];
              const float kkv = k * kkw, n2 = wave_sum(kkv * kkv), kk = kkv * rsqrtf(n2 + 1e-12f);
              const float key = k * (1.0f + (asig - 1.0f) * kaw);
              const float bon = wave_sum(r * key * rkw);
              if (ch == 0) bonus[(unsigned)((d * MROWS + row) * 32 + h)] = bon;
              const float ep = __expf(cv), em = __expf(-cv), ex = __expf(cx);
              const bf16 a_ = f2bf(-kk * ex), b_ = f2bf(kk * asig * em), k_ = f2bf(key * em), r_ = f2bf(r * ep), v_ = f2bf(v);
              At[t * 72 + ch] = a_; Bt[t * 72 + ch] = b_; Kt[t * 72 + ch] = k_; Rt[t * 72 + ch] = r_;
              BtT[ch * 72 + t] = b_; KtT[ch * 72 + t] = k_; Vt[ch * 72 + t] = v_; } }
        LBAR();
        for (int i = tid; i < 18432 / 16; i += 512) ((LAS3 v4u*)Ap)[i] = (v4u){0u, 0u, 0u, 0u};
        { const int q = wave >> 1, hf = wave & 1; LAS3 bf16* Xs = q < 2 ? At : Rt; LAS3 bf16* Ys = (q & 1) ? Kt : Bt;
#pragma unroll
          for (int mi = 0; mi < 2; ++mi) { const int mt = hf * 2 + mi; f32x4 acc[4];
#pragma unroll
              for (int nt = 0; nt < 4; ++nt) acc[nt] = (f32x4){0.f, 0.f, 0.f, 0.f};
#pragma unroll
              for (int ks = 0; ks < 2; ++ks) { const bf16x8 a = ldfrag(Xs, 72, mt * 16, ks * 32, fr, fq);
#pragma unroll
                  for (int nt = 0; nt < 4; ++nt) MMA_TRN(acc[nt], a, ldfrag(Ys, 72, nt * 16, ks * 32, fr, fq)); }
              const int t = mt * 16 + fr;
#pragma unroll
              for (int nt = 0; nt < 4; ++nt) { const int i0 = nt * 16 + 4 * fq; f32x4 o;
#pragma unroll
                  for (int e = 0; e < 4; ++e) { const int i = i0 + e; const bool keep = q < 2 ? (i < t) : (i <= t); o[e] = keep ? acc[nt][e] : 0.f; }
                  if (q == 0) { *(LAS3 f32x4*)(NT + t * 64 + i0) = o; const bool offd = nt != mt; v2u w; w.x = offd ? pk2(o[0], o[1]) : 0u; w.y = offd ? pk2(o[2], o[3]) : 0u; *(LAS3 v2u*)(NTb + t * 72 + i0) = w; }
                  else { v2u w; w.x = pk2(o[0], o[1]); w.y = pk2(o[2], o[3]); *(LAS3 v2u*)((q == 1 ? MkaT : (q == 2 ? MbrT : MkrT)) + t * 72 + i0) = w; } } } }
        LBAR();
        if (wave > 0) {
            for (int tile = wave - 1; tile < 16; tile += 7) { const int mt = tile >> 2, nt = tile & 3; f32x4 acc = (f32x4){0.f, 0.f, 0.f, 0.f};
#pragma unroll
                for (int ks = 0; ks < 2; ++ks) MMA_TRN(acc, ldfrag(Vt, 72, mt * 16, ks * 32, fr, fq), ldfrag(MkaT, 72, nt * 16, ks * 32, fr, fq));
                *(LAS3 f32x4*)(Wl + (mt * 16 + fr) * 64 + nt * 16 + 4 * fq) = acc; } }
        else { const int J = lane >> 4, cc = lane & 15; float z[16];
#pragma unroll
            for (int t = 0; t < 16; ++t) { float acc = t == cc ? 1.0f : 0.f;
#pragma unroll
                for (int i4 = 0; i4 < (t + 3) / 4; ++i4) { const f32x4 nv = *(const LAS3 f32x4*)(NT + (J * 16 + t) * 64 + J * 16 + i4 * 4);
#pragma unroll
                    for (int e = 0; e < 4; ++e) if (i4 * 4 + e < t) acc += nv[e] * z[i4 * 4 + e]; }
                z[t] = acc; DTb[(J * 16 + t) * 16 + cc] = f2bf(acc); } }
        LBAR();
        { LAS3 bf16* Ws = Wsc + wave * 256; const int r = wave * 16 + fr;
#pragma unroll
          for (int J = 0; J < 4; ++J) { f32x4 acc = (f32x4){0.f, 0.f, 0.f, 0.f};
              if (J > 0) {
#pragma unroll
                  for (int ks = 0; ks < (J + 1) / 2; ++ks) MMA_TRN(acc, ldfrag(Ap, 72, wave * 16, ks * 32, fr, fq), ldfrag(NTb, 72, J * 16, ks * 32, fr, fq)); }
              const int t0 = J * 16 + 4 * fq;
              if (wave < 4) { acc[0] += bf2f(At[(t0 + 0) * 72 + r]); acc[1] += bf2f(At[(t0 + 1) * 72 + r]); acc[2] += bf2f(At[(t0 + 2) * 72 + r]); acc[3] += bf2f(At[(t0 + 3) * 72 + r]); }
              else acc += *(const LAS3 f32x4*)(Wl + (r - 64) * 64 + t0);
              { v2u w; w.x = pk2(acc[0], acc[1]); w.y = pk2(acc[2], acc[3]); *(LAS3 v2u*)(Ws + fr * 16 + 4 * fq) = w; }
              asm volatile("s_waitcnt lgkmcnt(0)" ::: "memory");
              const bf16x8 zero8 = (bf16x8){0, 0, 0, 0, 0, 0, 0, 0};
              const bf16x8 wf = fq < 2 ? *(const LAS3 bf16x8*)(Ws + fr * 16 + 8 * fq) : zero8;
              const bf16x8 zf = fq < 2 ? *(const LAS3 bf16x8*)(DTb + (J * 16 + fr) * 16 + 8 * fq) : zero8;
              f32x4 x = (f32x4){0.f, 0.f, 0.f, 0.f};
              MMA_TRN(x, wf, zf);
              { v2u w; w.x = pk2(x[0], x[1]); w.y = pk2(x[2], x[3]); *(LAS3 v2u*)(Ap + r * 72 + t0) = w; }
              asm volatile("s_waitcnt lgkmcnt(0)" ::: "memory"); } }
        LBAR();
        if (cl + 1 < cl1) { R1_FETCH(cl + 1, 0); R1_FETCH(cl + 1, 1); }
        { const int o = wave >> 1, hf = wave & 1;
#pragma unroll
          for (int mi = 0; mi < 2; ++mi) { const int mt = hf * 2 + mi; f32x4 acc[4];
#pragma unroll
              for (int nt = 0; nt < 4; ++nt) acc[nt] = (f32x4){0.f, 0.f, 0.f, 0.f};
              if (o < 2) {
                  LAS3 bf16* Xs = o == 0 ? MbrT : BtT;
#pragma unroll
                  for (int ks = 0; ks < 2; ++ks) { const bf16x8 a = ldfrag(Xs, 72, mt * 16, ks * 32, fr, fq);
#pragma unroll
                      for (int nt = 0; nt < 4; ++nt) MMA_TRN(acc[nt], a, ldfrag(Ap, 72, nt * 16, ks * 32, fr, fq)); }
                  const int m = mt * 16 + fr; const float pc = o == 1 ? PC[m] : 1.0f; v4u wq;
#pragma unroll
                  for (int nt = 0; nt < 4; ++nt) { const int k0 = nt * 16 + 4 * fq; float v[4];
                      if (o == 0) { const v2u rr = *(const LAS3 v2u*)(Rt + m * 72 + k0); v[0] = acc[nt][0] + pg8::bf_lo(rr.x); v[1] = acc[nt][1] + pg8::bf_hi(rr.x); v[2] = acc[nt][2] + pg8::bf_lo(rr.y); v[3] = acc[nt][3] + pg8::bf_hi(rr.y); }
                      else {
#pragma unroll
                          for (int e = 0; e < 4; ++e) v[e] = (acc[nt][e] + ((k0 + e) == m ? 1.0f : 0.f)) * pc; }
                      if ((nt & 1) == 0) { wq.x = pk2(v[0], v[1]); wq.y = pk2(v[2], v[3]); }
                      else { wq.z = pk2(v[0], v[1]); wq.w = pk2(v[2], v[3]);
                          *(v4u*)(slot + (o == 0 ? 8192 : 0) + (size_t)(((mt * 2 + (nt >> 1)) * 64 + fq * 16 + fr) * 16)) = wq; } } }
              else {
                  LAS3 bf16* X1 = o == 2 ? BtT : MbrT; LAS3 bf16* X2 = o == 2 ? KtT : MkrT;
#pragma unroll
                  for (int ks = 0; ks < 2; ++ks) { const bf16x8 a1 = ldfrag(X1, 72, mt * 16, ks * 32, fr, fq), a2 = ldfrag(X2, 72, mt * 16, ks * 32, fr, fq);
#pragma unroll
                      for (int nt = 0; nt < 4; ++nt) { MMA_STD(acc[nt], a1, ldfrag(W1, 72, nt * 16, ks * 32, fr, fq)); MMA_STD(acc[nt], a2, ldfrag(Vt, 72, nt * 16, ks * 32, fr, fq)); } }
                  float pc[4];
#pragma unroll
                  for (int e = 0; e < 4; ++e) pc[e] = o == 2 ? PC[mt * 16 + 4 * fq + e] : 1.0f;
#pragma unroll
                  for (int nt = 0; nt < 4; ++nt) { v2u w; w.x = pk2(acc[nt][0] * pc[0], acc[nt][1] * pc[1]); w.y = pk2(acc[nt][2] * pc[2], acc[nt][3] * pc[3]);
                      *(v2u*)(slot + (o == 2 ? 16384 : 24576) + (size_t)(((nt * 4 + mt) * 64 + lane) * 8)) = w; } } } }
        LBAR();
    }
    }
}
#undef R1_FETCH
#define RW_LOAD(Tf, Rf, Sh, Yh, cl_) do { const unsigned char* slot_ = scratch + ((size_t)chn * 33 + (cl_)) * RW_SLOT; \
        _Pragma("unroll") for (int mt_ = 0; mt_ < 4; ++mt_) { \
            _Pragma("unroll") for (int s_ = 0; s_ < 2; ++s_) { Tf[mt_][s_] = *(const bf16x8*)(slot_ + ((mt_ * 2 + s_) * 64 + F.lane) * 16); Rf[mt_][s_] = *(const bf16x8*)(slot_ + 8192 + ((mt_ * 2 + s_) * 64 + F.lane) * 16); } \
            Sh[mt_] = *(const v2u*)(slot_ + 16384 + ((vt * 4 + mt_) * 64 + F.lane) * 8); Yh[mt_] = *(const v2u*)(slot_ + 24576 + ((vt * 4 + mt_) * 64 + F.lane) * 8); } } while (0)
#define RW_STEP(Tf, Rf, Sh, Yh, cl_) do { bf16x8 Sb[2]; const int r0s_ = chain_row(b, d, (gq * 33 + (cl_)) * 64); \
        _Pragma("unroll") for (int s2 = 0; s2 < 2; ++s2) { v4u w; w.x = pk2(S[2 * s2][0], S[2 * s2][1]); w.y = pk2(S[2 * s2][2], S[2 * s2][3]); w.z = pk2(S[2 * s2 + 1][0], S[2 * s2 + 1][1]); w.w = pk2(S[2 * s2 + 1][2], S[2 * s2 + 1][3]); \
            Sb[s2] = __builtin_bit_cast(bf16x8, w); } \
        _Pragma("unroll") for (int mt = 0; mt < 4; ++mt) { \
            f32x4 ya = (f32x4){pg8::bf_lo(Yh[mt].x), pg8::bf_hi(Yh[mt].x), pg8::bf_lo(Yh[mt].y), pg8::bf_hi(Yh[mt].y)}; \
            f32x4 sn = (f32x4){pg8::bf_lo(Sh[mt].x), pg8::bf_hi(Sh[mt].x), pg8::bf_lo(Sh[mt].y), pg8::bf_hi(Sh[mt].y)}; \
            _Pragma("unroll") for (int s2 = 0; s2 < 2; ++s2) { MMA_STD(ya, Rf[mt][s2], Sb[s2]); MMA_STD(sn, Tf[mt][s2], Sb[s2]); } \
            _Pragma("unroll") for (int e = 0; e < 4; ++e) { const int t = mt * 16 + 4 * fq + e; const int row = CROW(r0s_, d, t); \
                ydir[(unsigned)((d * MROWS + row) * D + h * 64 + vt * 16 + fr)] = f2bf(ya[e]); } \
            S[mt] = sn; } } while (0)
__device__ __forceinline__ void phase_rwkv_r2(const Frame& F, int gq) {
    const unsigned char* scratch = F.ws + WS_X2; bf16* ydir = (bf16*)(F.ws + WS_X1);
    f32x4* state = (f32x4*)(F.ws + WS_LAGG);
    if (F.wave >= 2) return;
    const int fr = F.lane & 15, fq = F.lane >> 4;
    for (int task = F.bid * 2 + F.wave; task < 512; task += F.G * 2) {
        const int chn = task >> 2, vt = task & 3, d = chn & 1, h = (chn >> 1) & 31, b = chn >> 6;
        f32x4 S[4];
#pragma unroll
        for (int mt = 0; mt < 4; ++mt) S[mt] = gq == 0 ? (f32x4){0.f, 0.f, 0.f, 0.f} : state[((size_t)task * 4 + mt) * 64 + F.lane];
        bf16x8 Ta[4][2], Ra[4][2]; v2u Sa[4], Ya[4];
#pragma unroll 1
        for (int cl = 0; cl < 33; ++cl) { RW_LOAD(Ta, Ra, Sa, Ya, cl); RW_STEP(Ta, Ra, Sa, Ya, cl); }
        if (gq < 3) {
#pragma unroll
            for (int mt = 0; mt < 4; ++mt) state[((size_t)task * 4 + mt) * 64 + F.lane] = S[mt]; }
    }
}
#undef RW_LOAD
#undef RW_STEP

__device__ __forceinline__ void phase_ssm_conv(const Frame& F, int L) {
    const bf16* P = (const bf16*)(F.ws + WS_P); bf16* XA = (bf16*)(F.ws + WS_X2);
    const float* cw = F.a->in[I_SCW] + (size_t)L * 4 * 3072; const float* cb = F.a->in[I_SCB] + (size_t)L * 3072;
    for (int gI = F.bid * 512 + F.tid; gI < (MROWS / 8) * 384; gI += F.G * 512) { const int rb = gI / 384, col = (gI - rb * 384) * 8, row0 = rb * 8;
        int pos0, len; seq_pos(row0, pos0, len);
        float w[4][8], bias[8];
#pragma unroll
        for (int tap = 0; tap < 4; ++tap) { const f32x4 a0 = *(const f32x4*)(cw + tap * 3072 + col), a1 = *(const f32x4*)(cw + tap * 3072 + col + 4);
            w[tap][0] = a0[0]; w[tap][1] = a0[1]; w[tap][2] = a0[2]; w[tap][3] = a0[3]; w[tap][4] = a1[0]; w[tap][5] = a1[1]; w[tap][6] = a1[2]; w[tap][7] = a1[3]; }
        { const f32x4 a0 = *(const f32x4*)(cb + col), a1 = *(const f32x4*)(cb + col + 4); bias[0] = a0[0]; bias[1] = a0[1]; bias[2] = a0[2]; bias[3] = a0[3]; bias[4] = a1[0]; bias[5] = a1[1]; bias[6] = a1[2]; bias[7] = a1[3]; }
        v4u win[3];
#pragma unroll
        for (int k = 0; k < 3; ++k) { const int q = pos0 + k - 2; win[k] = (q >= 0 && q < len) ? *(const v4u*)(P + (unsigned)((row0 + k - 2) * NP + PX + col)) : (v4u){0u, 0u, 0u, 0u}; }
#pragma unroll
        for (int r = 0; r < 8; ++r) { const int q = pos0 + r + 1; const v4u nx = (q < len) ? *(const v4u*)(P + (unsigned)((row0 + r + 1) * NP + PX + col)) : (v4u){0u, 0u, 0u, 0u};
            float o[8];
#pragma unroll
            for (int e = 0; e < 8; ++e) o[e] = bias[e];
            const v4u tp[4] = {win[0], win[1], win[2], nx};
#pragma unroll
            for (int tap = 0; tap < 4; ++tap) { const v4u x = tp[tap];
                o[0] += w[tap][0] * pg8::bf_lo(x.x); o[1] += w[tap][1] * pg8::bf_hi(x.x); o[2] += w[tap][2] * pg8::bf_lo(x.y); o[3] += w[tap][3] * pg8::bf_hi(x.y);
                o[4] += w[tap][4] * pg8::bf_lo(x.z); o[5] += w[tap][5] * pg8::bf_hi(x.z); o[6] += w[tap][6] * pg8::bf_lo(x.w); o[7] += w[tap][7] * pg8::bf_hi(x.w); }
            v4u wv; wv.x = pk2(siluf(o[0]), siluf(o[1])); wv.y = pk2(siluf(o[2]), siluf(o[3])); wv.z = pk2(siluf(o[4]), siluf(o[5])); wv.w = pk2(siluf(o[6]), siluf(o[7]));
            *(v4u*)(XA + (unsigned)((row0 + r) * 3072 + col)) = wv;
            win[0] = win[1]; win[1] = win[2]; win[2] = nx; }
    }
}
__device__ __forceinline__ void phase_ssm_chain(const Frame& F, int L) {
    const bf16* P = (const bf16*)(F.ws + WS_P); const bf16* XA = (const bf16*)(F.ws + WS_X2);
    bf16* ydir = (bf16*)(F.ws + WS_X1);
    constexpr int SET = 72192;
    LAS3 bf16* Hb = (LAS3 bf16*)(F.lds + 2 * SET);
    const int fr = F.lane & 15, fq = F.lane >> 4;
#define SS_PTRS(set_) LAS3 bf16* Cb = (LAS3 bf16*)(F.lds + (set_) * SET); LAS3 bf16* Bb = Cb + 64 * 136; LAS3 bf16* BT = Bb + 64 * 136; LAS3 bf16* Sc = BT + 128 * 72; \
        LAS3 bf16* Xt = Sc + 64 * 72; LAS3 bf16* Xd = Xt + 32 * 72; LAS3 float* cum = (LAS3 float*)(Xd + 32 * 72); LAS3 float* dtj = cum + 64; (void)Cb; (void)Bb; (void)BT; (void)Sc; (void)Xt; (void)Xd; (void)cum; (void)dtj
    for (int unit = F.bid; unit < 256; unit += F.G) {
        const int b = unit >> 7, h = (unit >> 2) & 31, d = (unit >> 1) & 1, ph = unit & 1, g = h >> 3;
        const float Ad = -__expf(F.a->in[I_SALOG][(L * 2 + d) * 32 + h]); const float dtb = F.a->in[I_SDTB][(L * 2 + d) * 32 + h];
        const int xcol = h * 64 + ph * 32;
        for (int i = F.tid; i < 32 * 136 / 2; i += 512) ((LAS3 unsigned*)Hb)[i] = 0u;
        f32x4 hacc[2]; hacc[0] = (f32x4){0.f, 0.f, 0.f, 0.f}; hacc[1] = hacc[0];
        v4u nb[4], nx; float ndt = 0.f;
#define SS_LOAD(c_) do { \
            const int r0l_ = chain_row(b, d, (c_) * 64); \
            _Pragma("unroll") for (int i_ = 0; i_ < 4; ++i_) { const int gI_ = F.tid + 512 * i_, j_ = gI_ >> 5, q_ = gI_ & 31; const int row_ = CROW(r0l_, d, j_); \
                const int col_ = q_ < 16 ? 2048 + g * 128 + q_ * 8 : 2560 + g * 128 + (q_ - 16) * 8; nb[i_] = *(const v4u*)(XA + (unsigned)(row_ * 3072 + col_)); } \
            if (F.tid < 256) { const int j_ = F.tid >> 2, q_ = F.tid & 3; const int row_ = CROW(r0l_, d, j_); nx = *(const v4u*)(XA + (unsigned)(row_ * 3072 + xcol + q_ * 8)); } \
            if (F.wave == 4) { const int row_ = CROW(r0l_, d, F.lane); ndt = bf2f(P[(unsigned)(row_ * NP + PDT + d * 32 + h)]); } } while (0)
#define SS_FRONT1(set_) do { SS_PTRS(set_); \
            _Pragma("unroll") for (int i_ = 0; i_ < 4; ++i_) { const int gI_ = F.tid + 512 * i_, j_ = gI_ >> 5, q_ = gI_ & 31; const v4u v_ = nb[i_]; \
                if (q_ < 16) { *(LAS3 v4u*)(Bb + j_ * 136 + q_ * 8) = v_; LAS3 bf16* bt_ = BT + (q_ * 8) * 72 + ((((j_ >> 3) ^ (q_ & 7)) << 3) | (j_ & 7)); \
                    bt_[0 * 72] = (bf16)(v_.x & 0xffff); bt_[1 * 72] = (bf16)(v_.x >> 16); bt_[2 * 72] = (bf16)(v_.y & 0xffff); bt_[3 * 72] = (bf16)(v_.y >> 16); \
                    bt_[4 * 72] = (bf16)(v_.z & 0xffff); bt_[5 * 72] = (bf16)(v_.z >> 16); bt_[6 * 72] = (bf16)(v_.w & 0xffff); bt_[7 * 72] = (bf16)(v_.w >> 16); } \
                else *(LAS3 v4u*)(Cb + j_ * 136 + (q_ - 16) * 8) = v_; } \
            if (F.tid < 256) { const int j_ = F.tid >> 2, q_ = F.tid & 3; const v4u v_ = nx; LAS3 bf16* xt_ = Xt + (q_ * 8) * 72 + ((((j_ >> 3) ^ (q_ & 7)) << 3) | (j_ & 7)); \
                xt_[0 * 72] = (bf16)(v_.x & 0xffff); xt_[1 * 72] = (bf16)(v_.x >> 16); xt_[2 * 72] = (bf16)(v_.y & 0xffff); xt_[3 * 72] = (bf16)(v_.y >> 16); \
                xt_[4 * 72] = (bf16)(v_.z & 0xffff); xt_[5 * 72] = (bf16)(v_.z >> 16); xt_[6 * 72] = (bf16)(v_.w & 0xffff); xt_[7 * 72] = (bf16)(v_.w >> 16); } \
            if (F.wave == 4) { const float dtv_ = softplusf(ndt + dtb); const float v_ = wave_scan(dtv_ * Ad, F.lane); cum[F.lane] = v_; dtj[F.lane] = dtv_; } } while (0)
#define SS_FRONT2(set_) do { SS_PTRS(set_); \
            { const int mt_ = F.wave >> 1; f32x4 acc_[2]; acc_[0] = (f32x4){0.f, 0.f, 0.f, 0.f}; acc_[1] = acc_[0]; \
              _Pragma("unroll") for (int ks_ = 0; ks_ < 4; ++ks_) { const bf16x8 a_ = ldfrag(Cb, 136, mt_ * 16, ks_ * 32, fr, fq); \
                  _Pragma("unroll") for (int x_ = 0; x_ < 2; ++x_) { const bf16x8 bb_ = ldfrag(Bb, 136, ((F.wave & 1) * 2 + x_) * 16, ks_ * 32, fr, fq); MMA_TRN(acc_[x_], a_, bb_); } } \
              const int i_ = mt_ * 16 + fr; const float ci_ = cum[i_]; \
              _Pragma("unroll") for (int x_ = 0; x_ < 2; ++x_) { const int j0_ = ((F.wave & 1) * 2 + x_) * 16 + 4 * fq; float sc_[4]; \
                  _Pragma("unroll") for (int e_ = 0; e_ < 4; ++e_) { const int jj_ = j0_ + e_; sc_[e_] = jj_ <= i_ ? acc_[x_][e_] * __expf(ci_ - cum[jj_]) * dtj[jj_] : 0.f; } \
                  v2u w_; w_.x = pk2(sc_[0], sc_[1]); w_.y = pk2(sc_[2], sc_[3]); *(LAS3 v2u*)(Sc + i_ * 72 + j0_) = w_; } } \
            { const int idx_ = F.tid * 4, p_ = idx_ >> 6, j0_ = idx_ & 63; const float cl_ = cum[63]; const v2u xv_ = *(const LAS3 v2u*)(Xt + p_ * 72 + ((((j0_ >> 3) ^ ((p_ >> 3) & 7)) << 3) | (j0_ & 7))); \
              const float x0_ = pg8::bf_lo(xv_.x) * dtj[j0_] * __expf(cl_ - cum[j0_]), x1_ = pg8::bf_hi(xv_.x) * dtj[j0_ + 1] * __expf(cl_ - cum[j0_ + 1]); \
              const float x2_ = pg8::bf_lo(xv_.y) * dtj[j0_ + 2] * __expf(cl_ - cum[j0_ + 2]), x3_ = pg8::bf_hi(xv_.y) * dtj[j0_ + 3] * __expf(cl_ - cum[j0_ + 3]); \
              v2u w_; w_.x = pk2(x0_, x1_); w_.y = pk2(x2_, x3_); *(LAS3 v2u*)(Xd + p_ * 72 + j0_) = w_; } } while (0)
        SS_LOAD(0);
        __syncthreads();
        SS_FRONT1(0);
        SS_LOAD(1);
        LBAR();
        SS_FRONT2(0);
        LBAR();
        for (int c = 0; c < 132; ++c) {
            const int cur = c & 1;
            if (c + 1 < 132) { SS_FRONT1(cur ^ 1); if (c + 2 < 132) SS_LOAD(c + 2); }
            { SS_PTRS(cur);
              { const int mt = F.wave >> 1, nt = F.wave & 1; f32x4 ad = (f32x4){0.f, 0.f, 0.f, 0.f}, ao = ad;
#pragma unroll
                for (int ks = 0; ks < 2; ++ks) MMA_TRN(ad, ldfrag(Sc, 72, mt * 16, ks * 32, fr, fq), ldfrag_sw(Xt, 72, nt * 16, ks * 32, fr, fq));
#pragma unroll
                for (int ks = 0; ks < 4; ++ks) MMA_TRN(ao, ldfrag(Cb, 136, mt * 16, ks * 32, fr, fq), ldfrag(Hb, 136, nt * 16, ks * 32, fr, fq));
                const int i = mt * 16 + fr; const float ei = __expf(cum[i]); const int row = CROW(chain_row(b, d, c * 64), d, i);
                v2u w; w.x = pk2(ad[0] + ei * ao[0], ad[1] + ei * ao[1]); w.y = pk2(ad[2] + ei * ao[2], ad[3] + ei * ao[3]);
                *(v2u*)(ydir + (unsigned)((d * MROWS + row) * D + xcol + nt * 16 + 4 * fq)) = w; }
              { const int mt = F.wave >> 2; const float dc = __expf(cum[63]);
#pragma unroll
                for (int x = 0; x < 2; ++x) { const int nt = (F.wave & 3) * 2 + x; hacc[x] *= dc;
#pragma unroll
                    for (int ks = 0; ks < 2; ++ks) MMA_TRN(hacc[x], ldfrag(Xd, 72, mt * 16, ks * 32, fr, fq), ldfrag_sw(BT, 72, nt * 16, ks * 32, fr, fq)); } } }
            LBAR();
            { const int mt = F.wave >> 2;
#pragma unroll
              for (int x = 0; x < 2; ++x) { const int nt = (F.wave & 3) * 2 + x; v2u w; w.x = pk2(hacc[x][0], hacc[x][1]); w.y = pk2(hacc[x][2], hacc[x][3]);
                  *(LAS3 v2u*)(Hb + (mt * 16 + fr) * 136 + nt * 16 + 4 * fq) = w; } }
            if (c + 1 < 132) SS_FRONT2(cur ^ 1);
            LBAR();
        }
        __syncthreads();
    }
#undef SS_PTRS
#undef SS_LOAD
#undef SS_FRONT1
#undef SS_FRONT2
}

__device__ __forceinline__ int chunk_row0(int ck) { return ck < 256 ? ck * 64 : MLAT + (ck - 256) * 64; }
template <bool FINAL>
__device__ __forceinline__ void phase_lru_par(const Frame& F, int L) {
    const bf16* P = (const bf16*)(F.ws + WS_P);
    const bf16* WgT = (const bf16*)(F.ws + WS_LGW);
    float* agg = (float*)(F.ws + WS_LAGG); const float* car = (const float*)(F.ws + WS_LCAR);
    bf16* Y = (bf16*)(F.ws + WS_Y3);
    const float* cw = F.a->in[I_LCW] + (size_t)L * 4 * 2048; const float* cb = F.a->in[I_LCB] + (size_t)L * 2048;
    LAS3 bf16* Xb = (LAS3 bf16*)F.lds;
    LAS3 float* Aa = (LAS3 float*)(F.lds + 17408);
    LAS3 float* Bx = Aa + 64 * 128;
    LAS3 float* Hf = Bx + 64 * 128;
    LAS3 bf16* RAW = (LAS3 bf16*)(F.lds + 115712);
    LAS3 bf16* GT = (LAS3 bf16*)(F.lds + 133936);
    LAS3 float* SGA = (LAS3 float*)(F.lds + 151344);
    LAS3 float* SGH = SGA + 512;
    v4u pw[3], pg[2];
#define LRU_FETCH(ck__) do { const int ck_ = (ck__), n_ = n, row0_ = chunk_row0(ck_); int pos_, len_; seq_pos(row0_, pos_, len_); \
        int tid_ = F.tid; asm volatile("" : "+v"(tid_)); \
        _Pragma("unroll") for (int i_ = 0; i_ < 3; ++i_) { const int idx_ = tid_ + 512 * i_, rr_ = idx_ >> 4, g_ = idx_ & 15; const int q_ = pos_ + rr_ - 2; \
            pw[i_] = (idx_ < 67 * 16 && q_ >= 0 && q_ < len_) ? *(const v4u*)(P + (size_t)(row0_ + rr_ - 2) * NP + PL + n_ * 128 + g_ * 8) : (v4u){0u, 0u, 0u, 0u}; } \
        if (FINAL) { _Pragma("unroll") for (int i_ = 0; i_ < 2; ++i_) { const int idx_ = tid_ + 512 * i_, rr_ = idx_ >> 4, g_ = idx_ & 15; \
            pg[i_] = *(const v4u*)(P + (size_t)(row0_ + rr_) * NP + PLG + n_ * 128 + g_ * 8); } } } while (0)
    const int n = F.bid & 15, ckstep = F.G >> 4;
    LAS3 float* CW = SGH + 512;
    for (int i = F.tid; i < 640; i += 512) CW[i] = i < 512 ? cw[(i >> 7) * 2048 + n * 128 + (i & 127)] : cb[n * 128 + (i & 127)];
    bf16x8 wf[2][2][4]; f32x4 gbv[2][2]; float sp8[2][4];
    { const int fr0 = F.lane & 15, fq0 = F.lane >> 4, j00 = F.wave * 16;
#pragma unroll
      for (int d = 0; d < 2; ++d) {
#pragma unroll
          for (int g = 0; g < 2; ++g) { const bf16* W = WgT + (size_t)(((d * 2 + g) * 16 + n) * 128) * 128;
#pragma unroll
              for (int ks = 0; ks < 4; ++ks) wf[d][g][ks] = ldfrag_g(W, 128, j00, ks * 32, fr0, fq0);
              gbv[d][g] = *(const f32x4*)(F.a->in[I_LGB] + (((size_t)L * 2 + d) * 2 + g) * 2048 + n * 128 + j00 + 4 * fq0); }
          const f32x4 lam = *(const f32x4*)(F.a->in[I_LLAM] + ((size_t)L * 2 + d) * 2048 + n * 128 + j00 + 4 * fq0);
#pragma unroll
          for (int i = 0; i < 4; ++i) sp8[d][i] = -8.0f * softplusf(-lam[i]); } }
    if ((F.bid >> 4) < 264) LRU_FETCH(F.bid >> 4);
    __syncthreads();
    for (int ck = F.bid >> 4; ck < 264; ck += ckstep) {
        int tid = F.tid; asm volatile("" : "+v"(tid));
        const int lane = tid & 63, wave = __builtin_amdgcn_readfirstlane(tid >> 6), fr = lane & 15, fq = lane >> 4;
        const int row0 = chunk_row0(ck);
#pragma unroll
        for (int i = 0; i < 3; ++i) { const int idx = tid + 512 * i, rr = idx >> 4, g = idx & 15; if (idx < 67 * 16) *(LAS3 v4u*)(RAW + rr * 136 + g * 8) = pw[i]; }
        if (FINAL) {
#pragma unroll
            for (int i = 0; i < 2; ++i) { const int idx = tid + 512 * i, rr = idx >> 4, g = idx & 15; *(LAS3 v4u*)(GT + rr * 136 + g * 8) = pg[i]; } }
        LBAR();
        if (ck + ckstep < 264) LRU_FETCH(ck + ckstep);
#pragma unroll 1
        for (int gI = tid; gI < 1024; gI += 512) { const int t = gI >> 4, c8 = (gI & 15) * 8, col = n * 128 + c8;
            float o[8];
            { const f32x4 b0 = *(const LAS3 f32x4*)(CW + 512 + c8), b1 = *(const LAS3 f32x4*)(CW + 512 + c8 + 4); o[0] = b0[0]; o[1] = b0[1]; o[2] = b0[2]; o[3] = b0[3]; o[4] = b1[0]; o[5] = b1[1]; o[6] = b1[2]; o[7] = b1[3]; }
#pragma unroll
            for (int tap = 0; tap < 4; ++tap) { const v4u x = *(const LAS3 v4u*)(RAW + (t + tap) * 136 + c8);
                const f32x4 w0 = *(const LAS3 f32x4*)(CW + tap * 128 + c8), w1 = *(const LAS3 f32x4*)(CW + tap * 128 + c8 + 4);
                o[0] += w0[0] * pg8::bf_lo(x.x); o[1] += w0[1] * pg8::bf_hi(x.x); o[2] += w0[2] * pg8::bf_lo(x.y); o[3] += w0[3] * pg8::bf_hi(x.y);
                o[4] += w1[0] * pg8::bf_lo(x.z); o[5] += w1[1] * pg8::bf_hi(x.z); o[6] += w1[2] * pg8::bf_lo(x.w); o[7] += w1[3] * pg8::bf_hi(x.w); }
            v4u w; w.x = pk2(o[0], o[1]); w.y = pk2(o[2], o[3]); w.z = pk2(o[4], o[5]); w.w = pk2(o[6], o[7]);
            *(LAS3 v4u*)(Xb + t * 136 + c8) = w; }
        LBAR();
#pragma unroll
        for (int d = 0; d < 2; ++d) {
            {
                const int j0 = wave * 16;
                f32x4 acc[2][4];
#pragma unroll
                for (int g = 0; g < 2; ++g)
#pragma unroll
                    for (int mt = 0; mt < 4; ++mt) acc[g][mt] = (f32x4){0.f, 0.f, 0.f, 0.f};
#pragma unroll
                for (int ks = 0; ks < 4; ++ks) {
#pragma unroll
                    for (int mt = 0; mt < 4; ++mt) { const bf16x8 a = ldfrag(Xb, 136, mt * 16, ks * 32, fr, fq); MMA_TRN(acc[0][mt], a, wf[d][0][ks]); MMA_TRN(acc[1][mt], a, wf[d][1][ks]); } }
                const f32x4 gb0 = gbv[d][0], gb1 = gbv[d][1];
#pragma unroll
                for (int mt = 0; mt < 4; ++mt) { const int t = mt * 16 + fr; f32x4 av, bv;
                    const v2u xr = *(const LAS3 v2u*)(Xb + t * 136 + j0 + 4 * fq);
                    const float xc[4] = {pg8::bf_lo(xr.x), pg8::bf_hi(xr.x), pg8::bf_lo(xr.y), pg8::bf_hi(xr.y)};
#pragma unroll
                    for (int i = 0; i < 4; ++i) { const float a = __expf(sigm(acc[0][mt][i] + gb0[i]) * sp8[d][i]); av[i] = a; bv[i] = __builtin_amdgcn_sqrtf(fmaxf(1.0f - a * a, 0.f)) * sigm(acc[1][mt][i] + gb1[i]) * xc[i]; }
                    *(LAS3 f32x4*)(Aa + t * 128 + j0 + 4 * fq) = av; *(LAS3 f32x4*)(Bx + t * 128 + j0 + 4 * fq) = bv; }
            }
            LBAR();
            {
                const int ch = tid & 127, sg = tid >> 7, col = n * 128 + ch;
                float h = 0.f, ap = 1.f;
#pragma unroll 4
                for (int s2 = 0; s2 < 16; ++s2) { const int s = sg * 16 + s2, t = d ? 63 - s : s; const float a = Aa[t * 128 + ch]; h = a * h + Bx[t * 128 + ch]; ap *= a; }
                SGA[sg * 128 + ch] = ap; SGH[sg * 128 + ch] = h;
                LBAR();
                if (!FINAL) {
                    if (sg == 0) { float hh = 0.f, aa = 1.f;
#pragma unroll
                        for (int q = 0; q < 4; ++q) { const float a = SGA[q * 128 + ch]; hh = a * hh + SGH[q * 128 + ch]; aa *= a; }
                        float2 o; o.x = aa; o.y = hh; *(float2*)(agg + (((size_t)d * 264 + ck) * 2048 + col) * 2) = o; } }
                else { float hh = car[((size_t)d * 264 + ck) * 2048 + col];
#pragma unroll
                    for (int q = 0; q < 3; ++q) if (q < sg) hh = SGA[q * 128 + ch] * hh + SGH[q * 128 + ch];
#pragma unroll 4
                    for (int s2 = 0; s2 < 16; ++s2) { const int s = sg * 16 + s2, t = d ? 63 - s : s; hh = Aa[t * 128 + ch] * hh + Bx[t * 128 + ch];
                        if (d == 0) Hf[t * 128 + ch] = hh;
                        else { const float gx = bf2f(GT[t * 136 + ch]); const float u = 0.7978845608028654f * (gx + 0.044715f * gx * gx * gx);
                            Y[(size_t)(row0 + t) * D + col] = f2bf((Hf[t * 128 + ch] + hh) * 0.5f * gx * (1.0f + tanh_fast(u))); } } }
            }
            LBAR();
        }
    }
#undef LRU_FETCH
}
__device__ __forceinline__ void phase_lru_carry(const Frame& F) {
    const float* agg = (const float*)(F.ws + WS_LAGG); float* car = (float*)(F.ws + WS_LCAR);
    const int gid = F.bid * 512 + F.tid;
    if (gid < 8192) { const int d = gid >> 12, b = (gid >> 11) & 1, col = gid & 2047; float h = 0.f;
#pragma unroll 1
        for (int i0 = 0; i0 < 132; i0 += 12) { float2 a[12]; size_t o[12];
#pragma unroll
            for (int j = 0; j < 12; ++j) { const int i = i0 + j; const int ck = i < 4 ? 256 + b * 4 + (d ? 3 - i : i) : b * 128 + (d ? 127 - (i - 4) : (i - 4));
                o[j] = ((size_t)d * 264 + ck) * 2048 + col; a[j] = *(const float2*)(agg + o[j] * 2); }
#pragma unroll
            for (int j = 0; j < 12; ++j) { car[o[j]] = h; h = a[j].x * h + a[j].y; } } }
}

__device__ __forceinline__ void phase_route(const Frame& F) {
    int* rt = (int*)(F.ws + WS_ROUTE); unsigned* ctl = (unsigned*)(F.ws + WS_CTL);
    const bf16* V = (const bf16*)(F.ws + WS_U); bf16* A = (bf16*)(F.ws + WS_MA);
    int base[9]; base[0] = 0;
#pragma unroll
    for (int e = 0; e < 8; ++e) { const int c = (int)__hip_atomic_load(&ctl[CW_CNT + e], __ATOMIC_RELAXED, __HIP_MEMORY_SCOPE_AGENT); base[e + 1] = base[e] + ((c + 255) & ~255); }
    if (F.bid == 0 && F.tid == 0) { rt[RT_NT] = base[8] >> 8; for (int e = 0; e < 8; ++e) { rt[RT_BASE + e] = base[e]; for (int t = base[e] >> 8; t < (base[e + 1] >> 8); ++t) rt[RT_TILEE + t] = e; } }
    for (int tok = F.bid * 8 + F.wave; tok < MLAT; tok += F.G * 8) {
        int r0 = 0, r1 = 0;
        if (F.lane == 0) { const int e0 = rt[RT_TOKE + tok * 2], e1 = rt[RT_TOKE + tok * 2 + 1];
            int b0 = 0, b1 = 0;
#pragma unroll
            for (int e = 0; e < 8; ++e) { if (e == e0) b0 = base[e]; if (e == e1) b1 = base[e]; }
            r0 = b0 + (int)atomicAdd(&ctl[CW_CUR + e0], 1u); r1 = b1 + (int)atomicAdd(&ctl[CW_CUR + e1], 1u);
            rt[RT_TOKROW + tok * 2] = r0; rt[RT_TOKROW + tok * 2 + 1] = r1; }
        r0 = __shfl(r0, 0); r1 = __shfl(r1, 0);
#pragma unroll
        for (int i = 0; i < 4; ++i) { const v4u v = *(const v4u*)(V + (size_t)tok * D + i * 512 + F.lane * 8);
            *(v4u*)(A + (size_t)r0 * D + i * 512 + F.lane * 8) = v; *(v4u*)(A + (size_t)r1 * D + i * 512 + F.lane * 8) = v; }
    }
    for (int e = 0; e < 8; ++e) { const int c = (int)__hip_atomic_load(&ctl[CW_CNT + e], __ATOMIC_RELAXED, __HIP_MEMORY_SCOPE_AGENT); const int lo = base[e] + c, hi = base[e + 1];
        for (int row = lo + F.bid * 8 + F.wave; row < hi; row += F.G * 8)
#pragma unroll
            for (int i = 0; i < 4; ++i) *(v4u*)(A + (size_t)row * D + i * 512 + F.lane * 8) = (v4u){0u, 0u, 0u, 0u}; }
}
__device__ __forceinline__ void phase_final(const Frame& F, const float* modL) {
    const int* rt = (const int*)(F.ws + WS_ROUTE);
    const float* hlat = (const float*)(F.ws + WS_HLAT); const bf16* O = (const bf16*)(F.ws + WS_X1);
    const float* nf = F.a->in[I_NFIN]; float* out = F.a->out;
    for (int tok = F.bid * 8 + F.wave; tok < MLAT; tok += F.G * 8) {
        const int b = tok >> 13; const float* gf = modL + b * 12288 + 5 * 2048;
        const int r0 = rt[RT_TOKROW + tok * 2], r1 = rt[RT_TOKROW + tok * 2 + 1]; const float p0 = ((const float*)rt)[RT_TOKP + tok * 2], p1 = ((const float*)rt)[RT_TOKP + tok * 2 + 1];
        f32x4 x[8]; float ss = 0.f;
#pragma unroll
        for (int i = 0; i < 8; ++i) { const int c = i * 256 + F.lane * 4;
            const f32x4 h = *(const f32x4*)(hlat + (size_t)tok * D + c), g = *(const f32x4*)(gf + c);
            const uint2 a = *(const uint2*)(O + (size_t)r0 * D + c), bb = *(const uint2*)(O + (size_t)r1 * D + c);
            f32x4 m; m[0] = p0 * pg8::bf_lo(a.x) + p1 * pg8::bf_lo(bb.x); m[1] = p0 * pg8::bf_hi(a.x) + p1 * pg8::bf_hi(bb.x); m[2] = p0 * pg8::bf_lo(a.y) + p1 * pg8::bf_lo(bb.y); m[3] = p0 * pg8::bf_hi(a.y) + p1 * pg8::bf_hi(bb.y);
            x[i] = h + g * m; ss += x[i][0] * x[i][0] + x[i][1] * x[i][1] + x[i][2] * x[i][2] + x[i][3] * x[i][3]; }
        ss = wave_sum(ss);
        const float rs = rsqrtf(ss * (1.0f / D) + EPS);
#pragma unroll
        for (int i = 0; i < 8; ++i) { const int c = i * 256 + F.lane * 4; const f32x4 g = *(const f32x4*)(nf + c); *(f32x4*)(out + (size_t)tok * D + c) = x[i] * rs * g; }
    }
}

constexpr int NPH_LAYER = 17, NPH = 1 + 2 * NPH_LAYER;
#if !MK_PER_PHASE
#define SEAM() xcd_barrier(bar)
#else
#define SEAM() do {} while (0)
#endif
#define IN(k) (lo <= (PB + (k)) && (PB + (k)) < hi)
template <int L>
__device__ __forceinline__ void layer_program(const Frame& F, const Args& args, const XcdBarrier& bar, const int lo, const int hi) {
    constexpr int PB = 1 + L * NPH_LAYER;
    const float* modL = (const float*)(F.ws + WS_MOD) + (size_t)L * 3 * 12288;
    if (IN(0)) { unsigned char* wsl = F.ws; asm volatile("" : "+s"(wsl)); if (L == 0) { phase_mod(F); __syncthreads(); phase_convw_layer(F, L, F.G, F.bid); phase_lora_prep(F, L, F.G, F.bid); } SEAM(); }
    if (IN(1)) { unsigned char* wsl = F.ws; asm volatile("" : "+s"(wsl)); phase_norm<false>(F, L == 0 ? args.in[I_X] : (const float*)(wsl + WS_HLAT), L == 0 ? args.in[I_CTX] : (const float*)(wsl + WS_HCTX), args.in[I_NMIX] + L * 2048, modL, 0, 2048, (bf16*)(wsl + WS_U), L & 1, MROWS); SEAM(); }
    if (IN(2)) { unsigned char* wsl = F.ws; asm volatile("" : "+s"(wsl)); pg8::Gemm g{(const bf16*)(wsl + WS_U), (const bf16*)(wsl + WS_X1), MROWS, NP, 2048}; pg8::StaticOrder S; S.init(MROWS, NP, F.G, F.bid); pg8::EpiStoreBf16 E{(bf16*)(wsl + WS_P), NP, 0};
        pg8::gemm_phase<pg8::EpiStoreBf16, pg8::StaticOrder, false>(F.lds, g, S, E, nullptr); SEAM(); }
    if (IN(3)) { unsigned char* wsl = F.ws; asm volatile("" : "+s"(wsl)); phase_lora_in(F, L); SEAM();
#pragma unroll 1
        for (int gq = 0; gq < 4; ++gq) { phase_rwkv_r1(F, L, gq); SEAM(); phase_rwkv_r2(F, gq); SEAM(); } }
    if (IN(4)) { unsigned char* wsl = F.ws; asm volatile("" : "+s"(wsl)); phase_rwkv_pre(F, L); SEAM();
        pg8::Gemm g{(const bf16*)(wsl + WS_SG), (const bf16*)(wsl + WS_GUP), MROWS, 2048, 256}; pg8::StaticOrder S; S.init(MROWS, 2048, F.G, F.bid);
        pg8::EpiGateMul E{(const bf16*)(wsl + WS_X1), (bf16*)(wsl + WS_Y3) + (size_t)MROWS * D};
        pg8::gemm_phase<pg8::EpiGateMul, pg8::StaticOrder, false>(F.lds, g, S, E, nullptr); SEAM(); }
    if (IN(5)) { unsigned char* wsl = F.ws; asm volatile("" : "+s"(wsl)); phase_ssm_conv(F, L); __syncthreads(); phase_lru_par<false>(F, L); SEAM(); }
    if (IN(6)) { unsigned char* wsl = F.ws; asm volatile("" : "+s"(wsl)); phase_lru_carry(F); phase_ssm_chain(F, L); SEAM(); }
    if (IN(7)) { unsigned char* wsl = F.ws; asm volatile("" : "+s"(wsl)); phase_ssm_out(F, L); __syncthreads(); phase_lru_par<true>(F, L); SEAM(); }
    constexpr int nM = L == 1 ? 64 : 66;
    if (IN(9)) { unsigned char* wsl = F.ws; asm volatile("" : "+s"(wsl)); pg8::Gemm g{(const bf16*)(wsl + WS_Y3), (const bf16*)(wsl + WS_WOUT), MROWS, 2048, 2048}; pg8::MergeOrder S{nM * 8, F.G, F.bid}; pg8::EpiMerge E{(const bf16*)(wsl + WS_P), NP, (bf16*)(wsl + WS_X1)};
        pg8::gemm_phase<pg8::EpiMerge, pg8::MergeOrder, false>(F.lds, g, S, E, nullptr); SEAM(); }
    if (IN(10)) { unsigned char* wsl = F.ws; asm volatile("" : "+s"(wsl)); pg8::Gemm g{(const bf16*)(wsl + WS_X1), (const bf16*)(wsl + WS_WOUT) + (size_t)3 * 2048 * 2048, nM * 256, 2048, 2048}; pg8::StaticOrder S; S.init(nM * 256, 2048, F.G, F.bid);
        pg8::EpiResid E{L == 0 ? args.in[I_X] : (const float*)(wsl + WS_HLAT), L == 0 ? args.in[I_CTX] : (const float*)(wsl + WS_HCTX), (float*)(wsl + WS_HLAT), (float*)(wsl + WS_HCTX), modL + 2 * 2048, L & 1};
        pg8::gemm_phase<pg8::EpiResid, pg8::StaticOrder, false>(F.lds, g, S, E, nullptr);
        if (L == 0) { __syncthreads(); if (F.G > 32) { if (F.bid >= 16) phase_convw_ffn(F, L, F.G - 16, F.bid - 16); } else phase_convw_ffn(F, L, F.G, F.bid); }
        SEAM(); }
    if (IN(11)) { unsigned char* wsl = F.ws; asm volatile("" : "+s"(wsl)); phase_norm<L == 1>(F, (const float*)(wsl + WS_HLAT), (const float*)(wsl + WS_HCTX), args.in[I_NFFN] + L * 2048, modL, 3 * 2048, 4 * 2048, (bf16*)(wsl + WS_U), 0, L == 0 ? MROWS : MLAT); SEAM(); }
    if (IN(12)) { unsigned char* wsl = F.ws; asm volatile("" : "+s"(wsl)); if (L == 1) { phase_convw_ffn(F, L, F.G, F.bid); SEAM(); } }
    if constexpr (L == 0) {
        if (IN(13)) { unsigned char* wsl = F.ws; asm volatile("" : "+s"(wsl)); pg8::Gemm g{(const bf16*)(wsl + WS_U), (const bf16*)(wsl + WS_F13), MROWS, 12288, 2048}; pg8::StaticOrder S; S.init(MROWS, 12288, F.G, F.bid); pg8::EpiSwiGLU E{(bf16*)(wsl + WS_FH), 6144, 0};
            pg8::gemm_phase<pg8::EpiSwiGLU, pg8::StaticOrder, false>(F.lds, g, S, E, nullptr); SEAM(); }
        if (IN(14)) { unsigned char* wsl = F.ws; asm volatile("" : "+s"(wsl)); pg8::Gemm g{(const bf16*)(wsl + WS_FH), (const bf16*)(wsl + WS_F2), MROWS, 2048, 6144}; pg8::StaticOrder S; S.init(MROWS, 2048, F.G, F.bid);
            pg8::EpiResid E{(const float*)(wsl + WS_HLAT), (const float*)(wsl + WS_HCTX), (float*)(wsl + WS_HLAT), (float*)(wsl + WS_HCTX), modL + 5 * 2048, 0};
            pg8::gemm_phase<pg8::EpiResid, pg8::StaticOrder, false>(F.lds, g, S, E, nullptr);
            __syncthreads(); if (F.G > 32) { if (F.bid >= 16) { phase_convw_layer(F, 1, F.G - 16, F.bid - 16); phase_lora_prep(F, 1, F.G - 16, F.bid - 16); } } else { phase_convw_layer(F, 1, F.G, F.bid); phase_lora_prep(F, 1, F.G, F.bid); }
            SEAM(); }
    } else {
        const int* rt = (const int*)(F.ws + WS_ROUTE);
        if (IN(13)) { unsigned char* wsl = F.ws; asm volatile("" : "+s"(wsl)); phase_route(F); SEAM(); }
        if (IN(14)) { unsigned char* wsl = F.ws; asm volatile("" : "+s"(wsl)); pg8::Gemm g{(const bf16*)(wsl + WS_MA), (const bf16*)(wsl + WS_M13), MOE_ROWS, 8 * 6144, 2048}; pg8::MoeOrder S{rt + RT_TILEE, rt + RT_NT, 24, F.G, F.bid};
            pg8::EpiSwiGLU E{(bf16*)(wsl + WS_MH), 3072, 24};
            pg8::gemm_phase<pg8::EpiSwiGLU, pg8::MoeOrder, false>(F.lds, g, S, E, nullptr); SEAM(); }
        if (IN(15)) { unsigned char* wsl = F.ws; asm volatile("" : "+s"(wsl)); pg8::Gemm g{(const bf16*)(wsl + WS_MH), (const bf16*)(wsl + WS_M2), MOE_ROWS, 8 * 2048, 3072}; pg8::MoeOrder S{rt + RT_TILEE, rt + RT_NT, 8, F.G, F.bid};
            pg8::EpiStoreBf16 E{(bf16*)(wsl + WS_X1), 2048, 8};
            pg8::gemm_phase<pg8::EpiStoreBf16, pg8::MoeOrder, false>(F.lds, g, S, E, nullptr); SEAM(); }
        if (IN(16)) { unsigned char* wsl = F.ws; asm volatile("" : "+s"(wsl)); phase_final(F, modL); }
    }
}
#undef IN
__global__ void __launch_bounds__(512, 2) fwd(Args args) {
    extern __shared__ __attribute__((aligned(16))) unsigned char lds_raw[];
    Frame F; F.a = &args; F.ws = args.ws; F.lds = (LAS3 unsigned char*)lds_raw;
    F.tid = threadIdx.x; F.lane = F.tid & 63; F.wave = __builtin_amdgcn_readfirstlane(F.tid >> 6); F.G = gridDim.x; F.bid = blockIdx.x;
    volatile LAS3 unsigned* MISC = (volatile LAS3 unsigned*)(F.lds + MISC_OFF);
    if (F.tid < 32) MISC[F.tid] = 0u;
    __syncthreads();
    unsigned* ctl = (unsigned*)(F.ws + WS_CTL);
#if !MK_PER_PHASE
    XcdBarrier bar = xcd_barrier_post(ctl + CW_BAR, MISC + 8);
#else
    XcdBarrier bar; bar.bar = ctl + CW_BAR; bar.x = 0; bar.st = MISC + 8;
#endif
    const int lo = args.lo, hi = args.hi;
    layer_program<0>(F, args, bar, lo, hi);
    layer_program<1>(F, args, bar, lo, hi);
}

extern "C" void kernel_launch(void* const* d_in, const int* in_sizes, int n_in, void* d_out, int out_size, void* d_ws, size_t ws_size, hipStream_t stream) {
    static int grid = 0;
    if (grid == 0) {
        if (n_in != N_INPUTS || out_size != MLAT * D || ws_size < WS_END) { fprintf(stderr, "kernel_launch: unexpected shapes (n_in %d, out %d, ws %zu); nothing launched\n", n_in, out_size, ws_size); grid = -1; return; }
        int dev = 0, cus = 0;
        if (hipGetDevice(&dev) != hipSuccess || hipDeviceGetAttribute(&cus, hipDeviceAttributeMultiprocessorCount, dev) != hipSuccess) { grid = -1; return; }
        if (hipFuncSetAttribute((const void*)fwd, hipFuncAttributeMaxDynamicSharedMemorySize, LDS_BYTES) != hipSuccess) { fprintf(stderr, "kernel_launch: hipFuncSetAttribute failed\n"); grid = -1; return; }
        int per_cu = 0;
        if (hipOccupancyMaxActiveBlocksPerMultiprocessor(&per_cu, (const void*)fwd, 512, LDS_BYTES) != hipSuccess || per_cu < 1) { fprintf(stderr, "kernel_launch: occupancy query says %d\n", per_cu); }
        (void)hipGetLastError();
        grid = cus;
    }
    if (grid < 0) return;
    (void)hipMemsetAsync((char*)d_ws + WS_CTL, 0, CTL_BYTES, stream);
    Args a{};
    for (int i = 0; i < N_INPUTS; ++i) a.in[i] = (const float*)d_in[i];
    a.out = (float*)d_out; a.ws = (unsigned char*)d_ws;
#if MK_PER_PHASE
    for (int p = 0; p < NPH; ++p) { a.lo = p; a.hi = p + 1; hipLaunchKernelGGL(fwd, dim3(grid), dim3(512), LDS_BYTES, stream, a); }
#else
    a.lo = 0; a.hi = NPH; hipLaunchKernelGGL(fwd, dim3(grid), dim3(512), LDS_BYTES, stream, a);
#endif
}
```

```cpp
#include <hip/hip_runtime.h>
#include <cstdio>
#include <cstdint>

#ifndef MK_PER_PHASE
#define MK_PER_PHASE 0
#endif

namespace pg8 {
#define PG8_LAS __attribute__((address_space(3)))
typedef unsigned short bf16_t;
typedef short bf16x8 __attribute__((ext_vector_type(8)));
typedef float f32x4 __attribute__((ext_vector_type(4)));
typedef unsigned u32x4 __attribute__((ext_vector_type(4)));
constexpr int BM = 256, BK = 64, HALF = 128, HTB = HALF * BK * 2  , STAGE_BYTES = 8 * HTB, NXCD = 8, WGM = 8;

__host__ __device__ __forceinline__ int lds_byte(int r, int c) { const int st = (r >> 4) * 2 + (c >> 5), rr = r & 15, cc = c & 31, ob = rr * 64 + cc * 2; return st * 1024 + (ob ^ (((ob >> 9) & 1) << 5)); }
__host__ __device__ __forceinline__ void stage_rc(int b, int& R, int& C) { const int st = b / 1024, sb = b % 1024, swz = sb ^ (((sb >> 9) & 1) << 5); R = (st >> 1) * 16 + swz / 64; C = (st & 1) * 32 + (swz % 64) / 2; }
__host__ __device__ __forceinline__ int perm32(int rho) { const int n = rho >> 4, i = rho & 15; return 8 * (i >> 2) + 4 * n + (i & 3); }

struct Unit { int pm, pn; };
struct Gemm { const bf16_t* A; const bf16_t* Bt; int M, N, K; };

struct StaticOrder {
    int nM, nN, nwg, G, c;
    __host__ __device__ void init(int M, int N, int G_, int c_) { nM = M / BM; nN = N / BM; nwg = nM * nN; G = G_; c = c_; }
    __host__ __device__ bool next(int i, Unit& u) const {
        const long L = (long)i * G + c; if (L >= nwg) return false;
        int wgid = (int)L; { const int q = nwg / NXCD, r = nwg % NXCD, xcd = wgid % NXCD, off = wgid / NXCD; wgid = (xcd < r ? xcd * (q + 1) : r * (q + 1) + (xcd - r) * q) + off; }
        const int nig = WGM * nN, gid = wgid / nig, fm = gid * WGM, gsz = (nM - fm) < WGM ? (nM - fm) : WGM;
        u.pm = fm + ((wgid % nig) % gsz); u.pn = (wgid % nig) / gsz; return true;
    }
    __device__ __forceinline__ void a_ready(const Unit&) const {}
    __device__ __forceinline__ void done(const Unit&) const {}
};
typedef __bf16 hbf16x2_ __attribute__((ext_vector_type(2)));
typedef float hf32x2_ __attribute__((ext_vector_type(2)));
__device__ __forceinline__ unsigned cvt_pk_bf16(float lo, float hi) { const hf32x2_ v = {lo, hi}; const hbf16x2_ b = __builtin_convertvector(v, hbf16x2_); return __builtin_bit_cast(unsigned, b); }
typedef float f32x2 __attribute__((ext_vector_type(2)));
__device__ __forceinline__ f32x2 gelu_pk(f32x2 v) {
    const f32x2 av = __builtin_elementwise_abs(v), d = av * 0.2316418882f + 1.0f;
    f32x2 t; t.x = __builtin_amdgcn_rcpf(d.x); t.y = __builtin_amdgcn_rcpf(d.y);
    f32x2 q = t * 0.5307027145f + (-0.7265760135f); q = q * t + 0.7107068705f; q = q * t + (-0.142248368f); q = q * t + 0.127414796f; q = q * t;
    const f32x2 s = (v * v) * (-0.72134752044f);
    f32x2 e; e.x = __builtin_amdgcn_exp2f(s.x); e.y = __builtin_amdgcn_exp2f(s.y);
    const f32x2 m = v * (q * e), r = v - m;
    f32x2 o; o.x = v.x < 0.f ? m.x : r.x; o.y = v.y < 0.f ? m.y : r.y; return o;
}
template <class Epi, class Sched, bool ALIGN_EPI = false, bool SP2 = false>
__device__ __forceinline__ void gemm_phase(PG8_LAS unsigned char* lds, const Gemm g, const Sched& S, const Epi& E) {
    const int tid = threadIdx.x, wid = __builtin_amdgcn_readfirstlane(tid >> 6), lane = tid & 63, wr = wid >> 2, wc = wid & 3, fr = lane & 15, fq = lane >> 4;
    const int K = g.K, nt = K / BK;
    unsigned voffA[2], voffB[2];
#pragma unroll
    for (int i = 0; i < 2; ++i) { int R, C; stage_rc(tid * 16 + i * 8192, R, C); const int Rb = Epi::PERM ? ((R & ~31) + perm32(R & 31)) : R;
        voffA[i] = (unsigned)(R * K + C) * 2u; voffB[i] = (unsigned)(Rb * K + C) * 2u; }
    const size_t kstep = (size_t)(BK * 2);
    const size_t hstep = (size_t)HALF * K * 2;
    const size_t tstep = 2 * hstep;
    const unsigned ldsw = (unsigned)wid * 1024u;
    const int aoff = lds_byte(wr * 64 + fr, fq * 8), boff = lds_byte(wc * 32 + fr, fq * 8);
#define PG8_SA(b, h) (((b) * 2 + (h)) * HTB)
#define PG8_SB(b, h) ((4 + (b) * 2 + (h)) * HTB)
#define PG8_STAGE(bufoff, gbase, voff) do { _Pragma("unroll") for (int _i = 0; _i < 2; ++_i) \
        __builtin_amdgcn_global_load_lds((const unsigned*)((const char*)(gbase) + (voff)[_i]), (PG8_LAS unsigned*)(lds + (bufoff) + ldsw + _i * 8192), 16, 0, 0); } while (0)
#define PG8_LDA(dst, b, h) do { _Pragma("unroll") for (int m = 0; m < 4; ++m) _Pragma("unroll") for (int k = 0; k < 2; ++k) dst[m][k] = *(const PG8_LAS bf16x8*)(lds + PG8_SA(b, h) + aoff + m * 2048 + k * 1024); } while (0)
#define PG8_LDB(dst, b, h) do { _Pragma("unroll") for (int n = 0; n < 2; ++n) _Pragma("unroll") for (int k = 0; k < 2; ++k) dst[n][k] = *(const PG8_LAS bf16x8*)(lds + PG8_SB(b, h) + boff + n * 2048 + k * 1024); } while (0)
#define PG8_MMA(ai, bj, At, Bt) do { __builtin_amdgcn_s_setprio(1); _Pragma("unroll") for (int m = 0; m < 4; ++m) _Pragma("unroll") for (int n = 0; n < 2; ++n) _Pragma("unroll") for (int k = 0; k < 2; ++k) \
        acc[ai][bj][m][n] = __builtin_amdgcn_mfma_f32_16x16x32_bf16(Bt[n][k], At[m][k], acc[ai][bj][m][n], 0, 0, 0); __builtin_amdgcn_s_setprio(0); } while (0)
#define PG8_WAIT_V(n) asm volatile("s_waitcnt vmcnt(" #n ")" ::: "memory")
#define PG8_WAIT_L(n) asm volatile("s_waitcnt lgkmcnt(" #n ")" ::: "memory")
#define PG8_BAR __builtin_amdgcn_s_barrier()
#define PG8_SCHED __builtin_amdgcn_sched_barrier(0)
    Unit cur, nxt; int ui = 0;
    if (!S.next(0, cur)) return;
    f32x4 acc[2][2][4][2];
#pragma unroll
    for (int a = 0; a < 2; ++a)
#pragma unroll
        for (int b = 0; b < 2; ++b)
#pragma unroll
            for (int m = 0; m < 4; ++m)
#pragma unroll
                for (int n = 0; n < 2; ++n) acc[a][b][m][n] = (f32x4){0.f, 0.f, 0.f, 0.f};
    bf16x8 At[4][2], B0[2][2], B1[2][2];
    const char* cA = (const char*)g.A + (size_t)cur.pm * tstep; const char* cB = (const char*)g.Bt + (size_t)cur.pn * tstep;
    S.a_ready(cur);
    if constexpr (SP2) {
        PG8_STAGE(PG8_SB(0, 0), cB, voffB); PG8_STAGE(PG8_SB(0, 1), cB + hstep, voffB); PG8_STAGE(PG8_SA(0, 0), cA, voffA); PG8_STAGE(PG8_SA(0, 1), cA + hstep, voffA);
        if (wr == 1) PG8_BAR;
        PG8_WAIT_V(2); PG8_BAR;
        PG8_STAGE(PG8_SB(1, 0), cB + kstep, voffB); PG8_STAGE(PG8_SA(1, 0), cA + kstep, voffA); PG8_STAGE(PG8_SB(1, 1), cB + hstep + kstep, voffB);
        PG8_WAIT_V(6); PG8_BAR;
    } else {
        PG8_STAGE(PG8_SB(0, 0), cB, voffB); PG8_STAGE(PG8_SA(0, 0), cA, voffA); PG8_STAGE(PG8_SB(0, 1), cB + hstep, voffB); PG8_STAGE(PG8_SA(0, 1), cA + hstep, voffA);
        if (wr == 1) PG8_BAR;
        PG8_WAIT_V(4); PG8_BAR;
        PG8_STAGE(PG8_SB(1, 0), cB + kstep, voffB); PG8_STAGE(PG8_SA(1, 0), cA + kstep, voffA); PG8_STAGE(PG8_SB(1, 1), cB + hstep + kstep, voffB);
        PG8_WAIT_V(6); PG8_BAR;
    }
    for (;;) {
        const bool has_next = S.next(ui + 1, nxt);
        const char* nA = has_next ? (const char*)g.A + (size_t)nxt.pm * tstep : cA; const char* nB = has_next ? (const char*)g.Bt + (size_t)nxt.pn * tstep : cB;
        for (int t = 0; t < nt; t += 2) {
            const bool last = (t == nt - 2);
            const char* a1 = cA + (size_t)(t + 1) * kstep;
            const char* a2 = last ? nA : cA + (size_t)(t + 2) * kstep; const char* b2 = last ? nB : cB + (size_t)(t + 2) * kstep;
            const char* a3 = a2 + kstep; const char* b3 = b2 + kstep;
            if (last && has_next) S.a_ready(nxt);
            if constexpr (SP2) {
            PG8_LDB(B0, 0, 0); PG8_LDB(B1, 0, 1); PG8_SCHED; PG8_LDA(At, 0, 0); PG8_STAGE(PG8_SA(1, 1), a1 + hstep, voffA);
            PG8_WAIT_V(8); PG8_WAIT_L(0); PG8_BAR; PG8_MMA(0, 0, At, B0); PG8_MMA(0, 1, At, B1); PG8_BAR; PG8_SCHED;
            PG8_LDA(At, 0, 1); PG8_STAGE(PG8_SB(0, 0), b2, voffB); PG8_STAGE(PG8_SB(0, 1), b2 + hstep, voffB); PG8_STAGE(PG8_SA(0, 0), a2, voffA);
            PG8_WAIT_V(8); PG8_WAIT_L(0); PG8_BAR; PG8_MMA(1, 0, At, B0); PG8_MMA(1, 1, At, B1); PG8_BAR; PG8_SCHED;
            PG8_LDB(B0, 1, 0); PG8_LDB(B1, 1, 1); PG8_SCHED; PG8_LDA(At, 1, 0); PG8_STAGE(PG8_SA(0, 1), a2 + hstep, voffA);
            PG8_WAIT_V(8); PG8_WAIT_L(0); PG8_BAR; PG8_MMA(0, 0, At, B0); PG8_MMA(0, 1, At, B1); PG8_BAR; PG8_SCHED;
            PG8_LDA(At, 1, 1); PG8_STAGE(PG8_SB(1, 0), b3, voffB); PG8_STAGE(PG8_SB(1, 1), b3 + hstep, voffB); PG8_STAGE(PG8_SA(1, 0), a3, voffA);
            PG8_WAIT_V(8); PG8_WAIT_L(0); PG8_BAR; PG8_MMA(1, 0, At, B0); PG8_MMA(1, 1, At, B1); PG8_BAR; PG8_SCHED;
            } else {
            PG8_LDB(B0, 0, 0); PG8_SCHED; PG8_LDA(At, 0, 0); PG8_STAGE(PG8_SA(1, 1), a1 + hstep, voffA);
            PG8_WAIT_L(8); PG8_BAR; PG8_WAIT_L(0); PG8_MMA(0, 0, At, B0); PG8_BAR; PG8_SCHED;
            PG8_LDB(B1, 0, 1); PG8_STAGE(PG8_SB(0, 0), b2, voffB);
            PG8_BAR; PG8_WAIT_L(0); PG8_MMA(0, 1, At, B1); PG8_BAR;
            PG8_LDA(At, 0, 1); PG8_STAGE(PG8_SA(0, 0), a2, voffA);
            PG8_BAR; PG8_WAIT_L(0); PG8_MMA(1, 0, At, B0); PG8_BAR; PG8_SCHED;
            PG8_STAGE(PG8_SB(0, 1), b2 + hstep, voffB);
            PG8_WAIT_V(6); PG8_BAR; PG8_MMA(1, 1, At, B1); PG8_BAR;
            PG8_LDB(B0, 1, 0); PG8_SCHED; PG8_LDA(At, 1, 0); PG8_STAGE(PG8_SA(0, 1), a2 + hstep, voffA);
            PG8_WAIT_L(8); PG8_BAR; PG8_WAIT_L(0); PG8_MMA(0, 0, At, B0); PG8_BAR; PG8_SCHED;
            PG8_LDB(B1, 1, 1); PG8_STAGE(PG8_SB(1, 0), b3, voffB);
            PG8_BAR; PG8_WAIT_L(0); PG8_MMA(0, 1, At, B1); PG8_BAR;
            PG8_LDA(At, 1, 1); PG8_STAGE(PG8_SA(1, 0), a3, voffA);
            PG8_BAR; PG8_WAIT_L(0); PG8_MMA(1, 0, At, B0); PG8_BAR; PG8_SCHED;
            PG8_STAGE(PG8_SB(1, 1), b3 + hstep, voffB);
            PG8_WAIT_V(6); PG8_BAR; PG8_MMA(1, 1, At, B1); PG8_BAR;
            }
        }
        if constexpr (ALIGN_EPI) { if (wr == 0) PG8_BAR; }
        if constexpr (!Epi::AFTER_DRAIN) { E(acc, cur, wr, wc, fr, fq); S.done(cur); }
        if (!has_next) break;
#pragma unroll
        for (int a = 0; a < 2; ++a)
#pragma unroll
            for (int b = 0; b < 2; ++b)
#pragma unroll
                for (int m = 0; m < 4; ++m)
#pragma unroll
                    for (int n = 0; n < 2; ++n) acc[a][b][m][n] = (f32x4){0.f, 0.f, 0.f, 0.f};
        cur = nxt; cA = nA; cB = nB; ++ui;
        if constexpr (ALIGN_EPI) { if (wr == 1) PG8_BAR; }
    }
    PG8_WAIT_V(0);
    if constexpr (!ALIGN_EPI) { if (wr == 0) PG8_BAR; }
    PG8_BAR;
    if constexpr (Epi::AFTER_DRAIN) { E.fused(acc, cur, wr, wc, fr, fq, lds, wid, lane); S.done(cur); }
#undef PG8_SA
#undef PG8_SB
#undef PG8_STAGE
#undef PG8_LDA
#undef PG8_LDB
#undef PG8_MMA
#undef PG8_WAIT_V
#undef PG8_WAIT_L
#undef PG8_BAR
#undef PG8_SCHED
}

template <class Epi, class Sched, bool STAMP>
__device__ __forceinline__ void gemm_phase(PG8_LAS unsigned char* lds, const Gemm g, const Sched& S, const Epi& E, unsigned long long*) { gemm_phase<Epi, Sched, true, true>(lds, g, S, E); }
__device__ __forceinline__ float bf_lo(unsigned w) { return __uint_as_float(w << 16); }
__device__ __forceinline__ float bf_hi(unsigned w) { return __uint_as_float(w & 0xffff0000u); }
__device__ __forceinline__ float sigmoidf_(float x) { return __builtin_amdgcn_rcpf(1.0f + __expf(-x)); }
__device__ __forceinline__ void sigmoid2_(float x0, float x1, float& s0, float& s1) { const float d0 = 1.0f + __expf(-fmaxf(x0, -40.f)), d1 = 1.0f + __expf(-fmaxf(x1, -40.f)), r = __builtin_amdgcn_rcpf(d0 * d1); s0 = d1 * r; s1 = d0 * r; }

struct EpiStoreBf16 {
    static constexpr bool PERM = true, AFTER_DRAIN = false;
    bf16_t* O; int ldc; int npn;
    __device__ __forceinline__ void operator()(const f32x4 (&acc)[2][2][4][2], const Unit& u, int wr, int wc, int fr, int fq) const {
        const int pn = npn ? (u.pn % npn) : u.pn;
        const int row0 = u.pm * BM + wr * 64 + fr, col0 = pn * BM + wc * 32 + 8 * fq;
#pragma unroll
        for (int ai = 0; ai < 2; ++ai)
#pragma unroll
            for (int m = 0; m < 4; ++m) { bf16_t* rowp = O + (size_t)(row0 + ai * HALF + m * 16) * ldc + col0;
#pragma unroll
                for (int bj = 0; bj < 2; ++bj) { const f32x4 v0 = acc[ai][bj][m][0], v1 = acc[ai][bj][m][1];
                    u32x4 w; w.x = cvt_pk_bf16(v0[0], v0[1]); w.y = cvt_pk_bf16(v0[2], v0[3]); w.z = cvt_pk_bf16(v1[0], v1[1]); w.w = cvt_pk_bf16(v1[2], v1[3]);
                    *(u32x4*)(rowp + bj * HALF) = w; } }
    }
};
struct EpiSwiGLU {
    static constexpr bool PERM = true, AFTER_DRAIN = false;
    bf16_t* H; int ldh; int npn;
    __device__ __forceinline__ void operator()(const f32x4 (&acc)[2][2][4][2], const Unit& u, int wr, int wc, int fr, int fq) const {
        const int pn = npn ? (u.pn % npn) : u.pn;
        const int row0 = u.pm * BM + wr * 64 + fr, col0 = pn * HALF + wc * 32 + 8 * fq;
#pragma unroll
        for (int ai = 0; ai < 2; ++ai)
#pragma unroll
            for (int m = 0; m < 4; ++m) { bf16_t* rowp = H + (size_t)(row0 + ai * HALF + m * 16) * ldh + col0;
                float o[8];
#pragma unroll
                for (int n = 0; n < 2; ++n)
#pragma unroll
                    for (int j = 0; j < 4; j += 2) { const float a0 = acc[ai][0][m][n][j], a1 = acc[ai][0][m][n][j + 1]; float s0, s1; sigmoid2_(a0, a1, s0, s1);
                        o[n * 4 + j] = a0 * s0 * acc[ai][1][m][n][j]; o[n * 4 + j + 1] = a1 * s1 * acc[ai][1][m][n][j + 1]; }
                u32x4 w; w.x = cvt_pk_bf16(o[0], o[1]); w.y = cvt_pk_bf16(o[2], o[3]); w.z = cvt_pk_bf16(o[4], o[5]); w.w = cvt_pk_bf16(o[6], o[7]);
                *(u32x4*)rowp = w; }
    }
};
struct EpiMerge {
    static constexpr bool PERM = true, AFTER_DRAIN = false;
    const bf16_t* P; int ldp; bf16_t* Mb;
    __device__ __forceinline__ void operator()(const f32x4 (&acc)[2][2][4][2], const Unit& u, int wr, int wc, int fr, int fq) const {
        const int br = u.pn >> 3, pn = u.pn & 7, pm = u.pm - br * 66;
        const int row0 = pm * BM + wr * 64 + fr, col0 = pn * BM + wc * 32 + 8 * fq;
#pragma unroll
        for (int ai = 0; ai < 2; ++ai)
#pragma unroll
            for (int m = 0; m < 4; ++m) { const size_t row = (size_t)(row0 + ai * HALF + m * 16);
#pragma unroll
                for (int bj = 0; bj < 2; ++bj) { const int col = col0 + bj * HALF;
                    const u32x4 g = *(const u32x4*)(P + row * ldp + br * 2048 + col);
                    const f32x4 v0 = acc[ai][bj][m][0], v1 = acc[ai][bj][m][1];
                    float o[8];
                    { float s0, s1; sigmoid2_(bf_lo(g.x), bf_hi(g.x), s0, s1); o[0] = s0 * v0[0]; o[1] = s1 * v0[1]; sigmoid2_(bf_lo(g.y), bf_hi(g.y), s0, s1); o[2] = s0 * v0[2]; o[3] = s1 * v0[3];
                      sigmoid2_(bf_lo(g.z), bf_hi(g.z), s0, s1); o[4] = s0 * v1[0]; o[5] = s1 * v1[1]; sigmoid2_(bf_lo(g.w), bf_hi(g.w), s0, s1); o[6] = s0 * v1[2]; o[7] = s1 * v1[3]; }
                    bf16_t* mp = Mb + row * 2048 + col;
                    if (br > 0) { const u32x4 q = *(const u32x4*)mp;
                        o[0] += bf_lo(q.x); o[1] += bf_hi(q.x); o[2] += bf_lo(q.y); o[3] += bf_hi(q.y); o[4] += bf_lo(q.z); o[5] += bf_hi(q.z); o[6] += bf_lo(q.w); o[7] += bf_hi(q.w); }
                    u32x4 w; w.x = cvt_pk_bf16(o[0], o[1]); w.y = cvt_pk_bf16(o[2], o[3]); w.z = cvt_pk_bf16(o[4], o[5]); w.w = cvt_pk_bf16(o[6], o[7]);
                    *(u32x4*)mp = w; } }
    }
};
struct MergeOrder {
    int ntile, G, c;
    __device__ bool next(int i, Unit& u) const { const int t = i / 3, br = i - 3 * t; const long q = (long)t * G + ((G & 7) == 0 ? (c & 7) * (G >> 3) + (c >> 3) : c); if (q >= ntile) return false;
        u.pm = br * 66 + (int)(q >> 3); u.pn = br * 8 + (int)(q & 7); return true; }
    __device__ __forceinline__ void a_ready(const Unit&) const {}
    __device__ __forceinline__ void done(const Unit&) const {}
};
struct EpiResid {
    static constexpr bool PERM = false, AFTER_DRAIN = false;
    const float* hin_lat; const float* hin_ctx; float* hout_lat; float* hout_ctx; const float* gate; int odd;
    __device__ __forceinline__ void operator()(const f32x4 (&acc)[2][2][4][2], const Unit& u, int wr, int wc, int fr, int fq) const {
        const int row0 = u.pm * BM + wr * 64 + fr, col0 = u.pn * BM + wc * 32 + 4 * fq;
#pragma unroll
        for (int ai = 0; ai < 2; ++ai)
#pragma unroll
            for (int m = 0; m < 4; ++m) { const int R = row0 + ai * HALF + m * 16;
                const float* hi; float* ho; const float* gv;
                if (R < 16384) { const int b = R >> 13, lp = R & 8191; const int l = odd ? ((lp & 127) * 64 + (lp >> 7)) : lp; const size_t dr = (size_t)(b * 8192 + l) * 2048;
                    hi = hin_lat + dr; ho = hout_lat + dr; gv = gate + b * 12288; }
                else { const size_t dr = (size_t)(R - 16384) * 2048; hi = hin_ctx + dr; ho = hout_ctx + dr; gv = gate + 2 * 12288; }
#pragma unroll
                for (int bj = 0; bj < 2; ++bj)
#pragma unroll
                    for (int n = 0; n < 2; ++n) { const int c = col0 + bj * HALF + n * 16;
                        const f32x4 h = *(const f32x4*)(hi + c), g = *(const f32x4*)(gv + c);
                        *(f32x4*)(ho + c) = h + g * acc[ai][bj][m][n]; } }
    }
};
struct EpiGateMul {
    static constexpr bool PERM = true, AFTER_DRAIN = false;
    const bf16_t* Z; bf16_t* Y;
    __device__ __forceinline__ void operator()(const f32x4 (&acc)[2][2][4][2], const Unit& u, int wr, int wc, int fr, int fq) const {
        const int row0 = u.pm * BM + wr * 64 + fr, col0 = u.pn * BM + wc * 32 + 8 * fq;
#pragma unroll
        for (int ai = 0; ai < 2; ++ai)
#pragma unroll
            for (int m = 0; m < 4; ++m) { const size_t ro = (size_t)(row0 + ai * HALF + m * 16) * 2048 + col0;
#pragma unroll
                for (int bj = 0; bj < 2; ++bj) { const u32x4 z = *(const u32x4*)(Z + ro + bj * HALF); const f32x4 v0 = acc[ai][bj][m][0], v1 = acc[ai][bj][m][1];
                    u32x4 w; w.x = cvt_pk_bf16(bf_lo(z.x) * v0[0], bf_hi(z.x) * v0[1]); w.y = cvt_pk_bf16(bf_lo(z.y) * v0[2], bf_hi(z.y) * v0[3]);
                    w.z = cvt_pk_bf16(bf_lo(z.z) * v1[0], bf_hi(z.z) * v1[1]); w.w = cvt_pk_bf16(bf_lo(z.w) * v1[2], bf_hi(z.w) * v1[3]);
                    *(u32x4*)(Y + ro + bj * HALF) = w; }
                __builtin_amdgcn_sched_barrier(0); }
    }
};
struct MoeOrder {
    const int* tile_e; const int* ntiles; int npn, G, c, xmaj;
    __device__ bool next(int i, Unit& u) const { const long L = (long)i * G + (xmaj ? (c & 7) * (G >> 3) + (c >> 3) : c); const int nt = *ntiles; if (L >= (long)nt * npn) return false;
        const int pm = (int)(L / npn), pl = (int)(L - (long)pm * npn); u.pm = pm; u.pn = tile_e[pm] * npn + pl; return true; }
    __device__ __forceinline__ void a_ready(const Unit&) const {}
    __device__ __forceinline__ void done(const Unit&) const {}
};
}

#include <vector>
#include <vector>

#define XB_TMO      128
#define XB_XCNT(j)  (256  + 64 * (j))
#define XB_XSUB(j)  (1280 + 64 * (j))
#define XB_XGEN(j)  (2304 + 64 * (j))
#define XB_TOP      3328
#define XB_TOPGEN   3392
#define XCD_BAR_WORDS 3456
#define XB_SPIN_CAP (1u << 18)
#define LAS __attribute__((address_space(3)))

__device__ __forceinline__ unsigned xb_ld(unsigned* p)              { return __hip_atomic_load(p, __ATOMIC_RELAXED, __HIP_MEMORY_SCOPE_AGENT); }
__device__ __forceinline__ unsigned xb_add(unsigned* p, unsigned v) { return __hip_atomic_fetch_add(p, v, __ATOMIC_RELAXED, __HIP_MEMORY_SCOPE_AGENT); }
__device__ __forceinline__ unsigned xb_xcc_id() { return (unsigned)__builtin_amdgcn_s_getreg((3 << 11) | 20) & 0xFu; }
#define XB_SPIN(cond, bar) do { unsigned _sp = 0; while (cond) { __builtin_amdgcn_s_sleep(1); \
    if ((++_sp & 255u) == 0u) { if (xb_ld(&(bar)[XB_TMO])) break; if (_sp > XB_SPIN_CAP) { atomicAdd(&(bar)[XB_TMO], 1u); break; } } } } while (0)

struct XcdBarrier {
    unsigned* bar; unsigned x;
    volatile LAS unsigned* st;
};

__device__ __forceinline__ XcdBarrier xcd_barrier_post(unsigned* bar, volatile LAS unsigned* st) {
    XcdBarrier b; b.bar = bar; b.x = xb_xcc_id(); b.st = st;
    if (threadIdx.x == 0) (void)xb_add(&bar[XB_XCNT(b.x)], 1u);
    return b;
}
__device__ __forceinline__ void xcd_barrier_complete(unsigned* bar, unsigned x, unsigned& nloc, unsigned& nx) {
    const unsigned G = gridDim.x * gridDim.y * gridDim.z;
    unsigned sum, cnt, mine, sp = 0u;
    for (;;) {
        sum = 0u; cnt = 0u; mine = 0u;
#pragma unroll
        for (unsigned j = 0; j < 16; ++j) { const unsigned c = xb_ld(&bar[XB_XCNT(j)]); sum += c; cnt += (c > 0u) ? 1u : 0u; mine = (j == x) ? c : mine; }
        if (sum == G) break;
        __builtin_amdgcn_s_sleep(1);
        if ((++sp & 255u) == 0u) { if (xb_ld(&bar[XB_TMO])) break; if (sp > XB_SPIN_CAP) { atomicAdd(&bar[XB_TMO], 1u); break; } }
    }
    nloc = mine > 0u ? mine : 1u; nx = cnt > 0u ? cnt : 1u;
}

__device__ __forceinline__ void xcd_barrier(const XcdBarrier& b) {
    asm volatile("s_waitcnt vmcnt(0)" ::: "memory");
    __syncthreads();
    if (threadIdx.x == 0) {
        unsigned* bar = b.bar;
        __builtin_amdgcn_s_waitcnt(0);
        unsigned nloc = b.st[0], nx = b.st[1];
        if (nloc == 0u) { xcd_barrier_complete(bar, b.x, nloc, nx); b.st[0] = nloc; b.st[1] = nx; }
        const unsigned old = xb_add(&bar[XB_XSUB(b.x)], 1u);
        const unsigned gen = old / nloc;
        if (old + 1u == (gen + 1u) * nloc) {
            __builtin_amdgcn_fence(__ATOMIC_RELEASE, "agent");
            asm volatile("s_waitcnt vmcnt(0)" ::: "memory");
            const unsigned og = xb_add(&bar[XB_TOP], 1u);
            const unsigned tg = og / nx;
            if (og + 1u == (tg + 1u) * nx) xb_add(&bar[XB_TOPGEN], 1u);
            else XB_SPIN(xb_ld(&bar[XB_TOPGEN]) == tg, bar);
            __builtin_amdgcn_fence(__ATOMIC_ACQUIRE, "agent");
            xb_add(&bar[XB_XGEN(b.x)], 1u);
            asm volatile("s_waitcnt vmcnt(0)" ::: "memory");
        } else {
            XB_SPIN(xb_ld(&bar[XB_XGEN(b.x)]) == gen, bar);
            __builtin_amdgcn_fence(__ATOMIC_ACQUIRE, "agent");
            asm volatile("s_waitcnt vmcnt(0)" ::: "memory");
        }
    }
    __syncthreads();
}

typedef unsigned short bf16;
typedef unsigned v4u __attribute__((ext_vector_type(4)));
typedef unsigned v2u __attribute__((ext_vector_type(2)));
typedef float f32x4 __attribute__((ext_vector_type(4)));
constexpr int D = 2048, SEQ = 8192, CTXL = 256, MLAT = 16384, MCTX = 512, MROWS = 16896;
constexpr int NP = 22272;
constexpr int PG = 0, PL = 6144, PLG = 8192, PR = 10240, PK = 12288, PV = 14336, PZ = 16384, PX = 18432, PWL = 21504, PAL = 21696, PGL = 21888, PDT = 22144;
constexpr int N_IN = 22208;
constexpr float EPS = 1e-6f;
enum { I_X = 0, I_C, I_CTX, I_CCTX, I_ADAW, I_ADAB, I_NMIX, I_NFFN, I_NFIN, I_WIN, I_LCW, I_LCB, I_LGW, I_LGB, I_LLAM,
       I_RMU, I_RW0, I_RWUP, I_RA0, I_RAUP, I_RGUP, I_RKK, I_RKA, I_RRK, I_RLNW, I_RLNB,
       I_SCW, I_SCB, I_SALOG, I_SDTB, I_SD, I_SNW, I_WOL, I_WOR, I_WOS, I_WO, I_F1, I_F3, I_F2, I_MR, I_M1, I_M3, I_M2, N_INPUTS };
constexpr size_t MiB = 1u << 20;
constexpr size_t WS_CTL = 0, CTL_BYTES = 1 * MiB;
constexpr size_t WS_MOD = 1 * MiB;
constexpr size_t WS_ROUTE = 2 * MiB;
constexpr size_t WS_BONUS = 3 * MiB;
constexpr size_t WS_HCTX = 8 * MiB;
constexpr size_t WS_WOUT = 12 * MiB;
constexpr size_t WS_HLAT = 44 * MiB;
constexpr size_t WS_Y3 = 172 * MiB;
constexpr size_t WS_X1 = 370 * MiB;
constexpr size_t WS_U = WS_X1 + 87 * MiB;
constexpr size_t WS_P = 523 * MiB;
constexpr size_t WS_LGW = 1241 * MiB;
constexpr size_t WS_LORA = 1243 * MiB;
constexpr size_t WS_GUP = 1245 * MiB;
constexpr size_t WS_LAGG = 1246 * MiB;
constexpr size_t WS_LCAR = 1256 * MiB;
constexpr size_t WS_X2 = 1264 * MiB;
constexpr size_t WS_LIN = 1396 * MiB;
constexpr size_t WS_SG = 1409 * MiB;
constexpr size_t WS_M2 = 1418 * MiB;
constexpr size_t WS_END = 1514 * MiB;
constexpr size_t WS_F13 = WS_P, WS_F2 = WS_P + 48 * MiB, WS_FH = WS_P + 72 * MiB;
constexpr size_t WS_M13 = WS_P, WS_MA = WS_P + 288 * MiB, WS_MH = WS_P + 424 * MiB;
constexpr int MOE_ROWS = 34816;
static_assert(WS_MH + (size_t)MOE_ROWS * 3072 * 2 <= WS_END && WS_FH + (size_t)MROWS * 6144 * 2 <= WS_END && WS_P + (size_t)MROWS * NP * 2 <= WS_END, "ws map");
constexpr int CW_BAR = 4096;
constexpr int CW_CNT = 16384, CW_CUR = 16384 + 64;
constexpr int RT_TOKE = 0, RT_TOKP = 32768, RT_TOKROW = 65536, RT_TILEE = 98304, RT_NT = 98304 + 256, RT_BASE = 98304 + 320;
constexpr int LDS_BYTES = 163840, MISC_OFF = 163840 - 256;

struct Args { const float* in[N_INPUTS]; float* out; unsigned char* ws; int lo, hi; };

__device__ __forceinline__ float bf2f(bf16 b) { return __uint_as_float(((unsigned)b) << 16); }
typedef __bf16 hbf16x2 __attribute__((ext_vector_type(2)));
typedef float hf32x2 __attribute__((ext_vector_type(2)));
__device__ __forceinline__ unsigned pk2(float lo, float hi) { const hf32x2 v = {lo, hi}; const hbf16x2 b = __builtin_convertvector(v, hbf16x2); return __builtin_bit_cast(unsigned, b); }
__device__ __forceinline__ bf16 f2bf(float f) { return (bf16)(pk2(f, f) & 0xffffu); }
#define DPPF(v, ctrl) __int_as_float(__builtin_amdgcn_update_dpp(0, __float_as_int(v), (ctrl), 0xF, 0xF, true))
__device__ __forceinline__ float quad_xor1(float v) { return DPPF(v, 0xB1); }
__device__ __forceinline__ float quad_xor2(float v) { return DPPF(v, 0x4E); }
__device__ __forceinline__ float rdlane(float v, int l) { return __int_as_float(__builtin_amdgcn_readlane(__float_as_int(v), l)); }
__device__ __forceinline__ float wave_sum(float v) { v += DPPF(v, 0xB1); v += DPPF(v, 0x4E); v += DPPF(v, 0x141); v += DPPF(v, 0x140);
    v += __int_as_float(__builtin_amdgcn_update_dpp(0, __float_as_int(v), 0x142, 0xA, 0xF, false));
    v += __int_as_float(__builtin_amdgcn_update_dpp(0, __float_as_int(v), 0x143, 0xC, 0xF, false));
    return rdlane(v, 63); }
__device__ __forceinline__ float wave_scan(float v, int lane) { v += DPPF(v, 0x111); v += DPPF(v, 0x112); v += DPPF(v, 0x114); v += DPPF(v, 0x118);
    const float t0 = rdlane(v, 15), t1 = rdlane(v, 31), t2 = rdlane(v, 47); const int r = lane >> 4;
    return v + (r >= 1 ? t0 : 0.f) + (r >= 2 ? t1 : 0.f) + (r >= 3 ? t2 : 0.f); }
__device__ __forceinline__ float sigm(float x) { return __builtin_amdgcn_rcpf(1.0f + __expf(-x)); }
__device__ __forceinline__ float siluf(float x) { return x * sigm(x); }
__device__ __forceinline__ float softplusf(float x) { const float e = __expf(x); return x > 20.f ? x : (e < 0.05f ? e * (1.0f - e * (0.5f - e * (0.33333333f - 0.25f * e))) : __logf(1.0f + e)); }
__device__ __forceinline__ float tanh_fast(float x) { return 1.0f - 2.0f * __builtin_amdgcn_rcpf(1.0f + __expf(2.0f * x)); }
__device__ __forceinline__ float softplus_fast(float x) { return x > 20.f ? x : __logf(1.0f + __expf(x)); }
#define LBAR() do { asm volatile("s_waitcnt lgkmcnt(0)" ::: "memory"); __builtin_amdgcn_s_barrier(); asm volatile("" ::: "memory"); } while (0)
__device__ __forceinline__ float gelu_tanh(float x) { const float u = 0.7978845608028654f * (x + 0.044715f * x * x * x); return 0.5f * x * (1.0f + tanhf(u)); }
__device__ __forceinline__ void seq_pos(int row, int& pos, int& len) { if (row < MLAT) { pos = row & (SEQ - 1); len = SEQ; } else { pos = (row - MLAT) & (CTXL - 1); len = CTXL; } }
__device__ __forceinline__ int chain_row(int b, int dir, int s) { if (s < CTXL) { const int t = dir ? CTXL - 1 - s : s; return MLAT + b * CTXL + t; } s -= CTXL; const int t = dir ? SEQ - 1 - s : s; return b * SEQ + t; }
#define CROW(r0_, dir_, t_) ((dir_) ? (r0_) - (t_) : (r0_) + (t_))
__device__ __forceinline__ float Pat(const bf16* P, int row, int col) { return bf2f(P[(size_t)row * NP + col]); }
__device__ __forceinline__ float shifted(const bf16* P, int row, int col, float mu) {
    int pos, len; seq_pos(row, pos, len);
    const float p = Pat(P, row, col), pv = pos > 0 ? Pat(P, row - 1, col) : 0.f, nx = pos < len - 1 ? Pat(P, row + 1, col) : 0.f;
    return p + mu * (0.5f * (pv + nx) - p);
}
__device__ __forceinline__ float dwconv(const bf16* P, int row, int col, const float* w, int ncol, int wc, float bias) {
    int pos, len; seq_pos(row, pos, len);
    float o = bias;
#pragma unroll
    for (int tap = 0; tap < 4; ++tap) { const int q = pos + tap - 2; if (q >= 0 && q < len) o += w[tap * ncol + wc] * Pat(P, row + tap - 2, col); }
    return o;
}
#define LAS3 __attribute__((address_space(3)))

struct Frame { const Args* a; unsigned char* ws; LAS3 unsigned char* lds; int tid, lane, wave, G, bid; };

__device__ __forceinline__ void phase_mod(const Frame& F) {
    LAS3 float* sv = (LAS3 float*)F.lds;
    LAS3 float* red = sv + 3 * 2048;
    const float* c = F.a->in[I_C]; const float* cc = F.a->in[I_CCTX];
    for (int i = F.tid; i < 3 * 2048; i += 512) { const int w = i >> 11, k = i & 2047; const float x = w < 2 ? c[w * 2048 + k] : cc[k]; sv[i] = siluf(x); }
    __syncthreads();
    float* mod = (float*)(F.ws + WS_MOD);
    const int kg = F.tid >> 7, j = F.tid & 127;
    for (int unit = F.bid; unit < 192; unit += F.G) {
        const int layer = unit / 96, col = (unit % 96) * 128 + j;
        const float* W = F.a->in[I_ADAW] + (size_t)layer * 2048 * 12288 + col;
        float a0 = 0.f, a1 = 0.f, a2 = 0.f;
        for (int k = kg * 512; k < kg * 512 + 512; ++k) { const float w = W[(size_t)k * 12288]; a0 += sv[k] * w; a1 += sv[2048 + k] * w; a2 += sv[4096 + k] * w; }
        red[(kg * 3 + 0) * 128 + j] = a0; red[(kg * 3 + 1) * 128 + j] = a1; red[(kg * 3 + 2) * 128 + j] = a2;
        __syncthreads();
        if (F.tid < 384) { const int w = F.tid >> 7; float s = F.a->in[I_ADAB][layer * 12288 + col];
            for (int q = 0; q < 4; ++q) s += red[(q * 3 + w) * 128 + j];
            mod[(size_t)(layer * 3 + w) * 12288 + col] = s; }
        __syncthreads();
    }
}

__device__ __forceinline__ int map_row(int type, int base, int n) {
    if (type == 0) return base + n;
    if (type == 2) return base + (n >> 7) * 256 + (n & 127);
    if (n < 16384) return n;
    if (n < 17024) return PWL + (n - 16384);
    if (n < 22144) return n - 640;
    return PDT + (n - 22144);
}
__device__ __forceinline__ void convT(const Frame& F, const float* src, int K, int N, bf16* dst, int type, int base, int& tile_rot, int nw, int rk) {
    LAS3 float* tile = (LAS3 float*)F.lds;
    const int nkt = K / 64, nnt = N / 64, nt = nkt * nnt;
    for (int t = (rk + nw - (tile_rot % nw)) % nw; t < nt; t += nw) {
        const int kt = t % nkt, ntl = t / nkt, k0 = kt * 64, n0 = ntl * 64;
        { const int r = F.tid >> 4, c4 = (F.tid & 15) * 4;
#pragma unroll
          for (int p = 0; p < 2; ++p) { const f32x4 v = *(const f32x4*)(src + (size_t)(k0 + r + p * 32) * N + n0 + c4);
              tile[(r + p * 32) * 65 + c4 + 0] = v[0]; tile[(r + p * 32) * 65 + c4 + 1] = v[1]; tile[(r + p * 32) * 65 + c4 + 2] = v[2]; tile[(r + p * 32) * 65 + c4 + 3] = v[3]; } }
        __syncthreads();
        { const int n = F.tid >> 3, kq = (F.tid & 7) * 8; float v[8];
#pragma unroll
          for (int i = 0; i < 8; ++i) v[i] = tile[(kq + i) * 65 + n];
          v4u w; w.x = pk2(v[0], v[1]); w.y = pk2(v[2], v[3]); w.z = pk2(v[4], v[5]); w.w = pk2(v[6], v[7]);
          *(v4u*)(dst + (size_t)map_row(type, base, n0 + n) * K + k0 + kq) = w; }
        __syncthreads();
    }
    tile_rot += nt;
}
__device__ __forceinline__ void phase_convw_layer(const Frame& F, int L, int nw, int rk) {
    int rot = 0;
    bf16* wt_in = (bf16*)(F.ws + WS_X1); bf16* wt_out = (bf16*)(F.ws + WS_WOUT);
    convT(F, F.a->in[I_WIN] + (size_t)L * 2048 * N_IN, 2048, N_IN, wt_in, 1, 0, rot, nw, rk);
    for (int i = rk * 512 + F.tid; i < 64 * 2048 / 8; i += nw * 512) ((v4u*)(wt_in + (size_t)N_IN * 2048))[i] = (v4u){0u, 0u, 0u, 0u};
    convT(F, F.a->in[I_WOL] + (size_t)L * 2048 * 2048, 2048, 2048, wt_out, 0, 0, rot, nw, rk);
    convT(F, F.a->in[I_WOR] + (size_t)L * 2048 * 2048, 2048, 2048, wt_out, 0, 2048, rot, nw, rk);
    convT(F, F.a->in[I_WOS] + (size_t)L * 2048 * 2048, 2048, 2048, wt_out, 0, 4096, rot, nw, rk);
    convT(F, F.a->in[I_WO] + (size_t)L * 2048 * 2048, 2048, 2048, wt_out, 0, 6144, rot, nw, rk);
    convT(F, F.a->in[I_RGUP] + (size_t)L * 256 * 2048, 256, 2048, (bf16*)(F.ws + WS_GUP), 0, 0, rot, nw, rk);
    for (int m = 0; m < 64; ++m) convT(F, F.a->in[I_LGW] + ((size_t)L * 64 + m) * 128 * 128, 128, 128, (bf16*)(F.ws + WS_LGW), 0, m * 128, rot, nw, rk);
}
__device__ __forceinline__ void phase_convw_ffn(const Frame& F, int L, int nw, int rk, int part = 3) {
    int rot = 0;
    if (L == 0) {
        convT(F, F.a->in[I_F1], 2048, 6144, (bf16*)(F.ws + WS_F13), 2, 0, rot, nw, rk);
        convT(F, F.a->in[I_F3], 2048, 6144, (bf16*)(F.ws + WS_F13), 2, 128, rot, nw, rk);
        convT(F, F.a->in[I_F2], 6144, 2048, (bf16*)(F.ws + WS_F2), 0, 0, rot, nw, rk);
    } else {
        for (int e = 0; e < 8; ++e) {
            if (part & 1) { convT(F, F.a->in[I_M1] + (size_t)e * 2048 * 3072, 2048, 3072, (bf16*)(F.ws + WS_M13), 2, e * 6144, rot, nw, rk);
                            convT(F, F.a->in[I_M3] + (size_t)e * 2048 * 3072, 2048, 3072, (bf16*)(F.ws + WS_M13), 2, e * 6144 + 128, rot, nw, rk); }
            if (part & 2) convT(F, F.a->in[I_M2] + (size_t)e * 3072 * 2048, 3072, 2048, (bf16*)(F.ws + WS_M2), 0, e * 2048, rot, nw, rk);
        }
    }
}

template <bool ROUTER> __forceinline__
__device__ __forceinline__ void phase_norm(const Frame& F, const float* hlat, const float* hctx, const float* gain, const float* modL, int sh_off, int sc_off, bf16* out, int permute, int nrows) {
    const float* router = F.a->in[I_MR];
    int* rt = (int*)(F.ws + WS_ROUTE); unsigned* ctl = (unsigned*)(F.ws + WS_CTL);
    for (int row = F.bid * 8 + F.wave; row < nrows; row += F.G * 8) {
        int lane = F.lane; asm volatile("" : "+v"(lane));
        const float* src; const float* mv; int drow;
        if (row < MLAT) { const int b = row >> 13, l = row & 8191; src = hlat + (size_t)row * D; mv = modL + b * 12288;
            drow = permute ? (b * 8192 + (l & 63) * 128 + (l >> 6)) : row; }
        else { src = hctx + (size_t)(row - MLAT) * D; mv = modL + 2 * 12288; drow = row; }
        f32x4 x[8]; float ss = 0.f;
#pragma unroll
        for (int i = 0; i < 8; ++i) { x[i] = *(const f32x4*)(src + i * 256 + lane * 4); ss += x[i][0] * x[i][0] + x[i][1] * x[i][1] + x[i][2] * x[i][2] + x[i][3] * x[i][3]; }
        ss = wave_sum(ss);
        const float rs = rsqrtf(ss * (1.0f / D) + EPS);
        float lg[8];
        if (ROUTER) {
#pragma unroll
            for (int e = 0; e < 8; ++e) lg[e] = 0.f; }
#pragma unroll
        for (int i = 0; i < 8; ++i) { const int c = i * 256 + lane * 4;
            const f32x4 g = *(const f32x4*)(gain + c), sc = *(const f32x4*)(mv + sc_off + c), sh = *(const f32x4*)(mv + sh_off + c);
            f32x4 v;
#pragma unroll
            for (int j = 0; j < 4; ++j) v[j] = x[i][j] * rs * g[j] * (1.0f + sc[j]) + sh[j];
            uint2 w; w.x = pk2(v[0], v[1]); w.y = pk2(v[2], v[3]);
            *(uint2*)(out + (size_t)drow * D + c) = w;
            if (ROUTER) {
#pragma unroll
                for (int j = 0; j < 4; ++j) { const f32x4 r0 = *(const f32x4*)(router + (size_t)(c + j) * 8), r1 = *(const f32x4*)(router + (size_t)(c + j) * 8 + 4);
                    lg[0] += v[j] * r0[0]; lg[1] += v[j] * r0[1]; lg[2] += v[j] * r0[2]; lg[3] += v[j] * r0[3]; lg[4] += v[j] * r1[0]; lg[5] += v[j] * r1[1]; lg[6] += v[j] * r1[2]; lg[7] += v[j] * r1[3]; } }
        }
        if (ROUTER) {
#pragma unroll
            for (int e = 0; e < 8; ++e) lg[e] = wave_sum(lg[e]);
            if (lane == 0) {
                int e0 = 0; float v0 = lg[0];
#pragma unroll
                for (int e = 1; e < 8; ++e) if (lg[e] > v0) { v0 = lg[e]; e0 = e; }
                int e1 = -1; float v1 = -3.0e38f;
#pragma unroll
                for (int e = 0; e < 8; ++e) if (e != e0 && lg[e] > v1) { v1 = lg[e]; e1 = e; }
                const float p0 = 1.0f / (1.0f + __expf(v1 - v0));
                rt[RT_TOKE + row * 2] = e0; rt[RT_TOKE + row * 2 + 1] = e1;
                ((float*)rt)[RT_TOKP + row * 2] = p0; ((float*)rt)[RT_TOKP + row * 2 + 1] = 1.0f - p0;
                atomicAdd(&ctl[CW_CNT + e0], 1u); atomicAdd(&ctl[CW_CNT + e1], 1u);
            }
        }
    }
}

typedef short bf16x8 __attribute__((ext_vector_type(8)));
__device__ __forceinline__ bf16x8 ldfrag(const LAS3 bf16* p, int ld, int r0, int k0, int fr, int fq) { return *(const LAS3 bf16x8*)(p + (r0 + fr) * ld + k0 + 8 * fq); }
__device__ __forceinline__ bf16x8 ldfrag_sw(const LAS3 bf16* p, int ld, int r0, int k0, int fr, int fq) { const int r = r0 + fr, c = ((k0 >> 3) + fq) ^ ((r >> 3) & 7); return *(const LAS3 bf16x8*)(p + r * ld + c * 8); }
__device__ __forceinline__ bf16x8 ldfrag_g(const bf16* p, int ld, int r0, int k0, int fr, int fq) { return *(const bf16x8*)(p + (size_t)(r0 + fr) * ld + k0 + 8 * fq); }
#define MMA_TRN(acc, xf, yf) acc = __builtin_amdgcn_mfma_f32_16x16x32_bf16(yf, xf, acc, 0, 0, 0)
#define MMA_STD(acc, xf, yf) acc = __builtin_amdgcn_mfma_f32_16x16x32_bf16(xf, yf, acc, 0, 0, 0)
__device__ __forceinline__ void phase_rwkv_seq(const Frame& F, int L) {
    const bf16* P = (const bf16*)(F.ws + WS_P);
    bf16* ydir = (bf16*)(F.ws + WS_X1);
    float* bonus = (float*)(F.ws + WS_BONUS);
    const float* mu = F.a->in[I_RMU] + (size_t)L * 6784;
    LAS3 float* Fr = (LAS3 float*)F.lds; LAS3 float* Fk = Fr + 2048; LAS3 float* Fv = Fk + 2048; LAS3 float* Fa = Fv + 2048; LAS3 float* Fb = Fa + 2048; LAS3 float* Fw = Fb + 2048;
    LAS3 float* Lw = Fw + 2048; LAS3 float* La = Lw + 32 * 96; LAS3 float* Yb = La + 32 * 96;
    for (int unit = F.bid; unit < 128; unit += F.G) {
        const int b = unit >> 6, h = (unit >> 1) & 31, d = unit & 1;
        const float* w0 = F.a->in[I_RW0] + (size_t)(L * 2 + d) * 2048; const float* a0 = F.a->in[I_RA0] + (size_t)(L * 2 + d) * 2048;
        const float* wup = F.a->in[I_RWUP] + (size_t)(L * 2 + d) * 96 * 2048; const float* aup = F.a->in[I_RAUP] + (size_t)(L * 2 + d) * 96 * 2048;
        const float* kkw = F.a->in[I_RKK] + (size_t)L * 2048; const float* kaw = F.a->in[I_RKA] + (size_t)L * 2048; const float* rkw = F.a->in[I_RRK] + (size_t)L * 2048;
        float S[8];
#pragma unroll
        for (int j = 0; j < 8; ++j) S[j] = 0.f;
        for (int ch = 0; ch < 264; ++ch) {
            for (int idx = F.tid; idx < 32 * 96; idx += 512) { const int t = idx / 96, j = idx - t * 96; const int row = chain_row(b, d, ch * 32 + t);
                Lw[idx] = tanhf(shifted(P, row, PWL + d * 96 + j, mu[6144 + d * 96 + j]));
                La[idx] = shifted(P, row, PAL + d * 96 + j, mu[6144 + 192 + d * 96 + j]); }
            __syncthreads();
            for (int i = 0; i < 4; ++i) { const int t = F.wave * 4 + i, c = F.lane, col = h * 64 + c; const int row = chain_row(b, d, ch * 32 + t);
                const float r = shifted(P, row, PR + col, mu[col]), k = shifted(P, row, PK + col, mu[2048 + col]), v = shifted(P, row, PV + col, mu[4096 + col]);
                float wpre = w0[col], apre = a0[col];
                for (int j = 0; j < 96; ++j) { wpre += Lw[t * 96 + j] * wup[(size_t)j * 2048 + col]; apre += La[t * 96 + j] * aup[(size_t)j * 2048 + col]; }
                const float wraw = -softplusf(-wpre) - 0.5f, wdec = __expf(-__expf(wraw)), asig = sigm(apre);
                const float kkv = k * kkw[col], n2 = wave_sum(kkv * kkv), kk = kkv * rsqrtf(n2 + 1e-12f);
                const float key = k * (1.0f + (asig - 1.0f) * kaw[col]);
                const float bon = wave_sum(r * key * rkw[col]);
                if (c == 0) bonus[((size_t)d * MROWS + row) * 32 + h] = bon;
                Fr[t * 64 + c] = r; Fk[t * 64 + c] = key; Fv[t * 64 + c] = v; Fa[t * 64 + c] = -kk; Fb[t * 64 + c] = kk * asig; Fw[t * 64 + c] = wdec; }
            __syncthreads();
            { const int vi = F.tid >> 3, kp = F.tid & 7;
              for (int t = 0; t < 32; ++t) { const int o = t * 64 + kp * 8;
                  float sa = 0.f;
#pragma unroll
                  for (int j = 0; j < 8; ++j) sa += S[j] * Fa[o + j];
                  sa += __shfl_xor(sa, 1); sa += __shfl_xor(sa, 2); sa += __shfl_xor(sa, 4);
                  const float vv = Fv[t * 64 + vi]; float y = 0.f;
#pragma unroll
                  for (int j = 0; j < 8; ++j) { S[j] = S[j] * Fw[o + j] + sa * Fb[o + j] + vv * Fk[o + j]; y += S[j] * Fr[o + j]; }
                  y += __shfl_xor(y, 1); y += __shfl_xor(y, 2); y += __shfl_xor(y, 4);
                  if (kp == 0) Yb[t * 64 + vi] = y; } }
            __syncthreads();
            for (int idx = F.tid; idx < 2048; idx += 512) { const int t = idx >> 6, c = idx & 63; const int row = chain_row(b, d, ch * 32 + t);
                ydir[((size_t)d * MROWS + row) * D + h * 64 + c] = f2bf(Yb[idx]); }
        }
        __syncthreads();
    }
}
__device__ __forceinline__ void phase_rwkv_out(const Frame& F, int L) {
    const bf16* P = (const bf16*)(F.ws + WS_P);
    const bf16* ydir = (const bf16*)(F.ws + WS_X1);
    const float* bonus = (const float*)(F.ws + WS_BONUS);
    bf16* Y = (bf16*)(F.ws + WS_Y3) + (size_t)1 * MROWS * D;
    const float* mu = F.a->in[I_RMU] + (size_t)L * 6784;
    const bf16* GupT = (const bf16*)(F.ws + WS_GUP);
    const float* lnw = F.a->in[I_RLNW] + (size_t)L * 2048; const float* lnb = F.a->in[I_RLNB] + (size_t)L * 2048;
    LAS3 bf16* sg = (LAS3 bf16*)F.lds;
    for (int unit = F.bid; unit < MROWS / 16; unit += F.G) {
        int tid = F.tid; asm volatile("" : "+v"(tid));
        const int lane = tid & 63, wave = __builtin_amdgcn_readfirstlane(tid >> 6), fr = lane & 15, fq = lane >> 4;
        const int row0 = unit * 16;
        { const int t = tid >> 5, j8 = (tid & 31) * 8, row = row0 + t; int pos, len; seq_pos(row, pos, len);
          const v4u x = *(const v4u*)(P + (size_t)row * NP + PGL + j8); v4u xp = (v4u){0u, 0u, 0u, 0u}, xn = xp;
          if (pos > 0) xp = *(const v4u*)(P + (size_t)(row - 1) * NP + PGL + j8);
          if (pos < len - 1) xn = *(const v4u*)(P + (size_t)(row + 1) * NP + PGL + j8);
          const float* mp = mu + 6144 + 384 + j8; float o[8];
          const float xv[8] = {pg8::bf_lo(x.x), pg8::bf_hi(x.x), pg8::bf_lo(x.y), pg8::bf_hi(x.y), pg8::bf_lo(x.z), pg8::bf_hi(x.z), pg8::bf_lo(x.w), pg8::bf_hi(x.w)};
          const float pv[8] = {pg8::bf_lo(xp.x), pg8::bf_hi(xp.x), pg8::bf_lo(xp.y), pg8::bf_hi(xp.y), pg8::bf_lo(xp.z), pg8::bf_hi(xp.z), pg8::bf_lo(xp.w), pg8::bf_hi(xp.w)};
          const float nv[8] = {pg8::bf_lo(xn.x), pg8::bf_hi(xn.x), pg8::bf_lo(xn.y), pg8::bf_hi(xn.y), pg8::bf_lo(xn.z), pg8::bf_hi(xn.z), pg8::bf_lo(xn.w), pg8::bf_hi(xn.w)};
#pragma unroll
          for (int j = 0; j < 8; ++j) o[j] = sigm(xv[j] + mp[j] * (0.5f * (pv[j] + nv[j]) - xv[j]));
          v4u w; w.x = pk2(o[0], o[1]); w.y = pk2(o[2], o[3]); w.z = pk2(o[4], o[5]); w.w = pk2(o[6], o[7]);
          *(LAS3 v4u*)(sg + t * 264 + j8) = w; }
        LBAR();
        bf16x8 af[8];
#pragma unroll
        for (int ks = 0; ks < 8; ++ks) af[ks] = ldfrag(sg, 264, 0, ks * 32, fr, fq);
        const int row = row0 + fr; int pos, len; seq_pos(row, pos, len);
#pragma unroll 1
        for (int hh = 0; hh < 4; ++hh) { const int h = wave * 4 + hh;
            f32x4 g[4], y[4];
#pragma unroll
            for (int nt = 0; nt < 4; ++nt) { g[nt] = (f32x4){0.f, 0.f, 0.f, 0.f};
#pragma unroll
                for (int ks = 0; ks < 8; ++ks) MMA_TRN(g[nt], af[ks], ldfrag_g(GupT, 256, h * 64 + nt * 16, ks * 32, fr, fq)); }
            float s1 = 0.f;
#pragma unroll
            for (int nt = 0; nt < 4; ++nt) { const int c4 = h * 64 + nt * 16 + 4 * fq;
                const uint2 a = *(const uint2*)(ydir + (size_t)row * D + c4), bb = *(const uint2*)(ydir + ((size_t)MROWS + row) * D + c4);
                y[nt][0] = pg8::bf_lo(a.x) + pg8::bf_lo(bb.x); y[nt][1] = pg8::bf_hi(a.x) + pg8::bf_hi(bb.x); y[nt][2] = pg8::bf_lo(a.y) + pg8::bf_lo(bb.y); y[nt][3] = pg8::bf_hi(a.y) + pg8::bf_hi(bb.y);
                s1 += y[nt][0] + y[nt][1] + y[nt][2] + y[nt][3]; }
            s1 += __shfl_xor(s1, 16); s1 += __shfl_xor(s1, 32);
            const float mean = s1 * (1.0f / 64.0f); float q = 0.f;
#pragma unroll
            for (int nt = 0; nt < 4; ++nt)
#pragma unroll
                for (int e = 0; e < 4; ++e) { const float dl = y[nt][e] - mean; q += dl * dl; }
            q += __shfl_xor(q, 16); q += __shfl_xor(q, 32);
            const float rstd = rsqrtf(q * (1.0f / 64.0f) + 64e-5f);
            const float bon = bonus[(size_t)row * 32 + h] + bonus[((size_t)MROWS + row) * 32 + h];
#pragma unroll
            for (int nt = 0; nt < 4; ++nt) { const int c4 = h * 64 + nt * 16 + 4 * fq;
                const uint2 x = *(const uint2*)(P + (size_t)row * NP + PV + c4); uint2 xp = make_uint2(0u, 0u), xn = xp;
                if (pos > 0) xp = *(const uint2*)(P + (size_t)(row - 1) * NP + PV + c4);
                if (pos < len - 1) xn = *(const uint2*)(P + (size_t)(row + 1) * NP + PV + c4);
                const f32x4 lw = *(const f32x4*)(lnw + c4), lb = *(const f32x4*)(lnb + c4), muv = *(const f32x4*)(mu + 4096 + c4);
                const float xv[4] = {pg8::bf_lo(x.x), pg8::bf_hi(x.x), pg8::bf_lo(x.y), pg8::bf_hi(x.y)}, pv[4] = {pg8::bf_lo(xp.x), pg8::bf_hi(xp.x), pg8::bf_lo(xp.y), pg8::bf_hi(xp.y)}, nv[4] = {pg8::bf_lo(xn.x), pg8::bf_hi(xn.x), pg8::bf_lo(xn.y), pg8::bf_hi(xn.y)};
                float o[4];
#pragma unroll
                for (int e = 0; e < 4; ++e) { const float vv = xv[e] + muv[e] * (0.5f * (pv[e] + nv[e]) - xv[e]); o[e] = ((y[nt][e] - mean) * rstd * lw[e] + lb[e] + bon * vv) * g[nt][e]; }
                uint2 w; w.x = pk2(o[0], o[1]); w.y = pk2(o[2], o[3]);
                *(uint2*)(Y + (size_t)row * D + c4) = w; } }
        LBAR();
    }
}

__device__ __forceinline__ void phase_ssm_seq(const Frame& F, int L) {
    const bf16* P = (const bf16*)(F.ws + WS_P);
    bf16* ydir = (bf16*)(F.ws + WS_X1);
    const float* cw = F.a->in[I_SCW] + (size_t)L * 4 * 3072; const float* cb = F.a->in[I_SCB] + (size_t)L * 3072;
    LAS3 float* X = (LAS3 float*)F.lds; LAS3 float* Bm = X + 32 * 64; LAS3 float* Cm = Bm + 32 * 128; LAS3 float* dtv = Cm + 32 * 128; LAS3 float* dav = dtv + 32; LAS3 float* Yb = dav + 32;
    for (int unit = F.bid; unit < 128; unit += F.G) {
        const int b = unit >> 6, h = (unit >> 1) & 31, d = unit & 1, g = h >> 3;
        const float Ad = -__expf(F.a->in[I_SALOG][(L * 2 + d) * 32 + h]); const float dtb = F.a->in[I_SDTB][(L * 2 + d) * 32 + h];
        float hs[16];
#pragma unroll
        for (int j = 0; j < 16; ++j) hs[j] = 0.f;
        for (int ch = 0; ch < 264; ++ch) {
            for (int idx = F.tid; idx < 32 * 320; idx += 512) { const int t = idx / 320, q = idx - t * 320; const int row = chain_row(b, d, ch * 32 + t);
                const int col = q < 64 ? h * 64 + q : (q < 192 ? 2048 + g * 128 + (q - 64) : 2560 + g * 128 + (q - 192));
                const float v = siluf(dwconv(P, row, PX + col, cw, 3072, col, cb[col]));
                if (q < 64) X[t * 64 + q] = v; else if (q < 192) Bm[t * 128 + q - 64] = v; else Cm[t * 128 + q - 192] = v; }
            if (F.tid < 32) { const int row = chain_row(b, d, ch * 32 + F.tid); const float dt = softplusf(Pat(P, row, PDT + d * 32 + h) + dtb); dtv[F.tid] = dt; dav[F.tid] = __expf(dt * Ad); }
            __syncthreads();
            { const int p = F.tid >> 3, np = F.tid & 7;
              for (int t = 0; t < 32; ++t) { const float da = dav[t], xs = dtv[t] * X[t * 64 + p]; float y = 0.f;
#pragma unroll
                  for (int j = 0; j < 16; ++j) { hs[j] = hs[j] * da + xs * Bm[t * 128 + np * 16 + j]; y += hs[j] * Cm[t * 128 + np * 16 + j]; }
                  y += __shfl_xor(y, 1); y += __shfl_xor(y, 2); y += __shfl_xor(y, 4);
                  if (np == 0) Yb[t * 64 + p] = y; } }
            __syncthreads();
            for (int idx = F.tid; idx < 2048; idx += 512) { const int t = idx >> 6, c = idx & 63; const int row = chain_row(b, d, ch * 32 + t);
                ydir[((size_t)d * MROWS + row) * D + h * 64 + c] = f2bf(Yb[idx]); }
        }
        __syncthreads();
    }
}
__device__ __forceinline__ void phase_ssm_out(const Frame& F, int L) {
    const bf16* P = (const bf16*)(F.ws + WS_P);
    const bf16* ydir = (const bf16*)(F.ws + WS_X1);
    bf16* Y = (bf16*)(F.ws + WS_Y3) + (size_t)2 * MROWS * D; const bf16* XA = (const bf16*)(F.ws + WS_X2);
    const float* dsk = F.a->in[I_SD] + (size_t)L * 32; const float* nw = F.a->in[I_SNW] + (size_t)L * 2048;
    for (int row = F.bid * 8 + F.wave; row < MROWS; row += F.G * 8) {
#pragma unroll 2
        for (int g = 0; g < 4; ++g) { const int c0 = g * 512 + F.lane * 8;
            const v4u a = *(const v4u*)(ydir + (size_t)row * D + c0), bb = *(const v4u*)(ydir + ((size_t)MROWS + row) * D + c0), zz = *(const v4u*)(P + (size_t)row * NP + PZ + c0);
            float y[8], z[8];
            y[0] = pg8::bf_lo(a.x) + pg8::bf_lo(bb.x); y[1] = pg8::bf_hi(a.x) + pg8::bf_hi(bb.x); y[2] = pg8::bf_lo(a.y) + pg8::bf_lo(bb.y); y[3] = pg8::bf_hi(a.y) + pg8::bf_hi(bb.y);
            y[4] = pg8::bf_lo(a.z) + pg8::bf_lo(bb.z); y[5] = pg8::bf_hi(a.z) + pg8::bf_hi(bb.z); y[6] = pg8::bf_lo(a.w) + pg8::bf_lo(bb.w); y[7] = pg8::bf_hi(a.w) + pg8::bf_hi(bb.w);
            z[0] = pg8::bf_lo(zz.x); z[1] = pg8::bf_hi(zz.x); z[2] = pg8::bf_lo(zz.y); z[3] = pg8::bf_hi(zz.y); z[4] = pg8::bf_lo(zz.z); z[5] = pg8::bf_hi(zz.z); z[6] = pg8::bf_lo(zz.w); z[7] = pg8::bf_hi(zz.w);
            const float dk = dsk[c0 >> 6]; float ss = 0.f; const v4u xx = *(const v4u*)(XA + (size_t)row * 3072 + c0);
            const float xs[8] = {pg8::bf_lo(xx.x), pg8::bf_hi(xx.x), pg8::bf_lo(xx.y), pg8::bf_hi(xx.y), pg8::bf_lo(xx.z), pg8::bf_hi(xx.z), pg8::bf_lo(xx.w), pg8::bf_hi(xx.w)};
#pragma unroll
            for (int j = 0; j < 8; ++j) { y[j] = (y[j] + dk * xs[j]) * siluf(z[j]); ss += y[j] * y[j]; }
            ss = wave_sum(ss);
            const float rs = rsqrtf(ss * (1.0f / 512.0f) + EPS);
            v4u w; w.x = pk2(y[0] * rs * nw[c0 + 0], y[1] * rs * nw[c0 + 1]); w.y = pk2(y[2] * rs * nw[c0 + 2], y[3] * rs * nw[c0 + 3]);
            w.z = pk2(y[4] * rs * nw[c0 + 4], y[5] * rs * nw[c0 + 5]); w.w = pk2(y[6] * rs * nw[c0 + 6], y[7] * rs * nw[c0 + 7]);
            *(v4u*)(Y + (size_t)row * D + c0) = w; }
    }
}

__device__ __forceinline__ void phase_lru_seq(const Frame& F, int L) {
    const bf16* P = (const bf16*)(F.ws + WS_P);
    bf16* hdir = (bf16*)(F.ws + WS_X1);
    const float* cw = F.a->in[I_LCW] + (size_t)L * 4 * 2048; const float* cb = F.a->in[I_LCB] + (size_t)L * 2048;
    LAS3 float* Xc = (LAS3 float*)F.lds; LAS3 float* Ga = Xc + 32 * 128; LAS3 float* Gb = Ga + 32 * 128; LAS3 float* Hb = Gb + 32 * 128;
    for (int unit = F.bid; unit < 64; unit += F.G) {
        const int b = unit >> 5, n = (unit >> 1) & 15, d = unit & 1;
        const int half = F.tid >> 8, gi = (F.tid >> 7) & 1, j = F.tid & 127, col = n * 128 + j;
        const float* gw = F.a->in[I_LGW] + ((((size_t)L * 2 + d) * 2 + gi) * 16 + n) * 128 * 128;
        const float gb = F.a->in[I_LGB][(((size_t)L * 2 + d) * 2 + gi) * 2048 + col];
        const float sp = softplusf(-F.a->in[I_LLAM][((size_t)L * 2 + d) * 2048 + col]);
        float hst = 0.f;
        for (int ch = 0; ch < 264; ++ch) {
            for (int idx = F.tid; idx < 32 * 128; idx += 512) { const int t = idx >> 7, k = idx & 127; const int row = chain_row(b, d, ch * 32 + t);
                Xc[idx] = dwconv(P, row, PL + n * 128 + k, cw, 2048, n * 128 + k, cb[n * 128 + k]); }
            __syncthreads();
            { float acc[16];
#pragma unroll
              for (int i = 0; i < 16; ++i) acc[i] = gb;
              for (int k = 0; k < 128; ++k) { const float w = gw[k * 128 + j];
#pragma unroll
                  for (int i = 0; i < 16; ++i) acc[i] += Xc[(half * 16 + i) * 128 + k] * w; }
#pragma unroll
              for (int i = 0; i < 16; ++i) { const float s = sigm(acc[i]); if (gi == 0) Ga[(half * 16 + i) * 128 + j] = -8.0f * s * sp; else Gb[(half * 16 + i) * 128 + j] = s; } }
            __syncthreads();
            if (F.tid < 128) { for (int t = 0; t < 32; ++t) { const float la = Ga[t * 128 + j], a = __expf(la); const float bx = sqrtf(-expm1f(2.0f * la)) * Gb[t * 128 + j] * Xc[t * 128 + j]; hst = a * hst + bx; Hb[t * 128 + j] = hst; } }
            __syncthreads();
            for (int idx = F.tid; idx < 32 * 128; idx += 512) { const int t = idx >> 7, k = idx & 127; const int row = chain_row(b, d, ch * 32 + t);
                hdir[((size_t)d * MROWS + row) * D + n * 128 + k] = f2bf(Hb[idx]); }
        }
        __syncthreads();
    }
}
__device__ __forceinline__ void phase_lru_out(const Frame& F, int L) {
    const bf16* P = (const bf16*)(F.ws + WS_P);
    const bf16* hdir = (const bf16*)(F.ws + WS_X1);
    bf16* Y = (bf16*)(F.ws + WS_Y3);
    for (size_t i = (size_t)F.bid * 512 + F.tid; i < (size_t)MROWS * D / 8; i += (size_t)F.G * 512) { const int row = (int)(i >> 8), c0 = (int)(i & 255) * 8;
        const v4u a = *(const v4u*)(hdir + (size_t)row * D + c0), bb = *(const v4u*)(hdir + ((size_t)MROWS + row) * D + c0), gg = *(const v4u*)(P + (size_t)row * NP + PLG + c0);
        v4u w;
        w.x = pk2((pg8::bf_lo(a.x) + pg8::bf_lo(bb.x)) * gelu_tanh(pg8::bf_lo(gg.x)), (pg8::bf_hi(a.x) + pg8::bf_hi(bb.x)) * gelu_tanh(pg8::bf_hi(gg.x)));
        w.y = pk2((pg8::bf_lo(a.y) + pg8::bf_lo(bb.y)) * gelu_tanh(pg8::bf_lo(gg.y)), (pg8::bf_hi(a.y) + pg8::bf_hi(bb.y)) * gelu_tanh(pg8::bf_hi(gg.y)));
        w.z = pk2((pg8::bf_lo(a.z) + pg8::bf_lo(bb.z)) * gelu_tanh(pg8::bf_lo(gg.z)), (pg8::bf_hi(a.z) + pg8::bf_hi(bb.z)) * gelu_tanh(pg8::bf_hi(gg.z)));
        w.w = pk2((pg8::bf_lo(a.w) + pg8::bf_lo(bb.w)) * gelu_tanh(pg8::bf_lo(gg.w)), (pg8::bf_hi(a.w) + pg8::bf_hi(bb.w)) * gelu_tanh(pg8::bf_hi(gg.w)));
        *(v4u*)(Y + (size_t)row * D + c0) = w; }
}


constexpr int RW_SLOT = 32768;
__device__ __forceinline__ void phase_lora_prep(const Frame& F, int L, int nw, int rk) {
    bf16* dst = (bf16*)(F.ws + WS_LORA);
    for (int idx = rk * 512 + F.tid; idx < 2 * 2 * 12 * 2048; idx += nw * 512) { const int col = idx & 2047, k8 = (idx >> 11) % 12, dw = idx / (12 * 2048);
        const float* src = (dw >> 1 ? F.a->in[I_RAUP] : F.a->in[I_RWUP]) + ((size_t)L * 2 + (dw & 1)) * 96 * 2048 + col; float v[8];
#pragma unroll
        for (int j = 0; j < 8; ++j) v[j] = src[(size_t)(k8 * 8 + j) * 2048];
        v4u w; w.x = pk2(v[0], v[1]); w.y = pk2(v[2], v[3]); w.z = pk2(v[4], v[5]); w.w = pk2(v[6], v[7]);
        *(v4u*)(dst + ((size_t)dw * 2048 + col) * 128 + k8 * 8) = w; }
}
__device__ __forceinline__ void phase_lora_in(const Frame& F, int L) {
    const bf16* P = (const bf16*)(F.ws + WS_P); bf16* LIN = (bf16*)(F.ws + WS_LIN);
    const float* mu = F.a->in[I_RMU] + (size_t)L * 6784 + 6144;
    for (int idx = F.bid * 512 + F.tid; idx < MROWS * 48; idx += F.G * 512) { const int row = idx / 48, g = idx - row * 48, d = g / 24, wa = (g % 24) / 12, k8 = (g % 12) * 8;
        const int col = (wa ? PAL : PWL) + d * 96 + k8; int pos, len; seq_pos(row, pos, len);
        const v4u x = *(const v4u*)(P + (size_t)row * NP + col); v4u xp = (v4u){0u, 0u, 0u, 0u}, xn = xp;
        if (pos > 0) xp = *(const v4u*)(P + (size_t)(row - 1) * NP + col);
        if (pos < len - 1) xn = *(const v4u*)(P + (size_t)(row + 1) * NP + col);
        const float* mp = mu + wa * 192 + d * 96 + k8; float o[8];
        const float xv[8] = {pg8::bf_lo(x.x), pg8::bf_hi(x.x), pg8::bf_lo(x.y), pg8::bf_hi(x.y), pg8::bf_lo(x.z), pg8::bf_hi(x.z), pg8::bf_lo(x.w), pg8::bf_hi(x.w)};
        const float pv[8] = {pg8::bf_lo(xp.x), pg8::bf_hi(xp.x), pg8::bf_lo(xp.y), pg8::bf_hi(xp.y), pg8::bf_lo(xp.z), pg8::bf_hi(xp.z), pg8::bf_lo(xp.w), pg8::bf_hi(xp.w)};
        const float nv[8] = {pg8::bf_lo(xn.x), pg8::bf_hi(xn.x), pg8::bf_lo(xn.y), pg8::bf_hi(xn.y), pg8::bf_lo(xn.z), pg8::bf_hi(xn.z), pg8::bf_lo(xn.w), pg8::bf_hi(xn.w)};
#pragma unroll
        for (int j = 0; j < 8; ++j) { const float sv = xv[j] + mp[j] * (0.5f * (pv[j] + nv[j]) - xv[j]); o[j] = wa ? sv : tanh_fast(sv); }
        v4u w; w.x = pk2(o[0], o[1]); w.y = pk2(o[2], o[3]); w.z = pk2(o[4], o[5]); w.w = pk2(o[6], o[7]);
        *(v4u*)(LIN + (size_t)row * 384 + d * 192 + wa * 96 + k8) = w; }
    bf16* SG = (bf16*)(F.ws + WS_SG); const float* mug = F.a->in[I_RMU] + (size_t)L * 6784 + 6144 + 384;
    for (int idx = F.bid * 512 + F.tid; idx < MROWS * 32; idx += F.G * 512) { const int row = idx >> 5, j8 = (idx & 31) * 8; int pos, len; seq_pos(row, pos, len);
        const v4u x = *(const v4u*)(P + (size_t)row * NP + PGL + j8); v4u xp = (v4u){0u, 0u, 0u, 0u}, xn = xp;
        if (pos > 0) xp = *(const v4u*)(P + (size_t)(row - 1) * NP + PGL + j8);
        if (pos < len - 1) xn = *(const v4u*)(P + (size_t)(row + 1) * NP + PGL + j8);
        const float* mp = mug + j8; float o[8];
        const float xv[8] = {pg8::bf_lo(x.x), pg8::bf_hi(x.x), pg8::bf_lo(x.y), pg8::bf_hi(x.y), pg8::bf_lo(x.z), pg8::bf_hi(x.z), pg8::bf_lo(x.w), pg8::bf_hi(x.w)};
        const float pv[8] = {pg8::bf_lo(xp.x), pg8::bf_hi(xp.x), pg8::bf_lo(xp.y), pg8::bf_hi(xp.y), pg8::bf_lo(xp.z), pg8::bf_hi(xp.z), pg8::bf_lo(xp.w), pg8::bf_hi(xp.w)};
        const float nv[8] = {pg8::bf_lo(xn.x), pg8::bf_hi(xn.x), pg8::bf_lo(xn.y), pg8::bf_hi(xn.y), pg8::bf_lo(xn.z), pg8::bf_hi(xn.z), pg8::bf_lo(xn.w), pg8::bf_hi(xn.w)};
#pragma unroll
        for (int j = 0; j < 8; ++j) o[j] = sigm(xv[j] + mp[j] * (0.5f * (pv[j] + nv[j]) - xv[j]));
        v4u w; w.x = pk2(o[0], o[1]); w.y = pk2(o[2], o[3]); w.z = pk2(o[4], o[5]); w.w = pk2(o[6], o[7]);
        *(v4u*)(SG + (size_t)row * 256 + j8) = w; }
}
__device__ __forceinline__ void phase_rwkv_pre(const Frame& F, int L) {
    const bf16* ydir = (const bf16*)(F.ws + WS_X1); bf16* Z = (bf16*)(F.ws + WS_Y3) + (size_t)MROWS * D;
    const float* bonus = (const float*)(F.ws + WS_BONUS); const bf16* P = (const bf16*)(F.ws + WS_P);
    const float* lnw = F.a->in[I_RLNW] + (size_t)L * 2048; const float* lnb = F.a->in[I_RLNB] + (size_t)L * 2048; const float* muv = F.a->in[I_RMU] + (size_t)L * 6784 + 4096;
    for (int row = F.bid * 8 + F.wave; row < MROWS; row += F.G * 8) {
        int lane = F.lane; asm volatile("" : "+v"(lane));
        int pos, len; seq_pos(row, pos, len);
#pragma unroll 2
        for (int i = 0; i < 4; ++i) { const int col = i * 512 + lane * 8, h = col >> 6;
            const v4u a = *(const v4u*)(ydir + (unsigned)(row * D + col)), bb = *(const v4u*)(ydir + (unsigned)((MROWS + row) * D + col));
            const v4u x = *(const v4u*)(P + (unsigned)(row * NP + PV + col)); v4u xp = (v4u){0u, 0u, 0u, 0u}, xn = xp;
            if (pos > 0) xp = *(const v4u*)(P + (unsigned)((row - 1) * NP + PV + col));
            if (pos < len - 1) xn = *(const v4u*)(P + (unsigned)((row + 1) * NP + PV + col));
            float y[8];
            y[0] = pg8::bf_lo(a.x) + pg8::bf_lo(bb.x); y[1] = pg8::bf_hi(a.x) + pg8::bf_hi(bb.x); y[2] = pg8::bf_lo(a.y) + pg8::bf_lo(bb.y); y[3] = pg8::bf_hi(a.y) + pg8::bf_hi(bb.y);
            y[4] = pg8::bf_lo(a.z) + pg8::bf_lo(bb.z); y[5] = pg8::bf_hi(a.z) + pg8::bf_hi(bb.z); y[6] = pg8::bf_lo(a.w) + pg8::bf_lo(bb.w); y[7] = pg8::bf_hi(a.w) + pg8::bf_hi(bb.w);
            float s1 = ((y[0] + y[1]) + (y[2] + y[3])) + ((y[4] + y[5]) + (y[6] + y[7]));
            s1 += DPPF(s1, 0xB1); s1 += DPPF(s1, 0x4E); s1 += DPPF(s1, 0x141);
            const float mean = s1 * (1.0f / 64.0f); float q = 0.f;
#pragma unroll
            for (int e = 0; e < 8; ++e) { const float dl = y[e] - mean; q += dl * dl; }
            q += DPPF(q, 0xB1); q += DPPF(q, 0x4E); q += DPPF(q, 0x141);
            const float rstd = rsqrtf(q * (1.0f / 64.0f) + 64e-5f);
            const float bon = bonus[(unsigned)(row * 32 + h)] + bonus[(unsigned)((MROWS + row) * 32 + h)];
            const f32x4 w0 = *(const f32x4*)(lnw + col), w1 = *(const f32x4*)(lnw + col + 4), b0 = *(const f32x4*)(lnb + col), b1 = *(const f32x4*)(lnb + col + 4), m0 = *(const f32x4*)(muv + col), m1 = *(const f32x4*)(muv + col + 4);
            const float xv[8] = {pg8::bf_lo(x.x), pg8::bf_hi(x.x), pg8::bf_lo(x.y), pg8::bf_hi(x.y), pg8::bf_lo(x.z), pg8::bf_hi(x.z), pg8::bf_lo(x.w), pg8::bf_hi(x.w)};
            const float pq[8] = {pg8::bf_lo(xp.x), pg8::bf_hi(xp.x), pg8::bf_lo(xp.y), pg8::bf_hi(xp.y), pg8::bf_lo(xp.z), pg8::bf_hi(xp.z), pg8::bf_lo(xp.w), pg8::bf_hi(xp.w)};
            const float nq[8] = {pg8::bf_lo(xn.x), pg8::bf_hi(xn.x), pg8::bf_lo(xn.y), pg8::bf_hi(xn.y), pg8::bf_lo(xn.z), pg8::bf_hi(xn.z), pg8::bf_lo(xn.w), pg8::bf_hi(xn.w)};
            const float lw[8] = {w0[0], w0[1], w0[2], w0[3], w1[0], w1[1], w1[2], w1[3]}, lb[8] = {b0[0], b0[1], b0[2], b0[3], b1[0], b1[1], b1[2], b1[3]}, mm[8] = {m0[0], m0[1], m0[2], m0[3], m1[0], m1[1], m1[2], m1[3]};
            float o[8];
#pragma unroll
            for (int e = 0; e < 8; ++e) { const float vv = xv[e] + mm[e] * (0.5f * (pq[e] + nq[e]) - xv[e]); o[e] = (y[e] - mean) * rstd * lw[e] + lb[e] + bon * vv; }
            v4u w; w.x = pk2(o[0], o[1]); w.y = pk2(o[2], o[3]); w.z = pk2(o[4], o[5]); w.w = pk2(o[6], o[7]);
            *(v4u*)(Z + (unsigned)(row * D + col)) = w; }
    }
}
#define SW64(row_, col_) ((row_) * 64 + ((col_) ^ (((row_) & 7) << 2)))
__device__ __forceinline__ void phase_rwkv_r1(const Frame& F, int L, int gq) {
    const bf16* P = (const bf16*)(F.ws + WS_P);
    float* bonus = (float*)(F.ws + WS_BONUS);
    const float* mu = F.a->in[I_RMU] + (size_t)L * 6784;
    const bf16* LoT = (const bf16*)(F.ws + WS_LORA); const bf16* LIN = (const bf16*)(F.ws + WS_LIN);
    unsigned char* scratch = F.ws + WS_X2;
    LAS3 unsigned char* B0 = F.lds;
    LAS3 bf16* LwB = (LAS3 bf16*)(B0 + 67584);
    LAS3 bf16* LaB = LwB + 64 * 136;
    LAS3 float* NT = (LAS3 float*)B0;
    LAS3 bf16* MkaT = (LAS3 bf16*)(B0 + 16384);
    LAS3 bf16* MbrT = (LAS3 bf16*)(B0 + 25600);
    LAS3 float* Wl = (LAS3 float*)(B0 + 34816);
    LAS3 float* As = (LAS3 float*)(B0 + 51200);
    LAS3 bf16* MkrT = (LAS3 bf16*)(B0 + 51200);
    LAS3 bf16* At = (LAS3 bf16*)(B0 + 67584);
    LAS3 bf16* Bt = At + 64 * 72; LAS3 bf16* Kt = Bt + 64 * 72; LAS3 bf16* Rt = Kt + 64 * 72; LAS3 bf16* BtT = Rt + 64 * 72; LAS3 bf16* KtT = BtT + 64 * 72; LAS3 bf16* Vt = KtT + 64 * 72;
    LAS3 bf16* Ap = (LAS3 bf16*)(B0 + 132096);
    LAS3 bf16* W1 = Ap + 64 * 72;
    LAS3 float* CX = (LAS3 float*)(B0 + 132096);
    LAS3 float* PC = (LAS3 float*)(B0 + 150528);
    LAS3 float* SEG = PC + 64;
    LAS3 bf16* RL = (LAS3 bf16*)(B0 + 67584);
    LAS3 bf16* RKV = (LAS3 bf16*)B0;
    v4u pl[4], pr[4];
#define R1_FETCH(cl__, WHICH) do { const int cl_ = (cl__), c_ = gq * 33 + cl_, d_ = d, h_ = h, b_ = b; \
        const int r0_ = chain_row(b_, d_, c_ * 64), rmin_ = d_ ? r0_ - 63 : r0_; int pos_, len_; seq_pos(rmin_, pos_, len_); \
        int tid_ = F.tid; asm volatile("" : "+v"(tid_)); \
        _Pragma("unroll") for (int i_ = 0; i_ < 4; ++i_) { const int idx_ = tid_ + 512 * i_, rr_ = idx_ / 24, g_ = idx_ - rr_ * 24; \
            const bool ok_ = idx_ < 1584 && ((rr_ >= 1 && rr_ <= 64) || (rr_ == 0 && pos_ > 0) || (rr_ == 65 && pos_ + 64 < len_)); \
            const unsigned ro_ = (unsigned)((rmin_ - 1 + rr_) * NP); \
            if (WHICH == 0) { if (i_ < 3) { const int t_ = idx_ / 24, q_ = idx_ - t_ * 24; pl[i_] = *(const v4u*)(LIN + (unsigned)(CROW(r0_, d_, t_) * 384 + d_ * 192 + q_ * 8)); } } \
            else { const int cr2_ = (g_ < 8 ? PR : (g_ < 16 ? PK - 64 : PV - 128)) + h_ * 64 + g_ * 8; pr[i_] = ok_ ? *(const v4u*)(P + ro_ + cr2_) : (v4u){0u, 0u, 0u, 0u}; } } } while (0)
    LAS3 bf16* NTb = (LAS3 bf16*)(B0 + 153600);
    LAS3 bf16* DTb = (LAS3 bf16*)(B0 + 150784);
    LAS3 bf16* Wsc = (LAS3 bf16*)(B0 + 16384);
    LAS3 float* MU = SEG + 512;
#pragma unroll 1
    for (int chn = F.bid >> 1; chn < 128; chn += F.G >> 1) {
    const int d = chn & 1, h = (chn >> 1) & 31, b = chn >> 6, cl0 = (F.bid & 1) * 17, cl1 = (F.bid & 1) ? 33 : 17;
    __syncthreads();
    for (int i = F.tid; i < 192; i += 512) MU[i] = mu[6144 + (i < 96 ? 0 : 192 - 96) + d * 96 + i];
    bf16x8 wfr[3]; f32x4 lbias; float mur, muk, muv, kkw, kaw, rkw;
    { const int wa0 = F.wave >> 2, nt0 = F.wave & 3, fr0 = F.lane & 15, fq0 = F.lane >> 4;
#pragma unroll
      for (int ks = 0; ks < 3; ++ks) wfr[ks] = ldfrag_g(LoT + (size_t)(wa0 * 2 + d) * 2048 * 128, 128, h * 64 + nt0 * 16, ks * 32, fr0, fq0);
      lbias = *(const f32x4*)((wa0 ? F.a->in[I_RA0] : F.a->in[I_RW0]) + ((size_t)L * 2 + d) * 2048 + h * 64 + nt0 * 16 + 4 * fq0);
      const int col0 = h * 64 + F.lane;
      mur = mu[col0]; muk = mu[2048 + col0]; muv = mu[4096 + col0];
      kkw = F.a->in[I_RKK][(size_t)L * 2048 + col0]; kaw = F.a->in[I_RKA][(size_t)L * 2048 + col0]; rkw = F.a->in[I_RRK][(size_t)L * 2048 + col0]; }
    R1_FETCH(cl0, 0); R1_FETCH(cl0, 1);
    __syncthreads();
    for (int cl = cl0; cl < cl1; ++cl) {
        int tid = F.tid; asm volatile("" : "+v"(tid));
        const int lane = tid & 63, wave = __builtin_amdgcn_readfirstlane(tid >> 6), fr = lane & 15, fq = lane >> 4;
        const int c = gq * 33 + cl, unit = chn * 33 + cl;
        unsigned char* slot = scratch + (size_t)unit * RW_SLOT;
#pragma unroll
        for (int i = 0; i < 3; ++i) { const int idx = tid + 512 * i, t = idx / 24, q = idx - t * 24; *(LAS3 v4u*)((q >= 12 ? LaB + (q - 12) * 8 : LwB + q * 8) + t * 136) = pl[i]; }
#pragma unroll
        for (int i = 0; i < 4; ++i) { const int idx = tid + 512 * i, rr = idx / 24, g = idx - rr * 24; if (idx < 1584) *(LAS3 v4u*)(RKV + rr * 200 + g * 8) = pr[i]; }
        LBAR();
        { const int wa = wave >> 2, nt = wave & 3; f32x4 acc[4];
#pragma unroll
          for (int mt = 0; mt < 4; ++mt) acc[mt] = (f32x4){0.f, 0.f, 0.f, 0.f};
          LAS3 bf16* Xs = wa ? LaB : LwB;
#pragma unroll
          for (int ks = 0; ks < 3; ++ks)
#pragma unroll
              for (int mt = 0; mt < 4; ++mt) MMA_TRN(acc[mt], ldfrag(Xs, 136, mt * 16, ks * 32, fr, fq), wfr[ks]);
          if (wa) {
#pragma unroll
              for (int mt = 0; mt < 4; ++mt) { f32x4 o;
#pragma unroll
                  for (int e = 0; e < 4; ++e) o[e] = sigm(acc[mt][e] + lbias[e]);
                  *(LAS3 f32x4*)(As + SW64(mt * 16 + fr, nt * 16 + 4 * fq)) = o; } }
          else { f32x4 run = (f32x4){0.f, 0.f, 0.f, 0.f};
#pragma unroll
              for (int mt = 0; mt < 4; ++mt) { f32x4 inc, exc;
#pragma unroll
                  for (int e = 0; e < 4; ++e) { const float lw = -__expf(-softplus_fast(-(acc[mt][e] + lbias[e])) - 0.5f);
                      float v = lw; v += DPPF(v, 0x111); v += DPPF(v, 0x112); v += DPPF(v, 0x114); v += DPPF(v, 0x118);
                      inc[e] = v + run[e]; exc[e] = inc[e] - lw;
                      float tot = lw; tot += DPPF(tot, 0xB1); tot += DPPF(tot, 0x4E); tot += DPPF(tot, 0x141); tot += DPPF(tot, 0x140);
                      run[e] += tot; }
                  *(LAS3 f32x4*)(Wl + SW64(mt * 16 + fr, nt * 16 + 4 * fq)) = inc; *(LAS3 f32x4*)(CX + SW64(mt * 16 + fr, nt * 16 + 4 * fq)) = exc; }
              if (fr == 0) { f32x4 pc; pc[0] = __expf(run[0]); pc[1] = __expf(run[1]); pc[2] = __expf(run[2]); pc[3] = __expf(run[3]); *(LAS3 f32x4*)(PC + nt * 16 + 4 * fq) = pc; } } }
        LBAR();
        { const int ch = lane; const int rr0 = d ? 64 - wave * 8 : 1 + wave * 8, st = d ? -1 : 1;
          const LAS3 bf16* qb = RKV + ch;
          float rp = bf2f(qb[(rr0 - st) * 200]), kp = bf2f(qb[(rr0 - st) * 200 + 64]), vp = bf2f(qb[(rr0 - st) * 200 + 128]);
          float rc = bf2f(qb[rr0 * 200]), kc = bf2f(qb[rr0 * 200 + 64]), vc = bf2f(qb[rr0 * 200 + 128]);
          const int r0c = chain_row(b, d, c * 64);
          v4u bT, kT, vT; float bq = 0.f, kq = 0.f, vq = 0.f;
#pragma unroll
          for (int i = 0; i < 8; ++i) { const int t = wave * 8 + i; const int row = CROW(r0c, d, t); const int rn = rr0 + st * (i + 1);
              const float rx = bf2f(qb[rn * 200]), kx = bf2f(qb[rn * 200 + 64]), vx = bf2f(qb[rn * 200 + 128]);
              const float r = rc + mur * (0.5f * (rp + rx) - rc), k = kc + muk * (0.5f * (kp + kx) - kc), v = vc + muv * (0.5f * (vp + vx) - vc);
              rp = rc; kp = kc; vp = vc; rc = rx; kc = kx; vc = vx;
              const float asig = As[SW64(t, ch)], cv = Wl[SW64(t, ch)], cx = CX[SW64(t, ch)];
              const float kkv = k * kkw, n2 = wave_sum(kkv * kkv), kk = kkv * rsqrtf(n2 + 1e-12f);
              const float key = k * (1.0f + (asig - 1.0f) * kaw);
              const float bon = wave_sum(r * key * rkw);
              if (ch == 0) bonus[(unsigned)((d * MROWS + row) * 32 + h)] = bon;
              const float ep = __expf(cv), em = __expf(-cv), ex = __expf(cx);
              const float bf_ = kk * asig * em, kf_ = key * em;
              const bf16 a_ = f2bf(-kk * ex), b_ = f2bf(bf_), k_ = f2bf(kf_), r_ = f2bf(r * ep);
              At[t * 72 + ch] = a_; Bt[t * 72 + ch] = b_; Kt[t * 72 + ch] = k_; Rt[t * 72 + ch] = r_;
              if (i & 1) { bT[i >> 1] = pk2(bq, bf_); kT[i >> 1] = pk2(kq, kf_); vT[i >> 1] = pk2(vq, v); } else { bq = bf_; kq = kf_; vq = v; } }
          *(LAS3 v4u*)(BtT + ch * 72 + wave * 8) = bT; *(LAS3 v4u*)(KtT + ch * 72 + wave * 8) = kT; *(LAS3 v4u*)(Vt + ch * 72 + wave * 8) = vT; }
        LBAR();
        for (int i = tid; i < 18432 / 16; i += 512) ((LAS3 v4u*)Ap)[i] = (v4u){0u, 0u, 0u, 0u};
        { const int q = wave >> 1, hf = wave & 1; LAS3 bf16* Xs = q < 2 ? At : Rt; LAS3 bf16* Ys = (q & 1) ? Kt : Bt;
#pragma unroll
          for (int mi = 0; mi < 2; ++mi) { const int mt = hf * 2 + mi; f32x4 acc[4];
#pragma unroll
              for (int nt = 0; nt < 4; ++nt) acc[nt] = (f32x4){0.f, 0.f, 0.f, 0.f};
#pragma unroll
              for (int ks = 0; ks < 2; ++ks) { const bf16x8 a = ldfrag(Xs, 72, mt * 16, ks * 32, fr, fq);
#pragma unroll
                  for (int nt = 0; nt < 4; ++nt) MMA_TRN(acc[nt], a, ldfrag(Ys, 72, nt * 16, ks * 32, fr, fq)); }
              const int t = mt * 16 + fr;
#pragma unroll
              for (int nt = 0; nt < 4; ++nt) { const int i0 = nt * 16 + 4 * fq; f32x4 o;
#pragma unroll
                  for (int e = 0; e < 4; ++e) { const int i = i0 + e; const bool keep = q < 2 ? (i < t) : (i <= t); o[e] = keep ? acc[nt][e] : 0.f; }
                  if (q == 0) { *(LAS3 f32x4*)(NT + SW64(t, i0)) = o; const bool offd = nt != mt; v2u w; w.x = offd ? pk2(o[0], o[1]) : 0u; w.y = offd ? pk2(o[2], o[3]) : 0u; *(LAS3 v2u*)(NTb + t * 72 + i0) = w; }
                  else { v2u w; w.x = pk2(o[0], o[1]); w.y = pk2(o[2], o[3]); *(LAS3 v2u*)((q == 1 ? MkaT : (q == 2 ? MbrT : MkrT)) + t * 72 + i0) = w; } } } }
        LBAR();
        if (wave > 0) {
            for (int tile = wave - 1; tile < 16; tile += 7) { const int mt = tile >> 2, nt = tile & 3; f32x4 acc = (f32x4){0.f, 0.f, 0.f, 0.f};
#pragma unroll
                for (int ks = 0; ks < 2; ++ks) MMA_TRN(acc, ldfrag(Vt, 72, mt * 16, ks * 32, fr, fq), ldfrag(MkaT, 72, nt * 16, ks * 32, fr, fq));
                *(LAS3 f32x4*)(Wl + SW64(mt * 16 + fr, nt * 16 + 4 * fq)) = acc; } }
        else { const int J = lane >> 4, cc = lane & 15; float z[16];
#pragma unroll
            for (int t = 0; t < 16; ++t) { float acc = t == cc ? 1.0f : 0.f;
#pragma unroll
                for (int i4 = 0; i4 < (t + 3) / 4; ++i4) { const f32x4 nv = *(const LAS3 f32x4*)(NT + SW64(J * 16 + t, J * 16 + i4 * 4));
#pragma unroll
                    for (int e = 0; e < 4; ++e) if (i4 * 4 + e < t) acc += nv[e] * z[i4 * 4 + e]; }
                z[t] = acc; DTb[(J * 16 + t) * 16 + cc] = f2bf(acc); } }
        LBAR();
        { LAS3 bf16* Ws = Wsc + wave * 256; const int r = wave * 16 + fr;
#pragma unroll
          for (int J = 0; J < 4; ++J) { f32x4 acc = (f32x4){0.f, 0.f, 0.f, 0.f};
              if (J > 0) {
#pragma unroll
                  for (int ks = 0; ks < (J + 1) / 2; ++ks) MMA_TRN(acc, ldfrag(Ap, 72, wave * 16, ks * 32, fr, fq), ldfrag(NTb, 72, J * 16, ks * 32, fr, fq)); }
              const int t0 = J * 16 + 4 * fq;
              if (wave < 4) { acc[0] += bf2f(At[(t0 + 0) * 72 + r]); acc[1] += bf2f(At[(t0 + 1) * 72 + r]); acc[2] += bf2f(At[(t0 + 2) * 72 + r]); acc[3] += bf2f(At[(t0 + 3) * 72 + r]); }
              else acc += *(const LAS3 f32x4*)(Wl + SW64(r - 64, t0));
              { v2u w; w.x = pk2(acc[0], acc[1]); w.y = pk2(acc[2], acc[3]); *(LAS3 v2u*)(Ws + fr * 16 + 4 * fq) = w; }
              asm volatile("s_waitcnt lgkmcnt(0)" ::: "memory");
              const bf16x8 zero8 = (bf16x8){0, 0, 0, 0, 0, 0, 0, 0};
              const bf16x8 wf = fq < 2 ? *(const LAS3 bf16x8*)(Ws + fr * 16 + 8 * fq) : zero8;
              const bf16x8 zf = fq < 2 ? *(const LAS3 bf16x8*)(DTb + (J * 16 + fr) * 16 + 8 * fq) : zero8;
              f32x4 x = (f32x4){0.f, 0.f, 0.f, 0.f};
              MMA_TRN(x, wf, zf);
              { v2u w; w.x = pk2(x[0], x[1]); w.y = pk2(x[2], x[3]); *(LAS3 v2u*)(Ap + r * 72 + t0) = w; }
              asm volatile("s_waitcnt lgkmcnt(0)" ::: "memory"); } }
        LBAR();
        if (cl + 1 < cl1) { R1_FETCH(cl + 1, 0); R1_FETCH(cl + 1, 1); }
        { const int o = wave >> 1, hf = wave & 1;
#pragma unroll
          for (int mi = 0; mi < 2; ++mi) { const int mt = hf * 2 + mi; f32x4 acc[4];
#pragma unroll
              for (int nt = 0; nt < 4; ++nt) acc[nt] = (f32x4){0.f, 0.f, 0.f, 0.f};
              if (o < 2) {
                  LAS3 bf16* Xs = o == 0 ? MbrT : BtT;
#pragma unroll
                  for (int ks = 0; ks < 2; ++ks) { const bf16x8 a = ldfrag(Xs, 72, mt * 16, ks * 32, fr, fq);
#pragma unroll
                      for (int nt = 0; nt < 4; ++nt) MMA_TRN(acc[nt], a, ldfrag(Ap, 72, nt * 16, ks * 32, fr, fq)); }
                  const int m = mt * 16 + fr; const float pc = o == 1 ? PC[m] : 1.0f; v4u wq;
#pragma unroll
                  for (int nt = 0; nt < 4; ++nt) { const int k0 = nt * 16 + 4 * fq; float v[4];
                      if (o == 0) { const v2u rr = *(const LAS3 v2u*)(Rt + m * 72 + k0); v[0] = acc[nt][0] + pg8::bf_lo(rr.x); v[1] = acc[nt][1] + pg8::bf_hi(rr.x); v[2] = acc[nt][2] + pg8::bf_lo(rr.y); v[3] = acc[nt][3] + pg8::bf_hi(rr.y); }
                      else {
#pragma unroll
                          for (int e = 0; e < 4; ++e) v[e] = (acc[nt][e] + ((k0 + e) == m ? 1.0f : 0.f)) * pc; }
                      if ((nt & 1) == 0) { wq.x = pk2(v[0], v[1]); wq.y = pk2(v[2], v[3]); }
                      else { wq.z = pk2(v[0], v[1]); wq.w = pk2(v[2], v[3]);
                          *(v4u*)(slot + (o == 0 ? 8192 : 0) + (size_t)(((mt * 2 + (nt >> 1)) * 64 + fq * 16 + fr) * 16)) = wq; } } }
              else {
                  LAS3 bf16* X1 = o == 2 ? BtT : MbrT; LAS3 bf16* X2 = o == 2 ? KtT : MkrT;
#pragma unroll
                  for (int ks = 0; ks < 2; ++ks) { const bf16x8 a1 = ldfrag(X1, 72, mt * 16, ks * 32, fr, fq), a2 = ldfrag(X2, 72, mt * 16, ks * 32, fr, fq);
#pragma unroll
                      for (int nt = 0; nt < 4; ++nt) { MMA_STD(acc[nt], a1, ldfrag(W1, 72, nt * 16, ks * 32, fr, fq)); MMA_STD(acc[nt], a2, ldfrag(Vt, 72, nt * 16, ks * 32, fr, fq)); } }
                  float pc[4];
#pragma unroll
                  for (int e = 0; e < 4; ++e) pc[e] = o == 2 ? PC[mt * 16 + 4 * fq + e] : 1.0f;
#pragma unroll
                  for (int nt = 0; nt < 4; ++nt) { v2u w; w.x = pk2(acc[nt][0] * pc[0], acc[nt][1] * pc[1]); w.y = pk2(acc[nt][2] * pc[2], acc[nt][3] * pc[3]);
                      *(v2u*)(slot + (o == 2 ? 16384 : 24576) + (size_t)(((nt * 4 + mt) * 64 + lane) * 8)) = w; } } } }
        LBAR();
    }
    }
}
#undef R1_FETCH
__device__ __forceinline__ void phase_rwkv_r2(const Frame& F, int gq) {
    const unsigned char* scratch = F.ws + WS_X2; bf16* ydir = (bf16*)(F.ws + WS_X1);
    f32x4* state = (f32x4*)(F.ws + WS_LAGG);
    const int fr = F.lane & 15, fq = F.lane >> 4, tl = F.wave >> 2, mt = F.wave & 3;
    LAS3 unsigned char* XS = F.lds + tl * 4096;
    for (int tb = F.bid; tb < 256; tb += F.G) {
        const int chn = (tb & 7) * 16 + (tb >> 4), vt = ((tb >> 3) & 1) * 2 + tl, task = chn * 4 + vt, d = chn & 1, h = (chn >> 1) & 31, b = chn >> 6;
        f32x4 S = gq == 0 ? (f32x4){0.f, 0.f, 0.f, 0.f} : state[((size_t)task * 4 + mt) * 64 + F.lane];
        { v2u w; w.x = pk2(S[0], S[1]); w.y = pk2(S[2], S[3]); *(LAS3 v2u*)(XS + (F.lane * 4 + mt) * 8) = w; }
        bf16x8 Tq[4][2], Rq[4][2]; v2u Sq[4], Yq[4];
#define R2_LOAD(cl_, q_) do { const unsigned char* slot_ = scratch + ((size_t)chn * 33 + (cl_)) * RW_SLOT; \
            Tq[q_][0] = *(const bf16x8*)(slot_ + ((mt * 2 + 0) * 64 + F.lane) * 16); Tq[q_][1] = *(const bf16x8*)(slot_ + ((mt * 2 + 1) * 64 + F.lane) * 16); \
            Rq[q_][0] = *(const bf16x8*)(slot_ + 8192 + ((mt * 2 + 0) * 64 + F.lane) * 16); Rq[q_][1] = *(const bf16x8*)(slot_ + 8192 + ((mt * 2 + 1) * 64 + F.lane) * 16); \
            Sq[q_] = *(const v2u*)(slot_ + 16384 + ((vt * 4 + mt) * 64 + F.lane) * 8); Yq[q_] = *(const v2u*)(slot_ + 24576 + ((vt * 4 + mt) * 64 + F.lane) * 8); } while (0)
#pragma unroll
        for (int q = 0; q < 4; ++q) R2_LOAD(q, q);
        LBAR();
#define R2_STEP(cl_, q_) do { const int cl = (cl_); const LAS3 unsigned char* xr = XS + ((q_) & 1) * 2048 + F.lane * 32; \
            const v4u x0 = *(const LAS3 v4u*)xr, x1 = *(const LAS3 v4u*)(xr + 16); \
            const bf16x8 Sb0 = __builtin_bit_cast(bf16x8, x0), Sb1 = __builtin_bit_cast(bf16x8, x1); \
            f32x4 ya = (f32x4){pg8::bf_lo(Yq[q_].x), pg8::bf_hi(Yq[q_].x), pg8::bf_lo(Yq[q_].y), pg8::bf_hi(Yq[q_].y)}; \
            f32x4 sn = (f32x4){pg8::bf_lo(Sq[q_].x), pg8::bf_hi(Sq[q_].x), pg8::bf_lo(Sq[q_].y), pg8::bf_hi(Sq[q_].y)}; \
            MMA_STD(sn, Tq[q_][0], Sb0); MMA_STD(sn, Tq[q_][1], Sb1); MMA_STD(ya, Rq[q_][0], Sb0); MMA_STD(ya, Rq[q_][1], Sb1); \
            { v2u w; w.x = pk2(sn[0], sn[1]); w.y = pk2(sn[2], sn[3]); *(LAS3 v2u*)(XS + (((q_) + 1) & 1) * 2048 + (F.lane * 4 + mt) * 8) = w; } \
            S = sn; \
            if (cl + 4 < 33) R2_LOAD(cl + 4, q_); \
            { const int r0s = chain_row(b, d, (gq * 33 + cl) * 64); const unsigned yo = (unsigned)((d * MROWS + r0s) * D + h * 64 + vt * 16 + fr) * 2u; const int ys = d ? -(int)(D * 2) : (int)(D * 2); \
              _Pragma("unroll") for (int e = 0; e < 4; ++e) { const int t = mt * 16 + 4 * fq + e; *(bf16*)((char*)ydir + (unsigned)(yo + (unsigned)(ys * t))) = f2bf(ya[e]); } } \
            LBAR(); } while (0)
#pragma unroll 1
        for (int c0 = 0; c0 < 32; c0 += 4) { R2_STEP(c0, 0); R2_STEP(c0 + 1, 1); R2_STEP(c0 + 2, 2); R2_STEP(c0 + 3, 3); }
        R2_STEP(32, 0);
#undef R2_STEP
        if (gq < 3) state[((size_t)task * 4 + mt) * 64 + F.lane] = S;
    }
#undef R2_LOAD
}

__device__ __forceinline__ void phase_ssm_conv(const Frame& F, int L) {
    const bf16* P = (const bf16*)(F.ws + WS_P); bf16* XA = (bf16*)(F.ws + WS_X2);
    const float* cw = F.a->in[I_SCW] + (size_t)L * 4 * 3072; const float* cb = F.a->in[I_SCB] + (size_t)L * 3072;
    for (int gI = F.bid * 512 + F.tid; gI < (MROWS / 8) * 384; gI += F.G * 512) { const int rb = gI / 384, col = (gI - rb * 384) * 8, row0 = rb * 8;
        int pos0, len; seq_pos(row0, pos0, len);
        float w[4][8], bias[8];
#pragma unroll
        for (int tap = 0; tap < 4; ++tap) { const f32x4 a0 = *(const f32x4*)(cw + tap * 3072 + col), a1 = *(const f32x4*)(cw + tap * 3072 + col + 4);
            w[tap][0] = a0[0]; w[tap][1] = a0[1]; w[tap][2] = a0[2]; w[tap][3] = a0[3]; w[tap][4] = a1[0]; w[tap][5] = a1[1]; w[tap][6] = a1[2]; w[tap][7] = a1[3]; }
        { const f32x4 a0 = *(const f32x4*)(cb + col), a1 = *(const f32x4*)(cb + col + 4); bias[0] = a0[0]; bias[1] = a0[1]; bias[2] = a0[2]; bias[3] = a0[3]; bias[4] = a1[0]; bias[5] = a1[1]; bias[6] = a1[2]; bias[7] = a1[3]; }
        v4u win[3];
#pragma unroll
        for (int k = 0; k < 3; ++k) { const int q = pos0 + k - 2; win[k] = (q >= 0 && q < len) ? *(const v4u*)(P + (unsigned)((row0 + k - 2) * NP + PX + col)) : (v4u){0u, 0u, 0u, 0u}; }
#pragma unroll
        for (int r = 0; r < 8; ++r) { const int q = pos0 + r + 1; const v4u nx = (q < len) ? *(const v4u*)(P + (unsigned)((row0 + r + 1) * NP + PX + col)) : (v4u){0u, 0u, 0u, 0u};
            float o[8];
#pragma unroll
            for (int e = 0; e < 8; ++e) o[e] = bias[e];
            const v4u tp[4] = {win[0], win[1], win[2], nx};
#pragma unroll
            for (int tap = 0; tap < 4; ++tap) { const v4u x = tp[tap];
                o[0] += w[tap][0] * pg8::bf_lo(x.x); o[1] += w[tap][1] * pg8::bf_hi(x.x); o[2] += w[tap][2] * pg8::bf_lo(x.y); o[3] += w[tap][3] * pg8::bf_hi(x.y);
                o[4] += w[tap][4] * pg8::bf_lo(x.z); o[5] += w[tap][5] * pg8::bf_hi(x.z); o[6] += w[tap][6] * pg8::bf_lo(x.w); o[7] += w[tap][7] * pg8::bf_hi(x.w); }
            v4u wv; wv.x = pk2(siluf(o[0]), siluf(o[1])); wv.y = pk2(siluf(o[2]), siluf(o[3])); wv.z = pk2(siluf(o[4]), siluf(o[5])); wv.w = pk2(siluf(o[6]), siluf(o[7]));
            *(v4u*)(XA + (unsigned)((row0 + r) * 3072 + col)) = wv;
            win[0] = win[1]; win[1] = win[2]; win[2] = nx; }
    }
}
template <int PITCH> __device__ __forceinline__ unsigned tr_addr(const LAS3 bf16* M, int r0, int k0, int lane) {
    const int g = lane >> 4, q = (lane & 15) >> 2, p = lane & 3; return (unsigned)(size_t)(M + (k0 + 8 * g + q) * PITCH + r0 + 4 * p); }
__device__ __forceinline__ bf16x8 tr_pack(v2u lo, v2u hi) { v4u w; w.x = lo.x; w.y = lo.y; w.z = hi.x; w.w = hi.y; return __builtin_bit_cast(bf16x8, w); }
#define TRS2(x) #x
#define TRS(x) TRS2(x)
__device__ __forceinline__ void phase_ssm_chain(const Frame& F, int L) {
    const bf16* P = (const bf16*)(F.ws + WS_P); const bf16* XA = (const bf16*)(F.ws + WS_X2);
    bf16* ydir = (bf16*)(F.ws + WS_X1);
    constexpr int SET = 54784;
    LAS3 bf16* Hb = (LAS3 bf16*)(F.lds + 2 * SET);
    const int fr = F.lane & 15, fq = F.lane >> 4;
#define SS_PTRS(set_) LAS3 bf16* Cb = (LAS3 bf16*)(F.lds + (set_) * SET); LAS3 bf16* Bb = Cb + 64 * 136; LAS3 bf16* Sc = Bb + 64 * 136; \
        LAS3 bf16* Xr = Sc + 64 * 72; LAS3 bf16* Xd = Xr + 64 * 40; LAS3 float* cum = (LAS3 float*)(Xd + 64 * 40); LAS3 float* dtj = cum + 64; (void)Cb; (void)Bb; (void)Sc; (void)Xr; (void)Xd; (void)cum; (void)dtj
    for (int unit = F.bid; unit < 256; unit += F.G) {
        const int b = unit >> 7, h = (unit >> 2) & 31, d = (unit >> 1) & 1, ph = unit & 1, g = h >> 3;
        const float Ad = -__expf(F.a->in[I_SALOG][(L * 2 + d) * 32 + h]); const float dtb = F.a->in[I_SDTB][(L * 2 + d) * 32 + h];
        const int xcol = h * 64 + ph * 32;
        for (int i = F.tid; i < 32 * 136 / 2; i += 512) ((LAS3 unsigned*)Hb)[i] = 0u;
        f32x4 hacc[2]; hacc[0] = (f32x4){0.f, 0.f, 0.f, 0.f}; hacc[1] = hacc[0];
        v4u nb[4], nx; float ndt = 0.f;
#define SS_LOAD(c_) do { const int r0l_ = chain_row(b, d, (c_) * 64); \
            _Pragma("unroll") for (int i_ = 0; i_ < 4; ++i_) { const int gI_ = F.tid + 512 * i_, j_ = gI_ >> 5, q_ = gI_ & 31; const int row_ = CROW(r0l_, d, j_); \
                const int col_ = q_ < 16 ? 2048 + g * 128 + q_ * 8 : 2560 + g * 128 + (q_ - 16) * 8; nb[i_] = *(const v4u*)(XA + (unsigned)(row_ * 3072 + col_)); } \
            if (F.tid < 256) { const int j_ = F.tid >> 2, q_ = F.tid & 3; const int row_ = CROW(r0l_, d, j_); nx = *(const v4u*)(XA + (unsigned)(row_ * 3072 + xcol + q_ * 8)); } \
            if (F.wave == 4) { const int row_ = CROW(r0l_, d, F.lane); ndt = bf2f(P[(unsigned)(row_ * NP + PDT + d * 32 + h)]); } } while (0)
#define SS_FRONT1(set_) do { SS_PTRS(set_); \
            _Pragma("unroll") for (int i_ = 0; i_ < 4; ++i_) { const int gI_ = F.tid + 512 * i_, j_ = gI_ >> 5, q_ = gI_ & 31; \
                *(LAS3 v4u*)((q_ < 16 ? Bb + q_ * 8 : Cb + (q_ - 16) * 8) + j_ * 136) = nb[i_]; } \
            if (F.tid < 256) { const int j_ = F.tid >> 2, q_ = F.tid & 3; *(LAS3 v4u*)(Xr + j_ * 40 + q_ * 8) = nx; } \
            if (F.wave == 4) { const float dtv_ = softplusf(ndt + dtb); const float v_ = wave_scan(dtv_ * Ad, F.lane); cum[F.lane] = v_; dtj[F.lane] = dtv_; } } while (0)
#define SS_FRONT2(set_) do { SS_PTRS(set_); \
            { const int mt_ = F.wave >> 1; f32x4 acc_[2]; acc_[0] = (f32x4){0.f, 0.f, 0.f, 0.f}; acc_[1] = acc_[0]; \
              _Pragma("unroll") for (int ks_ = 0; ks_ < 4; ++ks_) { const bf16x8 a_ = ldfrag(Cb, 136, mt_ * 16, ks_ * 32, fr, fq); \
                  _Pragma("unroll") for (int x_ = 0; x_ < 2; ++x_) { const bf16x8 bb_ = ldfrag(Bb, 136, ((F.wave & 1) * 2 + x_) * 16, ks_ * 32, fr, fq); MMA_TRN(acc_[x_], a_, bb_); } } \
              const int i_ = mt_ * 16 + fr; const float ci_ = cum[i_]; \
              _Pragma("unroll") for (int x_ = 0; x_ < 2; ++x_) { const int j0_ = ((F.wave & 1) * 2 + x_) * 16 + 4 * fq; float sc_[4]; \
                  _Pragma("unroll") for (int e_ = 0; e_ < 4; ++e_) { const int jj_ = j0_ + e_; sc_[e_] = jj_ <= i_ ? acc_[x_][e_] * __expf(ci_ - cum[jj_]) * dtj[jj_] : 0.f; } \
                  v2u w_; w_.x = pk2(sc_[0], sc_[1]); w_.y = pk2(sc_[2], sc_[3]); *(LAS3 v2u*)(Sc + i_ * 72 + j0_) = w_; } } \
            { const int j_ = F.tid >> 3, p0_ = (F.tid & 7) * 4; const float f_ = dtj[j_] * __expf(cum[63] - cum[j_]); const v2u xv_ = *(const LAS3 v2u*)(Xr + j_ * 40 + p0_); \
              v2u w_; w_.x = pk2(pg8::bf_lo(xv_.x) * f_, pg8::bf_hi(xv_.x) * f_); w_.y = pk2(pg8::bf_lo(xv_.y) * f_, pg8::bf_hi(xv_.y) * f_); *(LAS3 v2u*)(Xd + j_ * 40 + p0_) = w_; } } while (0)
        SS_LOAD(0);
        __syncthreads();
        SS_FRONT1(0);
        SS_LOAD(1);
        LBAR();
        SS_FRONT2(0);
        LBAR();
        for (int c = 0; c < 132; ++c) {
            const int cur = c & 1;
            if (c + 1 < 132) { SS_FRONT1(cur ^ 1); if (c + 2 < 132) SS_LOAD(c + 2); }
            { SS_PTRS(cur);
              const int nt_y = F.wave & 1, mt_s = F.wave >> 2, nt_s = (F.wave & 3) * 2;
              const unsigned ax = tr_addr<40>(Xr, nt_y * 16, 0, F.lane), ad_ = tr_addr<40>(Xd, mt_s * 16, 0, F.lane), ab = tr_addr<136>(Bb, nt_s * 16, 0, F.lane);
              v2u t0, t1, t2, t3, t4, t5, t6, t7, t8, t9, t10, t11, t12, t13, t14, t15;
              asm volatile("ds_read_b64_tr_b16 %0, %16\n\tds_read_b64_tr_b16 %1, %16 offset:" TRS(4 * 40 * 2) "\n\tds_read_b64_tr_b16 %2, %16 offset:" TRS(32 * 40 * 2) "\n\tds_read_b64_tr_b16 %3, %16 offset:" TRS(36 * 40 * 2) "\n\t"
                           "ds_read_b64_tr_b16 %4, %17\n\tds_read_b64_tr_b16 %5, %17 offset:" TRS(4 * 40 * 2) "\n\tds_read_b64_tr_b16 %6, %17 offset:" TRS(32 * 40 * 2) "\n\tds_read_b64_tr_b16 %7, %17 offset:" TRS(36 * 40 * 2) "\n\t"
                           "ds_read_b64_tr_b16 %8, %18\n\tds_read_b64_tr_b16 %9, %18 offset:" TRS(4 * 136 * 2) "\n\tds_read_b64_tr_b16 %10, %18 offset:" TRS(32 * 136 * 2) "\n\tds_read_b64_tr_b16 %11, %18 offset:" TRS(36 * 136 * 2) "\n\t"
                           "ds_read_b64_tr_b16 %12, %18 offset:32\n\tds_read_b64_tr_b16 %13, %18 offset:" TRS(4 * 136 * 2 + 32) "\n\tds_read_b64_tr_b16 %14, %18 offset:" TRS(32 * 136 * 2 + 32) "\n\tds_read_b64_tr_b16 %15, %18 offset:" TRS(36 * 136 * 2 + 32) "\n\t"
                           "s_waitcnt lgkmcnt(0)"
                           : "=&v"(t0), "=&v"(t1), "=&v"(t2), "=&v"(t3), "=&v"(t4), "=&v"(t5), "=&v"(t6), "=&v"(t7), "=&v"(t8), "=&v"(t9), "=&v"(t10), "=&v"(t11), "=&v"(t12), "=&v"(t13), "=&v"(t14), "=&v"(t15)
                           : "v"(ax), "v"(ad_), "v"(ab) : "memory");
              const bf16x8 xT[2] = {tr_pack(t0, t1), tr_pack(t2, t3)}, xdT[2] = {tr_pack(t4, t5), tr_pack(t6, t7)}, bT[2][2] = {{tr_pack(t8, t9), tr_pack(t10, t11)}, {tr_pack(t12, t13), tr_pack(t14, t15)}};
              { const int mt = F.wave >> 1, nt = nt_y; f32x4 ad = (f32x4){0.f, 0.f, 0.f, 0.f}, ao = ad;
#pragma unroll
                for (int ks = 0; ks < 2; ++ks) MMA_TRN(ad, ldfrag(Sc, 72, mt * 16, ks * 32, fr, fq), xT[ks]);
#pragma unroll
                for (int ks = 0; ks < 4; ++ks) MMA_TRN(ao, ldfrag(Cb, 136, mt * 16, ks * 32, fr, fq), ldfrag(Hb, 136, nt * 16, ks * 32, fr, fq));
                const int i = mt * 16 + fr; const float ei = __expf(cum[i]); const int row = CROW(chain_row(b, d, c * 64), d, i);
                v2u w; w.x = pk2(ad[0] + ei * ao[0], ad[1] + ei * ao[1]); w.y = pk2(ad[2] + ei * ao[2], ad[3] + ei * ao[3]);
                *(v2u*)(ydir + (unsigned)((d * MROWS + row) * D + xcol + nt * 16 + 4 * fq)) = w; }
              { const float dc = __expf(cum[63]);
#pragma unroll
                for (int x = 0; x < 2; ++x) { hacc[x] *= dc;
#pragma unroll
                    for (int ks = 0; ks < 2; ++ks) MMA_TRN(hacc[x], xdT[ks], bT[x][ks]); } } }
            LBAR();
            { const int mt = F.wave >> 2;
#pragma unroll
              for (int x = 0; x < 2; ++x) { const int nt = (F.wave & 3) * 2 + x; v2u w; w.x = pk2(hacc[x][0], hacc[x][1]); w.y = pk2(hacc[x][2], hacc[x][3]);
                  *(LAS3 v2u*)(Hb + (mt * 16 + fr) * 136 + nt * 16 + 4 * fq) = w; } }
            if (c + 1 < 132) SS_FRONT2(cur ^ 1);
            LBAR();
        }
        __syncthreads();
    }
#undef SS_PTRS
#undef SS_LOAD
#undef SS_FRONT1
#undef SS_FRONT2
}

__device__ __forceinline__ int chunk_row0(int ck) { return ck < 256 ? ck * 64 : MLAT + (ck - 256) * 64; }
template <bool FINAL>
#define SW128(row_, col_) ((row_) * 128 + ((col_) ^ (((row_) & 7) << 2)))
__device__ __forceinline__ void phase_lru_par(const Frame& F, int L) {
    const bf16* P = (const bf16*)(F.ws + WS_P);
    const bf16* WgT = (const bf16*)(F.ws + WS_LGW);
    float* agg = (float*)(F.ws + WS_LAGG); const float* car = (const float*)(F.ws + WS_LCAR);
    bf16* Y = (bf16*)(F.ws + WS_Y3);
    const float* cw = F.a->in[I_LCW] + (size_t)L * 4 * 2048; const float* cb = F.a->in[I_LCB] + (size_t)L * 2048;
    LAS3 bf16* Xb = (LAS3 bf16*)F.lds;
    LAS3 float* Aa = (LAS3 float*)(F.lds + 17408);
    LAS3 float* Bx = Aa + 64 * 128;
    LAS3 float* Hf = Bx + 64 * 128;
    LAS3 bf16* RAW = (LAS3 bf16*)(F.lds + 115712);
    LAS3 bf16* GT = (LAS3 bf16*)(F.lds + 133936);
    LAS3 float* SGA = (LAS3 float*)(F.lds + 151344);
    LAS3 float* SGH = SGA + 512;
    v4u pw[3], pg[2];
#define LRU_FETCH(ck__) do { const int ck_ = (ck__), n_ = n, row0_ = chunk_row0(ck_); int pos_, len_; seq_pos(row0_, pos_, len_); \
        int tid_ = F.tid; asm volatile("" : "+v"(tid_)); \
        _Pragma("unroll") for (int i_ = 0; i_ < 3; ++i_) { const int idx_ = tid_ + 512 * i_, rr_ = idx_ >> 4, g_ = idx_ & 15; const int q_ = pos_ + rr_ - 2; \
            pw[i_] = (idx_ < 67 * 16 && q_ >= 0 && q_ < len_) ? *(const v4u*)(P + (size_t)(row0_ + rr_ - 2) * NP + PL + n_ * 128 + g_ * 8) : (v4u){0u, 0u, 0u, 0u}; } \
        if (FINAL) { _Pragma("unroll") for (int i_ = 0; i_ < 2; ++i_) { const int idx_ = tid_ + 512 * i_, rr_ = idx_ >> 4, g_ = idx_ & 15; \
            pg[i_] = *(const v4u*)(P + (size_t)(row0_ + rr_) * NP + PLG + n_ * 128 + g_ * 8); } } } while (0)
    const int n = F.bid & 15, ckstep = F.G >> 4;
    LAS3 float* CW = SGH + 512;
    for (int i = F.tid; i < 640; i += 512) CW[i] = i < 512 ? cw[(i >> 7) * 2048 + n * 128 + (i & 127)] : cb[n * 128 + (i & 127)];
    bf16x8 wf[2][2][4]; f32x4 gbv[2][2]; float sp8[2][4];
    { const int fr0 = F.lane & 15, fq0 = F.lane >> 4, j00 = F.wave * 16;
#pragma unroll
      for (int d = 0; d < 2; ++d) {
#pragma unroll
          for (int g = 0; g < 2; ++g) { const bf16* W = WgT + (size_t)(((d * 2 + g) * 16 + n) * 128) * 128;
#pragma unroll
              for (int ks = 0; ks < 4; ++ks) wf[d][g][ks] = ldfrag_g(W, 128, j00, ks * 32, fr0, fq0);
              gbv[d][g] = *(const f32x4*)(F.a->in[I_LGB] + (((size_t)L * 2 + d) * 2 + g) * 2048 + n * 128 + j00 + 4 * fq0); }
          const f32x4 lam = *(const f32x4*)(F.a->in[I_LLAM] + ((size_t)L * 2 + d) * 2048 + n * 128 + j00 + 4 * fq0);
#pragma unroll
          for (int i = 0; i < 4; ++i) sp8[d][i] = -8.0f * softplusf(-lam[i]); } }
    if ((F.bid >> 4) < 264) LRU_FETCH(F.bid >> 4);
    __syncthreads();
    for (int ck = F.bid >> 4; ck < 264; ck += ckstep) {
        int tid = F.tid; asm volatile("" : "+v"(tid));
        const int lane = tid & 63, wave = __builtin_amdgcn_readfirstlane(tid >> 6), fr = lane & 15, fq = lane >> 4;
        const int row0 = chunk_row0(ck);
#pragma unroll
        for (int i = 0; i < 3; ++i) { const int idx = tid + 512 * i, rr = idx >> 4, g = idx & 15; if (idx < 67 * 16) *(LAS3 v4u*)(RAW + rr * 136 + g * 8) = pw[i]; }
        if (FINAL) {
#pragma unroll
            for (int i = 0; i < 2; ++i) { const int idx = tid + 512 * i, rr = idx >> 4, g = idx & 15; *(LAS3 v4u*)(GT + rr * 136 + g * 8) = pg[i]; } }
        LBAR();
        if (ck + ckstep < 264) LRU_FETCH(ck + ckstep);
#pragma unroll 1
        for (int gI = tid; gI < 1024; gI += 512) { const int t = gI >> 4, c8 = (gI & 15) * 8, col = n * 128 + c8;
            float o[8];
            { const f32x4 b0 = *(const LAS3 f32x4*)(CW + 512 + c8), b1 = *(const LAS3 f32x4*)(CW + 512 + c8 + 4); o[0] = b0[0]; o[1] = b0[1]; o[2] = b0[2]; o[3] = b0[3]; o[4] = b1[0]; o[5] = b1[1]; o[6] = b1[2]; o[7] = b1[3]; }
#pragma unroll
            for (int tap = 0; tap < 4; ++tap) { const v4u x = *(const LAS3 v4u*)(RAW + (t + tap) * 136 + c8);
                const f32x4 w0 = *(const LAS3 f32x4*)(CW + tap * 128 + c8), w1 = *(const LAS3 f32x4*)(CW + tap * 128 + c8 + 4);
                o[0] += w0[0] * pg8::bf_lo(x.x); o[1] += w0[1] * pg8::bf_hi(x.x); o[2] += w0[2] * pg8::bf_lo(x.y); o[3] += w0[3] * pg8::bf_hi(x.y);
                o[4] += w1[0] * pg8::bf_lo(x.z); o[5] += w1[1] * pg8::bf_hi(x.z); o[6] += w1[2] * pg8::bf_lo(x.w); o[7] += w1[3] * pg8::bf_hi(x.w); }
            v4u w; w.x = pk2(o[0], o[1]); w.y = pk2(o[2], o[3]); w.z = pk2(o[4], o[5]); w.w = pk2(o[6], o[7]);
            *(LAS3 v4u*)(Xb + t * 136 + c8) = w; }
        LBAR();
#pragma unroll
        for (int d = 0; d < 2; ++d) {
            {
                const int j0 = wave * 16;
                f32x4 acc[2][4];
#pragma unroll
                for (int g = 0; g < 2; ++g)
#pragma unroll
                    for (int mt = 0; mt < 4; ++mt) acc[g][mt] = (f32x4){0.f, 0.f, 0.f, 0.f};
#pragma unroll
                for (int ks = 0; ks < 4; ++ks) {
#pragma unroll
                    for (int mt = 0; mt < 4; ++mt) { const bf16x8 a = ldfrag(Xb, 136, mt * 16, ks * 32, fr, fq); MMA_TRN(acc[0][mt], a, wf[d][0][ks]); MMA_TRN(acc[1][mt], a, wf[d][1][ks]); } }
                const f32x4 gb0 = gbv[d][0], gb1 = gbv[d][1];
#pragma unroll
                for (int mt = 0; mt < 4; ++mt) { const int t = mt * 16 + fr; f32x4 av, bv;
                    const v2u xr = *(const LAS3 v2u*)(Xb + t * 136 + j0 + 4 * fq);
                    const float xc[4] = {pg8::bf_lo(xr.x), pg8::bf_hi(xr.x), pg8::bf_lo(xr.y), pg8::bf_hi(xr.y)};
#pragma unroll
                    for (int i = 0; i < 4; ++i) {
                        const float d0 = 1.0f + __expf(-fmaxf(acc[0][mt][i] + gb0[i], -40.f)), d1 = 1.0f + __expf(-fmaxf(acc[1][mt][i] + gb1[i], -40.f)), rr = __builtin_amdgcn_rcpf(d0 * d1);
                        const float a = __expf(d1 * rr * sp8[d][i]); av[i] = a; bv[i] = __builtin_amdgcn_sqrtf(fmaxf(1.0f - a * a, 0.f)) * (d0 * rr) * xc[i]; }
                    *(LAS3 f32x4*)(Aa + SW128(t, j0 + 4 * fq)) = av; *(LAS3 f32x4*)(Bx + SW128(t, j0 + 4 * fq)) = bv; }
            }
            LBAR();
            {
                const int ch = tid & 127, sg = tid >> 7, col = n * 128 + ch;
                float h = 0.f, ap = 1.f;
#pragma unroll 4
                for (int s2 = 0; s2 < 16; ++s2) { const int s = sg * 16 + s2, t = d ? 63 - s : s; const float a = Aa[SW128(t, ch)]; h = a * h + Bx[SW128(t, ch)]; ap *= a; }
                SGA[sg * 128 + ch] = ap; SGH[sg * 128 + ch] = h;
                LBAR();
                if (!FINAL) {
                    if (sg == 0) { float hh = 0.f, aa = 1.f;
#pragma unroll
                        for (int q = 0; q < 4; ++q) { const float a = SGA[q * 128 + ch]; hh = a * hh + SGH[q * 128 + ch]; aa *= a; }
                        float2 o; o.x = aa; o.y = hh; *(float2*)(agg + (((size_t)d * 264 + ck) * 2048 + col) * 2) = o; } }
                else { float hh = car[((size_t)d * 264 + ck) * 2048 + col];
#pragma unroll
                    for (int q = 0; q < 3; ++q) if (q < sg) hh = SGA[q * 128 + ch] * hh + SGH[q * 128 + ch];
#pragma unroll 4
                    for (int s2 = 0; s2 < 16; ++s2) { const int s = sg * 16 + s2, t = d ? 63 - s : s; hh = Aa[SW128(t, ch)] * hh + Bx[SW128(t, ch)];
                        if (d == 0) Hf[t * 128 + ch] = hh;
                        else { const float gx = bf2f(GT[t * 136 + ch]); const float u = 0.7978845608028654f * (gx + 0.044715f * gx * gx * gx);
                            Y[(size_t)(row0 + t) * D + col] = f2bf((Hf[t * 128 + ch] + hh) * 0.5f * gx * (1.0f + tanh_fast(u))); } } }
            }
            LBAR();
        }
    }
#undef LRU_FETCH
}
__device__ __forceinline__ void phase_lru_carry(const Frame& F) {
    const float* agg = (const float*)(F.ws + WS_LAGG); float* car = (float*)(F.ws + WS_LCAR);
    const int gid = F.bid * 512 + F.tid;
    if (gid < 8192) { const int d = gid >> 12, b = (gid >> 11) & 1, col = gid & 2047; float h = 0.f;
#pragma unroll 1
        for (int i0 = 0; i0 < 132; i0 += 12) { float2 a[12]; size_t o[12];
#pragma unroll
            for (int j = 0; j < 12; ++j) { const int i = i0 + j; const int ck = i < 4 ? 256 + b * 4 + (d ? 3 - i : i) : b * 128 + (d ? 127 - (i - 4) : (i - 4));
                o[j] = ((size_t)d * 264 + ck) * 2048 + col; a[j] = *(const float2*)(agg + o[j] * 2); }
#pragma unroll
            for (int j = 0; j < 12; ++j) { car[o[j]] = h; h = a[j].x * h + a[j].y; } } }
}

__device__ __forceinline__ void phase_route(const Frame& F) {
    int* rt = (int*)(F.ws + WS_ROUTE); unsigned* ctl = (unsigned*)(F.ws + WS_CTL);
    const bf16* V = (const bf16*)(F.ws + WS_U); bf16* A = (bf16*)(F.ws + WS_MA);
    int base[9]; base[0] = 0;
#pragma unroll
    for (int e = 0; e < 8; ++e) { const int c = (int)__hip_atomic_load(&ctl[CW_CNT + e], __ATOMIC_RELAXED, __HIP_MEMORY_SCOPE_AGENT); base[e + 1] = base[e] + ((c + 255) & ~255); }
    if (F.bid == 0 && F.tid == 0) { rt[RT_NT] = base[8] >> 8; for (int e = 0; e < 8; ++e) { rt[RT_BASE + e] = base[e]; for (int t = base[e] >> 8; t < (base[e + 1] >> 8); ++t) rt[RT_TILEE + t] = e; } }
    for (int tok = F.bid * 8 + F.wave; tok < MLAT; tok += F.G * 8) {
        int r0 = 0, r1 = 0;
        if (F.lane == 0) { const int e0 = rt[RT_TOKE + tok * 2], e1 = rt[RT_TOKE + tok * 2 + 1];
            int b0 = 0, b1 = 0;
#pragma unroll
            for (int e = 0; e < 8; ++e) { if (e == e0) b0 = base[e]; if (e == e1) b1 = base[e]; }
            r0 = b0 + (int)atomicAdd(&ctl[CW_CUR + e0], 1u); r1 = b1 + (int)atomicAdd(&ctl[CW_CUR + e1], 1u);
            rt[RT_TOKROW + tok * 2] = r0; rt[RT_TOKROW + tok * 2 + 1] = r1; }
        r0 = __shfl(r0, 0); r1 = __shfl(r1, 0);
#pragma unroll
        for (int i = 0; i < 4; ++i) { const v4u v = *(const v4u*)(V + (size_t)tok * D + i * 512 + F.lane * 8);
            *(v4u*)(A + (size_t)r0 * D + i * 512 + F.lane * 8) = v; *(v4u*)(A + (size_t)r1 * D + i * 512 + F.lane * 8) = v; }
    }
    for (int e = 0; e < 8; ++e) { const int c = (int)__hip_atomic_load(&ctl[CW_CNT + e], __ATOMIC_RELAXED, __HIP_MEMORY_SCOPE_AGENT); const int lo = base[e] + c, hi = base[e + 1];
        for (int row = lo + F.bid * 8 + F.wave; row < hi; row += F.G * 8)
#pragma unroll
            for (int i = 0; i < 4; ++i) *(v4u*)(A + (size_t)row * D + i * 512 + F.lane * 8) = (v4u){0u, 0u, 0u, 0u}; }
}
__device__ __forceinline__ void phase_final(const Frame& F, const float* modL) {
    const int* rt = (const int*)(F.ws + WS_ROUTE);
    const float* hlat = (const float*)(F.ws + WS_HLAT); const bf16* O = (const bf16*)(F.ws + WS_X1);
    const float* nf = F.a->in[I_NFIN]; float* out = F.a->out;
    for (int tok = F.bid * 8 + F.wave; tok < MLAT; tok += F.G * 8) {
        const int b = tok >> 13; const float* gf = modL + b * 12288 + 5 * 2048;
        const int r0 = rt[RT_TOKROW + tok * 2], r1 = rt[RT_TOKROW + tok * 2 + 1]; const float p0 = ((const float*)rt)[RT_TOKP + tok * 2], p1 = ((const float*)rt)[RT_TOKP + tok * 2 + 1];
        f32x4 x[8]; float ss = 0.f;
#pragma unroll
        for (int i = 0; i < 8; ++i) { const int c = i * 256 + F.lane * 4;
            const f32x4 h = *(const f32x4*)(hlat + (size_t)tok * D + c), g = *(const f32x4*)(gf + c);
            const uint2 a = *(const uint2*)(O + (size_t)r0 * D + c), bb = *(const uint2*)(O + (size_t)r1 * D + c);
            f32x4 m; m[0] = p0 * pg8::bf_lo(a.x) + p1 * pg8::bf_lo(bb.x); m[1] = p0 * pg8::bf_hi(a.x) + p1 * pg8::bf_hi(bb.x); m[2] = p0 * pg8::bf_lo(a.y) + p1 * pg8::bf_lo(bb.y); m[3] = p0 * pg8::bf_hi(a.y) + p1 * pg8::bf_hi(bb.y);
            x[i] = h + g * m; ss += x[i][0] * x[i][0] + x[i][1] * x[i][1] + x[i][2] * x[i][2] + x[i][3] * x[i][3]; }
        ss = wave_sum(ss);
        const float rs = rsqrtf(ss * (1.0f / D) + EPS);
#pragma unroll
        for (int i = 0; i < 8; ++i) { const int c = i * 256 + F.lane * 4; const f32x4 g = *(const f32x4*)(nf + c); *(f32x4*)(out + (size_t)tok * D + c) = x[i] * rs * g; }
    }
}

constexpr int NPH_LAYER = 17, NPH = 1 + 2 * NPH_LAYER;
#if !MK_PER_PHASE
#define SEAM() xcd_barrier(bar)
#else
#define SEAM() do {} while (0)
#endif
#define IN(k) (lo <= (PB + (k)) && (PB + (k)) < hi)
template <int L>
__device__ __forceinline__ void layer_program(const Frame& F, const Args& args, const XcdBarrier& bar, const int lo, const int hi) {
    constexpr int PB = 1 + L * NPH_LAYER;
    const float* modL = (const float*)(F.ws + WS_MOD) + (size_t)L * 3 * 12288;
    if (IN(0)) { unsigned char* wsl = F.ws; asm volatile("" : "+s"(wsl)); if (L == 0) { phase_mod(F); __syncthreads(); phase_convw_layer(F, L, F.G, F.bid); phase_lora_prep(F, L, F.G, F.bid); SEAM(); } }
    if (IN(1)) { unsigned char* wsl = F.ws; asm volatile("" : "+s"(wsl)); phase_norm<false>(F, L == 0 ? args.in[I_X] : (const float*)(wsl + WS_HLAT), L == 0 ? args.in[I_CTX] : (const float*)(wsl + WS_HCTX), args.in[I_NMIX] + L * 2048, modL, 0, 2048, (bf16*)(wsl + WS_U), L & 1, MROWS); SEAM(); }
    if (IN(2)) { unsigned char* wsl = F.ws; asm volatile("" : "+s"(wsl)); pg8::Gemm g{(const bf16*)(wsl + WS_U), (const bf16*)(wsl + WS_X1), MROWS, NP, 2048}; pg8::StaticOrder S; S.init(MROWS, NP, F.G, F.bid); pg8::EpiStoreBf16 E{(bf16*)(wsl + WS_P), NP, 0};
        pg8::gemm_phase<pg8::EpiStoreBf16, pg8::StaticOrder, false>(F.lds, g, S, E, nullptr); SEAM(); }
    if (IN(3)) { unsigned char* wsl = F.ws; asm volatile("" : "+s"(wsl)); phase_lora_in(F, L); SEAM();
#pragma unroll 1
        for (int gq = 0; gq < 4; ++gq) { phase_rwkv_r1(F, L, gq); SEAM(); phase_rwkv_r2(F, gq); SEAM(); } }
    if (IN(4)) { unsigned char* wsl = F.ws; asm volatile("" : "+s"(wsl)); phase_rwkv_pre(F, L); __syncthreads(); phase_ssm_conv(F, L); __syncthreads(); phase_lru_par<false>(F, L); SEAM(); }
    if (IN(5)) { unsigned char* wsl = F.ws; asm volatile("" : "+s"(wsl));
        pg8::Gemm g{(const bf16*)(wsl + WS_SG), (const bf16*)(wsl + WS_GUP), MROWS, 2048, 256}; pg8::StaticOrder S; S.init(MROWS, 2048, F.G, F.bid);
        pg8::EpiGateMul E{(const bf16*)(wsl + WS_Y3) + (size_t)MROWS * D, (bf16*)(wsl + WS_Y3) + (size_t)MROWS * D};
        pg8::gemm_phase<pg8::EpiGateMul, pg8::StaticOrder, false>(F.lds, g, S, E, nullptr); __syncthreads(); }
    if (IN(5)) { unsigned char* wsl = F.ws; asm volatile("" : "+s"(wsl)); phase_lru_carry(F); phase_ssm_chain(F, L); SEAM(); }
    if (IN(7)) { unsigned char* wsl = F.ws; asm volatile("" : "+s"(wsl)); phase_ssm_out(F, L); __syncthreads(); phase_lru_par<true>(F, L); SEAM(); }
    constexpr int nM = L == 1 ? 64 : 66;
    if (IN(9)) { unsigned char* wsl = F.ws; asm volatile("" : "+s"(wsl)); pg8::Gemm g{(const bf16*)(wsl + WS_Y3), (const bf16*)(wsl + WS_WOUT), MROWS, 2048, 2048}; pg8::MergeOrder S{nM * 8, F.G, F.bid}; pg8::EpiMerge E{(const bf16*)(wsl + WS_P), NP, (bf16*)(wsl + WS_X1)};
        pg8::gemm_phase<pg8::EpiMerge, pg8::MergeOrder, false>(F.lds, g, S, E, nullptr);
        if (L == 0 && F.G == 256) { __syncthreads(); const int c = F.bid;
            if (!((c & 7) == 0 && c < 128)) { const int below = (c + 7) >> 3; phase_convw_ffn(F, 1, 240, c - (below < 16 ? below : 16), 2); } }
        SEAM(); }
    if (IN(10)) { unsigned char* wsl = F.ws; asm volatile("" : "+s"(wsl)); pg8::Gemm g{(const bf16*)(wsl + WS_X1), (const bf16*)(wsl + WS_WOUT) + (size_t)3 * 2048 * 2048, nM * 256, 2048, 2048}; pg8::StaticOrder S; S.init(nM * 256, 2048, F.G, F.bid);
        pg8::EpiResid E{L == 0 ? args.in[I_X] : (const float*)(wsl + WS_HLAT), L == 0 ? args.in[I_CTX] : (const float*)(wsl + WS_HCTX), (float*)(wsl + WS_HLAT), (float*)(wsl + WS_HCTX), modL + 2 * 2048, L & 1};
        pg8::gemm_phase<pg8::EpiResid, pg8::StaticOrder, false>(F.lds, g, S, E, nullptr);
        if (L == 0) { __syncthreads(); if (F.G > 32) { if (F.bid >= 16) phase_convw_ffn(F, L, F.G - 16, F.bid - 16); } else phase_convw_ffn(F, L, F.G, F.bid); }
        SEAM(); }
    if (IN(11)) { unsigned char* wsl = F.ws; asm volatile("" : "+s"(wsl)); phase_norm<L == 1>(F, (const float*)(wsl + WS_HLAT), (const float*)(wsl + WS_HCTX), args.in[I_NFFN] + L * 2048, modL, 3 * 2048, 4 * 2048, (bf16*)(wsl + WS_U), 0, L == 0 ? MROWS : MLAT); SEAM(); }
    if (IN(12)) { unsigned char* wsl = F.ws; asm volatile("" : "+s"(wsl)); if (L == 1) { phase_convw_ffn(F, L, F.G, F.bid, F.G == 256 ? 1 : 3); __syncthreads(); } }
    if constexpr (L == 0) {
        if (IN(13)) { unsigned char* wsl = F.ws; asm volatile("" : "+s"(wsl)); pg8::Gemm g{(const bf16*)(wsl + WS_U), (const bf16*)(wsl + WS_F13), MROWS, 12288, 2048}; pg8::StaticOrder S; S.init(MROWS, 12288, F.G, F.bid); pg8::EpiSwiGLU E{(bf16*)(wsl + WS_FH), 6144, 0};
            pg8::gemm_phase<pg8::EpiSwiGLU, pg8::StaticOrder, false>(F.lds, g, S, E, nullptr); SEAM(); }
        if (IN(14)) { unsigned char* wsl = F.ws; asm volatile("" : "+s"(wsl)); pg8::Gemm g{(const bf16*)(wsl + WS_FH), (const bf16*)(wsl + WS_F2), MROWS, 2048, 6144}; pg8::StaticOrder S; S.init(MROWS, 2048, F.G, F.bid);
            pg8::EpiResid E{(const float*)(wsl + WS_HLAT), (const float*)(wsl + WS_HCTX), (float*)(wsl + WS_HLAT), (float*)(wsl + WS_HCTX), modL + 5 * 2048, 0};
            pg8::gemm_phase<pg8::EpiResid, pg8::StaticOrder, false>(F.lds, g, S, E, nullptr);
            __syncthreads(); if (F.G > 32) { if (F.bid >= 16) { phase_convw_layer(F, 1, F.G - 16, F.bid - 16); phase_lora_prep(F, 1, F.G - 16, F.bid - 16); } } else { phase_convw_layer(F, 1, F.G, F.bid); phase_lora_prep(F, 1, F.G, F.bid); }
            SEAM(); }
    } else {
        const int* rt = (const int*)(F.ws + WS_ROUTE);
        if (IN(13)) { unsigned char* wsl = F.ws; asm volatile("" : "+s"(wsl)); phase_route(F); SEAM(); }
        if (IN(14)) { unsigned char* wsl = F.ws; asm volatile("" : "+s"(wsl)); pg8::Gemm g{(const bf16*)(wsl + WS_MA), (const bf16*)(wsl + WS_M13), MOE_ROWS, 8 * 6144, 2048}; pg8::MoeOrder S{rt + RT_TILEE, rt + RT_NT, 24, F.G, F.bid, 0};
            pg8::EpiSwiGLU E{(bf16*)(wsl + WS_MH), 3072, 24};
            pg8::gemm_phase<pg8::EpiSwiGLU, pg8::MoeOrder, false>(F.lds, g, S, E, nullptr); SEAM(); }
        if (IN(15)) { unsigned char* wsl = F.ws; asm volatile("" : "+s"(wsl)); pg8::Gemm g{(const bf16*)(wsl + WS_MH), (const bf16*)(wsl + WS_M2), MOE_ROWS, 8 * 2048, 3072}; pg8::MoeOrder S{rt + RT_TILEE, rt + RT_NT, 8, F.G, F.bid, (F.G & 7) == 0};
            pg8::EpiStoreBf16 E{(bf16*)(wsl + WS_X1), 2048, 8};
            pg8::gemm_phase<pg8::EpiStoreBf16, pg8::MoeOrder, false>(F.lds, g, S, E, nullptr); SEAM(); }
        if (IN(16)) { unsigned char* wsl = F.ws; asm volatile("" : "+s"(wsl)); phase_final(F, modL); }
    }
}
#undef IN
__global__ void __launch_bounds__(512, 2) fwd(Args args) {
    extern __shared__ __attribute__((aligned(16))) unsigned char lds_raw[];
    Frame F; F.a = &args; F.ws = args.ws; F.lds = (LAS3 unsigned char*)lds_raw;
    F.tid = threadIdx.x; F.lane = F.tid & 63; F.wave = __builtin_amdgcn_readfirstlane(F.tid >> 6); F.G = gridDim.x; F.bid = blockIdx.x;
    volatile LAS3 unsigned* MISC = (volatile LAS3 unsigned*)(F.lds + MISC_OFF);
    if (F.tid < 32) MISC[F.tid] = 0u;
    __syncthreads();
    unsigned* ctl = (unsigned*)(F.ws + WS_CTL);
#if !MK_PER_PHASE
    XcdBarrier bar = xcd_barrier_post(ctl + CW_BAR, MISC + 8);
#else
    XcdBarrier bar; bar.bar = ctl + CW_BAR; bar.x = 0; bar.st = MISC + 8;
#endif
    const int lo = args.lo, hi = args.hi;
    layer_program<0>(F, args, bar, lo, hi);
    layer_program<1>(F, args, bar, lo, hi);
}

extern "C" void kernel_launch(void* const* d_in, const int* in_sizes, int n_in, void* d_out, int out_size, void* d_ws, size_t ws_size, hipStream_t stream) {
    static int grid = 0;
    if (grid == 0) {
        if (n_in != N_INPUTS || out_size != MLAT * D || ws_size < WS_END) { fprintf(stderr, "kernel_launch: unexpected shapes (n_in %d, out %d, ws %zu); nothing launched\n", n_in, out_size, ws_size); grid = -1; return; }
        int dev = 0, cus = 0;
        if (hipGetDevice(&dev) != hipSuccess || hipDeviceGetAttribute(&cus, hipDeviceAttributeMultiprocessorCount, dev) != hipSuccess) { grid = -1; return; }
        if (hipFuncSetAttribute((const void*)fwd, hipFuncAttributeMaxDynamicSharedMemorySize, LDS_BYTES) != hipSuccess) { fprintf(stderr, "kernel_launch: hipFuncSetAttribute failed\n"); grid = -1; return; }
        int per_cu = 0;
        if (hipOccupancyMaxActiveBlocksPerMultiprocessor(&per_cu, (const void*)fwd, 512, LDS_BYTES) != hipSuccess || per_cu < 1) { fprintf(stderr, "kernel_launch: occupancy query says %d\n", per_cu); }
        (void)hipGetLastError();
        grid = cus;
    }
    if (grid < 0) return;
    (void)hipMemsetAsync((char*)d_ws + WS_CTL, 0, CTL_BYTES, stream);
    Args a{};
    for (int i = 0; i < N_INPUTS; ++i) a.in[i] = (const float*)d_in[i];
    a.out = (float*)d_out; a.ws = (unsigned char*)d_ws;
#if MK_PER_PHASE
    for (int p = 0; p < NPH; ++p) { a.lo = p; a.hi = p + 1; hipLaunchKernelGGL(fwd, dim3(grid), dim3(512), LDS_BYTES, stream, a); }
#else
    a.lo = 0; a.hi = NPH; hipLaunchKernelGGL(fwd, dim3(grid), dim3(512), LDS_BYTES, stream, a);
#endif
}
```

```cpp
#include <hip/hip_runtime.h>
#include <cstdio>
#include <cstdint>

#ifndef MK_PER_PHASE
#define MK_PER_PHASE 0
#endif

namespace pg8 {
#define PG8_LAS __attribute__((address_space(3)))
typedef unsigned short bf16_t;
typedef short bf16x8 __attribute__((ext_vector_type(8)));
typedef float f32x4 __attribute__((ext_vector_type(4)));
typedef unsigned u32x4 __attribute__((ext_vector_type(4)));
constexpr int BM = 256, BK = 64, HALF = 128, HTB = HALF * BK * 2  , STAGE_BYTES = 8 * HTB, NXCD = 8, WGM = 8;

__host__ __device__ __forceinline__ int lds_byte(int r, int c) { const int st = (r >> 4) * 2 + (c >> 5), rr = r & 15, cc = c & 31, ob = rr * 64 + cc * 2; return st * 1024 + (ob ^ (((ob >> 9) & 1) << 5)); }
__host__ __device__ __forceinline__ void stage_rc(int b, int& R, int& C) { const int st = b / 1024, sb = b % 1024, swz = sb ^ (((sb >> 9) & 1) << 5); R = (st >> 1) * 16 + swz / 64; C = (st & 1) * 32 + (swz % 64) / 2; }
__host__ __device__ __forceinline__ int perm32(int rho) { const int n = rho >> 4, i = rho & 15; return 8 * (i >> 2) + 4 * n + (i & 3); }

struct Unit { int pm, pn; };
struct Gemm { const bf16_t* A; const bf16_t* Bt; int M, N, K; };

struct StaticOrder {
    int nM, nN, nwg, G, c;
    __host__ __device__ void init(int M, int N, int G_, int c_) { nM = M / BM; nN = N / BM; nwg = nM * nN; G = G_; c = c_; }
    __host__ __device__ bool next(int i, Unit& u) const {
        const long L = (long)i * G + c; if (L >= nwg) return false;
        int wgid = (int)L; { const int q = nwg / NXCD, r = nwg % NXCD, xcd = wgid % NXCD, off = wgid / NXCD; wgid = (xcd < r ? xcd * (q + 1) : r * (q + 1) + (xcd - r) * q) + off; }
        const int nig = WGM * nN, gid = wgid / nig, fm = gid * WGM, gsz = (nM - fm) < WGM ? (nM - fm) : WGM;
        u.pm = fm + ((wgid % nig) % gsz); u.pn = (wgid % nig) / gsz; return true;
    }
    __device__ __forceinline__ void a_ready(const Unit&) const {}
    __device__ __forceinline__ void done(const Unit&) const {}
};
typedef __bf16 hbf16x2_ __attribute__((ext_vector_type(2)));
typedef float hf32x2_ __attribute__((ext_vector_type(2)));
__device__ __forceinline__ unsigned cvt_pk_bf16(float lo, float hi) { const hf32x2_ v = {lo, hi}; const hbf16x2_ b = __builtin_convertvector(v, hbf16x2_); return __builtin_bit_cast(unsigned, b); }
typedef float f32x2 __attribute__((ext_vector_type(2)));
__device__ __forceinline__ f32x2 gelu_pk(f32x2 v) {
    const f32x2 av = __builtin_elementwise_abs(v), d = av * 0.2316418882f + 1.0f;
    f32x2 t; t.x = __builtin_amdgcn_rcpf(d.x); t.y = __builtin_amdgcn_rcpf(d.y);
    f32x2 q = t * 0.5307027145f + (-0.7265760135f); q = q * t + 0.7107068705f; q = q * t + (-0.142248368f); q = q * t + 0.127414796f; q = q * t;
    const f32x2 s = (v * v) * (-0.72134752044f);
    f32x2 e; e.x = __builtin_amdgcn_exp2f(s.x); e.y = __builtin_amdgcn_exp2f(s.y);
    const f32x2 m = v * (q * e), r = v - m;
    f32x2 o; o.x = v.x < 0.f ? m.x : r.x; o.y = v.y < 0.f ? m.y : r.y; return o;
}
template <class Epi, class Sched, bool ALIGN_EPI = false, bool SP2 = false>
__device__ __forceinline__ void gemm_phase(PG8_LAS unsigned char* lds, const Gemm g, const Sched& S, const Epi& E) {
    const int tid = threadIdx.x, wid = __builtin_amdgcn_readfirstlane(tid >> 6), lane = tid & 63, wr = wid >> 2, wc = wid & 3, fr = lane & 15, fq = lane >> 4;
    const int K = g.K, nt = K / BK;
    unsigned voffA[2], voffB[2];
#pragma unroll
    for (int i = 0; i < 2; ++i) { int R, C; stage_rc(tid * 16 + i * 8192, R, C); const int Rb = Epi::PERM ? ((R & ~31) + perm32(R & 31)) : R;
        voffA[i] = (unsigned)(R * K + C) * 2u; voffB[i] = (unsigned)(Rb * K + C) * 2u; }
    const size_t kstep = (size_t)(BK * 2);
    const size_t hstep = (size_t)HALF * K * 2;
    const size_t tstep = 2 * hstep;
    const unsigned ldsw = (unsigned)wid * 1024u;
    const int aoff = lds_byte(wr * 64 + fr, fq * 8), boff = lds_byte(wc * 32 + fr, fq * 8);
#define PG8_SA(b, h) (((b) * 2 + (h)) * HTB)
#define PG8_SB(b, h) ((4 + (b) * 2 + (h)) * HTB)
#define PG8_STAGE(bufoff, gbase, voff) do { _Pragma("unroll") for (int _i = 0; _i < 2; ++_i) \
        __builtin_amdgcn_global_load_lds((const unsigned*)((const char*)(gbase) + (voff)[_i]), (PG8_LAS unsigned*)(lds + (bufoff) + ldsw + _i * 8192), 16, 0, 0); } while (0)
#define PG8_LDA(dst, b, h) do { _Pragma("unroll") for (int m = 0; m < 4; ++m) _Pragma("unroll") for (int k = 0; k < 2; ++k) dst[m][k] = *(const PG8_LAS bf16x8*)(lds + PG8_SA(b, h) + aoff + m * 2048 + k * 1024); } while (0)
#define PG8_LDB(dst, b, h) do { _Pragma("unroll") for (int n = 0; n < 2; ++n) _Pragma("unroll") for (int k = 0; k < 2; ++k) dst[n][k] = *(const PG8_LAS bf16x8*)(lds + PG8_SB(b, h) + boff + n * 2048 + k * 1024); } while (0)
#define PG8_MMA(ai, bj, At, Bt) do { __builtin_amdgcn_s_setprio(1); _Pragma("unroll") for (int m = 0; m < 4; ++m) _Pragma("unroll") for (int n = 0; n < 2; ++n) _Pragma("unroll") for (int k = 0; k < 2; ++k) \
        acc[ai][bj][m][n] = __builtin_amdgcn_mfma_f32_16x16x32_bf16(Bt[n][k], At[m][k], acc[ai][bj][m][n], 0, 0, 0); __builtin_amdgcn_s_setprio(0); } while (0)
#define PG8_WAIT_V(n) asm volatile("s_waitcnt vmcnt(" #n ")" ::: "memory")
#define PG8_WAIT_L(n) asm volatile("s_waitcnt lgkmcnt(" #n ")" ::: "memory")
#define PG8_BAR __builtin_amdgcn_s_barrier()
#define PG8_SCHED __builtin_amdgcn_sched_barrier(0)
    Unit cur, nxt; int ui = 0;
    if (!S.next(0, cur)) return;
    f32x4 acc[2][2][4][2];
#pragma unroll
    for (int a = 0; a < 2; ++a)
#pragma unroll
        for (int b = 0; b < 2; ++b)
#pragma unroll
            for (int m = 0; m < 4; ++m)
#pragma unroll
                for (int n = 0; n < 2; ++n) acc[a][b][m][n] = (f32x4){0.f, 0.f, 0.f, 0.f};
    bf16x8 At[4][2], B0[2][2], B1[2][2];
    const char* cA = (const char*)g.A + (size_t)cur.pm * tstep; const char* cB = (const char*)g.Bt + (size_t)cur.pn * tstep;
    S.a_ready(cur);
    if constexpr (SP2) {
        PG8_STAGE(PG8_SB(0, 0), cB, voffB); PG8_STAGE(PG8_SB(0, 1), cB + hstep, voffB); PG8_STAGE(PG8_SA(0, 0), cA, voffA); PG8_STAGE(PG8_SA(0, 1), cA + hstep, voffA);
        if (wr == 1) PG8_BAR;
        PG8_WAIT_V(2); PG8_BAR;
        PG8_STAGE(PG8_SB(1, 0), cB + kstep, voffB); PG8_STAGE(PG8_SA(1, 0), cA + kstep, voffA); PG8_STAGE(PG8_SB(1, 1), cB + hstep + kstep, voffB);
        PG8_WAIT_V(6); PG8_BAR;
    } else {
        PG8_STAGE(PG8_SB(0, 0), cB, voffB); PG8_STAGE(PG8_SA(0, 0), cA, voffA); PG8_STAGE(PG8_SB(0, 1), cB + hstep, voffB); PG8_STAGE(PG8_SA(0, 1), cA + hstep, voffA);
        if (wr == 1) PG8_BAR;
        PG8_WAIT_V(4); PG8_BAR;
        PG8_STAGE(PG8_SB(1, 0), cB + kstep, voffB); PG8_STAGE(PG8_SA(1, 0), cA + kstep, voffA); PG8_STAGE(PG8_SB(1, 1), cB + hstep + kstep, voffB);
        PG8_WAIT_V(6); PG8_BAR;
    }
    for (;;) {
        const bool has_next = S.next(ui + 1, nxt);
        const char* nA = has_next ? (const char*)g.A + (size_t)nxt.pm * tstep : cA; const char* nB = has_next ? (const char*)g.Bt + (size_t)nxt.pn * tstep : cB;
        for (int t = 0; t < nt; t += 2) {
            const bool last = (t == nt - 2);
            const char* a1 = cA + (size_t)(t + 1) * kstep;
            const char* a2 = last ? nA : cA + (size_t)(t + 2) * kstep; const char* b2 = last ? nB : cB + (size_t)(t + 2) * kstep;
            const char* a3 = a2 + kstep; const char* b3 = b2 + kstep;
            if (last && has_next) S.a_ready(nxt);
            if constexpr (SP2) {
            PG8_LDB(B0, 0, 0); PG8_LDB(B1, 0, 1); PG8_SCHED; PG8_LDA(At, 0, 0); PG8_STAGE(PG8_SA(1, 1), a1 + hstep, voffA);
            PG8_WAIT_V(8); PG8_WAIT_L(0); PG8_BAR; PG8_MMA(0, 0, At, B0); PG8_MMA(0, 1, At, B1); PG8_BAR; PG8_SCHED;
            PG8_LDA(At, 0, 1); PG8_STAGE(PG8_SB(0, 0), b2, voffB); PG8_STAGE(PG8_SB(0, 1), b2 + hstep, voffB); PG8_STAGE(PG8_SA(0, 0), a2, voffA);
            PG8_WAIT_V(8); PG8_WAIT_L(0); PG8_BAR; PG8_MMA(1, 0, At, B0); PG8_MMA(1, 1, At, B1); PG8_BAR; PG8_SCHED;
            PG8_LDB(B0, 1, 0); PG8_LDB(B1, 1, 1); PG8_SCHED; PG8_LDA(At, 1, 0); PG8_STAGE(PG8_SA(0, 1), a2 + hstep, voffA);
            PG8_WAIT_V(8); PG8_WAIT_L(0); PG8_BAR; PG8_MMA(0, 0, At, B0); PG8_MMA(0, 1, At, B1); PG8_BAR; PG8_SCHED;
            PG8_LDA(At, 1, 1); PG8_STAGE(PG8_SB(1, 0), b3, voffB); PG8_STAGE(PG8_SB(1, 1), b3 + hstep, voffB); PG8_STAGE(PG8_SA(1, 0), a3, voffA);
            PG8_WAIT_V(8); PG8_WAIT_L(0); PG8_BAR; PG8_MMA(1, 0, At, B0); PG8_MMA(1, 1, At, B1); PG8_BAR; PG8_SCHED;
            } else {
            PG8_LDB(B0, 0, 0); PG8_SCHED; PG8_LDA(At, 0, 0); PG8_STAGE(PG8_SA(1, 1), a1 + hstep, voffA);
            PG8_WAIT_L(8); PG8_BAR; PG8_WAIT_L(0); PG8_MMA(0, 0, At, B0); PG8_BAR; PG8_SCHED;
            PG8_LDB(B1, 0, 1); PG8_STAGE(PG8_SB(0, 0), b2, voffB);
            PG8_BAR; PG8_WAIT_L(0); PG8_MMA(0, 1, At, B1); PG8_BAR;
            PG8_LDA(At, 0, 1); PG8_STAGE(PG8_SA(0, 0), a2, voffA);
            PG8_BAR; PG8_WAIT_L(0); PG8_MMA(1, 0, At, B0); PG8_BAR; PG8_SCHED;
            PG8_STAGE(PG8_SB(0, 1), b2 + hstep, voffB);
            PG8_WAIT_V(6); PG8_BAR; PG8_MMA(1, 1, At, B1); PG8_BAR;
            PG8_LDB(B0, 1, 0); PG8_SCHED; PG8_LDA(At, 1, 0); PG8_STAGE(PG8_SA(0, 1), a2 + hstep, voffA);
            PG8_WAIT_L(8); PG8_BAR; PG8_WAIT_L(0); PG8_MMA(0, 0, At, B0); PG8_BAR; PG8_SCHED;
            PG8_LDB(B1, 1, 1); PG8_STAGE(PG8_SB(1, 0), b3, voffB);
            PG8_BAR; PG8_WAIT_L(0); PG8_MMA(0, 1, At, B1); PG8_BAR;
            PG8_LDA(At, 1, 1); PG8_STAGE(PG8_SA(1, 0), a3, voffA);
            PG8_BAR; PG8_WAIT_L(0); PG8_MMA(1, 0, At, B0); PG8_BAR; PG8_SCHED;
            PG8_STAGE(PG8_SB(1, 1), b3 + hstep, voffB);
            PG8_WAIT_V(6); PG8_BAR; PG8_MMA(1, 1, At, B1); PG8_BAR;
            }
        }
        if constexpr (ALIGN_EPI) { if (wr == 0) PG8_BAR; }
        if constexpr (!Epi::AFTER_DRAIN) { E(acc, cur, wr, wc, fr, fq); S.done(cur); }
        if (!has_next) break;
#pragma unroll
        for (int a = 0; a < 2; ++a)
#pragma unroll
            for (int b = 0; b < 2; ++b)
#pragma unroll
                for (int m = 0; m < 4; ++m)
#pragma unroll
                    for (int n = 0; n < 2; ++n) acc[a][b][m][n] = (f32x4){0.f, 0.f, 0.f, 0.f};
        cur = nxt; cA = nA; cB = nB; ++ui;
        if constexpr (ALIGN_EPI) { if (wr == 1) PG8_BAR; }
    }
    PG8_WAIT_V(0);
    if constexpr (!ALIGN_EPI) { if (wr == 0) PG8_BAR; }
    PG8_BAR;
    if constexpr (Epi::AFTER_DRAIN) { E.fused(acc, cur, wr, wc, fr, fq, lds, wid, lane); S.done(cur); }
#undef PG8_SA
#undef PG8_SB
#undef PG8_STAGE
#undef PG8_LDA
#undef PG8_LDB
#undef PG8_MMA
#undef PG8_WAIT_V
#undef PG8_WAIT_L
#undef PG8_BAR
#undef PG8_SCHED
}

template <class Epi, class Sched, bool STAMP>
__device__ __forceinline__ void gemm_phase(PG8_LAS unsigned char* lds, const Gemm g, const Sched& S, const Epi& E, unsigned long long*) { gemm_phase<Epi, Sched, true, true>(lds, g, S, E); }
__device__ __forceinline__ float bf_lo(unsigned w) { return __uint_as_float(w << 16); }
__device__ __forceinline__ float bf_hi(unsigned w) { return __uint_as_float(w & 0xffff0000u); }
__device__ __forceinline__ float sigmoidf_(float x) { return __builtin_amdgcn_rcpf(1.0f + __expf(-x)); }

struct EpiStoreBf16 {
    static constexpr bool PERM = true, AFTER_DRAIN = false;
    bf16_t* O; int ldc; int npn;
    __device__ __forceinline__ void operator()(const f32x4 (&acc)[2][2][4][2], const Unit& u, int wr, int wc, int fr, int fq) const {
        const int pn = npn ? (u.pn % npn) : u.pn;
        const int row0 = u.pm * BM + wr * 64 + fr, col0 = pn * BM + wc * 32 + 8 * fq;
#pragma unroll
        for (int ai = 0; ai < 2; ++ai)
#pragma unroll
            for (int m = 0; m < 4; ++m) { bf16_t* rowp = O + (size_t)(row0 + ai * HALF + m * 16) * ldc + col0;
#pragma unroll
                for (int bj = 0; bj < 2; ++bj) { const f32x4 v0 = acc[ai][bj][m][0], v1 = acc[ai][bj][m][1];
                    u32x4 w; w.x = cvt_pk_bf16(v0[0], v0[1]); w.y = cvt_pk_bf16(v0[2], v0[3]); w.z = cvt_pk_bf16(v1[0], v1[1]); w.w = cvt_pk_bf16(v1[2], v1[3]);
                    *(u32x4*)(rowp + bj * HALF) = w; } }
    }
};
struct EpiSwiGLU {
    static constexpr bool PERM = true, AFTER_DRAIN = false;
    bf16_t* H; int ldh; int npn;
    __device__ __forceinline__ void operator()(const f32x4 (&acc)[2][2][4][2], const Unit& u, int wr, int wc, int fr, int fq) const {
        const int pn = npn ? (u.pn % npn) : u.pn;
        const int row0 = u.pm * BM + wr * 64 + fr, col0 = pn * HALF + wc * 32 + 8 * fq;
#pragma unroll
        for (int ai = 0; ai < 2; ++ai)
#pragma unroll
            for (int m = 0; m < 4; ++m) { bf16_t* rowp = H + (size_t)(row0 + ai * HALF + m * 16) * ldh + col0;
                float o[8];
#pragma unroll
                for (int n = 0; n < 2; ++n)
#pragma unroll
                    for (int j = 0; j < 4; ++j) { const float a = acc[ai][0][m][n][j], b = acc[ai][1][m][n][j]; o[n * 4 + j] = a * sigmoidf_(a) * b; }
                u32x4 w; w.x = cvt_pk_bf16(o[0], o[1]); w.y = cvt_pk_bf16(o[2], o[3]); w.z = cvt_pk_bf16(o[4], o[5]); w.w = cvt_pk_bf16(o[6], o[7]);
                *(u32x4*)rowp = w; }
    }
};
struct EpiMerge {
    static constexpr bool PERM = true, AFTER_DRAIN = false;
    const bf16_t* P; int ldp; bf16_t* Mb;
    __device__ __forceinline__ void operator()(const f32x4 (&acc)[2][2][4][2], const Unit& u, int wr, int wc, int fr, int fq) const {
        const int br = u.pn >> 3, pn = u.pn & 7, pm = u.pm - br * 66;
        const int row0 = pm * BM + wr * 64 + fr, col0 = pn * BM + wc * 32 + 8 * fq;
        u32x4 gc[2], qc[2], gn[2], qn[2];
        { const size_t row = (size_t)row0;
#pragma unroll
          for (int bj = 0; bj < 2; ++bj) { gc[bj] = *(const u32x4*)(P + row * ldp + br * 2048 + col0 + bj * HALF); if (br > 0) qc[bj] = *(const u32x4*)(Mb + row * 2048 + col0 + bj * HALF); } }
#pragma unroll
        for (int st = 0; st < 8; ++st) { const int ai = st >> 2, m = st & 3; const size_t row = (size_t)(row0 + ai * HALF + m * 16);
            if (st < 7) { const size_t rn = (size_t)(row0 + ((st + 1) >> 2) * HALF + ((st + 1) & 3) * 16);
#pragma unroll
                for (int bj = 0; bj < 2; ++bj) { gn[bj] = *(const u32x4*)(P + rn * ldp + br * 2048 + col0 + bj * HALF); if (br > 0) qn[bj] = *(const u32x4*)(Mb + rn * 2048 + col0 + bj * HALF); } }
#pragma unroll
            for (int bj = 0; bj < 2; ++bj) { const int col = col0 + bj * HALF; const u32x4 g = gc[bj];
                const f32x4 v0 = acc[ai][bj][m][0], v1 = acc[ai][bj][m][1];
                float o[8];
                o[0] = sigmoidf_(bf_lo(g.x)) * v0[0]; o[1] = sigmoidf_(bf_hi(g.x)) * v0[1]; o[2] = sigmoidf_(bf_lo(g.y)) * v0[2]; o[3] = sigmoidf_(bf_hi(g.y)) * v0[3];
                o[4] = sigmoidf_(bf_lo(g.z)) * v1[0]; o[5] = sigmoidf_(bf_hi(g.z)) * v1[1]; o[6] = sigmoidf_(bf_lo(g.w)) * v1[2]; o[7] = sigmoidf_(bf_hi(g.w)) * v1[3];
                if (br > 0) { const u32x4 q = qc[bj];
                    o[0] += bf_lo(q.x); o[1] += bf_hi(q.x); o[2] += bf_lo(q.y); o[3] += bf_hi(q.y); o[4] += bf_lo(q.z); o[5] += bf_hi(q.z); o[6] += bf_lo(q.w); o[7] += bf_hi(q.w); }
                u32x4 w; w.x = cvt_pk_bf16(o[0], o[1]); w.y = cvt_pk_bf16(o[2], o[3]); w.z = cvt_pk_bf16(o[4], o[5]); w.w = cvt_pk_bf16(o[6], o[7]);
                *(u32x4*)(Mb + row * 2048 + col) = w; }
            gc[0] = gn[0]; gc[1] = gn[1]; qc[0] = qn[0]; qc[1] = qn[1]; }
    }
};
struct MergeOrder {
    int ntile, G, c;
    __device__ bool next(int i, Unit& u) const { const int t = i / 3, br = i - 3 * t; const long q = (long)t * G + ((G & 7) == 0 ? (c & 7) * (G >> 3) + (c >> 3) : c); if (q >= ntile) return false;
        u.pm = br * 66 + (int)(q >> 3); u.pn = br * 8 + (int)(q & 7); return true; }
    __device__ __forceinline__ void a_ready(const Unit&) const {}
    __device__ __forceinline__ void done(const Unit&) const {}
};
struct EpiResid {
    static constexpr bool PERM = false, AFTER_DRAIN = false;
    const float* hin_lat; const float* hin_ctx; float* hout_lat; float* hout_ctx; const float* gate; int odd;
    __device__ __forceinline__ void operator()(const f32x4 (&acc)[2][2][4][2], const Unit& u, int wr, int wc, int fr, int fq) const {
        const int row0 = u.pm * BM + wr * 64 + fr, col0 = u.pn * BM + wc * 32 + 4 * fq;
        const float* gv0 = gate + ((u.pm * BM) < 16384 ? ((u.pm * BM) >> 13) : 2) * 12288;
        f32x4 gq[2][2];
#pragma unroll
        for (int bj = 0; bj < 2; ++bj)
#pragma unroll
            for (int n = 0; n < 2; ++n) gq[bj][n] = *(const f32x4*)(gv0 + col0 + bj * HALF + n * 16);
#pragma unroll
        for (int ai = 0; ai < 2; ++ai)
#pragma unroll
            for (int m = 0; m < 4; ++m) { const int R = row0 + ai * HALF + m * 16;
                const float* hi; float* ho;
                if (R < 16384) { const int b = R >> 13, lp = R & 8191; const int l = odd ? ((lp & 127) * 64 + (lp >> 7)) : lp; const size_t dr = (size_t)(b * 8192 + l) * 2048;
                    hi = hin_lat + dr; ho = hout_lat + dr; }
                else { const size_t dr = (size_t)(R - 16384) * 2048; hi = hin_ctx + dr; ho = hout_ctx + dr; }
                f32x4 hq[2][2];
#pragma unroll
                for (int bj = 0; bj < 2; ++bj)
#pragma unroll
                    for (int n = 0; n < 2; ++n) hq[bj][n] = *(const f32x4*)(hi + col0 + bj * HALF + n * 16);
#pragma unroll
                for (int bj = 0; bj < 2; ++bj)
#pragma unroll
                    for (int n = 0; n < 2; ++n) *(f32x4*)(ho + col0 + bj * HALF + n * 16) = hq[bj][n] + gq[bj][n] * acc[ai][bj][m][n]; }
    }
};
struct EpiGateMul {
    static constexpr bool PERM = true, AFTER_DRAIN = false;
    const bf16_t* Z; bf16_t* Y;
    __device__ __forceinline__ void operator()(const f32x4 (&acc)[2][2][4][2], const Unit& u, int wr, int wc, int fr, int fq) const {
        const int row0 = u.pm * BM + wr * 64 + fr, col0 = u.pn * BM + wc * 32 + 8 * fq;
#pragma unroll
        for (int ai = 0; ai < 2; ++ai)
#pragma unroll
            for (int m = 0; m < 4; ++m) { const size_t ro = (size_t)(row0 + ai * HALF + m * 16) * 2048 + col0;
#pragma unroll
                for (int bj = 0; bj < 2; ++bj) { const u32x4 z = *(const u32x4*)(Z + ro + bj * HALF); const f32x4 v0 = acc[ai][bj][m][0], v1 = acc[ai][bj][m][1];
                    u32x4 w; w.x = cvt_pk_bf16(bf_lo(z.x) * v0[0], bf_hi(z.x) * v0[1]); w.y = cvt_pk_bf16(bf_lo(z.y) * v0[2], bf_hi(z.y) * v0[3]);
                    w.z = cvt_pk_bf16(bf_lo(z.z) * v1[0], bf_hi(z.z) * v1[1]); w.w = cvt_pk_bf16(bf_lo(z.w) * v1[2], bf_hi(z.w) * v1[3]);
                    *(u32x4*)(Y + ro + bj * HALF) = w; }
                __builtin_amdgcn_sched_barrier(0); }
    }
};
struct MoeOrder {
    const int* tile_e; const int* ntiles; int npn, G, c, xmaj;
    __device__ bool next(int i, Unit& u) const { const long L = (long)i * G + (xmaj ? (c & 7) * (G >> 3) + (c >> 3) : c); const int nt = *ntiles; if (L >= (long)nt * npn) return false;
        const int pm = (int)(L / npn), pl = (int)(L - (long)pm * npn); u.pm = pm; u.pn = tile_e[pm] * npn + pl; return true; }
    __device__ __forceinline__ void a_ready(const Unit&) const {}
    __device__ __forceinline__ void done(const Unit&) const {}
};
}

#include <vector>
#include <vector>

#define XB_TMO      128
#define XB_XCNT(j)  (256  + 64 * (j))
#define XB_XSUB(j)  (1280 + 64 * (j))
#define XB_XGEN(j)  (2304 + 64 * (j))
#define XB_TOP      3328
#define XB_TOPGEN   3392
#define XCD_BAR_WORDS 3456
#define XB_SPIN_CAP (1u << 18)
#define LAS __attribute__((address_space(3)))

__device__ __forceinline__ unsigned xb_ld(unsigned* p)              { return __hip_atomic_load(p, __ATOMIC_RELAXED, __HIP_MEMORY_SCOPE_AGENT); }
__device__ __forceinline__ unsigned xb_add(unsigned* p, unsigned v) { return __hip_atomic_fetch_add(p, v, __ATOMIC_RELAXED, __HIP_MEMORY_SCOPE_AGENT); }
__device__ __forceinline__ unsigned xb_xcc_id() { return (unsigned)__builtin_amdgcn_s_getreg((3 << 11) | 20) & 0xFu; }
#define XB_SPIN(cond, bar) do { unsigned _sp = 0; while (cond) { __builtin_amdgcn_s_sleep(1); \
    if ((++_sp & 255u) == 0u) { if (xb_ld(&(bar)[XB_TMO])) break; if (_sp > XB_SPIN_CAP) { atomicAdd(&(bar)[XB_TMO], 1u); break; } } } } while (0)

struct XcdBarrier {
    unsigned* bar; unsigned x;
    volatile LAS unsigned* st;
};

__device__ __forceinline__ XcdBarrier xcd_barrier_post(unsigned* bar, volatile LAS unsigned* st) {
    XcdBarrier b; b.bar = bar; b.x = xb_xcc_id(); b.st = st;
    if (threadIdx.x == 0) (void)xb_add(&bar[XB_XCNT(b.x)], 1u);
    return b;
}
__device__ __forceinline__ void xcd_barrier_complete(unsigned* bar, unsigned x, unsigned& nloc, unsigned& nx) {
    const unsigned G = gridDim.x * gridDim.y * gridDim.z;
    unsigned sum, cnt, mine, sp = 0u;
    for (;;) {
        sum = 0u; cnt = 0u; mine = 0u;
#pragma unroll
        for (unsigned j = 0; j < 16; ++j) { const unsigned c = xb_ld(&bar[XB_XCNT(j)]); sum += c; cnt += (c > 0u) ? 1u : 0u; mine = (j == x) ? c : mine; }
        if (sum == G) break;
        __builtin_amdgcn_s_sleep(1);
        if ((++sp & 255u) == 0u) { if (xb_ld(&bar[XB_TMO])) break; if (sp > XB_SPIN_CAP) { atomicAdd(&bar[XB_TMO], 1u); break; } }
    }
    nloc = mine > 0u ? mine : 1u; nx = cnt > 0u ? cnt : 1u;
}

__device__ __forceinline__ void xcd_barrier(const XcdBarrier& b) {
    asm volatile("s_waitcnt vmcnt(0)" ::: "memory");
    __syncthreads();
    if (threadIdx.x == 0) {
        unsigned* bar = b.bar;
        __builtin_amdgcn_s_waitcnt(0);
        unsigned nloc = b.st[0], nx = b.st[1];
        if (nloc == 0u) { xcd_barrier_complete(bar, b.x, nloc, nx); b.st[0] = nloc; b.st[1] = nx; }
        const unsigned old = xb_add(&bar[XB_XSUB(b.x)], 1u);
        const unsigned gen = old / nloc;
        if (old + 1u == (gen + 1u) * nloc) {
            __builtin_amdgcn_fence(__ATOMIC_RELEASE, "agent");
            asm volatile("s_waitcnt vmcnt(0)" ::: "memory");
            const unsigned og = xb_add(&bar[XB_TOP], 1u);
            const unsigned tg = og / nx;
            if (og + 1u == (tg + 1u) * nx) xb_add(&bar[XB_TOPGEN], 1u);
            else XB_SPIN(xb_ld(&bar[XB_TOPGEN]) == tg, bar);
            __builtin_amdgcn_fence(__ATOMIC_ACQUIRE, "agent");
            xb_add(&bar[XB_XGEN(b.x)], 1u);
            asm volatile("s_waitcnt vmcnt(0)" ::: "memory");
        } else {
            XB_SPIN(xb_ld(&bar[XB_XGEN(b.x)]) == gen, bar);
            __builtin_amdgcn_fence(__ATOMIC_ACQUIRE, "agent");
            asm volatile("s_waitcnt vmcnt(0)" ::: "memory");
        }
    }
    __syncthreads();
}

typedef unsigned short bf16;
typedef unsigned v4u __attribute__((ext_vector_type(4)));
typedef unsigned v2u __attribute__((ext_vector_type(2)));
typedef float f32x4 __attribute__((ext_vector_type(4)));
constexpr int D = 2048, SEQ = 8192, CTXL = 256, MLAT = 16384, MCTX = 512, MROWS = 16896;
constexpr int NP = 22272;
constexpr int PG = 0, PL = 6144, PLG = 8192, PR = 10240, PK = 12288, PV = 14336, PZ = 16384, PX = 18432, PWL = 21504, PAL = 21696, PGL = 21888, PDT = 22144;
constexpr int N_IN = 22208;
constexpr float EPS = 1e-6f;
enum { I_X = 0, I_C, I_CTX, I_CCTX, I_ADAW, I_ADAB, I_NMIX, I_NFFN, I_NFIN, I_WIN, I_LCW, I_LCB, I_LGW, I_LGB, I_LLAM,
       I_RMU, I_RW0, I_RWUP, I_RA0, I_RAUP, I_RGUP, I_RKK, I_RKA, I_RRK, I_RLNW, I_RLNB,
       I_SCW, I_SCB, I_SALOG, I_SDTB, I_SD, I_SNW, I_WOL, I_WOR, I_WOS, I_WO, I_F1, I_F3, I_F2, I_MR, I_M1, I_M3, I_M2, N_INPUTS };
constexpr size_t MiB = 1u << 20;
constexpr size_t WS_CTL = 0, CTL_BYTES = 1 * MiB;
constexpr size_t WS_MOD = 1 * MiB;
constexpr size_t WS_ROUTE = 2 * MiB;
constexpr size_t WS_BONUS = 3 * MiB;
constexpr size_t WS_HCTX = 8 * MiB;
constexpr size_t WS_WOUT = 12 * MiB;
constexpr size_t WS_HLAT = 44 * MiB;
constexpr size_t WS_Y3 = 172 * MiB;
constexpr size_t WS_X1 = 370 * MiB;
constexpr size_t WS_U = WS_X1 + 87 * MiB;
constexpr size_t WS_P = 523 * MiB;
constexpr size_t WS_LGW = 1241 * MiB;
constexpr size_t WS_LORA = 1243 * MiB;
constexpr size_t WS_GUP = 1245 * MiB;
constexpr size_t WS_LAGG = 1246 * MiB;
constexpr size_t WS_LCAR = 1256 * MiB;
constexpr size_t WS_X2 = 1264 * MiB;
constexpr size_t WS_LIN = 1396 * MiB;
constexpr size_t WS_SG = 1409 * MiB;
constexpr size_t WS_M2 = 1418 * MiB;
constexpr size_t WS_END = 1514 * MiB;
constexpr size_t WS_F13 = WS_P, WS_F2 = WS_P + 48 * MiB, WS_FH = WS_P + 72 * MiB;
constexpr size_t WS_M13 = WS_P, WS_MA = WS_P + 288 * MiB, WS_MH = WS_P + 424 * MiB;
constexpr int MOE_ROWS = 34816;
static_assert(WS_MH + (size_t)MOE_ROWS * 3072 * 2 <= WS_END && WS_FH + (size_t)MROWS * 6144 * 2 <= WS_END && WS_P + (size_t)MROWS * NP * 2 <= WS_END, "ws map");
constexpr int CW_BAR = 4096;
constexpr int CW_CNT = 16384, CW_CUR = 16384 + 64;
constexpr int RT_TOKE = 0, RT_TOKP = 32768, RT_TOKROW = 65536, RT_TILEE = 98304, RT_NT = 98304 + 256, RT_BASE = 98304 + 320;
constexpr int LDS_BYTES = 163840, MISC_OFF = 163840 - 256;

struct Args { const float* in[N_INPUTS]; float* out; unsigned char* ws; int lo, hi; };

__device__ __forceinline__ float bf2f(bf16 b) { return __uint_as_float(((unsigned)b) << 16); }
typedef __bf16 hbf16x2 __attribute__((ext_vector_type(2)));
typedef float hf32x2 __attribute__((ext_vector_type(2)));
__device__ __forceinline__ unsigned pk2(float lo, float hi) { const hf32x2 v = {lo, hi}; const hbf16x2 b = __builtin_convertvector(v, hbf16x2); return __builtin_bit_cast(unsigned, b); }
__device__ __forceinline__ bf16 f2bf(float f) { return (bf16)(pk2(f, f) & 0xffffu); }
#define DPPF(v, ctrl) __int_as_float(__builtin_amdgcn_update_dpp(0, __float_as_int(v), (ctrl), 0xF, 0xF, true))
__device__ __forceinline__ float quad_xor1(float v) { return DPPF(v, 0xB1); }
__device__ __forceinline__ float quad_xor2(float v) { return DPPF(v, 0x4E); }
__device__ __forceinline__ float rdlane(float v, int l) { return __int_as_float(__builtin_amdgcn_readlane(__float_as_int(v), l)); }
__device__ __forceinline__ float wave_sum(float v) { v += DPPF(v, 0xB1); v += DPPF(v, 0x4E); v += DPPF(v, 0x141); v += DPPF(v, 0x140);
    v += __int_as_float(__builtin_amdgcn_update_dpp(0, __float_as_int(v), 0x142, 0xA, 0xF, false));
    v += __int_as_float(__builtin_amdgcn_update_dpp(0, __float_as_int(v), 0x143, 0xC, 0xF, false));
    return rdlane(v, 63); }
__device__ __forceinline__ float wave_scan(float v, int lane) { v += DPPF(v, 0x111); v += DPPF(v, 0x112); v += DPPF(v, 0x114); v += DPPF(v, 0x118);
    const float t0 = rdlane(v, 15), t1 = rdlane(v, 31), t2 = rdlane(v, 47); const int r = lane >> 4;
    return v + (r >= 1 ? t0 : 0.f) + (r >= 2 ? t1 : 0.f) + (r >= 3 ? t2 : 0.f); }
__device__ __forceinline__ float sigm(float x) { return __builtin_amdgcn_rcpf(1.0f + __expf(-x)); }
__device__ __forceinline__ float siluf(float x) { return x * sigm(x); }
__device__ __forceinline__ float softplusf(float x) { const float e = __expf(x); return x > 20.f ? x : (e < 0.05f ? e * (1.0f - e * (0.5f - e * (0.33333333f - 0.25f * e))) : __logf(1.0f + e)); }
__device__ __forceinline__ float tanh_fast(float x) { return 1.0f - 2.0f * __builtin_amdgcn_rcpf(1.0f + __expf(2.0f * x)); }
__device__ __forceinline__ float softplus_fast(float x) { return x > 20.f ? x : __logf(1.0f + __expf(x)); }
#define LBAR() do { asm volatile("s_waitcnt lgkmcnt(0)" ::: "memory"); __builtin_amdgcn_s_barrier(); asm volatile("" ::: "memory"); } while (0)
__device__ __forceinline__ float gelu_tanh(float x) { const float u = 0.7978845608028654f * (x + 0.044715f * x * x * x); return 0.5f * x * (1.0f + tanhf(u)); }
__device__ __forceinline__ void seq_pos(int row, int& pos, int& len) { if (row < MLAT) { pos = row & (SEQ - 1); len = SEQ; } else { pos = (row - MLAT) & (CTXL - 1); len = CTXL; } }
__device__ __forceinline__ int chain_row(int b, int dir, int s) { if (s < CTXL) { const int t = dir ? CTXL - 1 - s : s; return MLAT + b * CTXL + t; } s -= CTXL; const int t = dir ? SEQ - 1 - s : s; return b * SEQ + t; }
#define CROW(r0_, dir_, t_) ((dir_) ? (r0_) - (t_) : (r0_) + (t_))
__device__ __forceinline__ float Pat(const bf16* P, int row, int col) { return bf2f(P[(size_t)row * NP + col]); }
__device__ __forceinline__ float shifted(const bf16* P, int row, int col, float mu) {
    int pos, len; seq_pos(row, pos, len);
    const float p = Pat(P, row, col), pv = pos > 0 ? Pat(P, row - 1, col) : 0.f, nx = pos < len - 1 ? Pat(P, row + 1, col) : 0.f;
    return p + mu * (0.5f * (pv + nx) - p);
}
__device__ __forceinline__ float dwconv(const bf16* P, int row, int col, const float* w, int ncol, int wc, float bias) {
    int pos, len; seq_pos(row, pos, len);
    float o = bias;
#pragma unroll
    for (int tap = 0; tap < 4; ++tap) { const int q = pos + tap - 2; if (q >= 0 && q < len) o += w[tap * ncol + wc] * Pat(P, row + tap - 2, col); }
    return o;
}
#define LAS3 __attribute__((address_space(3)))

struct Frame { const Args* a; unsigned char* ws; LAS3 unsigned char* lds; int tid, lane, wave, G, bid; };

__device__ __forceinline__ void phase_mod(const Frame& F) {
    LAS3 float* sv = (LAS3 float*)F.lds;
    LAS3 float* red = sv + 3 * 2048;
    const float* c = F.a->in[I_C]; const float* cc = F.a->in[I_CCTX];
    for (int i = F.tid; i < 3 * 2048; i += 512) { const int w = i >> 11, k = i & 2047; const float x = w < 2 ? c[w * 2048 + k] : cc[k]; sv[i] = siluf(x); }
    __syncthreads();
    float* mod = (float*)(F.ws + WS_MOD);
    const int q = F.tid & 31, kg = F.tid >> 5;
    for (int unit = F.bid; unit < 256; unit += F.G) {
        const int layer = unit >> 7, col0 = (unit & 127) * 96;
        if (q < 24) {
            const float* W = F.a->in[I_ADAW] + (size_t)layer * 2048 * 12288 + col0 + q * 4;
            f32x4 a0 = (f32x4){0.f, 0.f, 0.f, 0.f}, a1 = a0, a2 = a0;
#pragma unroll 1
            for (int k0 = kg * 128; k0 < kg * 128 + 128; k0 += 16) { f32x4 wv[16];
#pragma unroll
                for (int i = 0; i < 16; ++i) wv[i] = *(const f32x4*)(W + (size_t)(k0 + i) * 12288);
#pragma unroll
                for (int i4 = 0; i4 < 4; ++i4) { const f32x4 s0 = *(const LAS3 f32x4*)(sv + k0 + 4 * i4), s1 = *(const LAS3 f32x4*)(sv + 2048 + k0 + 4 * i4), s2 = *(const LAS3 f32x4*)(sv + 4096 + k0 + 4 * i4);
#pragma unroll
                    for (int e = 0; e < 4; ++e) { a0 += wv[i4 * 4 + e] * s0[e]; a1 += wv[i4 * 4 + e] * s1[e]; a2 += wv[i4 * 4 + e] * s2[e]; } } }
            *(LAS3 f32x4*)(red + (kg * 3 + 0) * 96 + q * 4) = a0; *(LAS3 f32x4*)(red + (kg * 3 + 1) * 96 + q * 4) = a1; *(LAS3 f32x4*)(red + (kg * 3 + 2) * 96 + q * 4) = a2; }
        __syncthreads();
        if (F.tid < 288) { const int w = F.tid / 96, j = F.tid - w * 96; float sum = F.a->in[I_ADAB][layer * 12288 + col0 + j];
#pragma unroll
            for (int g = 0; g < 16; ++g) sum += red[(g * 3 + w) * 96 + j];
            mod[(size_t)(layer * 3 + w) * 12288 + col0 + j] = sum; }
        __syncthreads();
    }
}

__device__ __forceinline__ int map_row(int type, int base, int n) {
    if (type == 0) return base + n;
    if (type == 2) return base + (n >> 7) * 256 + (n & 127);
    if (n < 16384) return n;
    if (n < 17024) return PWL + (n - 16384);
    if (n < 22144) return n - 640;
    return PDT + (n - 22144);
}
__device__ __forceinline__ void convT(const Frame& F, const float* src, int K, int N, bf16* dst, int type, int base, int& tile_rot, int nw, int rk) {
    LAS3 float* tile = (LAS3 float*)F.lds;
    const int nkt = K / 64, nnt = N / 64, nt = nkt * nnt;
    for (int t = (rk + nw - (tile_rot % nw)) % nw; t < nt; t += nw) {
        const int kt = t % nkt, ntl = t / nkt, k0 = kt * 64, n0 = ntl * 64;
        { const int r = F.tid >> 4, c4 = (F.tid & 15) * 4;
#pragma unroll
          for (int p = 0; p < 2; ++p) { const f32x4 v = *(const f32x4*)(src + (size_t)(k0 + r + p * 32) * N + n0 + c4);
              tile[(r + p * 32) * 65 + c4 + 0] = v[0]; tile[(r + p * 32) * 65 + c4 + 1] = v[1]; tile[(r + p * 32) * 65 + c4 + 2] = v[2]; tile[(r + p * 32) * 65 + c4 + 3] = v[3]; } }
        __syncthreads();
        { const int n = F.tid >> 3, kq = (F.tid & 7) * 8; float v[8];
#pragma unroll
          for (int i = 0; i < 8; ++i) v[i] = tile[(kq + i) * 65 + n];
          v4u w; w.x = pk2(v[0], v[1]); w.y = pk2(v[2], v[3]); w.z = pk2(v[4], v[5]); w.w = pk2(v[6], v[7]);
          *(v4u*)(dst + (size_t)map_row(type, base, n0 + n) * K + k0 + kq) = w; }
        __syncthreads();
    }
    tile_rot += nt;
}
__device__ __forceinline__ void phase_convw_layer(const Frame& F, int L, int nw, int rk) {
    int rot = 0;
    bf16* wt_in = (bf16*)(F.ws + WS_X1); bf16* wt_out = (bf16*)(F.ws + WS_WOUT);
    convT(F, F.a->in[I_WIN] + (size_t)L * 2048 * N_IN, 2048, N_IN, wt_in, 1, 0, rot, nw, rk);
    for (int i = rk * 512 + F.tid; i < 64 * 2048 / 8; i += nw * 512) ((v4u*)(wt_in + (size_t)N_IN * 2048))[i] = (v4u){0u, 0u, 0u, 0u};
    convT(F, F.a->in[I_WOL] + (size_t)L * 2048 * 2048, 2048, 2048, wt_out, 0, 0, rot, nw, rk);
    convT(F, F.a->in[I_WOR] + (size_t)L * 2048 * 2048, 2048, 2048, wt_out, 0, 2048, rot, nw, rk);
    convT(F, F.a->in[I_WOS] + (size_t)L * 2048 * 2048, 2048, 2048, wt_out, 0, 4096, rot, nw, rk);
    convT(F, F.a->in[I_WO] + (size_t)L * 2048 * 2048, 2048, 2048, wt_out, 0, 6144, rot, nw, rk);
    convT(F, F.a->in[I_RGUP] + (size_t)L * 256 * 2048, 256, 2048, (bf16*)(F.ws + WS_GUP), 0, 0, rot, nw, rk);
    for (int m = 0; m < 64; ++m) convT(F, F.a->in[I_LGW] + ((size_t)L * 64 + m) * 128 * 128, 128, 128, (bf16*)(F.ws + WS_LGW), 0, m * 128, rot, nw, rk);
}
__device__ __forceinline__ void phase_convw_ffn(const Frame& F, int L, int nw, int rk, int part = 3) {
    int rot = 0;
    if (L == 0) {
        convT(F, F.a->in[I_F1], 2048, 6144, (bf16*)(F.ws + WS_F13), 2, 0, rot, nw, rk);
        convT(F, F.a->in[I_F3], 2048, 6144, (bf16*)(F.ws + WS_F13), 2, 128, rot, nw, rk);
        convT(F, F.a->in[I_F2], 6144, 2048, (bf16*)(F.ws + WS_F2), 0, 0, rot, nw, rk);
    } else {
        for (int e = 0; e < 8; ++e) {
            if (part & 1) { convT(F, F.a->in[I_M1] + (size_t)e * 2048 * 3072, 2048, 3072, (bf16*)(F.ws + WS_M13), 2, e * 6144, rot, nw, rk);
                            convT(F, F.a->in[I_M3] + (size_t)e * 2048 * 3072, 2048, 3072, (bf16*)(F.ws + WS_M13), 2, e * 6144 + 128, rot, nw, rk); }
            if (part & 2) convT(F, F.a->in[I_M2] + (size_t)e * 3072 * 2048, 3072, 2048, (bf16*)(F.ws + WS_M2), 0, e * 2048, rot, nw, rk);
        }
    }
}

template <bool ROUTER> __forceinline__
__device__ __forceinline__ void phase_norm(const Frame& F, const float* hlat, const float* hctx, const float* gain, const float* modL, int sh_off, int sc_off, bf16* out, int permute, int nrows) {
    const float* router = F.a->in[I_MR];
    int* rt = (int*)(F.ws + WS_ROUTE); unsigned* ctl = (unsigned*)(F.ws + WS_CTL);
    LAS3 float* CA = (LAS3 float*)F.lds; LAS3 float* CB = CA + 3 * 2048; LAS3 f32x4* RLa = (LAS3 f32x4*)(CB + 3 * 2048); LAS3 f32x4* RLb = RLa + 2048;
    for (int idx = F.tid; idx < 3 * 2048; idx += 512) { const int mb = idx >> 11, c = idx & 2047; const float* mv = modL + mb * 12288; CA[idx] = gain[c] * (1.0f + mv[sc_off + c]); CB[idx] = mv[sh_off + c]; }
    if (ROUTER) for (int c = F.tid; c < 2048; c += 512) { const int slot = ((c >> 8) * 4 + (c & 3)) * 64 + ((c >> 2) & 63);
        RLa[slot] = *(const f32x4*)(router + (size_t)c * 8); RLb[slot] = *(const f32x4*)(router + (size_t)c * 8 + 4); }
    __syncthreads();
    for (int row = F.bid * 8 + F.wave; row < nrows; row += F.G * 8) {
        int lane = F.lane; asm volatile("" : "+v"(lane));
        const float* src; int mb; int drow;
        if (row < MLAT) { const int b = row >> 13, l = row & 8191; src = hlat + (size_t)row * D; mb = b;
            drow = permute ? (b * 8192 + (l & 63) * 128 + (l >> 6)) : row; }
        else { src = hctx + (size_t)(row - MLAT) * D; mb = 2; drow = row; }
        f32x4 x[8]; float ss = 0.f;
#pragma unroll
        for (int i = 0; i < 8; ++i) { x[i] = *(const f32x4*)(src + i * 256 + lane * 4); ss += x[i][0] * x[i][0] + x[i][1] * x[i][1] + x[i][2] * x[i][2] + x[i][3] * x[i][3]; }
        ss = wave_sum(ss);
        const float rs = rsqrtf(ss * (1.0f / D) + EPS);
        float lg[8];
        if (ROUTER) {
#pragma unroll
            for (int e = 0; e < 8; ++e) lg[e] = 0.f; }
#pragma unroll
        for (int i = 0; i < 8; ++i) { const int c = i * 256 + lane * 4;
            const f32x4 ca = *(const LAS3 f32x4*)(CA + mb * 2048 + c), cb = *(const LAS3 f32x4*)(CB + mb * 2048 + c);
            f32x4 v;
#pragma unroll
            for (int j = 0; j < 4; ++j) v[j] = x[i][j] * rs * ca[j] + cb[j];
            uint2 w; w.x = pk2(v[0], v[1]); w.y = pk2(v[2], v[3]);
            *(uint2*)(out + (size_t)drow * D + c) = w;
            if (ROUTER) {
#pragma unroll
                for (int j = 0; j < 4; ++j) { const f32x4 r0 = RLa[(i * 4 + j) * 64 + lane], r1 = RLb[(i * 4 + j) * 64 + lane];
                    lg[0] += v[j] * r0[0]; lg[1] += v[j] * r0[1]; lg[2] += v[j] * r0[2]; lg[3] += v[j] * r0[3]; lg[4] += v[j] * r1[0]; lg[5] += v[j] * r1[1]; lg[6] += v[j] * r1[2]; lg[7] += v[j] * r1[3]; } }
        }
        if (ROUTER) {
#pragma unroll
            for (int e = 0; e < 8; ++e) lg[e] = wave_sum(lg[e]);
            if (lane == 0) {
                int e0 = 0; float v0 = lg[0];
#pragma unroll
                for (int e = 1; e < 8; ++e) if (lg[e] > v0) { v0 = lg[e]; e0 = e; }
                int e1 = -1; float v1 = -3.0e38f;
#pragma unroll
                for (int e = 0; e < 8; ++e) if (e != e0 && lg[e] > v1) { v1 = lg[e]; e1 = e; }
                const float p0 = 1.0f / (1.0f + __expf(v1 - v0));
                rt[RT_TOKE + row * 2] = e0; rt[RT_TOKE + row * 2 + 1] = e1;
                ((float*)rt)[RT_TOKP + row * 2] = p0; ((float*)rt)[RT_TOKP + row * 2 + 1] = 1.0f - p0;
                atomicAdd(&ctl[CW_CNT + e0], 1u); atomicAdd(&ctl[CW_CNT + e1], 1u);
            }
        }
    }
}

typedef short bf16x8 __attribute__((ext_vector_type(8)));
__device__ __forceinline__ bf16x8 ldfrag(const LAS3 bf16* p, int ld, int r0, int k0, int fr, int fq) { return *(const LAS3 bf16x8*)(p + (r0 + fr) * ld + k0 + 8 * fq); }
__device__ __forceinline__ bf16x8 ldfrag_sw(const LAS3 bf16* p, int ld, int r0, int k0, int fr, int fq) { const int r = r0 + fr, c = ((k0 >> 3) + fq) ^ ((r >> 3) & 7); return *(const LAS3 bf16x8*)(p + r * ld + c * 8); }
__device__ __forceinline__ bf16x8 ldfrag_g(const bf16* p, int ld, int r0, int k0, int fr, int fq) { return *(const bf16x8*)(p + (size_t)(r0 + fr) * ld + k0 + 8 * fq); }
#define MMA_TRN(acc, xf, yf) acc = __builtin_amdgcn_mfma_f32_16x16x32_bf16(yf, xf, acc, 0, 0, 0)
#define MMA_STD(acc, xf, yf) acc = __builtin_amdgcn_mfma_f32_16x16x32_bf16(xf, yf, acc, 0, 0, 0)
__device__ __forceinline__ void phase_rwkv_seq(const Frame& F, int L) {
    const bf16* P = (const bf16*)(F.ws + WS_P);
    bf16* ydir = (bf16*)(F.ws + WS_X1);
    float* bonus = (float*)(F.ws + WS_BONUS);
    const float* mu = F.a->in[I_RMU] + (size_t)L * 6784;
    LAS3 float* Fr = (LAS3 float*)F.lds; LAS3 float* Fk = Fr + 2048; LAS3 float* Fv = Fk + 2048; LAS3 float* Fa = Fv + 2048; LAS3 float* Fb = Fa + 2048; LAS3 float* Fw = Fb + 2048;
    LAS3 float* Lw = Fw + 2048; LAS3 float* La = Lw + 32 * 96; LAS3 float* Yb = La + 32 * 96;
    for (int unit = F.bid; unit < 128; unit += F.G) {
        const int b = unit >> 6, h = (unit >> 1) & 31, d = unit & 1;
        const float* w0 = F.a->in[I_RW0] + (size_t)(L * 2 + d) * 2048; const float* a0 = F.a->in[I_RA0] + (size_t)(L * 2 + d) * 2048;
        const float* wup = F.a->in[I_RWUP] + (size_t)(L * 2 + d) * 96 * 2048; const float* aup = F.a->in[I_RAUP] + (size_t)(L * 2 + d) * 96 * 2048;
        const float* kkw = F.a->in[I_RKK] + (size_t)L * 2048; const float* kaw = F.a->in[I_RKA] + (size_t)L * 2048; const float* rkw = F.a->in[I_RRK] + (size_t)L * 2048;
        float S[8];
#pragma unroll
        for (int j = 0; j < 8; ++j) S[j] = 0.f;
        for (int ch = 0; ch < 264; ++ch) {
            for (int idx = F.tid; idx < 32 * 96; idx += 512) { const int t = idx / 96, j = idx - t * 96; const int row = chain_row(b, d, ch * 32 + t);
                Lw[idx] = tanhf(shifted(P, row, PWL + d * 96 + j, mu[6144 + d * 96 + j]));
                La[idx] = shifted(P, row, PAL + d * 96 + j, mu[6144 + 192 + d * 96 + j]); }
            __syncthreads();
            for (int i = 0; i < 4; ++i) { const int t = F.wave * 4 + i, c = F.lane, col = h * 64 + c; const int row = chain_row(b, d, ch * 32 + t);
                const float r = shifted(P, row, PR + col, mu[col]), k = shifted(P, row, PK + col, mu[2048 + col]), v = shifted(P, row, PV + col, mu[4096 + col]);
                float wpre = w0[col], apre = a0[col];
                for (int j = 0; j < 96; ++j) { wpre += Lw[t * 96 + j] * wup[(size_t)j * 2048 + col]; apre += La[t * 96 + j] * aup[(size_t)j * 2048 + col]; }
                const float wraw = -softplusf(-wpre) - 0.5f, wdec = __expf(-__expf(wraw)), asig = sigm(apre);
                const float kkv = k * kkw[col], n2 = wave_sum(kkv * kkv), kk = kkv * rsqrtf(n2 + 1e-12f);
                const float key = k * (1.0f + (asig - 1.0f) * kaw[col]);
                const float bon = wave_sum(r * key * rkw[col]);
                if (c == 0) bonus[((size_t)d * MROWS + row) * 32 + h] = bon;
                Fr[t * 64 + c] = r; Fk[t * 64 + c] = key; Fv[t * 64 + c] = v; Fa[t * 64 + c] = -kk; Fb[t * 64 + c] = kk * asig; Fw[t * 64 + c] = wdec; }
            __syncthreads();
            { const int vi = F.tid >> 3, kp = F.tid & 7;
              for (int t = 0; t < 32; ++t) { const int o = t * 64 + kp * 8;
                  float sa = 0.f;
#pragma unroll
                  for (int j = 0; j < 8; ++j) sa += S[j] * Fa[o + j];
                  sa += __shfl_xor(sa, 1); sa += __shfl_xor(sa, 2); sa += __shfl_xor(sa, 4);
                  const float vv = Fv[t * 64 + vi]; float y = 0.f;
#pragma unroll
                  for (int j = 0; j < 8; ++j) { S[j] = S[j] * Fw[o + j] + sa * Fb[o + j] + vv * Fk[o + j]; y += S[j] * Fr[o + j]; }
                  y += __shfl_xor(y, 1); y += __shfl_xor(y, 2); y += __shfl_xor(y, 4);
                  if (kp == 0) Yb[t * 64 + vi] = y; } }
            __syncthreads();
            for (int idx = F.tid; idx < 2048; idx += 512) { const int t = idx >> 6, c = idx & 63; const int row = chain_row(b, d, ch * 32 + t);
                ydir[((size_t)d * MROWS + row) * D + h * 64 + c] = f2bf(Yb[idx]); }
        }
        __syncthreads();
    }
}
__device__ __forceinline__ void phase_rwkv_out(const Frame& F, int L) {
    const bf16* P = (const bf16*)(F.ws + WS_P);
    const bf16* ydir = (const bf16*)(F.ws + WS_X1);
    const float* bonus = (const float*)(F.ws + WS_BONUS);
    bf16* Y = (bf16*)(F.ws + WS_Y3) + (size_t)1 * MROWS * D;
    const float* mu = F.a->in[I_RMU] + (size_t)L * 6784;
    const bf16* GupT = (const bf16*)(F.ws + WS_GUP);
    const float* lnw = F.a->in[I_RLNW] + (size_t)L * 2048; const float* lnb = F.a->in[I_RLNB] + (size_t)L * 2048;
    LAS3 bf16* sg = (LAS3 bf16*)F.lds;
    for (int unit = F.bid; unit < MROWS / 16; unit += F.G) {
        int tid = F.tid; asm volatile("" : "+v"(tid));
        const int lane = tid & 63, wave = __builtin_amdgcn_readfirstlane(tid >> 6), fr = lane & 15, fq = lane >> 4;
        const int row0 = unit * 16;
        { const int t = tid >> 5, j8 = (tid & 31) * 8, row = row0 + t; int pos, len; seq_pos(row, pos, len);
          const v4u x = *(const v4u*)(P + (size_t)row * NP + PGL + j8); v4u xp = (v4u){0u, 0u, 0u, 0u}, xn = xp;
          if (pos > 0) xp = *(const v4u*)(P + (size_t)(row - 1) * NP + PGL + j8);
          if (pos < len - 1) xn = *(const v4u*)(P + (size_t)(row + 1) * NP + PGL + j8);
          const float* mp = mu + 6144 + 384 + j8; float o[8];
          const float xv[8] = {pg8::bf_lo(x.x), pg8::bf_hi(x.x), pg8::bf_lo(x.y), pg8::bf_hi(x.y), pg8::bf_lo(x.z), pg8::bf_hi(x.z), pg8::bf_lo(x.w), pg8::bf_hi(x.w)};
          const float pv[8] = {pg8::bf_lo(xp.x), pg8::bf_hi(xp.x), pg8::bf_lo(xp.y), pg8::bf_hi(xp.y), pg8::bf_lo(xp.z), pg8::bf_hi(xp.z), pg8::bf_lo(xp.w), pg8::bf_hi(xp.w)};
          const float nv[8] = {pg8::bf_lo(xn.x), pg8::bf_hi(xn.x), pg8::bf_lo(xn.y), pg8::bf_hi(xn.y), pg8::bf_lo(xn.z), pg8::bf_hi(xn.z), pg8::bf_lo(xn.w), pg8::bf_hi(xn.w)};
#pragma unroll
          for (int j = 0; j < 8; ++j) o[j] = sigm(xv[j] + mp[j] * (0.5f * (pv[j] + nv[j]) - xv[j]));
          v4u w; w.x = pk2(o[0], o[1]); w.y = pk2(o[2], o[3]); w.z = pk2(o[4], o[5]); w.w = pk2(o[6], o[7]);
          *(LAS3 v4u*)(sg + t * 264 + j8) = w; }
        LBAR();
        bf16x8 af[8];
#pragma unroll
        for (int ks = 0; ks < 8; ++ks) af[ks] = ldfrag(sg, 264, 0, ks * 32, fr, fq);
        const int row = row0 + fr; int pos, len; seq_pos(row, pos, len);
#pragma unroll 1
        for (int hh = 0; hh < 4; ++hh) { const int h = wave * 4 + hh;
            f32x4 g[4], y[4];
#pragma unroll
            for (int nt = 0; nt < 4; ++nt) { g[nt] = (f32x4){0.f, 0.f, 0.f, 0.f};
#pragma unroll
                for (int ks = 0; ks < 8; ++ks) MMA_TRN(g[nt], af[ks], ldfrag_g(GupT, 256, h * 64 + nt * 16, ks * 32, fr, fq)); }
            float s1 = 0.f;
#pragma unroll
            for (int nt = 0; nt < 4; ++nt) { const int c4 = h * 64 + nt * 16 + 4 * fq;
                const uint2 a = *(const uint2*)(ydir + (size_t)row * D + c4), bb = *(const uint2*)(ydir + ((size_t)MROWS + row) * D + c4);
                y[nt][0] = pg8::bf_lo(a.x) + pg8::bf_lo(bb.x); y[nt][1] = pg8::bf_hi(a.x) + pg8::bf_hi(bb.x); y[nt][2] = pg8::bf_lo(a.y) + pg8::bf_lo(bb.y); y[nt][3] = pg8::bf_hi(a.y) + pg8::bf_hi(bb.y);
                s1 += y[nt][0] + y[nt][1] + y[nt][2] + y[nt][3]; }
            s1 += __shfl_xor(s1, 16); s1 += __shfl_xor(s1, 32);
            const float mean = s1 * (1.0f / 64.0f); float q = 0.f;
#pragma unroll
            for (int nt = 0; nt < 4; ++nt)
#pragma unroll
                for (int e = 0; e < 4; ++e) { const float dl = y[nt][e] - mean; q += dl * dl; }
            q += __shfl_xor(q, 16); q += __shfl_xor(q, 32);
            const float rstd = rsqrtf(q * (1.0f / 64.0f) + 64e-5f);
            const float bon = bonus[(size_t)row * 32 + h] + bonus[((size_t)MROWS + row) * 32 + h];
#pragma unroll
            for (int nt = 0; nt < 4; ++nt) { const int c4 = h * 64 + nt * 16 + 4 * fq;
                const uint2 x = *(const uint2*)(P + (size_t)row * NP + PV + c4); uint2 xp = make_uint2(0u, 0u), xn = xp;
                if (pos > 0) xp = *(const uint2*)(P + (size_t)(row - 1) * NP + PV + c4);
                if (pos < len - 1) xn = *(const uint2*)(P + (size_t)(row + 1) * NP + PV + c4);
                const f32x4 lw = *(const f32x4*)(lnw + c4), lb = *(const f32x4*)(lnb + c4), muv = *(const f32x4*)(mu + 4096 + c4);
                const float xv[4] = {pg8::bf_lo(x.x), pg8::bf_hi(x.x), pg8::bf_lo(x.y), pg8::bf_hi(x.y)}, pv[4] = {pg8::bf_lo(xp.x), pg8::bf_hi(xp.x), pg8::bf_lo(xp.y), pg8::bf_hi(xp.y)}, nv[4] = {pg8::bf_lo(xn.x), pg8::bf_hi(xn.x), pg8::bf_lo(xn.y), pg8::bf_hi(xn.y)};
                float o[4];
#pragma unroll
                for (int e = 0; e < 4; ++e) { const float vv = xv[e] + muv[e] * (0.5f * (pv[e] + nv[e]) - xv[e]); o[e] = ((y[nt][e] - mean) * rstd * lw[e] + lb[e] + bon * vv) * g[nt][e]; }
                uint2 w; w.x = pk2(o[0], o[1]); w.y = pk2(o[2], o[3]);
                *(uint2*)(Y + (size_t)row * D + c4) = w; } }
        LBAR();
    }
}

__device__ __forceinline__ void phase_ssm_seq(const Frame& F, int L) {
    const bf16* P = (const bf16*)(F.ws + WS_P);
    bf16* ydir = (bf16*)(F.ws + WS_X1);
    const float* cw = F.a->in[I_SCW] + (size_t)L * 4 * 3072; const float* cb = F.a->in[I_SCB] + (size_t)L * 3072;
    LAS3 float* X = (LAS3 float*)F.lds; LAS3 float* Bm = X + 32 * 64; LAS3 float* Cm = Bm + 32 * 128; LAS3 float* dtv = Cm + 32 * 128; LAS3 float* dav = dtv + 32; LAS3 float* Yb = dav + 32;
    for (int unit = F.bid; unit < 128; unit += F.G) {
        const int b = unit >> 6, h = (unit >> 1) & 31, d = unit & 1, g = h >> 3;
        const float Ad = -__expf(F.a->in[I_SALOG][(L * 2 + d) * 32 + h]); const float dtb = F.a->in[I_SDTB][(L * 2 + d) * 32 + h];
        float hs[16];
#pragma unroll
        for (int j = 0; j < 16; ++j) hs[j] = 0.f;
        for (int ch = 0; ch < 264; ++ch) {
            for (int idx = F.tid; idx < 32 * 320; idx += 512) { const int t = idx / 320, q = idx - t * 320; const int row = chain_row(b, d, ch * 32 + t);
                const int col = q < 64 ? h * 64 + q : (q < 192 ? 2048 + g * 128 + (q - 64) : 2560 + g * 128 + (q - 192));
                const float v = siluf(dwconv(P, row, PX + col, cw, 3072, col, cb[col]));
                if (q < 64) X[t * 64 + q] = v; else if (q < 192) Bm[t * 128 + q - 64] = v; else Cm[t * 128 + q - 192] = v; }
            if (F.tid < 32) { const int row = chain_row(b, d, ch * 32 + F.tid); const float dt = softplusf(Pat(P, row, PDT + d * 32 + h) + dtb); dtv[F.tid] = dt; dav[F.tid] = __expf(dt * Ad); }
            __syncthreads();
            { const int p = F.tid >> 3, np = F.tid & 7;
              for (int t = 0; t < 32; ++t) { const float da = dav[t], xs = dtv[t] * X[t * 64 + p]; float y = 0.f;
#pragma unroll
                  for (int j = 0; j < 16; ++j) { hs[j] = hs[j] * da + xs * Bm[t * 128 + np * 16 + j]; y += hs[j] * Cm[t * 128 + np * 16 + j]; }
                  y += __shfl_xor(y, 1); y += __shfl_xor(y, 2); y += __shfl_xor(y, 4);
                  if (np == 0) Yb[t * 64 + p] = y; } }
            __syncthreads();
            for (int idx = F.tid; idx < 2048; idx += 512) { const int t = idx >> 6, c = idx & 63; const int row = chain_row(b, d, ch * 32 + t);
                ydir[((size_t)d * MROWS + row) * D + h * 64 + c] = f2bf(Yb[idx]); }
        }
        __syncthreads();
    }
}
__device__ __forceinline__ void phase_ssm_out(const Frame& F, int L) {
    const bf16* P = (const bf16*)(F.ws + WS_P);
    const bf16* ydir = (const bf16*)(F.ws + WS_X1);
    bf16* Y = (bf16*)(F.ws + WS_Y3) + (size_t)2 * MROWS * D; const bf16* XA = (const bf16*)(F.ws + WS_X2);
    const float* dsk = F.a->in[I_SD] + (size_t)L * 32; const float* nw = F.a->in[I_SNW] + (size_t)L * 2048;
    for (int row = F.bid * 8 + F.wave; row < MROWS; row += F.G * 8) {
#pragma unroll 2
        for (int g = 0; g < 4; ++g) { const int c0 = g * 512 + F.lane * 8;
            const v4u a = *(const v4u*)(ydir + (size_t)row * D + c0), bb = *(const v4u*)(ydir + ((size_t)MROWS + row) * D + c0), zz = *(const v4u*)(P + (size_t)row * NP + PZ + c0);
            float y[8], z[8];
            y[0] = pg8::bf_lo(a.x) + pg8::bf_lo(bb.x); y[1] = pg8::bf_hi(a.x) + pg8::bf_hi(bb.x); y[2] = pg8::bf_lo(a.y) + pg8::bf_lo(bb.y); y[3] = pg8::bf_hi(a.y) + pg8::bf_hi(bb.y);
            y[4] = pg8::bf_lo(a.z) + pg8::bf_lo(bb.z); y[5] = pg8::bf_hi(a.z) + pg8::bf_hi(bb.z); y[6] = pg8::bf_lo(a.w) + pg8::bf_lo(bb.w); y[7] = pg8::bf_hi(a.w) + pg8::bf_hi(bb.w);
            z[0] = pg8::bf_lo(zz.x); z[1] = pg8::bf_hi(zz.x); z[2] = pg8::bf_lo(zz.y); z[3] = pg8::bf_hi(zz.y); z[4] = pg8::bf_lo(zz.z); z[5] = pg8::bf_hi(zz.z); z[6] = pg8::bf_lo(zz.w); z[7] = pg8::bf_hi(zz.w);
            const float dk = dsk[c0 >> 6]; float ss = 0.f; const v4u xx = *(const v4u*)(XA + (size_t)row * 3072 + c0);
            const float xs[8] = {pg8::bf_lo(xx.x), pg8::bf_hi(xx.x), pg8::bf_lo(xx.y), pg8::bf_hi(xx.y), pg8::bf_lo(xx.z), pg8::bf_hi(xx.z), pg8::bf_lo(xx.w), pg8::bf_hi(xx.w)};
#pragma unroll
            for (int j = 0; j < 8; ++j) { y[j] = (y[j] + dk * xs[j]) * siluf(z[j]); ss += y[j] * y[j]; }
            ss = wave_sum(ss);
            const float rs = rsqrtf(ss * (1.0f / 512.0f) + EPS);
            v4u w; w.x = pk2(y[0] * rs * nw[c0 + 0], y[1] * rs * nw[c0 + 1]); w.y = pk2(y[2] * rs * nw[c0 + 2], y[3] * rs * nw[c0 + 3]);
            w.z = pk2(y[4] * rs * nw[c0 + 4], y[5] * rs * nw[c0 + 5]); w.w = pk2(y[6] * rs * nw[c0 + 6], y[7] * rs * nw[c0 + 7]);
            *(v4u*)(Y + (size_t)row * D + c0) = w; }
    }
}

__device__ __forceinline__ void phase_lru_seq(const Frame& F, int L) {
    const bf16* P = (const bf16*)(F.ws + WS_P);
    bf16* hdir = (bf16*)(F.ws + WS_X1);
    const float* cw = F.a->in[I_LCW] + (size_t)L * 4 * 2048; const float* cb = F.a->in[I_LCB] + (size_t)L * 2048;
    LAS3 float* Xc = (LAS3 float*)F.lds; LAS3 float* Ga = Xc + 32 * 128; LAS3 float* Gb = Ga + 32 * 128; LAS3 float* Hb = Gb + 32 * 128;
    for (int unit = F.bid; unit < 64; unit += F.G) {
        const int b = unit >> 5, n = (unit >> 1) & 15, d = unit & 1;
        const int half = F.tid >> 8, gi = (F.tid >> 7) & 1, j = F.tid & 127, col = n * 128 + j;
        const float* gw = F.a->in[I_LGW] + ((((size_t)L * 2 + d) * 2 + gi) * 16 + n) * 128 * 128;
        const float gb = F.a->in[I_LGB][(((size_t)L * 2 + d) * 2 + gi) * 2048 + col];
        const float sp = softplusf(-F.a->in[I_LLAM][((size_t)L * 2 + d) * 2048 + col]);
        float hst = 0.f;
        for (int ch = 0; ch < 264; ++ch) {
            for (int idx = F.tid; idx < 32 * 128; idx += 512) { const int t = idx >> 7, k = idx & 127; const int row = chain_row(b, d, ch * 32 + t);
                Xc[idx] = dwconv(P, row, PL + n * 128 + k, cw, 2048, n * 128 + k, cb[n * 128 + k]); }
            __syncthreads();
            { float acc[16];
#pragma unroll
              for (int i = 0; i < 16; ++i) acc[i] = gb;
              for (int k = 0; k < 128; ++k) { const float w = gw[k * 128 + j];
#pragma unroll
                  for (int i = 0; i < 16; ++i) acc[i] += Xc[(half * 16 + i) * 128 + k] * w; }
#pragma unroll
              for (int i = 0; i < 16; ++i) { const float s = sigm(acc[i]); if (gi == 0) Ga[(half * 16 + i) * 128 + j] = -8.0f * s * sp; else Gb[(half * 16 + i) * 128 + j] = s; } }
            __syncthreads();
            if (F.tid < 128) { for (int t = 0; t < 32; ++t) { const float la = Ga[t * 128 + j], a = __expf(la); const float bx = sqrtf(-expm1f(2.0f * la)) * Gb[t * 128 + j] * Xc[t * 128 + j]; hst = a * hst + bx; Hb[t * 128 + j] = hst; } }
            __syncthreads();
            for (int idx = F.tid; idx < 32 * 128; idx += 512) { const int t = idx >> 7, k = idx & 127; const int row = chain_row(b, d, ch * 32 + t);
                hdir[((size_t)d * MROWS + row) * D + n * 128 + k] = f2bf(Hb[idx]); }
        }
        __syncthreads();
    }
}
__device__ __forceinline__ void phase_lru_out(const Frame& F, int L) {
    const bf16* P = (const bf16*)(F.ws + WS_P);
    const bf16* hdir = (const bf16*)(F.ws + WS_X1);
    bf16* Y = (bf16*)(F.ws + WS_Y3);
    for (size_t i = (size_t)F.bid * 512 + F.tid; i < (size_t)MROWS * D / 8; i += (size_t)F.G * 512) { const int row = (int)(i >> 8), c0 = (int)(i & 255) * 8;
        const v4u a = *(const v4u*)(hdir + (size_t)row * D + c0), bb = *(const v4u*)(hdir + ((size_t)MROWS + row) * D + c0), gg = *(const v4u*)(P + (size_t)row * NP + PLG + c0);
        v4u w;
        w.x = pk2((pg8::bf_lo(a.x) + pg8::bf_lo(bb.x)) * gelu_tanh(pg8::bf_lo(gg.x)), (pg8::bf_hi(a.x) + pg8::bf_hi(bb.x)) * gelu_tanh(pg8::bf_hi(gg.x)));
        w.y = pk2((pg8::bf_lo(a.y) + pg8::bf_lo(bb.y)) * gelu_tanh(pg8::bf_lo(gg.y)), (pg8::bf_hi(a.y) + pg8::bf_hi(bb.y)) * gelu_tanh(pg8::bf_hi(gg.y)));
        w.z = pk2((pg8::bf_lo(a.z) + pg8::bf_lo(bb.z)) * gelu_tanh(pg8::bf_lo(gg.z)), (pg8::bf_hi(a.z) + pg8::bf_hi(bb.z)) * gelu_tanh(pg8::bf_hi(gg.z)));
        w.w = pk2((pg8::bf_lo(a.w) + pg8::bf_lo(bb.w)) * gelu_tanh(pg8::bf_lo(gg.w)), (pg8::bf_hi(a.w) + pg8::bf_hi(bb.w)) * gelu_tanh(pg8::bf_hi(gg.w)));
        *(v4u*)(Y + (size_t)row * D + c0) = w; }
}


constexpr int RW_SLOT = 32768;
__device__ __forceinline__ void phase_lora_prep(const Frame& F, int L, int nw, int rk) {
    bf16* dst = (bf16*)(F.ws + WS_LORA);
    for (int idx = rk * 512 + F.tid; idx < 2 * 2 * 12 * 2048; idx += nw * 512) { const int col = idx & 2047, k8 = (idx >> 11) % 12, dw = idx / (12 * 2048);
        const float* src = (dw >> 1 ? F.a->in[I_RAUP] : F.a->in[I_RWUP]) + ((size_t)L * 2 + (dw & 1)) * 96 * 2048 + col; float v[8];
#pragma unroll
        for (int j = 0; j < 8; ++j) v[j] = src[(size_t)(k8 * 8 + j) * 2048];
        v4u w; w.x = pk2(v[0], v[1]); w.y = pk2(v[2], v[3]); w.z = pk2(v[4], v[5]); w.w = pk2(v[6], v[7]);
        *(v4u*)(dst + ((size_t)dw * 2048 + col) * 128 + k8 * 8) = w; }
}
__device__ __forceinline__ void phase_lora_in(const Frame& F, int L) {
    const bf16* P = (const bf16*)(F.ws + WS_P); bf16* LIN = (bf16*)(F.ws + WS_LIN);
    const float* mu = F.a->in[I_RMU] + (size_t)L * 6784 + 6144;
    for (int idx = F.bid * 512 + F.tid; idx < MROWS * 48; idx += F.G * 512) { const int row = idx / 48, g = idx - row * 48, d = g / 24, wa = (g % 24) / 12, k8 = (g % 12) * 8;
        const int col = (wa ? PAL : PWL) + d * 96 + k8; int pos, len; seq_pos(row, pos, len);
        const v4u x = *(const v4u*)(P + (size_t)row * NP + col); v4u xp = (v4u){0u, 0u, 0u, 0u}, xn = xp;
        if (pos > 0) xp = *(const v4u*)(P + (size_t)(row - 1) * NP + col);
        if (pos < len - 1) xn = *(const v4u*)(P + (size_t)(row + 1) * NP + col);
        const float* mp = mu + wa * 192 + d * 96 + k8; float o[8];
        const float xv[8] = {pg8::bf_lo(x.x), pg8::bf_hi(x.x), pg8::bf_lo(x.y), pg8::bf_hi(x.y), pg8::bf_lo(x.z), pg8::bf_hi(x.z), pg8::bf_lo(x.w), pg8::bf_hi(x.w)};
        const float pv[8] = {pg8::bf_lo(xp.x), pg8::bf_hi(xp.x), pg8::bf_lo(xp.y), pg8::bf_hi(xp.y), pg8::bf_lo(xp.z), pg8::bf_hi(xp.z), pg8::bf_lo(xp.w), pg8::bf_hi(xp.w)};
        const float nv[8] = {pg8::bf_lo(xn.x), pg8::bf_hi(xn.x), pg8::bf_lo(xn.y), pg8::bf_hi(xn.y), pg8::bf_lo(xn.z), pg8::bf_hi(xn.z), pg8::bf_lo(xn.w), pg8::bf_hi(xn.w)};
#pragma unroll
        for (int j = 0; j < 8; ++j) { const float sv = xv[j] + mp[j] * (0.5f * (pv[j] + nv[j]) - xv[j]); o[j] = wa ? sv : tanh_fast(sv); }
        v4u w; w.x = pk2(o[0], o[1]); w.y = pk2(o[2], o[3]); w.z = pk2(o[4], o[5]); w.w = pk2(o[6], o[7]);
        *(v4u*)(LIN + (size_t)row * 384 + d * 192 + wa * 96 + k8) = w; }
    bf16* SG = (bf16*)(F.ws + WS_SG); const float* mug = F.a->in[I_RMU] + (size_t)L * 6784 + 6144 + 384;
    for (int idx = F.bid * 512 + F.tid; idx < MROWS * 32; idx += F.G * 512) { const int row = idx >> 5, j8 = (idx & 31) * 8; int pos, len; seq_pos(row, pos, len);
        const v4u x = *(const v4u*)(P + (size_t)row * NP + PGL + j8); v4u xp = (v4u){0u, 0u, 0u, 0u}, xn = xp;
        if (pos > 0) xp = *(const v4u*)(P + (size_t)(row - 1) * NP + PGL + j8);
        if (pos < len - 1) xn = *(const v4u*)(P + (size_t)(row + 1) * NP + PGL + j8);
        const float* mp = mug + j8; float o[8];
        const float xv[8] = {pg8::bf_lo(x.x), pg8::bf_hi(x.x), pg8::bf_lo(x.y), pg8::bf_hi(x.y), pg8::bf_lo(x.z), pg8::bf_hi(x.z), pg8::bf_lo(x.w), pg8::bf_hi(x.w)};
        const float pv[8] = {pg8::bf_lo(xp.x), pg8::bf_hi(xp.x), pg8::bf_lo(xp.y), pg8::bf_hi(xp.y), pg8::bf_lo(xp.z), pg8::bf_hi(xp.z), pg8::bf_lo(xp.w), pg8::bf_hi(xp.w)};
        const float nv[8] = {pg8::bf_lo(xn.x), pg8::bf_hi(xn.x), pg8::bf_lo(xn.y), pg8::bf_hi(xn.y), pg8::bf_lo(xn.z), pg8::bf_hi(xn.z), pg8::bf_lo(xn.w), pg8::bf_hi(xn.w)};
#pragma unroll
        for (int j = 0; j < 8; ++j) o[j] = sigm(xv[j] + mp[j] * (0.5f * (pv[j] + nv[j]) - xv[j]));
        v4u w; w.x = pk2(o[0], o[1]); w.y = pk2(o[2], o[3]); w.z = pk2(o[4], o[5]); w.w = pk2(o[6], o[7]);
        *(v4u*)(SG + (size_t)row * 256 + j8) = w; }
}
__device__ __forceinline__ void phase_rwkv_pre(const Frame& F, int L) {
    const bf16* ydir = (const bf16*)(F.ws + WS_X1); bf16* Z = (bf16*)(F.ws + WS_Y3) + (size_t)MROWS * D;
    const float* bonus = (const float*)(F.ws + WS_BONUS); const bf16* P = (const bf16*)(F.ws + WS_P);
    const float* lnw = F.a->in[I_RLNW] + (size_t)L * 2048; const float* lnb = F.a->in[I_RLNB] + (size_t)L * 2048; const float* muv = F.a->in[I_RMU] + (size_t)L * 6784 + 4096;
    for (int row = F.bid * 8 + F.wave; row < MROWS; row += F.G * 8) {
        int lane = F.lane; asm volatile("" : "+v"(lane));
        int pos, len; seq_pos(row, pos, len);
#pragma unroll 2
        for (int i = 0; i < 4; ++i) { const int col = i * 512 + lane * 8, h = col >> 6;
            const v4u a = *(const v4u*)(ydir + (unsigned)(row * D + col)), bb = *(const v4u*)(ydir + (unsigned)((MROWS + row) * D + col));
            const v4u x = *(const v4u*)(P + (unsigned)(row * NP + PV + col)); v4u xp = (v4u){0u, 0u, 0u, 0u}, xn = xp;
            if (pos > 0) xp = *(const v4u*)(P + (unsigned)((row - 1) * NP + PV + col));
            if (pos < len - 1) xn = *(const v4u*)(P + (unsigned)((row + 1) * NP + PV + col));
            float y[8];
            y[0] = pg8::bf_lo(a.x) + pg8::bf_lo(bb.x); y[1] = pg8::bf_hi(a.x) + pg8::bf_hi(bb.x); y[2] = pg8::bf_lo(a.y) + pg8::bf_lo(bb.y); y[3] = pg8::bf_hi(a.y) + pg8::bf_hi(bb.y);
            y[4] = pg8::bf_lo(a.z) + pg8::bf_lo(bb.z); y[5] = pg8::bf_hi(a.z) + pg8::bf_hi(bb.z); y[6] = pg8::bf_lo(a.w) + pg8::bf_lo(bb.w); y[7] = pg8::bf_hi(a.w) + pg8::bf_hi(bb.w);
            float s1 = ((y[0] + y[1]) + (y[2] + y[3])) + ((y[4] + y[5]) + (y[6] + y[7]));
            s1 += DPPF(s1, 0xB1); s1 += DPPF(s1, 0x4E); s1 += DPPF(s1, 0x141);
            const float mean = s1 * (1.0f / 64.0f); float q = 0.f;
#pragma unroll
            for (int e = 0; e < 8; ++e) { const float dl = y[e] - mean; q += dl * dl; }
            q += DPPF(q, 0xB1); q += DPPF(q, 0x4E); q += DPPF(q, 0x141);
            const float rstd = rsqrtf(q * (1.0f / 64.0f) + 64e-5f);
            const float bon = bonus[(unsigned)(row * 32 + h)] + bonus[(unsigned)((MROWS + row) * 32 + h)];
            const f32x4 w0 = *(const f32x4*)(lnw + col), w1 = *(const f32x4*)(lnw + col + 4), b0 = *(const f32x4*)(lnb + col), b1 = *(const f32x4*)(lnb + col + 4), m0 = *(const f32x4*)(muv + col), m1 = *(const f32x4*)(muv + col + 4);
            const float xv[8] = {pg8::bf_lo(x.x), pg8::bf_hi(x.x), pg8::bf_lo(x.y), pg8::bf_hi(x.y), pg8::bf_lo(x.z), pg8::bf_hi(x.z), pg8::bf_lo(x.w), pg8::bf_hi(x.w)};
            const float pq[8] = {pg8::bf_lo(xp.x), pg8::bf_hi(xp.x), pg8::bf_lo(xp.y), pg8::bf_hi(xp.y), pg8::bf_lo(xp.z), pg8::bf_hi(xp.z), pg8::bf_lo(xp.w), pg8::bf_hi(xp.w)};
            const float nq[8] = {pg8::bf_lo(xn.x), pg8::bf_hi(xn.x), pg8::bf_lo(xn.y), pg8::bf_hi(xn.y), pg8::bf_lo(xn.z), pg8::bf_hi(xn.z), pg8::bf_lo(xn.w), pg8::bf_hi(xn.w)};
            const float lw[8] = {w0[0], w0[1], w0[2], w0[3], w1[0], w1[1], w1[2], w1[3]}, lb[8] = {b0[0], b0[1], b0[2], b0[3], b1[0], b1[1], b1[2], b1[3]}, mm[8] = {m0[0], m0[1], m0[2], m0[3], m1[0], m1[1], m1[2], m1[3]};
            float o[8];
#pragma unroll
            for (int e = 0; e < 8; ++e) { const float vv = xv[e] + mm[e] * (0.5f * (pq[e] + nq[e]) - xv[e]); o[e] = (y[e] - mean) * rstd * lw[e] + lb[e] + bon * vv; }
            v4u w; w.x = pk2(o[0], o[1]); w.y = pk2(o[2], o[3]); w.z = pk2(o[4], o[5]); w.w = pk2(o[6], o[7]);
            *(v4u*)(Z + (unsigned)(row * D + col)) = w; }
    }
}
#define SW64(row_, col_) ((row_) * 64 + ((col_) ^ (((row_) & 7) << 2)))
__device__ __forceinline__ void phase_rwkv_r1(const Frame& F, int L, int gq) {
    const bf16* P = (const bf16*)(F.ws + WS_P);
    float* bonus = (float*)(F.ws + WS_BONUS);
    const float* mu = F.a->in[I_RMU] + (size_t)L * 6784;
    const bf16* LoT = (const bf16*)(F.ws + WS_LORA); const bf16* LIN = (const bf16*)(F.ws + WS_LIN);
    unsigned char* scratch = F.ws + WS_X2;
    LAS3 unsigned char* B0 = F.lds;
    LAS3 bf16* LwB = (LAS3 bf16*)(B0 + 67584);
    LAS3 bf16* LaB = LwB + 64 * 136;
    LAS3 float* NT = (LAS3 float*)B0;
    LAS3 bf16* MkaT = (LAS3 bf16*)(B0 + 16384);
    LAS3 bf16* MbrT = (LAS3 bf16*)(B0 + 25600);
    LAS3 float* Wl = (LAS3 float*)(B0 + 34816);
    LAS3 float* As = (LAS3 float*)(B0 + 51200);
    LAS3 bf16* MkrT = (LAS3 bf16*)(B0 + 51200);
    LAS3 bf16* At = (LAS3 bf16*)(B0 + 67584);
    LAS3 bf16* Bt = At + 64 * 72; LAS3 bf16* Kt = Bt + 64 * 72; LAS3 bf16* Rt = Kt + 64 * 72; LAS3 bf16* BtT = Rt + 64 * 72; LAS3 bf16* KtT = BtT + 64 * 72; LAS3 bf16* Vt = KtT + 64 * 72;
    LAS3 bf16* Ap = (LAS3 bf16*)(B0 + 132096);
    LAS3 bf16* W1 = Ap + 64 * 72;
    LAS3 float* CX = (LAS3 float*)(B0 + 132096);
    LAS3 float* PC = (LAS3 float*)(B0 + 150528);
    LAS3 float* SEG = PC + 64;
    LAS3 bf16* RL = (LAS3 bf16*)(B0 + 67584);
    LAS3 bf16* RKV = (LAS3 bf16*)B0;
    v4u pl[4], pr[4];
#define R1_FETCH(cl__, WHICH) do { const int cl_ = (cl__), c_ = gq * 33 + cl_, d_ = d, h_ = h, b_ = b; \
        const int r0_ = chain_row(b_, d_, c_ * 64), rmin_ = d_ ? r0_ - 63 : r0_; int pos_, len_; seq_pos(rmin_, pos_, len_); \
        int tid_ = F.tid; asm volatile("" : "+v"(tid_)); \
        _Pragma("unroll") for (int i_ = 0; i_ < 4; ++i_) { const int idx_ = tid_ + 512 * i_, rr_ = idx_ / 24, g_ = idx_ - rr_ * 24; \
            const bool ok_ = idx_ < 1584 && ((rr_ >= 1 && rr_ <= 64) || (rr_ == 0 && pos_ > 0) || (rr_ == 65 && pos_ + 64 < len_)); \
            const unsigned ro_ = (unsigned)((rmin_ - 1 + rr_) * NP); \
            if (WHICH == 0) { if (i_ < 3) { const int t_ = idx_ / 24, q_ = idx_ - t_ * 24; pl[i_] = *(const v4u*)(LIN + (unsigned)(CROW(r0_, d_, t_) * 384 + d_ * 192 + q_ * 8)); } } \
            else { const int cr2_ = (g_ < 8 ? PR : (g_ < 16 ? PK - 64 : PV - 128)) + h_ * 64 + g_ * 8; pr[i_] = ok_ ? *(const v4u*)(P + ro_ + cr2_) : (v4u){0u, 0u, 0u, 0u}; } } } while (0)
    LAS3 bf16* NTb = (LAS3 bf16*)(B0 + 153600);
    LAS3 bf16* DTb = (LAS3 bf16*)(B0 + 150784);
    LAS3 bf16* Wsc = (LAS3 bf16*)(B0 + 16384);
    LAS3 float* MU = SEG + 512;
#pragma unroll 1
    for (int chn = F.bid >> 1; chn < 128; chn += F.G >> 1) {
    const int d = chn & 1, h = (chn >> 1) & 31, b = chn >> 6, cl0 = (F.bid & 1) * 17, cl1 = (F.bid & 1) ? 33 : 17;
    __syncthreads();
    for (int i = F.tid; i < 192; i += 512) MU[i] = mu[6144 + (i < 96 ? 0 : 192 - 96) + d * 96 + i];
    bf16x8 wfr[3]; f32x4 lbias; float mur, muk, muv, kkw, kaw, rkw;
    { const int wa0 = F.wave >> 2, nt0 = F.wave & 3, fr0 = F.lane & 15, fq0 = F.lane >> 4;
#pragma unroll
      for (int ks = 0; ks < 3; ++ks) wfr[ks] = ldfrag_g(LoT + (size_t)(wa0 * 2 + d) * 2048 * 128, 128, h * 64 + nt0 * 16, ks * 32, fr0, fq0);
      lbias = *(const f32x4*)((wa0 ? F.a->in[I_RA0] : F.a->in[I_RW0]) + ((size_t)L * 2 + d) * 2048 + h * 64 + nt0 * 16 + 4 * fq0);
      const int col0 = h * 64 + F.lane;
      mur = mu[col0]; muk = mu[2048 + col0]; muv = mu[4096 + col0];
      kkw = F.a->in[I_RKK][(size_t)L * 2048 + col0]; kaw = F.a->in[I_RKA][(size_t)L * 2048 + col0]; rkw = F.a->in[I_RRK][(size_t)L * 2048 + col0]; }
    R1_FETCH(cl0, 0); R1_FETCH(cl0, 1);
    __syncthreads();
    for (int cl = cl0; cl < cl1; ++cl) {
        int tid = F.tid; asm volatile("" : "+v"(tid));
        const int lane = tid & 63, wave = __builtin_amdgcn_readfirstlane(tid >> 6), fr = lane & 15, fq = lane >> 4;
        const int c = gq * 33 + cl, unit = chn * 33 + cl;
        unsigned char* slot = scratch + (size_t)unit * RW_SLOT;
#pragma unroll
        for (int i = 0; i < 3; ++i) { const int idx = tid + 512 * i, t = idx / 24, q = idx - t * 24; *(LAS3 v4u*)((q >= 12 ? LaB + (q - 12) * 8 : LwB + q * 8) + t * 136) = pl[i]; }
#pragma unroll
        for (int i = 0; i < 4; ++i) { const int idx = tid + 512 * i, rr = idx / 24, g = idx - rr * 24; if (idx < 1584) *(LAS3 v4u*)(RKV + rr * 200 + g * 8) = pr[i]; }
        LBAR();
        if (cl + 1 < cl1) { R1_FETCH(cl + 1, 0); R1_FETCH(cl + 1, 1); }
        { const int wa = wave >> 2, nt = wave & 3; f32x4 acc[4];
#pragma unroll
          for (int mt = 0; mt < 4; ++mt) acc[mt] = (f32x4){0.f, 0.f, 0.f, 0.f};
          LAS3 bf16* Xs = wa ? LaB : LwB;
#pragma unroll
          for (int ks = 0; ks < 3; ++ks)
#pragma unroll
              for (int mt = 0; mt < 4; ++mt) MMA_TRN(acc[mt], ldfrag(Xs, 136, mt * 16, ks * 32, fr, fq), wfr[ks]);
          if (wa) {
#pragma unroll
              for (int mt = 0; mt < 4; ++mt) { f32x4 o;
#pragma unroll
                  for (int e = 0; e < 4; ++e) o[e] = sigm(acc[mt][e] + lbias[e]);
                  *(LAS3 f32x4*)(As + SW64(mt * 16 + fr, nt * 16 + 4 * fq)) = o; } }
          else { f32x4 run = (f32x4){0.f, 0.f, 0.f, 0.f};
#pragma unroll
              for (int mt = 0; mt < 4; ++mt) { f32x4 inc, exc;
#pragma unroll
                  for (int e = 0; e < 4; ++e) { const float lw = -__expf(-softplus_fast(-(acc[mt][e] + lbias[e])) - 0.5f);
                      float v = lw; v += DPPF(v, 0x111); v += DPPF(v, 0x112); v += DPPF(v, 0x114); v += DPPF(v, 0x118);
                      inc[e] = v + run[e]; exc[e] = inc[e] - lw;
                      float tot = lw; tot += DPPF(tot, 0xB1); tot += DPPF(tot, 0x4E); tot += DPPF(tot, 0x141); tot += DPPF(tot, 0x140);
                      run[e] += tot; }
                  *(LAS3 f32x4*)(Wl + SW64(mt * 16 + fr, nt * 16 + 4 * fq)) = inc; *(LAS3 f32x4*)(CX + SW64(mt * 16 + fr, nt * 16 + 4 * fq)) = exc; }
              if (fr == 0) { f32x4 pc; pc[0] = __expf(run[0]); pc[1] = __expf(run[1]); pc[2] = __expf(run[2]); pc[3] = __expf(run[3]); *(LAS3 f32x4*)(PC + nt * 16 + 4 * fq) = pc; } } }
        LBAR();
        { const int ch = lane; const int rr0 = d ? 64 - wave * 8 : 1 + wave * 8, st = d ? -1 : 1;
          const LAS3 bf16* qb = RKV + ch;
          float rp = bf2f(qb[(rr0 - st) * 200]), kp = bf2f(qb[(rr0 - st) * 200 + 64]), vp = bf2f(qb[(rr0 - st) * 200 + 128]);
          float rc = bf2f(qb[rr0 * 200]), kc = bf2f(qb[rr0 * 200 + 64]), vc = bf2f(qb[rr0 * 200 + 128]);
          const int r0c = chain_row(b, d, c * 64);
          v4u bT, kT, vT; float bq = 0.f, kq = 0.f, vq = 0.f;
#pragma unroll
          for (int i = 0; i < 8; ++i) { const int t = wave * 8 + i; const int row = CROW(r0c, d, t); const int rn = rr0 + st * (i + 1);
              const float rx = bf2f(qb[rn * 200]), kx = bf2f(qb[rn * 200 + 64]), vx = bf2f(qb[rn * 200 + 128]);
              const float r = rc + mur * (0.5f * (rp + rx) - rc), k = kc + muk * (0.5f * (kp + kx) - kc), v = vc + muv * (0.5f * (vp + vx) - vc);
              rp = rc; kp = kc; vp = vc; rc = rx; kc = kx; vc = vx;
              const float asig = As[SW64(t, ch)], cv = Wl[SW64(t, ch)], cx = CX[SW64(t, ch)];
              const float kkv = k * kkw, n2 = wave_sum(kkv * kkv), kk = kkv * rsqrtf(n2 + 1e-12f);
              const float key = k * (1.0f + (asig - 1.0f) * kaw);
              const float bon = wave_sum(r * key * rkw);
              if (ch == 0) bonus[(unsigned)((d * MROWS + row) * 32 + h)] = bon;
              const float ep = __expf(cv), em = __expf(-cv), ex = __expf(cx);
              const float bf_ = kk * asig * em, kf_ = key * em;
              const bf16 a_ = f2bf(-kk * ex), b_ = f2bf(bf_), k_ = f2bf(kf_), r_ = f2bf(r * ep);
              At[t * 72 + ch] = a_; Bt[t * 72 + ch] = b_; Kt[t * 72 + ch] = k_; Rt[t * 72 + ch] = r_;
              if (i & 1) { bT[i >> 1] = pk2(bq, bf_); kT[i >> 1] = pk2(kq, kf_); vT[i >> 1] = pk2(vq, v); } else { bq = bf_; kq = kf_; vq = v; } }
          *(LAS3 v4u*)(BtT + ch * 72 + wave * 8) = bT; *(LAS3 v4u*)(KtT + ch * 72 + wave * 8) = kT; *(LAS3 v4u*)(Vt + ch * 72 + wave * 8) = vT; }
        LBAR();
        for (int i = tid; i < 18432 / 16; i += 512) ((LAS3 v4u*)Ap)[i] = (v4u){0u, 0u, 0u, 0u};
        { const int q = wave >> 1, hf = wave & 1; LAS3 bf16* Xs = q < 2 ? At : Rt; LAS3 bf16* Ys = (q & 1) ? Kt : Bt;
#pragma unroll
          for (int mi = 0; mi < 2; ++mi) { const int mt = hf * 2 + mi; f32x4 acc[4];
#pragma unroll
              for (int nt = 0; nt < 4; ++nt) acc[nt] = (f32x4){0.f, 0.f, 0.f, 0.f};
#pragma unroll
              for (int ks = 0; ks < 2; ++ks) { const bf16x8 a = ldfrag(Xs, 72, mt * 16, ks * 32, fr, fq);
#pragma unroll
                  for (int nt = 0; nt < 4; ++nt) MMA_TRN(acc[nt], a, ldfrag(Ys, 72, nt * 16, ks * 32, fr, fq)); }
              const int t = mt * 16 + fr;
#pragma unroll
              for (int nt = 0; nt < 4; ++nt) { const int i0 = nt * 16 + 4 * fq; f32x4 o;
#pragma unroll
                  for (int e = 0; e < 4; ++e) { const int i = i0 + e; const bool keep = q < 2 ? (i < t) : (i <= t); o[e] = keep ? acc[nt][e] : 0.f; }
                  if (q == 0) { *(LAS3 f32x4*)(NT + SW64(t, i0)) = o; const bool offd = nt != mt; v2u w; w.x = offd ? pk2(o[0], o[1]) : 0u; w.y = offd ? pk2(o[2], o[3]) : 0u; *(LAS3 v2u*)(NTb + t * 72 + i0) = w; }
                  else { v2u w; w.x = pk2(o[0], o[1]); w.y = pk2(o[2], o[3]); *(LAS3 v2u*)((q == 1 ? MkaT : (q == 2 ? MbrT : MkrT)) + t * 72 + i0) = w; } } } }
        LBAR();
        if (wave > 0) {
            for (int tile = wave - 1; tile < 16; tile += 7) { const int mt = tile >> 2, nt = tile & 3; f32x4 acc = (f32x4){0.f, 0.f, 0.f, 0.f};
#pragma unroll
                for (int ks = 0; ks < 2; ++ks) MMA_TRN(acc, ldfrag(Vt, 72, mt * 16, ks * 32, fr, fq), ldfrag(MkaT, 72, nt * 16, ks * 32, fr, fq));
                *(LAS3 f32x4*)(Wl + SW64(mt * 16 + fr, nt * 16 + 4 * fq)) = acc; } }
        else { const int J = lane >> 4, cc = lane & 15; float z[16];
#pragma unroll
            for (int t = 0; t < 16; ++t) { float acc = t == cc ? 1.0f : 0.f;
#pragma unroll
                for (int i4 = 0; i4 < (t + 3) / 4; ++i4) { const f32x4 nv = *(const LAS3 f32x4*)(NT + SW64(J * 16 + t, J * 16 + i4 * 4));
#pragma unroll
                    for (int e = 0; e < 4; ++e) if (i4 * 4 + e < t) acc += nv[e] * z[i4 * 4 + e]; }
                z[t] = acc; DTb[(J * 16 + t) * 16 + cc] = f2bf(acc); } }
        LBAR();
        { LAS3 bf16* Ws = Wsc + wave * 256; const int r = wave * 16 + fr;
#pragma unroll
          for (int J = 0; J < 4; ++J) { f32x4 acc = (f32x4){0.f, 0.f, 0.f, 0.f};
              if (J > 0) {
#pragma unroll
                  for (int ks = 0; ks < (J + 1) / 2; ++ks) MMA_TRN(acc, ldfrag(Ap, 72, wave * 16, ks * 32, fr, fq), ldfrag(NTb, 72, J * 16, ks * 32, fr, fq)); }
              const int t0 = J * 16 + 4 * fq;
              if (wave < 4) { acc[0] += bf2f(At[(t0 + 0) * 72 + r]); acc[1] += bf2f(At[(t0 + 1) * 72 + r]); acc[2] += bf2f(At[(t0 + 2) * 72 + r]); acc[3] += bf2f(At[(t0 + 3) * 72 + r]); }
              else acc += *(const LAS3 f32x4*)(Wl + SW64(r - 64, t0));
              { v2u w; w.x = pk2(acc[0], acc[1]); w.y = pk2(acc[2], acc[3]); *(LAS3 v2u*)(Ws + fr * 16 + 4 * fq) = w; }
              asm volatile("s_waitcnt lgkmcnt(0)" ::: "memory");
              const bf16x8 zero8 = (bf16x8){0, 0, 0, 0, 0, 0, 0, 0};
              const bf16x8 wf = fq < 2 ? *(const LAS3 bf16x8*)(Ws + fr * 16 + 8 * fq) : zero8;
              const bf16x8 zf = fq < 2 ? *(const LAS3 bf16x8*)(DTb + (J * 16 + fr) * 16 + 8 * fq) : zero8;
              f32x4 x = (f32x4){0.f, 0.f, 0.f, 0.f};
              MMA_TRN(x, wf, zf);
              { v2u w; w.x = pk2(x[0], x[1]); w.y = pk2(x[2], x[3]); *(LAS3 v2u*)(Ap + r * 72 + t0) = w; }
              asm volatile("s_waitcnt lgkmcnt(0)" ::: "memory"); } }
        LBAR();
        { const int o = wave >> 1, hf = wave & 1;
#pragma unroll
          for (int mi = 0; mi < 2; ++mi) { const int mt = hf * 2 + mi; f32x4 acc[4];
#pragma unroll
              for (int nt = 0; nt < 4; ++nt) acc[nt] = (f32x4){0.f, 0.f, 0.f, 0.f};
              if (o < 2) {
                  LAS3 bf16* Xs = o == 0 ? MbrT : BtT;
#pragma unroll
                  for (int ks = 0; ks < 2; ++ks) { const bf16x8 a = ldfrag(Xs, 72, mt * 16, ks * 32, fr, fq);
#pragma unroll
                      for (int nt = 0; nt < 4; ++nt) MMA_TRN(acc[nt], a, ldfrag(Ap, 72, nt * 16, ks * 32, fr, fq)); }
                  const int m = mt * 16 + fr; const float pc = o == 1 ? PC[m] : 1.0f; v4u wq;
#pragma unroll
                  for (int nt = 0; nt < 4; ++nt) { const int k0 = nt * 16 + 4 * fq; float v[4];
                      if (o == 0) { const v2u rr = *(const LAS3 v2u*)(Rt + m * 72 + k0); v[0] = acc[nt][0] + pg8::bf_lo(rr.x); v[1] = acc[nt][1] + pg8::bf_hi(rr.x); v[2] = acc[nt][2] + pg8::bf_lo(rr.y); v[3] = acc[nt][3] + pg8::bf_hi(rr.y); }
                      else {
#pragma unroll
                          for (int e = 0; e < 4; ++e) v[e] = (acc[nt][e] + ((k0 + e) == m ? 1.0f : 0.f)) * pc; }
                      if ((nt & 1) == 0) { wq.x = pk2(v[0], v[1]); wq.y = pk2(v[2], v[3]); }
                      else { wq.z = pk2(v[0], v[1]); wq.w = pk2(v[2], v[3]);
                          *(v4u*)(slot + (o == 0 ? 8192 : 0) + (size_t)(((mt * 2 + (nt >> 1)) * 64 + fq * 16 + fr) * 16)) = wq; } } }
              else {
                  LAS3 bf16* X1 = o == 2 ? BtT : MbrT; LAS3 bf16* X2 = o == 2 ? KtT : MkrT;
#pragma unroll
                  for (int ks = 0; ks < 2; ++ks) { const bf16x8 a1 = ldfrag(X1, 72, mt * 16, ks * 32, fr, fq), a2 = ldfrag(X2, 72, mt * 16, ks * 32, fr, fq);
#pragma unroll
                      for (int nt = 0; nt < 4; ++nt) { MMA_STD(acc[nt], a1, ldfrag(W1, 72, nt * 16, ks * 32, fr, fq)); MMA_STD(acc[nt], a2, ldfrag(Vt, 72, nt * 16, ks * 32, fr, fq)); } }
                  float pc[4];
#pragma unroll
                  for (int e = 0; e < 4; ++e) pc[e] = o == 2 ? PC[mt * 16 + 4 * fq + e] : 1.0f;
#pragma unroll
                  for (int nt = 0; nt < 4; ++nt) { v2u w; w.x = pk2(acc[nt][0] * pc[0], acc[nt][1] * pc[1]); w.y = pk2(acc[nt][2] * pc[2], acc[nt][3] * pc[3]);
                      *(v2u*)(slot + (o == 2 ? 16384 : 24576) + (size_t)(((nt * 4 + mt) * 64 + lane) * 8)) = w; } } } }
        LBAR();
    }
    }
}
#undef R1_FETCH
__device__ __forceinline__ void phase_rwkv_r2(const Frame& F, int gq) {
    const unsigned char* scratch = F.ws + WS_X2; bf16* ydir = (bf16*)(F.ws + WS_X1);
    f32x4* state = (f32x4*)(F.ws + WS_LAGG);
    const int fr = F.lane & 15, fq = F.lane >> 4, tl = F.wave >> 2, mt = F.wave & 3;
    LAS3 unsigned char* XS = F.lds + tl * 4096;
    for (int tb = F.bid; tb < 256; tb += F.G) {
        const int chn = (tb & 7) * 16 + (tb >> 4), vt = ((tb >> 3) & 1) * 2 + tl, task = chn * 4 + vt, d = chn & 1, h = (chn >> 1) & 31, b = chn >> 6;
        f32x4 S = gq == 0 ? (f32x4){0.f, 0.f, 0.f, 0.f} : state[((size_t)task * 4 + mt) * 64 + F.lane];
        { v2u w; w.x = pk2(S[0], S[1]); w.y = pk2(S[2], S[3]); *(LAS3 v2u*)(XS + (F.lane * 4 + mt) * 8) = w; }
        bf16x8 Tq[4][2], Rq[4][2]; v2u Sq[4], Yq[4];
#define R2_LOAD(cl_, q_) do { const unsigned char* slot_ = scratch + ((size_t)chn * 33 + (cl_)) * RW_SLOT; \
            Tq[q_][0] = *(const bf16x8*)(slot_ + ((mt * 2 + 0) * 64 + F.lane) * 16); Tq[q_][1] = *(const bf16x8*)(slot_ + ((mt * 2 + 1) * 64 + F.lane) * 16); \
            Rq[q_][0] = *(const bf16x8*)(slot_ + 8192 + ((mt * 2 + 0) * 64 + F.lane) * 16); Rq[q_][1] = *(const bf16x8*)(slot_ + 8192 + ((mt * 2 + 1) * 64 + F.lane) * 16); \
            Sq[q_] = *(const v2u*)(slot_ + 16384 + ((vt * 4 + mt) * 64 + F.lane) * 8); Yq[q_] = *(const v2u*)(slot_ + 24576 + ((vt * 4 + mt) * 64 + F.lane) * 8); } while (0)
#pragma unroll
        for (int q = 0; q < 4; ++q) R2_LOAD(q, q);
        LBAR();
#define R2_STEP(cl_, q_) do { const int cl = (cl_); const LAS3 unsigned char* xr = XS + ((q_) & 1) * 2048 + F.lane * 32; \
            const v4u x0 = *(const LAS3 v4u*)xr, x1 = *(const LAS3 v4u*)(xr + 16); \
            const bf16x8 Sb0 = __builtin_bit_cast(bf16x8, x0), Sb1 = __builtin_bit_cast(bf16x8, x1); \
            f32x4 ya = (f32x4){pg8::bf_lo(Yq[q_].x), pg8::bf_hi(Yq[q_].x), pg8::bf_lo(Yq[q_].y), pg8::bf_hi(Yq[q_].y)}; \
            f32x4 sn = (f32x4){pg8::bf_lo(Sq[q_].x), pg8::bf_hi(Sq[q_].x), pg8::bf_lo(Sq[q_].y), pg8::bf_hi(Sq[q_].y)}; \
            MMA_STD(sn, Tq[q_][0], Sb0); MMA_STD(sn, Tq[q_][1], Sb1); MMA_STD(ya, Rq[q_][0], Sb0); MMA_STD(ya, Rq[q_][1], Sb1); \
            { v2u w; w.x = pk2(sn[0], sn[1]); w.y = pk2(sn[2], sn[3]); *(LAS3 v2u*)(XS + (((q_) + 1) & 1) * 2048 + (F.lane * 4 + mt) * 8) = w; } \
            S = sn; \
            if (cl + 4 < 33) R2_LOAD(cl + 4, q_); \
            { const int r0s = chain_row(b, d, (gq * 33 + cl) * 64); const unsigned yo = (unsigned)((d * MROWS + r0s) * D + h * 64 + vt * 16 + fr) * 2u; const int ys = d ? -(int)(D * 2) : (int)(D * 2); \
              _Pragma("unroll") for (int e = 0; e < 4; ++e) { const int t = mt * 16 + 4 * fq + e; *(bf16*)((char*)ydir + (unsigned)(yo + (unsigned)(ys * t))) = f2bf(ya[e]); } } \
            LBAR(); } while (0)
#pragma unroll 1
        for (int c0 = 0; c0 < 32; c0 += 4) { R2_STEP(c0, 0); R2_STEP(c0 + 1, 1); R2_STEP(c0 + 2, 2); R2_STEP(c0 + 3, 3); }
        R2_STEP(32, 0);
#undef R2_STEP
        if (gq < 3) state[((size_t)task * 4 + mt) * 64 + F.lane] = S;
    }
#undef R2_LOAD
}

__device__ __forceinline__ void phase_ssm_conv(const Frame& F, int L) {
    const bf16* P = (const bf16*)(F.ws + WS_P); bf16* XA = (bf16*)(F.ws + WS_X2);
    const float* cw = F.a->in[I_SCW] + (size_t)L * 4 * 3072; const float* cb = F.a->in[I_SCB] + (size_t)L * 3072;
    for (int gI = F.bid * 512 + F.tid; gI < (MROWS / 8) * 384; gI += F.G * 512) { const int rb = gI / 384, col = (gI - rb * 384) * 8, row0 = rb * 8;
        int pos0, len; seq_pos(row0, pos0, len);
        float w[4][8], bias[8];
#pragma unroll
        for (int tap = 0; tap < 4; ++tap) { const f32x4 a0 = *(const f32x4*)(cw + tap * 3072 + col), a1 = *(const f32x4*)(cw + tap * 3072 + col + 4);
            w[tap][0] = a0[0]; w[tap][1] = a0[1]; w[tap][2] = a0[2]; w[tap][3] = a0[3]; w[tap][4] = a1[0]; w[tap][5] = a1[1]; w[tap][6] = a1[2]; w[tap][7] = a1[3]; }
        { const f32x4 a0 = *(const f32x4*)(cb + col), a1 = *(const f32x4*)(cb + col + 4); bias[0] = a0[0]; bias[1] = a0[1]; bias[2] = a0[2]; bias[3] = a0[3]; bias[4] = a1[0]; bias[5] = a1[1]; bias[6] = a1[2]; bias[7] = a1[3]; }
        v4u win[3];
#pragma unroll
        for (int k = 0; k < 3; ++k) { const int q = pos0 + k - 2; win[k] = (q >= 0 && q < len) ? *(const v4u*)(P + (unsigned)((row0 + k - 2) * NP + PX + col)) : (v4u){0u, 0u, 0u, 0u}; }
#pragma unroll
        for (int r = 0; r < 8; ++r) { const int q = pos0 + r + 1; const v4u nx = (q < len) ? *(const v4u*)(P + (unsigned)((row0 + r + 1) * NP + PX + col)) : (v4u){0u, 0u, 0u, 0u};
            float o[8];
#pragma unroll
            for (int e = 0; e < 8; ++e) o[e] = bias[e];
            const v4u tp[4] = {win[0], win[1], win[2], nx};
#pragma unroll
            for (int tap = 0; tap < 4; ++tap) { const v4u x = tp[tap];
                o[0] += w[tap][0] * pg8::bf_lo(x.x); o[1] += w[tap][1] * pg8::bf_hi(x.x); o[2] += w[tap][2] * pg8::bf_lo(x.y); o[3] += w[tap][3] * pg8::bf_hi(x.y);
                o[4] += w[tap][4] * pg8::bf_lo(x.z); o[5] += w[tap][5] * pg8::bf_hi(x.z); o[6] += w[tap][6] * pg8::bf_lo(x.w); o[7] += w[tap][7] * pg8::bf_hi(x.w); }
            v4u wv; wv.x = pk2(siluf(o[0]), siluf(o[1])); wv.y = pk2(siluf(o[2]), siluf(o[3])); wv.z = pk2(siluf(o[4]), siluf(o[5])); wv.w = pk2(siluf(o[6]), siluf(o[7]));
            *(v4u*)(XA + (unsigned)((row0 + r) * 3072 + col)) = wv;
            win[0] = win[1]; win[1] = win[2]; win[2] = nx; }
    }
}
template <int PITCH> __device__ __forceinline__ unsigned tr_addr(const LAS3 bf16* M, int r0, int k0, int lane) {
    const int g = lane >> 4, q = (lane & 15) >> 2, p = lane & 3; return (unsigned)(size_t)(M + (k0 + 8 * g + q) * PITCH + r0 + 4 * p); }
__device__ __forceinline__ bf16x8 tr_pack(v2u lo, v2u hi) { v4u w; w.x = lo.x; w.y = lo.y; w.z = hi.x; w.w = hi.y; return __builtin_bit_cast(bf16x8, w); }
#define TRS2(x) #x
#define TRS(x) TRS2(x)
__device__ __forceinline__ void phase_ssm_chain(const Frame& F, int L) {
    const bf16* P = (const bf16*)(F.ws + WS_P); const bf16* XA = (const bf16*)(F.ws + WS_X2);
    bf16* ydir = (bf16*)(F.ws + WS_X1);
    constexpr int SET = 54784;
    LAS3 bf16* Hb = (LAS3 bf16*)(F.lds + 2 * SET);
    const int fr = F.lane & 15, fq = F.lane >> 4;
#define SS_PTRS(set_) LAS3 bf16* Cb = (LAS3 bf16*)(F.lds + (set_) * SET); LAS3 bf16* Bb = Cb + 64 * 136; LAS3 bf16* Sc = Bb + 64 * 136; \
        LAS3 bf16* Xr = Sc + 64 * 72; LAS3 bf16* Xd = Xr + 64 * 40; LAS3 float* cum = (LAS3 float*)(Xd + 64 * 40); LAS3 float* dtj = cum + 64; (void)Cb; (void)Bb; (void)Sc; (void)Xr; (void)Xd; (void)cum; (void)dtj
    for (int unit = F.bid; unit < 256; unit += F.G) {
        const int b = unit >> 7, h = (unit >> 2) & 31, d = (unit >> 1) & 1, ph = unit & 1, g = h >> 3;
        const float Ad = -__expf(F.a->in[I_SALOG][(L * 2 + d) * 32 + h]); const float dtb = F.a->in[I_SDTB][(L * 2 + d) * 32 + h];
        const int xcol = h * 64 + ph * 32;
        for (int i = F.tid; i < 32 * 136 / 2; i += 512) ((LAS3 unsigned*)Hb)[i] = 0u;
        f32x4 hacc[2]; hacc[0] = (f32x4){0.f, 0.f, 0.f, 0.f}; hacc[1] = hacc[0];
        v4u nb[4], nx; float ndt = 0.f;
#define SS_LOAD(c_) do { const int r0l_ = chain_row(b, d, (c_) * 64); \
            _Pragma("unroll") for (int i_ = 0; i_ < 4; ++i_) { const int gI_ = F.tid + 512 * i_, j_ = gI_ >> 5, q_ = gI_ & 31; const int row_ = CROW(r0l_, d, j_); \
                const int col_ = q_ < 16 ? 2048 + g * 128 + q_ * 8 : 2560 + g * 128 + (q_ - 16) * 8; nb[i_] = *(const v4u*)(XA + (unsigned)(row_ * 3072 + col_)); } \
            if (F.tid < 256) { const int j_ = F.tid >> 2, q_ = F.tid & 3; const int row_ = CROW(r0l_, d, j_); nx = *(const v4u*)(XA + (unsigned)(row_ * 3072 + xcol + q_ * 8)); } \
            if (F.wave == 4) { const int row_ = CROW(r0l_, d, F.lane); ndt = bf2f(P[(unsigned)(row_ * NP + PDT + d * 32 + h)]); } } while (0)
#define SS_FRONT1(set_) do { SS_PTRS(set_); \
            _Pragma("unroll") for (int i_ = 0; i_ < 4; ++i_) { const int gI_ = F.tid + 512 * i_, j_ = gI_ >> 5, q_ = gI_ & 31; \
                *(LAS3 v4u*)((q_ < 16 ? Bb + q_ * 8 : Cb + (q_ - 16) * 8) + j_ * 136) = nb[i_]; } \
            if (F.tid < 256) { const int j_ = F.tid >> 2, q_ = F.tid & 3; *(LAS3 v4u*)(Xr + j_ * 40 + q_ * 8) = nx; } \
            if (F.wave == 4) { const float dtv_ = softplusf(ndt + dtb); const float v_ = wave_scan(dtv_ * Ad, F.lane); cum[F.lane] = v_; dtj[F.lane] = dtv_; } } while (0)
#define SS_FRONT2(set_) do { SS_PTRS(set_); \
            { const int mt_ = F.wave >> 1; f32x4 acc_[2]; acc_[0] = (f32x4){0.f, 0.f, 0.f, 0.f}; acc_[1] = acc_[0]; \
              _Pragma("unroll") for (int ks_ = 0; ks_ < 4; ++ks_) { const bf16x8 a_ = ldfrag(Cb, 136, mt_ * 16, ks_ * 32, fr, fq); \
                  _Pragma("unroll") for (int x_ = 0; x_ < 2; ++x_) { const bf16x8 bb_ = ldfrag(Bb, 136, ((F.wave & 1) * 2 + x_) * 16, ks_ * 32, fr, fq); MMA_TRN(acc_[x_], a_, bb_); } } \
              const int i_ = mt_ * 16 + fr; const float ci_ = cum[i_]; \
              _Pragma("unroll") for (int x_ = 0; x_ < 2; ++x_) { const int j0_ = ((F.wave & 1) * 2 + x_) * 16 + 4 * fq; float sc_[4]; \
                  const f32x4 cj_ = *(const LAS3 f32x4*)(cum + j0_), dj_ = *(const LAS3 f32x4*)(dtj + j0_);     \
                  _Pragma("unroll") for (int e_ = 0; e_ < 4; ++e_) { const int jj_ = j0_ + e_; sc_[e_] = jj_ <= i_ ? acc_[x_][e_] * __expf(ci_ - cj_[e_]) * dj_[e_] : 0.f; } \
                  v2u w_; w_.x = pk2(sc_[0], sc_[1]); w_.y = pk2(sc_[2], sc_[3]); *(LAS3 v2u*)(Sc + i_ * 72 + j0_) = w_; } } \
            { const int j_ = F.tid >> 3, p0_ = (F.tid & 7) * 4; const float f_ = dtj[j_] * __expf(cum[63] - cum[j_]); const v2u xv_ = *(const LAS3 v2u*)(Xr + j_ * 40 + p0_); \
              v2u w_; w_.x = pk2(pg8::bf_lo(xv_.x) * f_, pg8::bf_hi(xv_.x) * f_); w_.y = pk2(pg8::bf_lo(xv_.y) * f_, pg8::bf_hi(xv_.y) * f_); *(LAS3 v2u*)(Xd + j_ * 40 + p0_) = w_; } } while (0)
        SS_LOAD(0);
        __syncthreads();
        SS_FRONT1(0);
        SS_LOAD(1);
        LBAR();
        SS_FRONT2(0);
        LBAR();
        for (int c = 0; c < 132; ++c) {
            const int cur = c & 1;
            if (c + 1 < 132) { SS_FRONT1(cur ^ 1); if (c + 2 < 132) SS_LOAD(c + 2); }
            { SS_PTRS(cur);
              const int nt_y = F.wave & 1, mt_s = F.wave >> 2, nt_s = (F.wave & 3) * 2;
              const unsigned ax = tr_addr<40>(Xr, nt_y * 16, 0, F.lane), ad_ = tr_addr<40>(Xd, mt_s * 16, 0, F.lane), ab = tr_addr<136>(Bb, nt_s * 16, 0, F.lane);
              v2u t0, t1, t2, t3, t4, t5, t6, t7, t8, t9, t10, t11, t12, t13, t14, t15;
              asm volatile("ds_read_b64_tr_b16 %0, %16\n\tds_read_b64_tr_b16 %1, %16 offset:" TRS(4 * 40 * 2) "\n\tds_read_b64_tr_b16 %2, %16 offset:" TRS(32 * 40 * 2) "\n\tds_read_b64_tr_b16 %3, %16 offset:" TRS(36 * 40 * 2) "\n\t"
                           "ds_read_b64_tr_b16 %4, %17\n\tds_read_b64_tr_b16 %5, %17 offset:" TRS(4 * 40 * 2) "\n\tds_read_b64_tr_b16 %6, %17 offset:" TRS(32 * 40 * 2) "\n\tds_read_b64_tr_b16 %7, %17 offset:" TRS(36 * 40 * 2) "\n\t"
                           "ds_read_b64_tr_b16 %8, %18\n\tds_read_b64_tr_b16 %9, %18 offset:" TRS(4 * 136 * 2) "\n\tds_read_b64_tr_b16 %10, %18 offset:" TRS(32 * 136 * 2) "\n\tds_read_b64_tr_b16 %11, %18 offset:" TRS(36 * 136 * 2) "\n\t"
                           "ds_read_b64_tr_b16 %12, %18 offset:32\n\tds_read_b64_tr_b16 %13, %18 offset:" TRS(4 * 136 * 2 + 32) "\n\tds_read_b64_tr_b16 %14, %18 offset:" TRS(32 * 136 * 2 + 32) "\n\tds_read_b64_tr_b16 %15, %18 offset:" TRS(36 * 136 * 2 + 32) "\n\t"
                           "s_waitcnt lgkmcnt(0)"
                           : "=&v"(t0), "=&v"(t1), "=&v"(t2), "=&v"(t3), "=&v"(t4), "=&v"(t5), "=&v"(t6), "=&v"(t7), "=&v"(t8), "=&v"(t9), "=&v"(t10), "=&v"(t11), "=&v"(t12), "=&v"(t13), "=&v"(t14), "=&v"(t15)
                           : "v"(ax), "v"(ad_), "v"(ab) : "memory");
              const bf16x8 xT[2] = {tr_pack(t0, t1), tr_pack(t2, t3)}, xdT[2] = {tr_pack(t4, t5), tr_pack(t6, t7)}, bT[2][2] = {{tr_pack(t8, t9), tr_pack(t10, t11)}, {tr_pack(t12, t13), tr_pack(t14, t15)}};
              { const int mt = F.wave >> 1, nt = nt_y; f32x4 ad = (f32x4){0.f, 0.f, 0.f, 0.f}, ao = ad;
#pragma unroll
                for (int ks = 0; ks < 2; ++ks) MMA_TRN(ad, ldfrag(Sc, 72, mt * 16, ks * 32, fr, fq), xT[ks]);
#pragma unroll
                for (int ks = 0; ks < 4; ++ks) MMA_TRN(ao, ldfrag(Cb, 136, mt * 16, ks * 32, fr, fq), ldfrag(Hb, 136, nt * 16, ks * 32, fr, fq));
                const int i = mt * 16 + fr; const float ei = __expf(cum[i]); const int row = CROW(chain_row(b, d, c * 64), d, i);
                v2u w; w.x = pk2(ad[0] + ei * ao[0], ad[1] + ei * ao[1]); w.y = pk2(ad[2] + ei * ao[2], ad[3] + ei * ao[3]);
                *(v2u*)(ydir + (unsigned)((d * MROWS + row) * D + xcol + nt * 16 + 4 * fq)) = w; }
              { const float dc = __expf(cum[63]);
#pragma unroll
                for (int x = 0; x < 2; ++x) { hacc[x] *= dc;
#pragma unroll
                    for (int ks = 0; ks < 2; ++ks) MMA_TRN(hacc[x], xdT[ks], bT[x][ks]); } } }
            LBAR();
            { const int mt = F.wave >> 2;
#pragma unroll
              for (int x = 0; x < 2; ++x) { const int nt = (F.wave & 3) * 2 + x; v2u w; w.x = pk2(hacc[x][0], hacc[x][1]); w.y = pk2(hacc[x][2], hacc[x][3]);
                  *(LAS3 v2u*)(Hb + (mt * 16 + fr) * 136 + nt * 16 + 4 * fq) = w; } }
            if (c + 1 < 132) SS_FRONT2(cur ^ 1);
            LBAR();
        }
        __syncthreads();
    }
#undef SS_PTRS
#undef SS_LOAD
#undef SS_FRONT1
#undef SS_FRONT2
}

__device__ __forceinline__ int chunk_row0(int ck) { return ck < 256 ? ck * 64 : MLAT + (ck - 256) * 64; }
template <bool FINAL>
#define SW128(row_, col_) ((row_) * 128 + ((col_) ^ (((row_) & 7) << 2)))
__device__ __forceinline__ void phase_lru_par(const Frame& F, int L) {
    const bf16* P = (const bf16*)(F.ws + WS_P);
    const bf16* WgT = (const bf16*)(F.ws + WS_LGW);
    float* agg = (float*)(F.ws + WS_LAGG); const float* car = (const float*)(F.ws + WS_LCAR);
    bf16* Y = (bf16*)(F.ws + WS_Y3);
    const float* cw = F.a->in[I_LCW] + (size_t)L * 4 * 2048; const float* cb = F.a->in[I_LCB] + (size_t)L * 2048;
    LAS3 bf16* Xb = (LAS3 bf16*)F.lds;
    LAS3 float* Aa = (LAS3 float*)(F.lds + 17408);
    LAS3 float* Bx = Aa + 64 * 128;
    LAS3 float* Hf = Bx + 64 * 128;
    LAS3 bf16* RAW = (LAS3 bf16*)(F.lds + 115712);
    LAS3 bf16* GT = (LAS3 bf16*)(F.lds + 133936);
    LAS3 float* SGA = (LAS3 float*)(F.lds + 151344);
    LAS3 float* SGH = SGA + 512;
    v4u pw[3], pg[2];
#define LRU_FETCH(ck__) do { const int ck_ = (ck__), n_ = n, row0_ = chunk_row0(ck_); int pos_, len_; seq_pos(row0_, pos_, len_); \
        int tid_ = F.tid; asm volatile("" : "+v"(tid_)); \
        _Pragma("unroll") for (int i_ = 0; i_ < 3; ++i_) { const int idx_ = tid_ + 512 * i_, rr_ = idx_ >> 4, g_ = idx_ & 15; const int q_ = pos_ + rr_ - 2; \
            pw[i_] = (idx_ < 67 * 16 && q_ >= 0 && q_ < len_) ? *(const v4u*)(P + (size_t)(row0_ + rr_ - 2) * NP + PL + n_ * 128 + g_ * 8) : (v4u){0u, 0u, 0u, 0u}; } \
        if (FINAL) { _Pragma("unroll") for (int i_ = 0; i_ < 2; ++i_) { const int idx_ = tid_ + 512 * i_, rr_ = idx_ >> 4, g_ = idx_ & 15; \
            pg[i_] = *(const v4u*)(P + (size_t)(row0_ + rr_) * NP + PLG + n_ * 128 + g_ * 8); } } } while (0)
    const int n = F.bid & 15, ckstep = F.G >> 4;
    LAS3 float* CW = SGH + 512;
    for (int i = F.tid; i < 640; i += 512) CW[i] = i < 512 ? cw[(i >> 7) * 2048 + n * 128 + (i & 127)] : cb[n * 128 + (i & 127)];
    bf16x8 wf[2][2][4]; f32x4 gbv[2][2]; float sp8[2][4];
    { const int fr0 = F.lane & 15, fq0 = F.lane >> 4, j00 = F.wave * 16;
#pragma unroll
      for (int d = 0; d < 2; ++d) {
#pragma unroll
          for (int g = 0; g < 2; ++g) { const bf16* W = WgT + (size_t)(((d * 2 + g) * 16 + n) * 128) * 128;
#pragma unroll
              for (int ks = 0; ks < 4; ++ks) wf[d][g][ks] = ldfrag_g(W, 128, j00, ks * 32, fr0, fq0);
              gbv[d][g] = *(const f32x4*)(F.a->in[I_LGB] + (((size_t)L * 2 + d) * 2 + g) * 2048 + n * 128 + j00 + 4 * fq0); }
          const f32x4 lam = *(const f32x4*)(F.a->in[I_LLAM] + ((size_t)L * 2 + d) * 2048 + n * 128 + j00 + 4 * fq0);
#pragma unroll
          for (int i = 0; i < 4; ++i) sp8[d][i] = -8.0f * softplusf(-lam[i]); } }
    if ((F.bid >> 4) < 264) LRU_FETCH(F.bid >> 4);
    __syncthreads();
    f32x4 cwr[5][2];
    { const int c8r = (F.tid & 15) * 8;
#pragma unroll
      for (int tap = 0; tap < 5; ++tap) { cwr[tap][0] = *(const LAS3 f32x4*)(CW + tap * 128 + c8r); cwr[tap][1] = *(const LAS3 f32x4*)(CW + tap * 128 + c8r + 4); } }
    for (int ck = F.bid >> 4; ck < 264; ck += ckstep) {
        int tid = F.tid; asm volatile("" : "+v"(tid));
        const int lane = tid & 63, wave = __builtin_amdgcn_readfirstlane(tid >> 6), fr = lane & 15, fq = lane >> 4;
        const int row0 = chunk_row0(ck);
#pragma unroll
        for (int i = 0; i < 3; ++i) { const int idx = tid + 512 * i, rr = idx >> 4, g = idx & 15; if (idx < 67 * 16) *(LAS3 v4u*)(RAW + rr * 136 + g * 8) = pw[i]; }
        if (FINAL) {
#pragma unroll
            for (int i = 0; i < 2; ++i) { const int idx = tid + 512 * i, rr = idx >> 4, g = idx & 15; *(LAS3 v4u*)(GT + rr * 136 + g * 8) = pg[i]; } }
        LBAR();
        if (ck + ckstep < 264) LRU_FETCH(ck + ckstep);
#pragma unroll 1
        for (int gI = tid; gI < 1024; gI += 512) { const int t = gI >> 4, c8 = (gI & 15) * 8, col = n * 128 + c8;
            float o[8];
            { const f32x4 b0 = cwr[4][0], b1 = cwr[4][1]; o[0] = b0[0]; o[1] = b0[1]; o[2] = b0[2]; o[3] = b0[3]; o[4] = b1[0]; o[5] = b1[1]; o[6] = b1[2]; o[7] = b1[3]; }
#pragma unroll
            for (int tap = 0; tap < 4; ++tap) { const v4u x = *(const LAS3 v4u*)(RAW + (t + tap) * 136 + c8);
                const f32x4 w0 = cwr[tap][0], w1 = cwr[tap][1];
                o[0] += w0[0] * pg8::bf_lo(x.x); o[1] += w0[1] * pg8::bf_hi(x.x); o[2] += w0[2] * pg8::bf_lo(x.y); o[3] += w0[3] * pg8::bf_hi(x.y);
                o[4] += w1[0] * pg8::bf_lo(x.z); o[5] += w1[1] * pg8::bf_hi(x.z); o[6] += w1[2] * pg8::bf_lo(x.w); o[7] += w1[3] * pg8::bf_hi(x.w); }
            v4u w; w.x = pk2(o[0], o[1]); w.y = pk2(o[2], o[3]); w.z = pk2(o[4], o[5]); w.w = pk2(o[6], o[7]);
            *(LAS3 v4u*)(Xb + t * 136 + c8) = w; }
        LBAR();
        float hf[16];
#pragma unroll
        for (int d = 0; d < 2; ++d) {
            {
                const int j0 = wave * 16;
                f32x4 acc[2][4];
#pragma unroll
                for (int g = 0; g < 2; ++g)
#pragma unroll
                    for (int mt = 0; mt < 4; ++mt) acc[g][mt] = (f32x4){0.f, 0.f, 0.f, 0.f};
#pragma unroll
                for (int ks = 0; ks < 4; ++ks) {
#pragma unroll
                    for (int mt = 0; mt < 4; ++mt) { const bf16x8 a = ldfrag(Xb, 136, mt * 16, ks * 32, fr, fq); MMA_TRN(acc[0][mt], a, wf[d][0][ks]); MMA_TRN(acc[1][mt], a, wf[d][1][ks]); } }
                const f32x4 gb0 = gbv[d][0], gb1 = gbv[d][1];
#pragma unroll
                for (int mt = 0; mt < 4; ++mt) { const int t = mt * 16 + fr; f32x4 av, bv;
                    const v2u xr = *(const LAS3 v2u*)(Xb + t * 136 + j0 + 4 * fq);
                    const float xc[4] = {pg8::bf_lo(xr.x), pg8::bf_hi(xr.x), pg8::bf_lo(xr.y), pg8::bf_hi(xr.y)};
#pragma unroll
                    for (int i = 0; i < 4; ++i) {
                        const float d0 = 1.0f + __expf(-fmaxf(acc[0][mt][i] + gb0[i], -40.f)), d1 = 1.0f + __expf(-fmaxf(acc[1][mt][i] + gb1[i], -40.f)), rr = __builtin_amdgcn_rcpf(d0 * d1);
                        const float a = __expf(d1 * rr * sp8[d][i]); av[i] = a; bv[i] = __builtin_amdgcn_sqrtf(fmaxf(1.0f - a * a, 0.f)) * (d0 * rr) * xc[i]; }
                    *(LAS3 f32x4*)(Aa + SW128(t, j0 + 4 * fq)) = av; *(LAS3 f32x4*)(Bx + SW128(t, j0 + 4 * fq)) = bv; }
            }
            LBAR();
            {
                const int ch = tid & 127, sgt = tid >> 7, sg = d ? 3 - sgt : sgt, col = n * 128 + ch;
                float h = 0.f, ap = 1.f; float aq[16], bq[16];
#pragma unroll
                for (int s2 = 0; s2 < 16; ++s2) { const int s = sg * 16 + s2, t = d ? 63 - s : s; aq[s2] = Aa[SW128(t, ch)]; bq[s2] = Bx[SW128(t, ch)]; }
#pragma unroll
                for (int s2 = 0; s2 < 16; ++s2) { h = aq[s2] * h + bq[s2]; ap *= aq[s2]; }
                SGA[sg * 128 + ch] = ap; SGH[sg * 128 + ch] = h;
                LBAR();
                if (!FINAL) {
                    if (sg == 0) { float hh = 0.f, aa = 1.f;
#pragma unroll
                        for (int q = 0; q < 4; ++q) { const float a = SGA[q * 128 + ch]; hh = a * hh + SGH[q * 128 + ch]; aa *= a; }
                        float2 o; o.x = aa; o.y = hh; *(float2*)(agg + (((size_t)d * 264 + ck) * 2048 + col) * 2) = o; } }
                else { float hh = car[((size_t)d * 264 + ck) * 2048 + col];
#pragma unroll
                    for (int q = 0; q < 3; ++q) if (q < sg) hh = SGA[q * 128 + ch] * hh + SGH[q * 128 + ch];
#pragma unroll
                    for (int s2 = 0; s2 < 16; ++s2) { const int s = sg * 16 + s2, t = d ? 63 - s : s; hh = aq[s2] * hh + bq[s2];
                        if (d == 0) hf[s2] = hh;
                        else { const float gx = bf2f(GT[t * 136 + ch]); const float u = 0.7978845608028654f * (gx + 0.044715f * gx * gx * gx);
                            Y[(size_t)(row0 + t) * D + col] = f2bf((hf[15 - s2] + hh) * 0.5f * gx * (1.0f + tanh_fast(u))); } } }
            }
            LBAR();
        }
    }
#undef LRU_FETCH
}
__device__ __forceinline__ void phase_lru_carry(const Frame& F) {
    const float* agg = (const float*)(F.ws + WS_LAGG); float* car = (float*)(F.ws + WS_LCAR);
    for (int gid = ((F.bid + F.G - (16 % F.G)) % F.G) * 512 + F.tid; gid < 8192; gid += F.G * 512) { const int d = gid >> 12, b = (gid >> 11) & 1, col = gid & 2047; float h = 0.f;
        { float2 a[4]; size_t o[4];
#pragma unroll
          for (int i = 0; i < 4; ++i) { o[i] = ((size_t)d * 264 + 256 + b * 4 + (d ? 3 - i : i)) * 2048 + col; a[i] = *(const float2*)(agg + o[i] * 2); }
#pragma unroll
          for (int i = 0; i < 4; ++i) { car[o[i]] = h; h = a[i].x * h + a[i].y; } }
        const long st = d ? -2048 : 2048; long o0 = (long)(((size_t)d * 264 + b * 128 + (d ? 127 : 0)) * 2048 + col);
#pragma unroll 1
        for (int i0 = 0; i0 < 128; i0 += 32) { float2 a[32];
#pragma unroll
            for (int j = 0; j < 32; ++j) a[j] = *(const float2*)(agg + (o0 + j * st) * 2);
#pragma unroll
            for (int j = 0; j < 32; ++j) { car[o0 + j * st] = h; h = a[j].x * h + a[j].y; }
            o0 += 32 * st; } }
}

__device__ __forceinline__ void phase_route(const Frame& F) {
    int* rt = (int*)(F.ws + WS_ROUTE); unsigned* ctl = (unsigned*)(F.ws + WS_CTL);
    const bf16* V = (const bf16*)(F.ws + WS_U); bf16* A = (bf16*)(F.ws + WS_MA);
    int base[9]; base[0] = 0;
#pragma unroll
    for (int e = 0; e < 8; ++e) { const int c = (int)__hip_atomic_load(&ctl[CW_CNT + e], __ATOMIC_RELAXED, __HIP_MEMORY_SCOPE_AGENT); base[e + 1] = base[e] + ((c + 255) & ~255); }
    if (F.bid == 0 && F.tid == 0) { rt[RT_NT] = base[8] >> 8; for (int e = 0; e < 8; ++e) { rt[RT_BASE + e] = base[e]; for (int t = base[e] >> 8; t < (base[e + 1] >> 8); ++t) rt[RT_TILEE + t] = e; } }
    for (int tok = F.bid * 8 + F.wave; tok < MLAT; tok += F.G * 8) {
        int r0 = 0, r1 = 0;
        if (F.lane == 0) { const int e0 = rt[RT_TOKE + tok * 2], e1 = rt[RT_TOKE + tok * 2 + 1];
            int b0 = 0, b1 = 0;
#pragma unroll
            for (int e = 0; e < 8; ++e) { if (e == e0) b0 = base[e]; if (e == e1) b1 = base[e]; }
            r0 = b0 + (int)atomicAdd(&ctl[CW_CUR + e0], 1u); r1 = b1 + (int)atomicAdd(&ctl[CW_CUR + e1], 1u);
            rt[RT_TOKROW + tok * 2] = r0; rt[RT_TOKROW + tok * 2 + 1] = r1; }
        r0 = __shfl(r0, 0); r1 = __shfl(r1, 0);
#pragma unroll
        for (int i = 0; i < 4; ++i) { const v4u v = *(const v4u*)(V + (size_t)tok * D + i * 512 + F.lane * 8);
            *(v4u*)(A + (size_t)r0 * D + i * 512 + F.lane * 8) = v; *(v4u*)(A + (size_t)r1 * D + i * 512 + F.lane * 8) = v; }
    }
    for (int e = 0; e < 8; ++e) { const int c = (int)__hip_atomic_load(&ctl[CW_CNT + e], __ATOMIC_RELAXED, __HIP_MEMORY_SCOPE_AGENT); const int lo = base[e] + c, hi = base[e + 1];
        for (int row = lo + F.bid * 8 + F.wave; row < hi; row += F.G * 8)
#pragma unroll
            for (int i = 0; i < 4; ++i) *(v4u*)(A + (size_t)row * D + i * 512 + F.lane * 8) = (v4u){0u, 0u, 0u, 0u}; }
}
__device__ __forceinline__ void phase_final(const Frame& F, const float* modL) {
    const int* rt = (const int*)(F.ws + WS_ROUTE);
    const float* hlat = (const float*)(F.ws + WS_HLAT); const bf16* O = (const bf16*)(F.ws + WS_X1);
    const float* nf = F.a->in[I_NFIN]; float* out = F.a->out;
    for (int tok = F.bid * 8 + F.wave; tok < MLAT; tok += F.G * 8) {
        const int b = tok >> 13; const float* gf = modL + b * 12288 + 5 * 2048;
        const int r0 = rt[RT_TOKROW + tok * 2], r1 = rt[RT_TOKROW + tok * 2 + 1]; const float p0 = ((const float*)rt)[RT_TOKP + tok * 2], p1 = ((const float*)rt)[RT_TOKP + tok * 2 + 1];
        f32x4 x[8]; float ss = 0.f;
#pragma unroll
        for (int i = 0; i < 8; ++i) { const int c = i * 256 + F.lane * 4;
            const f32x4 h = *(const f32x4*)(hlat + (size_t)tok * D + c), g = *(const f32x4*)(gf + c);
            const uint2 a = *(const uint2*)(O + (size_t)r0 * D + c), bb = *(const uint2*)(O + (size_t)r1 * D + c);
            f32x4 m; m[0] = p0 * pg8::bf_lo(a.x) + p1 * pg8::bf_lo(bb.x); m[1] = p0 * pg8::bf_hi(a.x) + p1 * pg8::bf_hi(bb.x); m[2] = p0 * pg8::bf_lo(a.y) + p1 * pg8::bf_lo(bb.y); m[3] = p0 * pg8::bf_hi(a.y) + p1 * pg8::bf_hi(bb.y);
            x[i] = h + g * m; ss += x[i][0] * x[i][0] + x[i][1] * x[i][1] + x[i][2] * x[i][2] + x[i][3] * x[i][3]; }
        ss = wave_sum(ss);
        const float rs = rsqrtf(ss * (1.0f / D) + EPS);
#pragma unroll
        for (int i = 0; i < 8; ++i) { const int c = i * 256 + F.lane * 4; const f32x4 g = *(const f32x4*)(nf + c); *(f32x4*)(out + (size_t)tok * D + c) = x[i] * rs * g; }
    }
}

constexpr int NPH_LAYER = 17, NPH = 1 + 2 * NPH_LAYER;
#if !MK_PER_PHASE
#define SEAM() xcd_barrier(bar)
#else
#define SEAM() do {} while (0)
#endif
#define IN(k) (lo <= (PB + (k)) && (PB + (k)) < hi)
template <int L>
__device__ __forceinline__ void layer_program(const Frame& F, const Args& args, const XcdBarrier& bar, const int lo, const int hi) {
    constexpr int PB = 1 + L * NPH_LAYER;
    const float* modL = (const float*)(F.ws + WS_MOD) + (size_t)L * 3 * 12288;
    if (IN(0)) { unsigned char* wsl = F.ws; asm volatile("" : "+s"(wsl)); if (L == 0) { phase_mod(F); __syncthreads(); phase_convw_layer(F, L, F.G, F.bid); phase_lora_prep(F, L, F.G, F.bid); SEAM(); } }
    if (IN(1)) { unsigned char* wsl = F.ws; asm volatile("" : "+s"(wsl)); phase_norm<false>(F, L == 0 ? args.in[I_X] : (const float*)(wsl + WS_HLAT), L == 0 ? args.in[I_CTX] : (const float*)(wsl + WS_HCTX), args.in[I_NMIX] + L * 2048, modL, 0, 2048, (bf16*)(wsl + WS_U), L & 1, MROWS); SEAM(); }
    if (IN(2)) { unsigned char* wsl = F.ws; asm volatile("" : "+s"(wsl)); pg8::Gemm g{(const bf16*)(wsl + WS_U), (const bf16*)(wsl + WS_X1), MROWS, NP, 2048}; pg8::StaticOrder S; S.init(MROWS, NP, F.G, F.bid); pg8::EpiStoreBf16 E{(bf16*)(wsl + WS_P), NP, 0};
        pg8::gemm_phase<pg8::EpiStoreBf16, pg8::StaticOrder, false>(F.lds, g, S, E, nullptr); SEAM(); }
    if (IN(3)) { unsigned char* wsl = F.ws; asm volatile("" : "+s"(wsl)); phase_lora_in(F, L); SEAM();
#pragma unroll 1
        for (int gq = 0; gq < 4; ++gq) { phase_rwkv_r1(F, L, gq); SEAM(); phase_rwkv_r2(F, gq); SEAM(); } }
    if (IN(4)) { unsigned char* wsl = F.ws; asm volatile("" : "+s"(wsl)); phase_rwkv_pre(F, L); __syncthreads(); phase_ssm_conv(F, L); __syncthreads(); phase_lru_par<false>(F, L); SEAM(); }
    if (IN(5)) { unsigned char* wsl = F.ws; asm volatile("" : "+s"(wsl));
        pg8::Gemm g{(const bf16*)(wsl + WS_SG), (const bf16*)(wsl + WS_GUP), MROWS, 2048, 256}; pg8::StaticOrder S; S.init(MROWS, 2048, F.G, F.bid);
        pg8::EpiGateMul E{(const bf16*)(wsl + WS_Y3) + (size_t)MROWS * D, (bf16*)(wsl + WS_Y3) + (size_t)MROWS * D};
        pg8::gemm_phase<pg8::EpiGateMul, pg8::StaticOrder, false>(F.lds, g, S, E, nullptr); __syncthreads(); }
    if (IN(5)) { unsigned char* wsl = F.ws; asm volatile("" : "+s"(wsl)); phase_lru_carry(F); phase_ssm_chain(F, L); SEAM(); }
    if (IN(7)) { unsigned char* wsl = F.ws; asm volatile("" : "+s"(wsl)); phase_ssm_out(F, L); __syncthreads(); phase_lru_par<true>(F, L); SEAM(); }
    constexpr int nM = L == 1 ? 64 : 66;
    if (IN(9)) { unsigned char* wsl = F.ws; asm volatile("" : "+s"(wsl)); pg8::Gemm g{(const bf16*)(wsl + WS_Y3), (const bf16*)(wsl + WS_WOUT), MROWS, 2048, 2048}; pg8::MergeOrder S{nM * 8, F.G, F.bid}; pg8::EpiMerge E{(const bf16*)(wsl + WS_P), NP, (bf16*)(wsl + WS_X1)};
        pg8::gemm_phase<pg8::EpiMerge, pg8::MergeOrder, false>(F.lds, g, S, E, nullptr);
        if (L == 0 && F.G == 256) { __syncthreads(); const int c = F.bid;
            if (!((c & 7) == 0 && c < 128)) { const int below = (c + 7) >> 3; phase_convw_ffn(F, 1, 240, c - (below < 16 ? below : 16), 2); } }
        SEAM(); }
    if (IN(10)) { unsigned char* wsl = F.ws; asm volatile("" : "+s"(wsl)); pg8::Gemm g{(const bf16*)(wsl + WS_X1), (const bf16*)(wsl + WS_WOUT) + (size_t)3 * 2048 * 2048, nM * 256, 2048, 2048}; pg8::StaticOrder S; S.init(nM * 256, 2048, F.G, F.bid);
        pg8::EpiResid E{L == 0 ? args.in[I_X] : (const float*)(wsl + WS_HLAT), L == 0 ? args.in[I_CTX] : (const float*)(wsl + WS_HCTX), (float*)(wsl + WS_HLAT), (float*)(wsl + WS_HCTX), modL + 2 * 2048, L & 1};
        pg8::gemm_phase<pg8::EpiResid, pg8::StaticOrder, false>(F.lds, g, S, E, nullptr);
        if (L == 0) { __syncthreads(); if (F.G > 32) { if (F.bid >= 16) phase_convw_ffn(F, L, F.G - 16, F.bid - 16); } else phase_convw_ffn(F, L, F.G, F.bid); }
        SEAM(); }
    if (IN(11)) { unsigned char* wsl = F.ws; asm volatile("" : "+s"(wsl)); phase_norm<L == 1>(F, (const float*)(wsl + WS_HLAT), (const float*)(wsl + WS_HCTX), args.in[I_NFFN] + L * 2048, modL, 3 * 2048, 4 * 2048, (bf16*)(wsl + WS_U), 0, L == 0 ? MROWS : MLAT); SEAM(); }
    if (IN(12)) { unsigned char* wsl = F.ws; asm volatile("" : "+s"(wsl)); if (L == 1) { phase_convw_ffn(F, L, F.G, F.bid, F.G == 256 ? 1 : 3); __syncthreads(); } }
    if constexpr (L == 0) {
        if (IN(13)) { unsigned char* wsl = F.ws; asm volatile("" : "+s"(wsl)); pg8::Gemm g{(const bf16*)(wsl + WS_U), (const bf16*)(wsl + WS_F13), MROWS, 12288, 2048}; pg8::StaticOrder S; S.init(MROWS, 12288, F.G, F.bid); pg8::EpiSwiGLU E{(bf16*)(wsl + WS_FH), 6144, 0};
            pg8::gemm_phase<pg8::EpiSwiGLU, pg8::StaticOrder, false>(F.lds, g, S, E, nullptr); SEAM(); }
        if (IN(14)) { unsigned char* wsl = F.ws; asm volatile("" : "+s"(wsl)); pg8::Gemm g{(const bf16*)(wsl + WS_FH), (const bf16*)(wsl + WS_F2), MROWS, 2048, 6144}; pg8::StaticOrder S; S.init(MROWS, 2048, F.G, F.bid);
            pg8::EpiResid E{(const float*)(wsl + WS_HLAT), (const float*)(wsl + WS_HCTX), (float*)(wsl + WS_HLAT), (float*)(wsl + WS_HCTX), modL + 5 * 2048, 0};
            pg8::gemm_phase<pg8::EpiResid, pg8::StaticOrder, false>(F.lds, g, S, E, nullptr);
            __syncthreads(); if (F.G > 32) { if (F.bid >= 16) { phase_convw_layer(F, 1, F.G - 16, F.bid - 16); phase_lora_prep(F, 1, F.G - 16, F.bid - 16); } } else { phase_convw_layer(F, 1, F.G, F.bid); phase_lora_prep(F, 1, F.G, F.bid); }
            SEAM(); }
    } else {
        const int* rt = (const int*)(F.ws + WS_ROUTE);
        if (IN(13)) { unsigned char* wsl = F.ws; asm volatile("" : "+s"(wsl)); phase_route(F); SEAM(); }
        if (IN(14)) { unsigned char* wsl = F.ws; asm volatile("" : "+s"(wsl)); pg8::Gemm g{(const bf16*)(wsl + WS_MA), (const bf16*)(wsl + WS_M13), MOE_ROWS, 8 * 6144, 2048}; pg8::MoeOrder S{rt + RT_TILEE, rt + RT_NT, 24, F.G, F.bid, 0};
            pg8::EpiSwiGLU E{(bf16*)(wsl + WS_MH), 3072, 24};
            pg8::gemm_phase<pg8::EpiSwiGLU, pg8::MoeOrder, false>(F.lds, g, S, E, nullptr); SEAM(); }
        if (IN(15)) { unsigned char* wsl = F.ws; asm volatile("" : "+s"(wsl)); pg8::Gemm g{(const bf16*)(wsl + WS_MH), (const bf16*)(wsl + WS_M2), MOE_ROWS, 8 * 2048, 3072}; pg8::MoeOrder S{rt + RT_TILEE, rt + RT_NT, 8, F.G, F.bid, (F.G & 7) == 0};
            pg8::EpiStoreBf16 E{(bf16*)(wsl + WS_X1), 2048, 8};
            pg8::gemm_phase<pg8::EpiStoreBf16, pg8::MoeOrder, false>(F.lds, g, S, E, nullptr); SEAM(); }
        if (IN(16)) { unsigned char* wsl = F.ws; asm volatile("" : "+s"(wsl)); phase_final(F, modL); }
    }
}
#undef IN
__global__ void __launch_bounds__(512, 2) fwd(Args args) {
    extern __shared__ __attribute__((aligned(16))) unsigned char lds_raw[];
    Frame F; F.a = &args; F.ws = args.ws; F.lds = (LAS3 unsigned char*)lds_raw;
    F.tid = threadIdx.x; F.lane = F.tid & 63; F.wave = __builtin_amdgcn_readfirstlane(F.tid >> 6); F.G = gridDim.x; F.bid = blockIdx.x;
    volatile LAS3 unsigned* MISC = (volatile LAS3 unsigned*)(F.lds + MISC_OFF);
    if (F.tid < 32) MISC[F.tid] = 0u;
    __syncthreads();
    unsigned* ctl = (unsigned*)(F.ws + WS_CTL);
#if !MK_PER_PHASE
    XcdBarrier bar = xcd_barrier_post(ctl + CW_BAR, MISC + 8);
#else
    XcdBarrier bar; bar.bar = ctl + CW_BAR; bar.x = 0; bar.st = MISC + 8;
#endif
    const int lo = args.lo, hi = args.hi;
    layer_program<0>(F, args, bar, lo, hi);
    layer_program<1>(F, args, bar, lo, hi);
}

extern "C" void kernel_launch(void* const* d_in, const int* in_sizes, int n_in, void* d_out, int out_size, void* d_ws, size_t ws_size, hipStream_t stream) {
    static int grid = 0;
    if (grid == 0) {
        if (n_in != N_INPUTS || out_size != MLAT * D || ws_size < WS_END) { fprintf(stderr, "kernel_launch: unexpected shapes (n_in %d, out %d, ws %zu); nothing launched\n", n_in, out_size, ws_size); grid = -1; return; }
        int dev = 0, cus = 0;
        if (hipGetDevice(&dev) != hipSuccess || hipDeviceGetAttribute(&cus, hipDeviceAttributeMultiprocessorCount, dev) != hipSuccess) { grid = -1; return; }
        if (hipFuncSetAttribute((const void*)fwd, hipFuncAttributeMaxDynamicSharedMemorySize, LDS_BYTES) != hipSuccess) { fprintf(stderr, "kernel_launch: hipFuncSetAttribute failed\n"); grid = -1; return; }
        int per_cu = 0;
        if (hipOccupancyMaxActiveBlocksPerMultiprocessor(&per_cu, (const void*)fwd, 512, LDS_BYTES) != hipSuccess || per_cu < 1) { fprintf(stderr, "kernel_launch: occupancy query says %d\n", per_cu); }
        (void)hipGetLastError();
        grid = cus;
    }
    if (grid < 0) return;
    (void)hipMemsetAsync((char*)d_ws + WS_CTL, 0, CTL_BYTES, stream);
    Args a{};
    for (int i = 0; i < N_INPUTS; ++i) a.in[i] = (const float*)d_in[i];
    a.out = (float*)d_out; a.ws = (unsigned char*)d_ws;
#if MK_PER_PHASE
    for (int p = 0; p < NPH; ++p) { a.lo = p; a.hi = p + 1; hipLaunchKernelGGL(fwd, dim3(grid), dim3(512), LDS_BYTES, stream, a); }
#else
    a.lo = 0; a.hi = NPH; hipLaunchKernelGGL(fwd, dim3(grid), dim3(512), LDS_BYTES, stream, a);
#endif
}
```
